# Optimizing an MI355X kernel written in HIP

```python
import jax, jax.numpy as jnp
from jax import lax
import numpy as np

D_MODEL = 1024
BATCH = 8
SEQ = 8192
DEPTH = 4

N_EVEN = (DEPTH + 1) // 2
N_ODD = DEPTH // 2
EPS = 1e-5
CONV_DIM = D_MODEL // 2
CONV_GROUPS = 8
CONV_WIDTH = 3
GMLP_DIM = D_MODEL // 2
GMLP_HEADS = 4
GMLP_HEAD_DIM = GMLP_DIM // GMLP_HEADS
CHUNK = 128
MIX_IN = 3 * CONV_DIM + 2 * GMLP_DIM
HEAD_DIM = 64
N_Q_HEADS = D_MODEL // HEAD_DIM
N_KV_HEADS = max(1, N_Q_HEADS // 8)
Q_PER_KV = N_Q_HEADS // N_KV_HEADS
WINDOW = 128
ROPE_DIM = HEAD_DIM // 4
ROPE_THETA = 500000.0
ATTN_SCALE = HEAD_DIM ** -0.5
QKV_DIM = (N_Q_HEADS + 2 * N_KV_HEADS) * HEAD_DIM
MAX_POS_OFFSET = 4096
FFN_DIM = ((8 * D_MODEL // 3 + 255) // 256) * 256
N_EXPERTS = 8
TOP_K = 2
EXPERT_DIM = 7 * D_MODEL // 2
MOE_BLOCK = 256

kernel_name = "hybrid_conv_gmlp_swa_moe_trunk"


def rms_norm(x, g):
    xf = x.astype(jnp.float32)
    y = xf * lax.rsqrt(jnp.mean(xf * xf, axis=-1, keepdims=True) + EPS)
    return (y * g.astype(jnp.float32)).astype(x.dtype)


def layer_norm(x, g, b):
    xf = x.astype(jnp.float32)
    mu = jnp.mean(xf, axis=-1, keepdims=True)
    var = jnp.mean(jnp.square(xf - mu), axis=-1, keepdims=True)
    y = (xf - mu) * lax.rsqrt(var + EPS)
    return (y * g.astype(jnp.float32) + b.astype(jnp.float32)).astype(x.dtype)


def swiglu(x, wg, wu, wd):
    return (jax.nn.silu(x @ wg) * (x @ wu)) @ wd


def causal_depthwise_conv(h, w):
    K = w.shape[-1]
    S = h.shape[1]
    hp = jnp.pad(h, ((0, 0), (K - 1, 0), (0, 0)))
    out = hp[:, 0:S, :] * w[:, 0]
    for k in range(1, K):
        out = out + hp[:, k:k + S, :] * w[:, k]
    return out


def gmlp_spatial_gate(u, v, ln_g, ln_b, w_s, b_s):
    B, S, _ = v.shape
    nc = S // CHUNK
    vn = layer_norm(v, ln_g, ln_b).reshape(B, nc, CHUNK, GMLP_HEADS, GMLP_HEAD_DIM)
    causal = jnp.tril(jnp.ones((CHUNK, CHUNK), dtype=bool))
    w = jnp.where(causal[None], w_s, jnp.zeros_like(w_s)).astype(v.dtype)
    mixed = jnp.einsum('hij,bcjhd->bcihd', w, vn) + b_s.T.astype(v.dtype)[None, None, :, :, None]
    return u * mixed.reshape(B, S, GMLP_DIM)


def conv_gmlp_mixer(xn, w_in, conv_w, ln_g, ln_b, w_s, b_s, w_out):
    z = xn @ w_in
    a_b, a_c, a_x, b_u, b_v = jnp.split(
        z, [CONV_DIM, 2 * CONV_DIM, 3 * CONV_DIM, 3 * CONV_DIM + GMLP_DIM], axis=-1)
    y_a = a_b * causal_depthwise_conv(a_c * a_x, conv_w)
    y_b = gmlp_spatial_gate(jax.nn.gelu(b_u, approximate=False), jax.nn.gelu(b_v, approximate=False),
                            ln_g, ln_b, w_s, b_s)
    return jnp.concatenate([y_a, y_b], axis=-1) @ w_out


def partial_rope(t, cos, sin):
    half = ROPE_DIM // 2
    tr = t[..., :ROPE_DIM].astype(jnp.float32)
    t1, t2 = tr[..., :half], tr[..., half:]
    rot = jnp.concatenate([t1 * cos - t2 * sin, t2 * cos + t1 * sin], axis=-1).astype(t.dtype)
    return jnp.concatenate([rot, t[..., ROPE_DIM:]], axis=-1)


def swa_sink_attention(xn, positions, w_qkv, b_qkv, sinks, w_o, b_o):
    B, S, _ = xn.shape
    nb = S // WINDOW
    qkv = xn @ w_qkv + b_qkv
    q, k, v = jnp.split(qkv, [N_Q_HEADS * HEAD_DIM, (N_Q_HEADS + N_KV_HEADS) * HEAD_DIM], axis=-1)
    q = q.reshape(B, S, N_Q_HEADS, HEAD_DIM)
    k = k.reshape(B, S, N_KV_HEADS, HEAD_DIM)
    v = v.reshape(B, S, N_KV_HEADS, HEAD_DIM)
    inv_freq = ROPE_THETA ** (-jnp.arange(0, ROPE_DIM, 2, dtype=jnp.float32) / ROPE_DIM)
    ang = positions.astype(jnp.float32)[..., None] * inv_freq
    cos = jnp.cos(ang)[:, :, None, :]
    sin = jnp.sin(ang)[:, :, None, :]
    q = partial_rope(q, cos, sin)
    k = partial_rope(k, cos, sin)
    qb = q.reshape(B, nb, WINDOW, N_KV_HEADS, Q_PER_KV, HEAD_DIM)

    def band(t):
        tb = t.reshape(B, nb, WINDOW, N_KV_HEADS, HEAD_DIM)
        prev = jnp.pad(tb, ((0, 0), (1, 0), (0, 0), (0, 0), (0, 0)))[:, :-1]
        return jnp.concatenate([prev, tb], axis=2)

    kb, vb = band(k), band(v)
    s = jnp.einsum('bnqhgd,bnshd->bnhgqs', qb, kb, preferred_element_type=jnp.float32) * ATTN_SCALE
    qi = jnp.arange(WINDOW)[:, None]
    sj = jnp.arange(2 * WINDOW)[None, :]
    rel = qi + WINDOW - sj
    local = (rel >= 0) & (rel < WINDOW)
    valid = (jnp.arange(nb)[:, None] * WINDOW - WINDOW + sj) >= 0
    mask = local[None] & valid[:, None, :]
    s = jnp.where(mask[None, :, None, None], s, -jnp.inf)
    sink = sinks.astype(jnp.float32).reshape(N_KV_HEADS, Q_PER_KV)[None, None, :, :, None]
    m = jnp.maximum(jnp.max(s, axis=-1), sink)
    p = jnp.exp(s - m[..., None])
    denom = jnp.sum(p, axis=-1) + jnp.exp(sink - m)
    probs = (p / denom[..., None]).astype(vb.dtype)
    o = jnp.einsum('bnhgqs,bnshd->bnqhgd', probs, vb).reshape(B, S, N_Q_HEADS * HEAD_DIM)
    return o @ w_o + b_o


def moe_swiglu(xn, router_w, wg, wu, wd):
    B, S, D = xn.shape
    N = B * S
    NP = N * TOP_K
    xf = xn.reshape(N, D)
    logits = jnp.dot(xf, router_w, preferred_element_type=jnp.float32)
    top_vals, top_idx = lax.top_k(logits, TOP_K)
    gates = jax.nn.softmax(top_vals, axis=-1)
    expert_ids = top_idx.reshape(NP).astype(jnp.int32)
    token_ids = jnp.repeat(jnp.arange(N, dtype=jnp.int32), TOP_K)
    pair_gates = gates.reshape(NP)
    order = jnp.argsort(expert_ids)
    sorted_e = expert_ids[order]
    sizes = jnp.bincount(expert_ids, length=N_EXPERTS).astype(jnp.int32)
    padded = ((sizes + MOE_BLOCK - 1) // MOE_BLOCK) * MOE_BLOCK
    starts = jnp.cumsum(sizes) - sizes
    pends = jnp.cumsum(padded)
    pstarts = pends - padded
    dest = pstarts[sorted_e] + jnp.arange(NP, dtype=jnp.int32) - starts[sorted_e]
    n_rows = (-(-NP // MOE_BLOCK)) * MOE_BLOCK + N_EXPERTS * MOE_BLOCK
    n_blocks = n_rows // MOE_BLOCK
    row_token = jnp.zeros((n_rows,), jnp.int32).at[dest].set(token_ids[order])
    row_gate = jnp.zeros((n_rows,), jnp.float32).at[dest].set(pair_gates[order])
    block_start = jnp.arange(n_blocks, dtype=jnp.int32) * MOE_BLOCK
    block_expert = jnp.minimum(jnp.searchsorted(pends, block_start, side='right'), N_EXPERTS - 1)
    x_rows = xf[row_token].reshape(n_blocks, MOE_BLOCK, D)

    def expert_block(args):
        xb, e = args
        return (jax.nn.silu(xb @ wg[e]) * (xb @ wu[e])) @ wd[e]

    y_rows = lax.map(expert_block, (x_rows, block_expert)).reshape(n_rows, D)
    y = jnp.zeros((N, D), xn.dtype).at[row_token].add(y_rows * row_gate[:, None].astype(xn.dtype))
    return y.reshape(B, S, D)


def setup_inputs(seed: int = 0) -> dict:
    key = jax.random.key(seed)
    ks = iter(jax.random.split(key, 32))

    def nrm(shape, scale):
        return jax.random.normal(next(ks), shape, jnp.float32) * scale

    def gain(shape):
        return 1.0 + nrm(shape, 0.05)

    NE, NO, D = N_EVEN, N_ODD, D_MODEL
    x = nrm((BATCH, SEQ, D), 1.0)
    positions = (jax.random.randint(next(ks), (BATCH, 1), 0, MAX_POS_OFFSET, dtype=jnp.int32)
                 + jnp.arange(SEQ, dtype=jnp.int32)[None, :])
    return {
        "x": x,
        "positions": positions,
        "final_norm_g": gain((D,)),
        "ev_norm1_g": gain((NE, D)),
        "ev_w_in": nrm((NE, D, MIX_IN), D ** -0.5),
        "ev_conv_w": nrm((NE, CONV_DIM, CONV_WIDTH), CONV_WIDTH ** -0.5),
        "ev_ln_g": gain((NE, GMLP_DIM)),
        "ev_ln_b": nrm((NE, GMLP_DIM), 0.02),
        "ev_spatial_w": nrm((NE, GMLP_HEADS, CHUNK, CHUNK), CHUNK ** -0.5),
        "ev_spatial_b": 1.0 + nrm((NE, GMLP_HEADS, CHUNK), 0.1),
        "ev_w_out": nrm((NE, CONV_DIM + GMLP_DIM, D), (CONV_DIM + GMLP_DIM) ** -0.5),
        "ev_norm2_g": gain((NE, D)),
        "ev_ffn_wg": nrm((NE, D, FFN_DIM), D ** -0.5),
        "ev_ffn_wu": nrm((NE, D, FFN_DIM), D ** -0.5),
        "ev_ffn_wd": nrm((NE, FFN_DIM, D), FFN_DIM ** -0.5),
        "od_norm1_g": gain((NO, D)),
        "od_w_qkv": nrm((NO, D, QKV_DIM), D ** -0.5),
        "od_b_qkv": nrm((NO, QKV_DIM), 0.02),
        "od_sinks": nrm((NO, N_Q_HEADS), 1.0),
        "od_w_o": nrm((NO, N_Q_HEADS * HEAD_DIM, D), (N_Q_HEADS * HEAD_DIM) ** -0.5),
        "od_b_o": nrm((NO, D), 0.02),
        "od_norm2_g": gain((NO, D)),
        "od_router_w": nrm((NO, D, N_EXPERTS), D ** -0.5),
        "od_exp_wg": nrm((NO, N_EXPERTS, D, EXPERT_DIM), D ** -0.5),
        "od_exp_wu": nrm((NO, N_EXPERTS, D, EXPERT_DIM), D ** -0.5),
        "od_exp_wd": nrm((NO, N_EXPERTS, EXPERT_DIM, D), EXPERT_DIM ** -0.5),
    }


def reference(x, positions, final_norm_g,
              ev_norm1_g, ev_w_in, ev_conv_w, ev_ln_g, ev_ln_b, ev_spatial_w, ev_spatial_b,
              ev_w_out, ev_norm2_g, ev_ffn_wg, ev_ffn_wu, ev_ffn_wd,
              od_norm1_g, od_w_qkv, od_b_qkv, od_sinks, od_w_o, od_b_o, od_norm2_g,
              od_router_w, od_exp_wg, od_exp_wu, od_exp_wd):
    h = x
    for layer in range(DEPTH):
        i = layer // 2
        if layer % 2 == 0:
            h = h + conv_gmlp_mixer(rms_norm(h, ev_norm1_g[i]), ev_w_in[i], ev_conv_w[i],
                                    ev_ln_g[i], ev_ln_b[i], ev_spatial_w[i], ev_spatial_b[i],
                                    ev_w_out[i])
            h = h + swiglu(rms_norm(h, ev_norm2_g[i]), ev_ffn_wg[i], ev_ffn_wu[i], ev_ffn_wd[i])
        else:
            h = h + swa_sink_attention(rms_norm(h, od_norm1_g[i]), positions, od_w_qkv[i],
                                       od_b_qkv[i], od_sinks[i], od_w_o[i], od_b_o[i])
            h = h + moe_swiglu(rms_norm(h, od_norm2_g[i]), od_router_w[i], od_exp_wg[i],
                               od_exp_wu[i], od_exp_wd[i])
    return rms_norm(h, final_norm_g)
```

```cpp
#include <hip/hip_runtime.h>
#include <cstdio>
#include <cstdint>
#ifndef MK_ONE_LAUNCH
#define MK_ONE_LAUNCH 0
#endif
namespace pg8 {
#define PG8_LAS __attribute__((address_space(3)))
typedef unsigned short bf16_t;
typedef short bf16x8 __attribute__((ext_vector_type(8)));
typedef float f32x4 __attribute__((ext_vector_type(4)));
typedef unsigned u32x4 __attribute__((ext_vector_type(4)));
constexpr int BM = 256, BK = 64, HALF = 128, HTB = HALF * BK * 2  , STAGE_BYTES = 8 * HTB, NXCD = 8, WGM = 8;

__host__ __device__ __forceinline__ int lds_byte(int r, int c) { const int st = (r >> 4) * 2 + (c >> 5), rr = r & 15, cc = c & 31, ob = rr * 64 + cc * 2; return st * 1024 + (ob ^ (((ob >> 9) & 1) << 5)); }
__host__ __device__ __forceinline__ void stage_rc(int b, int& R, int& C) { const int st = b / 1024, sb = b % 1024, swz = sb ^ (((sb >> 9) & 1) << 5); R = (st >> 1) * 16 + swz / 64; C = (st & 1) * 32 + (swz % 64) / 2; }
__host__ __device__ __forceinline__ int perm32(int rho) { const int n = rho >> 4, i = rho & 15; return 8 * (i >> 2) + 4 * n + (i & 3); }

struct Unit { int pm, pn, e; };
struct Gemm { const bf16_t* A; const bf16_t* Bt; int K; size_t estride; };

struct StaticOrder {
    int nM, nN, nwg, G, c;
    __host__ __device__ void init(int M, int N, int G_, int c_) { nM = M / BM; nN = N / BM; nwg = nM * nN; G = G_; c = c_; }
    __host__ __device__ bool next(int i, Unit& u) const {
        const long L = (long)i * G + c; if (L >= nwg) return false;
        int wgid = (int)L; { const int q = nwg / NXCD, r = nwg % NXCD, xcd = wgid % NXCD, off = wgid / NXCD; wgid = (xcd < r ? xcd * (q + 1) : r * (q + 1) + (xcd - r) * q) + off; }
        const int nig = WGM * nN, gid = wgid / nig, fm = gid * WGM, gsz = (nM - fm) < WGM ? (nM - fm) : WGM;
        u.pm = fm + ((wgid % nig) % gsz); u.pn = (wgid % nig) / gsz; u.e = 0; return true;
    }
};
struct MoeOrder {
    int nM, nN, nwg, G, c; int p0, p1, p2, p3, p4, p5, p6;
    __device__ bool next(int i, Unit& u) const {
        const long L = (long)i * G + c; if (L >= nwg) return false;
        int wgid = (int)L; { const int q = nwg / NXCD, r = nwg % NXCD, xcd = wgid % NXCD, off = wgid / NXCD; wgid = (xcd < r ? xcd * (q + 1) : r * (q + 1) + (xcd - r) * q) + off; }
        const int nig = WGM * nN, gid = wgid / nig, fm = gid * WGM, gsz = (nM - fm) < WGM ? (nM - fm) : WGM;
        u.pm = fm + ((wgid % nig) % gsz); u.pn = (wgid % nig) / gsz;
        u.e = (u.pm >= p0) + (u.pm >= p1) + (u.pm >= p2) + (u.pm >= p3) + (u.pm >= p4) + (u.pm >= p5) + (u.pm >= p6); return true;
    }
};

__device__ __forceinline__ unsigned cvt_pk_bf16(float lo, float hi) { unsigned r; asm volatile("v_cvt_pk_bf16_f32 %0, %1, %2" : "=v"(r) : "v"(lo), "v"(hi)); return r; }
__device__ __forceinline__ u32x4 pack8(const f32x4 v0, const f32x4 v1) { u32x4 w; w.x = cvt_pk_bf16(v0[0], v0[1]); w.y = cvt_pk_bf16(v0[2], v0[3]); w.z = cvt_pk_bf16(v1[0], v1[1]); w.w = cvt_pk_bf16(v1[2], v1[3]); return w; }

struct EpiBf16Plain {
    static constexpr bool PERM = true;
    bf16_t* O; int ldc;
    __device__ __forceinline__ void operator()(const f32x4 (&acc)[2][2][4][2], const Unit& u, int wr, int wc, int fr, int fq) const {
        const int row0 = u.pm * BM + wr * 64 + fr, col0 = u.pn * BM + wc * 32 + 8 * fq;
#pragma unroll
        for (int ai = 0; ai < 2; ++ai)
#pragma unroll
            for (int m = 0; m < 4; ++m) { bf16_t* rowp = O + (size_t)(row0 + ai * HALF + m * 16) * ldc + col0;
#pragma unroll
                for (int bj = 0; bj < 2; ++bj) *(u32x4*)(rowp + bj * HALF) = pack8(acc[ai][bj][m][0], acc[ai][bj][m][1]); }
    }
};
__device__ __forceinline__ float silu_mul(float g, float u) { return g * u * __builtin_amdgcn_rcpf(1.0f + __builtin_amdgcn_exp2f(-1.4426950408889634f * g)); }
struct EpiSwiGLU {
    static constexpr bool PERM = true;
    bf16_t* O; int ldc;
    __device__ __forceinline__ void operator()(const f32x4 (&acc)[2][2][4][2], const Unit& u, int wr, int wc, int fr, int fq) const {
        const int row0 = u.pm * BM + wr * 64 + fr, col0 = u.pn * HALF + wc * 32 + 8 * fq;
#pragma unroll
        for (int ai = 0; ai < 2; ++ai)
#pragma unroll
            for (int m = 0; m < 4; ++m) { bf16_t* rowp = O + (size_t)(row0 + ai * HALF + m * 16) * ldc + col0;
                f32x4 v0, v1;
#pragma unroll
                for (int j = 0; j < 4; ++j) { v0[j] = silu_mul(acc[ai][0][m][0][j], acc[ai][1][m][0][j]); v1[j] = silu_mul(acc[ai][0][m][1][j], acc[ai][1][m][1][j]); }
                *(u32x4*)rowp = pack8(v0, v1); }
    }
};
struct EpiResF32 {
    static constexpr bool PERM = false;
    const float* base; float* out; int ldc; const float* bias;
    __device__ __forceinline__ void operator()(const f32x4 (&acc)[2][2][4][2], const Unit& u, int wr, int wc, int fr, int fq) const {
        const int row0 = u.pm * BM + wr * 64 + fr, col0 = u.pn * BM + wc * 32 + 4 * fq;
        f32x4 bv[2][2];
#pragma unroll
        for (int bj = 0; bj < 2; ++bj)
#pragma unroll
            for (int n = 0; n < 2; ++n) bv[bj][n] = bias ? *(const f32x4*)(bias + col0 + bj * HALF + n * 16) : (f32x4){0.f, 0.f, 0.f, 0.f};
#pragma unroll
        for (int ai = 0; ai < 2; ++ai)
#pragma unroll
            for (int m = 0; m < 4; ++m) { const size_t off = (size_t)(row0 + ai * HALF + m * 16) * ldc + col0;
#pragma unroll
                for (int bj = 0; bj < 2; ++bj)
#pragma unroll
                    for (int n = 0; n < 2; ++n) { const f32x4 b = *(const f32x4*)(base + off + bj * HALF + n * 16); *(f32x4*)(out + off + bj * HALF + n * 16) = b + acc[ai][bj][m][n] + bv[bj][n]; }
                asm volatile("" ::: "memory"); }
    }
};
struct EpiQKV {
    static constexpr bool PERM = true;
    bf16_t* O; const float* bias; const float* cs; float qscale;
    __device__ __forceinline__ void operator()(const f32x4 (&acc)[2][2][4][2], const Unit& u, int wr, int wc, int fr, int fq) const {
        const int row0 = u.pm * BM + wr * 64 + fr, colt = u.pn * BM, col0 = colt + wc * 32 + 8 * fq;
        const bool ropew = ((wc & 1) == 0);
        f32x4 bv[2][2];
#pragma unroll
        for (int bj = 0; bj < 2; ++bj)
#pragma unroll
            for (int n = 0; n < 2; ++n) bv[bj][n] = *(const f32x4*)(bias + col0 + bj * HALF + 4 * n);
        const float sgn = (fq == 0) ? -1.f : 1.f;
#pragma unroll
        for (int ai = 0; ai < 2; ++ai)
#pragma unroll
            for (int m = 0; m < 4; ++m) { const int row = row0 + ai * HALF + m * 16; bf16_t* rowp = O + (size_t)row * 1280 + col0;
                f32x4 c0 = (f32x4){1.f, 1.f, 1.f, 1.f}, c1 = c0, s0 = (f32x4){0.f, 0.f, 0.f, 0.f}, s1 = s0;
                if (ropew && fq < 2) { const f32x4* cp = (const f32x4*)(cs + (size_t)row * 16); c0 = cp[0]; c1 = cp[1]; s0 = cp[2] * sgn; s1 = cp[3] * sgn; }
#pragma unroll
                for (int bj = 0; bj < 2; ++bj) { f32x4 v0 = acc[ai][bj][m][0] + bv[bj][0], v1 = acc[ai][bj][m][1] + bv[bj][1];
                    const int gc = colt + bj * HALF;
                    if (ropew && gc < 1152) { f32x4 p0, p1;
#pragma unroll
                        for (int j = 0; j < 4; ++j) { p0[j] = __shfl_xor(v0[j], 16); p1[j] = __shfl_xor(v1[j], 16); }
                        v0 = v0 * c0 + p0 * s0; v1 = v1 * c1 + p1 * s1; }
                    if (gc < 1024) { v0 = v0 * qscale; v1 = v1 * qscale; }
                    *(u32x4*)(rowp + bj * HALF) = pack8(v0, v1); } }
    }
};
struct EpiMoeDown {
    static constexpr bool PERM = false;
    const int* rowtok; const float* rowgate; float* out;
    __device__ __forceinline__ void operator()(const f32x4 (&acc)[2][2][4][2], const Unit& u, int wr, int wc, int fr, int fq) const {
        const int slot0 = u.pm * BM + wr * 64 + fr, col0 = u.pn * BM + wc * 32 + 4 * fq;
#pragma unroll
        for (int ai = 0; ai < 2; ++ai)
#pragma unroll
            for (int m = 0; m < 4; ++m) { const int slot = slot0 + ai * HALF + m * 16; const int tok = rowtok[slot]; const float gate = rowgate[slot];
                if (tok >= 0) { float* rowp = out + (size_t)tok * 1024 + col0;
#pragma unroll
                    for (int bj = 0; bj < 2; ++bj)
#pragma unroll
                        for (int n = 0; n < 2; ++n) { const f32x4 b = *(const f32x4*)(rowp + bj * HALF + n * 16); *(f32x4*)(rowp + bj * HALF + n * 16) = b + acc[ai][bj][m][n] * gate; } }
                asm volatile("" ::: "memory"); }
    }
};

template <class Epi, class Sched, bool ALIGN_EPI = false, bool SP2 = false>
__device__ __forceinline__ void gemm_phase(PG8_LAS unsigned char* lds, const Gemm g, const Sched& S, const Epi& E) {
    int tid_ = threadIdx.x; asm volatile("" : "+v"(tid_));
    const int tid = tid_, wid = __builtin_amdgcn_readfirstlane(tid >> 6), lane = tid & 63, wr = wid >> 2, wc = wid & 3, fr = lane & 15, fq = lane >> 4;
    const int K = g.K, nt = K / BK;
    unsigned voffA[2], voffB[2];
#pragma unroll
    for (int i = 0; i < 2; ++i) { int R, C; stage_rc(tid * 16 + i * 8192, R, C); const int Rb = Epi::PERM ? ((R & ~31) + perm32(R & 31)) : R;
        voffA[i] = (unsigned)(R * K + C) * 2u; voffB[i] = (unsigned)(Rb * K + C) * 2u; }
    const size_t kstep = (size_t)(BK * 2);
    const size_t hstep = (size_t)HALF * K * 2;
    const size_t tstep = 2 * hstep;
    const unsigned ldsw = (unsigned)wid * 1024u;
    const int aoff = lds_byte(wr * 64 + fr, fq * 8), boff = lds_byte(wc * 32 + fr, fq * 8);
#define PG8_SA(b, h) (((b) * 2 + (h)) * HTB)
#define PG8_SB(b, h) ((4 + (b) * 2 + (h)) * HTB)
#define PG8_STAGE(bufoff, gbase, voff) do { _Pragma("unroll") for (int _i = 0; _i < 2; ++_i) \
        __builtin_amdgcn_global_load_lds((const unsigned*)((const char*)(gbase) + (voff)[_i]), (PG8_LAS unsigned*)(lds + (bufoff) + ldsw + _i * 8192), 16, 0, 0); } while (0)
#define PG8_LDA(dst, b, h) do { _Pragma("unroll") for (int m = 0; m < 4; ++m) _Pragma("unroll") for (int k = 0; k < 2; ++k) dst[m][k] = *(const PG8_LAS bf16x8*)(lds + PG8_SA(b, h) + aoff + m * 2048 + k * 1024); } while (0)
#define PG8_LDB(dst, b, h) do { _Pragma("unroll") for (int n = 0; n < 2; ++n) _Pragma("unroll") for (int k = 0; k < 2; ++k) dst[n][k] = *(const PG8_LAS bf16x8*)(lds + PG8_SB(b, h) + boff + n * 2048 + k * 1024); } while (0)
#define PG8_MMA(ai, bj, At, Bt) do { __builtin_amdgcn_s_setprio(1); _Pragma("unroll") for (int m = 0; m < 4; ++m) _Pragma("unroll") for (int n = 0; n < 2; ++n) _Pragma("unroll") for (int k = 0; k < 2; ++k) \
        acc[ai][bj][m][n] = __builtin_amdgcn_mfma_f32_16x16x32_bf16(Bt[n][k], At[m][k], acc[ai][bj][m][n], 0, 0, 0); __builtin_amdgcn_s_setprio(0); } while (0)
#define PG8_WAIT_V(n) asm volatile("s_waitcnt vmcnt(" #n ")" ::: "memory")
#define PG8_WAIT_L(n) asm volatile("s_waitcnt lgkmcnt(" #n ")" ::: "memory")
#define PG8_BAR __builtin_amdgcn_s_barrier()
#define PG8_SCHED __builtin_amdgcn_sched_barrier(0)
    Unit cur, nxt; int ui = 0;
    if (!S.next(0, cur)) return;
    f32x4 acc[2][2][4][2];
#pragma unroll
    for (int a = 0; a < 2; ++a)
#pragma unroll
        for (int b = 0; b < 2; ++b)
#pragma unroll
            for (int m = 0; m < 4; ++m)
#pragma unroll
                for (int n = 0; n < 2; ++n) acc[a][b][m][n] = (f32x4){0.f, 0.f, 0.f, 0.f};
    bf16x8 At[4][2], B0[2][2], B1[2][2];
    const char* cA = (const char*)g.A + (size_t)cur.pm * tstep; const char* cB = (const char*)g.Bt + (size_t)cur.e * g.estride + (size_t)cur.pn * tstep;
    if constexpr (SP2) {
        PG8_STAGE(PG8_SB(0, 0), cB, voffB); PG8_STAGE(PG8_SB(0, 1), cB + hstep, voffB); PG8_STAGE(PG8_SA(0, 0), cA, voffA); PG8_STAGE(PG8_SA(0, 1), cA + hstep, voffA);
        if (wr == 1) PG8_BAR;
        PG8_WAIT_V(2); PG8_BAR;
        PG8_STAGE(PG8_SB(1, 0), cB + kstep, voffB); PG8_STAGE(PG8_SA(1, 0), cA + kstep, voffA); PG8_STAGE(PG8_SB(1, 1), cB + hstep + kstep, voffB);
        PG8_WAIT_V(6); PG8_BAR;
    } else {
        PG8_STAGE(PG8_SB(0, 0), cB, voffB); PG8_STAGE(PG8_SA(0, 0), cA, voffA); PG8_STAGE(PG8_SB(0, 1), cB + hstep, voffB); PG8_STAGE(PG8_SA(0, 1), cA + hstep, voffA);
        if (wr == 1) PG8_BAR;
        PG8_WAIT_V(4); PG8_BAR;
        PG8_STAGE(PG8_SB(1, 0), cB + kstep, voffB); PG8_STAGE(PG8_SA(1, 0), cA + kstep, voffA); PG8_STAGE(PG8_SB(1, 1), cB + hstep + kstep, voffB);
        PG8_WAIT_V(6); PG8_BAR;
    }
    for (;;) {
        const bool has_next = S.next(ui + 1, nxt);
        const char* nA = has_next ? (const char*)g.A + (size_t)nxt.pm * tstep : cA; const char* nB = has_next ? (const char*)g.Bt + (size_t)nxt.e * g.estride + (size_t)nxt.pn * tstep : cB;
        for (int t = 0; t < nt; t += 2) {
            const bool last = (t == nt - 2);
            const char* a1 = cA + (size_t)(t + 1) * kstep;
            const char* a2 = last ? nA : cA + (size_t)(t + 2) * kstep; const char* b2 = last ? nB : cB + (size_t)(t + 2) * kstep;
            const char* a3 = a2 + kstep; const char* b3 = b2 + kstep;
            if constexpr (SP2) {
            PG8_LDB(B0, 0, 0); PG8_LDB(B1, 0, 1); PG8_SCHED; PG8_LDA(At, 0, 0); PG8_STAGE(PG8_SA(1, 1), a1 + hstep, voffA);
            PG8_WAIT_V(8); PG8_WAIT_L(0); PG8_BAR; PG8_MMA(0, 0, At, B0); PG8_MMA(0, 1, At, B1); PG8_BAR; PG8_SCHED;
            PG8_LDA(At, 0, 1); PG8_STAGE(PG8_SB(0, 0), b2, voffB); PG8_STAGE(PG8_SB(0, 1), b2 + hstep, voffB); PG8_STAGE(PG8_SA(0, 0), a2, voffA);
            PG8_WAIT_V(8); PG8_WAIT_L(0); PG8_BAR; PG8_MMA(1, 0, At, B0); PG8_MMA(1, 1, At, B1); PG8_BAR; PG8_SCHED;
            PG8_LDB(B0, 1, 0); PG8_LDB(B1, 1, 1); PG8_SCHED; PG8_LDA(At, 1, 0); PG8_STAGE(PG8_SA(0, 1), a2 + hstep, voffA);
            PG8_WAIT_V(8); PG8_WAIT_L(0); PG8_BAR; PG8_MMA(0, 0, At, B0); PG8_MMA(0, 1, At, B1); PG8_BAR; PG8_SCHED;
            PG8_LDA(At, 1, 1); PG8_STAGE(PG8_SB(1, 0), b3, voffB); PG8_STAGE(PG8_SB(1, 1), b3 + hstep, voffB); PG8_STAGE(PG8_SA(1, 0), a3, voffA);
            PG8_WAIT_V(8); PG8_WAIT_L(0); PG8_BAR; PG8_MMA(1, 0, At, B0); PG8_MMA(1, 1, At, B1); PG8_BAR; PG8_SCHED;
            } else {
            PG8_LDB(B0, 0, 0); PG8_SCHED; PG8_LDA(At, 0, 0); PG8_STAGE(PG8_SA(1, 1), a1 + hstep, voffA);
            PG8_WAIT_L(8); PG8_BAR; PG8_WAIT_L(0); PG8_MMA(0, 0, At, B0); PG8_BAR; PG8_SCHED;
            PG8_LDB(B1, 0, 1); PG8_STAGE(PG8_SB(0, 0), b2, voffB);
            PG8_BAR; PG8_WAIT_L(0); PG8_MMA(0, 1, At, B1); PG8_BAR;
            PG8_LDA(At, 0, 1); PG8_STAGE(PG8_SA(0, 0), a2, voffA);
            PG8_BAR; PG8_WAIT_L(0); PG8_MMA(1, 0, At, B0); PG8_BAR; PG8_SCHED;
            PG8_STAGE(PG8_SB(0, 1), b2 + hstep, voffB);
            PG8_WAIT_V(6); PG8_BAR; PG8_MMA(1, 1, At, B1); PG8_BAR;
            PG8_LDB(B0, 1, 0); PG8_SCHED; PG8_LDA(At, 1, 0); PG8_STAGE(PG8_SA(0, 1), a2 + hstep, voffA);
            PG8_WAIT_L(8); PG8_BAR; PG8_WAIT_L(0); PG8_MMA(0, 0, At, B0); PG8_BAR; PG8_SCHED;
            PG8_LDB(B1, 1, 1); PG8_STAGE(PG8_SB(1, 0), b3, voffB);
            PG8_BAR; PG8_WAIT_L(0); PG8_MMA(0, 1, At, B1); PG8_BAR;
            PG8_LDA(At, 1, 1); PG8_STAGE(PG8_SA(1, 0), a3, voffA);
            PG8_BAR; PG8_WAIT_L(0); PG8_MMA(1, 0, At, B0); PG8_BAR; PG8_SCHED;
            PG8_STAGE(PG8_SB(1, 1), b3 + hstep, voffB);
            PG8_WAIT_V(6); PG8_BAR; PG8_MMA(1, 1, At, B1); PG8_BAR;
            }
        }
        if constexpr (ALIGN_EPI) { if (wr == 0) PG8_BAR; }
        E(acc, cur, wr, wc, fr, fq);
        if (!has_next) break;
#pragma unroll
        for (int a = 0; a < 2; ++a)
#pragma unroll
            for (int b = 0; b < 2; ++b)
#pragma unroll
                for (int m = 0; m < 4; ++m)
#pragma unroll
                    for (int n = 0; n < 2; ++n) acc[a][b][m][n] = (f32x4){0.f, 0.f, 0.f, 0.f};
        cur = nxt; cA = nA; cB = nB; ++ui;
        if constexpr (ALIGN_EPI) { if (wr == 1) PG8_BAR; }
    }
    PG8_WAIT_V(0);
    if constexpr (!ALIGN_EPI) { if (wr == 0) PG8_BAR; }
    PG8_BAR;
#undef PG8_SA
#undef PG8_SB
#undef PG8_STAGE
#undef PG8_LDA
#undef PG8_LDB
#undef PG8_MMA
#undef PG8_WAIT_V
#undef PG8_WAIT_L
#undef PG8_BAR
#undef PG8_SCHED
}
}

constexpr int NWAVES = 8;
constexpr int NTOK = 65536, DM = 1024, SEQ = 8192;
constexpr int MIXIN = 2560, FFN = 2816, QKVD = 1280, EXPD = 3584, NEXP = 8;
constexpr int SETROWS = NTOK + NEXP * 256;
constexpr float EPS = 1e-5f;
constexpr float LOG2E = 1.4426950408889634f;
constexpr float QSCALE = 0.125f * LOG2E;

constexpr size_t MiB = 1u << 20;
constexpr size_t WS_CTL = 0, CTL_ZERO_BYTES = 1 * MiB;
constexpr size_t WS_CS = 1 * MiB;
constexpr size_t WS_TOKINFO = 5 * MiB;
constexpr size_t WS_ROWTOK = 7 * MiB;
constexpr size_t WS_ROWGATE = 8 * MiB;
constexpr size_t WS_WSP = 9 * MiB;
constexpr size_t WS_WIN = 16 * MiB, WS_WOUT = 21 * MiB, WS_FGU = 23 * MiB, WS_FD = 34 * MiB;
constexpr size_t WS_WQKV = 40 * MiB, WS_WO = 43 * MiB, WS_MGU = 45 * MiB, WS_MD = 157 * MiB;
constexpr size_t WS_XN = 216 * MiB;
constexpr size_t WS_XG = 344 * MiB;
constexpr size_t WS_BIG = 476 * MiB;
constexpr size_t WS_END = WS_BIG + (size_t)SETROWS * EXPD * 2;
static_assert(WS_MD + (size_t)NEXP * DM * EXPD * 2 <= WS_XN && WS_XN + (size_t)NTOK * DM * 2 <= WS_XG && WS_XG + (size_t)SETROWS * DM * 2 <= WS_BIG, "d_ws map");
static_assert(WS_FD + (size_t)DM * FFN * 2 <= WS_WQKV && WS_MGU + (size_t)NEXP * 2 * EXPD * DM * 2 <= WS_MD, "d_ws map (weights)");
constexpr int CW_BAR = 4096;
constexpr int CW_CNT = 16384;

constexpr int RING_BYTES = 131072;
constexpr int LDSCTL_OFF = RING_BYTES, MISC_OFF = LDSCTL_OFF + 320;
constexpr int LDS_BYTES = 147456;

#define GAS __attribute__((address_space(1)))
#define LAS __attribute__((address_space(3)))
typedef unsigned short bf16;
typedef unsigned v4u __attribute__((ext_vector_type(4)));
typedef unsigned v2u __attribute__((ext_vector_type(2)));
typedef float f32x4 __attribute__((ext_vector_type(4)));
typedef GAS unsigned gu32;
#define RLX_AGENT __ATOMIC_RELAXED, __HIP_MEMORY_SCOPE_AGENT
#define LDS_WAIT() asm volatile("s_waitcnt lgkmcnt(0)" ::: "memory")
#define VM_WAIT() asm volatile("s_waitcnt vmcnt(0)" ::: "memory")
__device__ __forceinline__ unsigned pk2(float lo, float hi) { return pg8::cvt_pk_bf16(lo, hi); }
__device__ __forceinline__ float bflo(unsigned w) { return __uint_as_float(w << 16); }
__device__ __forceinline__ float bfhi(unsigned w) { return __uint_as_float(w & 0xffff0000u); }
__device__ __forceinline__ float bf1(bf16 h) { return __uint_as_float(((unsigned)h) << 16); }
__device__ __forceinline__ bf16 f2bf1(float f) { return (bf16)(pk2(f, 0.f) & 0xffffu); }
__device__ __forceinline__ void unpack8(const v4u w, float (&f)[8]) { f[0] = bflo(w.x); f[1] = bfhi(w.x); f[2] = bflo(w.y); f[3] = bfhi(w.y); f[4] = bflo(w.z); f[5] = bfhi(w.z); f[6] = bflo(w.w); f[7] = bfhi(w.w); }
__device__ __forceinline__ v4u pack8f(const float (&f)[8]) { v4u w; w.x = pk2(f[0], f[1]); w.y = pk2(f[2], f[3]); w.z = pk2(f[4], f[5]); w.w = pk2(f[6], f[7]); return w; }
__device__ __forceinline__ float gelu_erf(float v) { return 0.5f * v * (1.0f + erff(v * 0.70710678118654752f)); }

#define XB_TMO      128
#define XB_XCNT(j)  (256  + 64 * (j))
#define XB_XSUB(j)  (1280 + 64 * (j))
#define XB_XGEN(j)  (2304 + 64 * (j))
#define XB_TOP      3328
#define XB_TOPGEN   3392
#define XCD_BAR_WORDS 3456
#define XB_SPIN_CAP (1u << 18)

__device__ __forceinline__ unsigned xb_ld(unsigned* p)              { return __hip_atomic_load(p, __ATOMIC_RELAXED, __HIP_MEMORY_SCOPE_AGENT); }
__device__ __forceinline__ unsigned xb_add(unsigned* p, unsigned v) { return __hip_atomic_fetch_add(p, v, __ATOMIC_RELAXED, __HIP_MEMORY_SCOPE_AGENT); }
__device__ __forceinline__ unsigned xb_xcc_id() { return (unsigned)__builtin_amdgcn_s_getreg((3 << 11) | 20) & 0xFu; }
#define XB_SPIN(cond, bar) do { unsigned _sp = 0; while (cond) { __builtin_amdgcn_s_sleep(1); \
    if ((++_sp & 255u) == 0u) { if (xb_ld(&(bar)[XB_TMO])) break; if (_sp > XB_SPIN_CAP) { atomicAdd(&(bar)[XB_TMO], 1u); break; } } } } while (0)

struct XcdBarrier {
    unsigned* bar; unsigned x;
    volatile LAS unsigned* st;
};

__device__ __forceinline__ XcdBarrier xcd_barrier_post(unsigned* bar, volatile LAS unsigned* st) {
    XcdBarrier b; b.bar = bar; b.x = xb_xcc_id(); b.st = st;
    if (threadIdx.x == 0) (void)xb_add(&bar[XB_XCNT(b.x)], 1u);
    return b;
}
__device__ __forceinline__ void xcd_barrier_complete(unsigned* bar, unsigned x, unsigned& nloc, unsigned& nx) {
    const unsigned G = gridDim.x * gridDim.y * gridDim.z;
    unsigned sum, cnt, mine, sp = 0u;
    for (;;) {
        sum = 0u; cnt = 0u; mine = 0u;
#pragma unroll
        for (unsigned j = 0; j < 16; ++j) { const unsigned c = xb_ld(&bar[XB_XCNT(j)]); sum += c; cnt += (c > 0u) ? 1u : 0u; mine = (j == x) ? c : mine; }
        if (sum == G) break;
        __builtin_amdgcn_s_sleep(1);
        if ((++sp & 255u) == 0u) { if (xb_ld(&bar[XB_TMO])) break; if (sp > XB_SPIN_CAP) { atomicAdd(&bar[XB_TMO], 1u); break; } }
    }
    nloc = mine > 0u ? mine : 1u; nx = cnt > 0u ? cnt : 1u;
}

__device__ __forceinline__ void xcd_barrier(const XcdBarrier& b) {
    asm volatile("s_waitcnt vmcnt(0)" ::: "memory");
    __syncthreads();
    if (threadIdx.x == 0) {
        unsigned* bar = b.bar;
        __builtin_amdgcn_s_waitcnt(0);
        unsigned nloc = b.st[0], nx = b.st[1];
        if (nloc == 0u) { xcd_barrier_complete(bar, b.x, nloc, nx); b.st[0] = nloc; b.st[1] = nx; }
        const unsigned old = xb_add(&bar[XB_XSUB(b.x)], 1u);
        const unsigned gen = old / nloc;
        if (old + 1u == (gen + 1u) * nloc) {
            __builtin_amdgcn_fence(__ATOMIC_RELEASE, "agent");
            asm volatile("s_waitcnt vmcnt(0)" ::: "memory");
            const unsigned og = xb_add(&bar[XB_TOP], 1u);
            const unsigned tg = og / nx;
            if (og + 1u == (tg + 1u) * nx) xb_add(&bar[XB_TOPGEN], 1u);
            else XB_SPIN(xb_ld(&bar[XB_TOPGEN]) == tg, bar);
            __builtin_amdgcn_fence(__ATOMIC_ACQUIRE, "agent");
            xb_add(&bar[XB_XGEN(b.x)], 1u);
            asm volatile("s_waitcnt vmcnt(0)" ::: "memory");
        } else {
            XB_SPIN(xb_ld(&bar[XB_XGEN(b.x)]) == gen, bar);
            __builtin_amdgcn_fence(__ATOMIC_ACQUIRE, "agent");
            asm volatile("s_waitcnt vmcnt(0)" ::: "memory");
        }
    }
    __syncthreads();
}

struct Frame {
    LAS unsigned char* lds;
    int tid, lane, wave;
    int vcu, G;
};
__device__ __forceinline__ float wave_sum(float v) {
#pragma unroll
    for (int o = 1; o < 64; o <<= 1) v += __shfl_xor(v, o);
    return v;
}

__device__ __forceinline__ void tr_item(const float* W, int N, int k0, int n0, bf16* WT, int K, int orow0, LAS float* scr, int lane) {
#pragma unroll 8
    for (int i = 0; i < 32; ++i) { const int kk = 2 * i + (lane >> 5); scr[kk * 33 + (lane & 31)] = W[(size_t)(k0 + kk) * N + n0 + (lane & 31)]; }
    LDS_WAIT(); asm volatile("" ::: "memory");
    const int c = lane & 7;
#pragma unroll
    for (int j = 0; j < 4; ++j) { const int n = (lane >> 3) + 8 * j; const LAS float* s = scr + (8 * c) * 33 + n;
        v4u o; o.x = pk2(s[0 * 33], s[1 * 33]); o.y = pk2(s[2 * 33], s[3 * 33]); o.z = pk2(s[4 * 33], s[5 * 33]); o.w = pk2(s[6 * 33], s[7 * 33]);
        *(GAS v4u*)(WT + (size_t)(orow0 + n) * K + k0 + 8 * c) = o; }
    LDS_WAIT(); asm volatile("" ::: "memory");
}
__device__ __forceinline__ void tr_plain(const float* W, int K, int N, bf16* WT, int item, LAS float* scr, int lane) {
    const int nblk = N / 32, kb = item / nblk, nb = item % nblk; tr_item(W, N, 64 * kb, 32 * nb, WT, K, 32 * nb, scr, lane);
}
__device__ __forceinline__ void tr_gu(const float* W, int K, int N, bf16* WT, int up, int item, LAS float* scr, int lane) {
    const int nblk = N / 32, kb = item / nblk, nb = item % nblk, n0 = 32 * nb; tr_item(W, N, 64 * kb, n0, WT, K, 256 * (n0 / 128) + 128 * up + (n0 % 128), scr, lane);
}

__device__ __forceinline__ void conv_even_phase(const Frame& F, const float* w_in, const float* w_out, const float* wg, const float* wu, const float* wd, const float* sw, unsigned char* ws) {
    LAS float* scr = (LAS float*)(F.lds + F.wave * 16384);
    const int gw = F.vcu * NWAVES + F.wave, NGW = F.G * NWAVES;
    constexpr int I_IN = (DM / 64) * (MIXIN / 32), I_OUT = (DM / 64) * (DM / 32), I_G = (DM / 64) * (FFN / 32), I_D = (FFN / 64) * (DM / 32);
    constexpr int NITEMS = I_IN + I_OUT + 2 * I_G + I_D;
    for (int it = gw; it < NITEMS; it += NGW) {
        int r = it;
        if (r < I_IN) { tr_plain(w_in, DM, MIXIN, (bf16*)(ws + WS_WIN), r, scr, F.lane); continue; } r -= I_IN;
        if (r < I_OUT) { tr_plain(w_out, DM, DM, (bf16*)(ws + WS_WOUT), r, scr, F.lane); continue; } r -= I_OUT;
        if (r < I_G) { tr_gu(wg, DM, FFN, (bf16*)(ws + WS_FGU), 0, r, scr, F.lane); continue; } r -= I_G;
        if (r < I_G) { tr_gu(wu, DM, FFN, (bf16*)(ws + WS_FGU), 1, r, scr, F.lane); continue; } r -= I_G;
        tr_plain(wd, FFN, DM, (bf16*)(ws + WS_FD), r, scr, F.lane);
    }
    float* wsp = (float*)(ws + WS_WSP);
    for (int idx = (F.vcu * NWAVES * 64) + F.tid; idx < 4 * 128 * 128; idx += F.G * NWAVES * 64) { const int ii = (idx >> 7) & 127, jj = idx & 127; wsp[idx] = (jj <= ii) ? sw[idx] : 0.f; }
}
__device__ __forceinline__ void conv_odd_phase(const Frame& F, const float* wqkv, const float* wo, const float* ewg, const float* ewu, const float* ewd, unsigned char* ws) {
    LAS float* scr = (LAS float*)(F.lds + F.wave * 16384);
    const int gw = F.vcu * NWAVES + F.wave, NGW = F.G * NWAVES;
    constexpr int I_Q = (DM / 64) * (QKVD / 32), I_O = (DM / 64) * (DM / 32), I_G = (DM / 64) * (EXPD / 32), I_D = (EXPD / 64) * (DM / 32);
    constexpr int NITEMS = I_Q + I_O + NEXP * (2 * I_G + I_D);
    for (int it = gw; it < NITEMS; it += NGW) {
        int r = it;
        if (r < I_Q) { tr_plain(wqkv, DM, QKVD, (bf16*)(ws + WS_WQKV), r, scr, F.lane); continue; } r -= I_Q;
        if (r < I_O) { tr_plain(wo, DM, DM, (bf16*)(ws + WS_WO), r, scr, F.lane); continue; } r -= I_O;
        const int e = r / (2 * I_G + I_D); r -= e * (2 * I_G + I_D);
        bf16* gu = (bf16*)(ws + WS_MGU) + (size_t)e * 2 * EXPD * DM; bf16* dd = (bf16*)(ws + WS_MD) + (size_t)e * DM * EXPD;
        if (r < I_G) { tr_gu(ewg + (size_t)e * DM * EXPD, DM, EXPD, gu, 0, r, scr, F.lane); continue; } r -= I_G;
        if (r < I_G) { tr_gu(ewu + (size_t)e * DM * EXPD, DM, EXPD, gu, 1, r, scr, F.lane); continue; } r -= I_G;
        tr_plain(ewd + (size_t)e * EXPD * DM, EXPD, DM, dd, r, scr, F.lane);
    }
}
__device__ __forceinline__ void rope_table_phase(const Frame& F, const int* pos, float* cs) {
    for (int idx = (F.vcu * NWAVES * 64) + F.tid; idx < NTOK * 8; idx += F.G * NWAVES * 64) {
        const int t = idx >> 3, i = idx & 7;
        const float inv = (float)exp(-log(500000.0) * (double)(2 * i) / 16.0);
        const float ang = (float)pos[t] * inv;
        cs[(size_t)t * 16 + i] = (float)cos((double)ang); cs[(size_t)t * 16 + 8 + i] = (float)sin((double)ang);
    }
}
__device__ __forceinline__ void rms_phase(const Frame& F, const float* hin, const float* g, bf16* XN) {
    const int gw = F.vcu * NWAVES + F.wave, NGW = F.G * NWAVES;
    f32x4 gv[4];
#pragma unroll
    for (int j = 0; j < 4; ++j) gv[j] = ((const f32x4*)g)[F.lane + 64 * j];
    for (int m = gw; m < NTOK; m += NGW) {
        const GAS f32x4* xr = (const GAS f32x4*)(hin + (size_t)m * DM) + F.lane;
        f32x4 v[4]; float s = 0.f;
#pragma unroll
        for (int j = 0; j < 4; ++j) { v[j] = xr[64 * j]; s += (v[j].x * v[j].x + v[j].y * v[j].y) + (v[j].z * v[j].z + v[j].w * v[j].w); }
        const float rstd = 1.0f / sqrtf(wave_sum(s) * (1.f / DM) + EPS);
        GAS v2u* o8 = (GAS v2u*)(XN + (size_t)m * DM) + F.lane;
#pragma unroll
        for (int j = 0; j < 4; ++j) { const f32x4 y = v[j] * rstd * gv[j]; v2u w; w.x = pk2(y.x, y.y); w.y = pk2(y.z, y.w); o8[64 * j] = w; }
    }
}
__device__ __forceinline__ void rms_final_phase(const Frame& F, float* h, const float* g) {
    const int gw = F.vcu * NWAVES + F.wave, NGW = F.G * NWAVES;
    f32x4 gv[4];
#pragma unroll
    for (int j = 0; j < 4; ++j) gv[j] = ((const f32x4*)g)[F.lane + 64 * j];
    for (int m = gw; m < NTOK; m += NGW) {
        GAS f32x4* xr = (GAS f32x4*)(h + (size_t)m * DM) + F.lane;
        f32x4 v[4]; float s = 0.f;
#pragma unroll
        for (int j = 0; j < 4; ++j) { v[j] = xr[64 * j]; s += (v[j].x * v[j].x + v[j].y * v[j].y) + (v[j].z * v[j].z + v[j].w * v[j].w); }
        const float rstd = 1.0f / sqrtf(wave_sum(s) * (1.f / DM) + EPS);
#pragma unroll
        for (int j = 0; j < 4; ++j) xr[64 * j] = v[j] * rstd * gv[j];
    }
}
__device__ __forceinline__ void rms_router_phase(const Frame& F, const float* h, const float* g, const float* rw, bf16* XN, unsigned* gcnt, unsigned* tokinfo, int* rowtok) {
    for (int idx = (F.vcu * NWAVES * 64) + F.tid; idx < 2 * SETROWS; idx += F.G * NWAVES * 64) rowtok[idx] = -1;
    LAS unsigned* lcnt = (LAS unsigned*)F.lds;
    LAS unsigned* lbase = lcnt + 16;
    LAS unsigned* rec = lcnt + 64;
    f32x4 gv[4];
#pragma unroll
    for (int j = 0; j < 4; ++j) gv[j] = ((const f32x4*)g)[F.lane + 64 * j];
    f32x4 rwv[4][4][2];
#pragma unroll
    for (int j = 0; j < 4; ++j)
#pragma unroll
        for (int c = 0; c < 4; ++c) { const f32x4* p = (const f32x4*)(rw + (size_t)(256 * j + 4 * F.lane + c) * 8); rwv[j][c][0] = p[0]; rwv[j][c][1] = p[1]; }
    for (int panel = F.vcu; panel < NTOK / 256; panel += F.G) {
        if (F.tid < 16) lcnt[F.tid] = 0u;
        __syncthreads();
        for (int r = 0; r < 32; ++r) {
            const int lrow = F.wave * 32 + r, m = panel * 256 + lrow;
            const GAS f32x4* xr = (const GAS f32x4*)(h + (size_t)m * DM) + F.lane;
            f32x4 v[4]; float s = 0.f;
#pragma unroll
            for (int j = 0; j < 4; ++j) { v[j] = xr[64 * j]; s += (v[j].x * v[j].x + v[j].y * v[j].y) + (v[j].z * v[j].z + v[j].w * v[j].w); }
            const float rstd = 1.0f / sqrtf(wave_sum(s) * (1.f / DM) + EPS);
            GAS v2u* o8 = (GAS v2u*)(XN + (size_t)m * DM) + F.lane;
            f32x4 l0 = (f32x4){0.f, 0.f, 0.f, 0.f}, l1 = l0;
#pragma unroll
            for (int j = 0; j < 4; ++j) { const f32x4 y = v[j] * rstd * gv[j]; v2u w; w.x = pk2(y.x, y.y); w.y = pk2(y.z, y.w); o8[64 * j] = w;
                l0 += rwv[j][0][0] * y.x + rwv[j][1][0] * y.y + rwv[j][2][0] * y.z + rwv[j][3][0] * y.w;
                l1 += rwv[j][0][1] * y.x + rwv[j][1][1] * y.y + rwv[j][2][1] * y.z + rwv[j][3][1] * y.w; }
            float lg[8];
#pragma unroll
            for (int e = 0; e < 4; ++e) { lg[e] = wave_sum(l0[e]); lg[4 + e] = wave_sum(l1[e]); }
            int e1 = 0; float v1 = lg[0];
#pragma unroll
            for (int e = 1; e < 8; ++e) if (lg[e] > v1) { v1 = lg[e]; e1 = e; }
            int e2 = -1; float v2 = -INFINITY;
#pragma unroll
            for (int e = 0; e < 8; ++e) if (e != e1 && (e2 < 0 || lg[e] > v2)) { v2 = lg[e]; e2 = e; }
            const float g2 = 1.0f / (1.0f + expf(v1 - v2)), g1 = 1.0f - g2;
            if (F.lane == 0) {
                const unsigned p1 = atomicAdd((unsigned*)(lcnt + e1), 1u), p2 = atomicAdd((unsigned*)(lcnt + 8 + e2), 1u);
                LAS unsigned* rr = rec + lrow * 8; rr[0] = (unsigned)e1; rr[1] = p1; rr[2] = __float_as_uint(g1); rr[3] = (unsigned)e2; rr[4] = p2; rr[5] = __float_as_uint(g2);
            }
        }
        __syncthreads();
        if (F.tid < 16) lbase[F.tid] = __hip_atomic_fetch_add(gcnt + F.tid, lcnt[F.tid], RLX_AGENT);
        __syncthreads();
        if (F.tid < 256) { const LAS unsigned* rr = rec + F.tid * 8; v4u a, b; a.x = rr[0]; a.y = rr[1] + lbase[rr[0]]; a.z = rr[2]; a.w = rr[3]; b.x = rr[4] + lbase[8 + rr[3]]; b.y = rr[5]; b.z = 0u; b.w = 0u;
            GAS v4u* ti = (GAS v4u*)(tokinfo + (size_t)(panel * 256 + F.tid) * 8); ti[0] = a; ti[1] = b; }
        __syncthreads();
    }
}
__device__ __forceinline__ void moe_prefix(const unsigned* gcnt_set, int (&pend)[8]) {
    int acc = 0;
#pragma unroll
    for (int e = 0; e < 8; ++e) { const unsigned c = __hip_atomic_load(gcnt_set + e, RLX_AGENT); acc += (int)((c + 255u) >> 8); pend[e] = acc; }
}
__device__ __forceinline__ void gather_phase(const Frame& F, int s, const unsigned* gcnt, const unsigned* tokinfo, const bf16* XN, bf16* XG, int* rowtok, float* rowgate) {
    int pend[8]; moe_prefix(gcnt + 8 * s, pend);
    const int gw = F.vcu * NWAVES + F.wave, NGW = F.G * NWAVES;
    for (int t = gw; t < NTOK; t += NGW) {
        const unsigned* ti = tokinfo + (size_t)t * 8 + 3 * s;
        const int e = (int)ti[0]; const unsigned pos = (s == 0) ? ti[1] : ti[1]; const unsigned gb = ti[2];
        int pstart = 0;
#pragma unroll
        for (int k = 0; k < 7; ++k) pstart = (e == k + 1) ? pend[k] : pstart;
        const size_t slot = (size_t)pstart * 256 + pos;
        const GAS v4u* src = (const GAS v4u*)(XN + (size_t)t * DM); GAS v4u* dst = (GAS v4u*)(XG + slot * DM);
        const v4u a = src[F.lane], b = src[64 + F.lane]; dst[F.lane] = a; dst[64 + F.lane] = b;
        if (F.lane == 0) { rowtok[(size_t)s * SETROWS + slot] = t; rowgate[(size_t)s * SETROWS + slot] = __uint_as_float(gb); }
    }
}

__device__ __forceinline__ void mixer_token_phase(const Frame& F, bf16* Z, bf16* Y, const float* convw, const float* lng, const float* lnb) {
    const int gw = F.vcu * NWAVES + F.wave, NGW = F.G * NWAVES, c8 = 8 * F.lane;
    float cw0[8], cw1[8], cw2[8], lg[8], lb[8];
#pragma unroll
    for (int j = 0; j < 8; ++j) { cw0[j] = convw[(c8 + j) * 3 + 0]; cw1[j] = convw[(c8 + j) * 3 + 1]; cw2[j] = convw[(c8 + j) * 3 + 2]; lg[j] = lng[c8 + j]; lb[j] = lnb[c8 + j]; }
    for (int base = gw * 32; base < NTOK; base += NGW * 32) {
        float cx1[8], cx2[8];
        if ((base % SEQ) != 0) {
            float a[8], b[8];
            unpack8(*(const GAS v4u*)(Z + (size_t)(base - 1) * MIXIN + 512 + c8), a); unpack8(*(const GAS v4u*)(Z + (size_t)(base - 1) * MIXIN + 1024 + c8), b);
#pragma unroll
            for (int j = 0; j < 8; ++j) cx1[j] = a[j] * b[j];
            unpack8(*(const GAS v4u*)(Z + (size_t)(base - 2) * MIXIN + 512 + c8), a); unpack8(*(const GAS v4u*)(Z + (size_t)(base - 2) * MIXIN + 1024 + c8), b);
#pragma unroll
            for (int j = 0; j < 8; ++j) cx2[j] = a[j] * b[j];
        } else {
#pragma unroll
            for (int j = 0; j < 8; ++j) { cx1[j] = 0.f; cx2[j] = 0.f; }
        }
        for (int r = 0; r < 32; ++r) {
            const size_t t = (size_t)(base + r);
            bf16* zr = Z + t * MIXIN; bf16* yr = Y + t * DM;
            float ab[8], ac[8], ax[8], bu[8], bv[8];
            unpack8(*(const GAS v4u*)(zr + c8), ab); unpack8(*(const GAS v4u*)(zr + 512 + c8), ac); unpack8(*(const GAS v4u*)(zr + 1024 + c8), ax);
            unpack8(*(const GAS v4u*)(zr + 1536 + c8), bu); unpack8(*(const GAS v4u*)(zr + 2048 + c8), bv);
            float ya[8], uu[8], vv[8]; float s = 0.f;
#pragma unroll
            for (int j = 0; j < 8; ++j) { const float cx0 = ac[j] * ax[j]; ya[j] = ab[j] * (cw0[j] * cx2[j] + cw1[j] * cx1[j] + cw2[j] * cx0); cx2[j] = cx1[j]; cx1[j] = cx0;
                uu[j] = gelu_erf(bu[j]); vv[j] = gelu_erf(bv[j]); s += vv[j]; }
            const float mu = wave_sum(s) * (1.f / 512.f); float q = 0.f;
#pragma unroll
            for (int j = 0; j < 8; ++j) { vv[j] -= mu; q += vv[j] * vv[j]; }
            const float rstd = 1.0f / sqrtf(wave_sum(q) * (1.f / 512.f) + EPS);
#pragma unroll
            for (int j = 0; j < 8; ++j) vv[j] = vv[j] * rstd * lg[j] + lb[j];
            *(GAS v4u*)(yr + c8) = pack8f(ya); *(GAS v4u*)(yr + 512 + c8) = pack8f(uu); *(GAS v4u*)(zr + 2048 + c8) = pack8f(vv);
        }
    }
}
__device__ __forceinline__ void spatial_naive_phase(const Frame& F, const bf16* Z, bf16* Y, const float* wsp, const float* sb) {
    const int c = F.tid, h = __builtin_amdgcn_readfirstlane(F.tid >> 7);
    for (int unit = F.vcu; unit < NTOK / 128; unit += F.G) {
        const size_t t0 = (size_t)unit * 128;
        float vn[128];
#pragma unroll
        for (int j = 0; j < 128; ++j) vn[j] = bf1(Z[(t0 + j) * MIXIN + 2048 + c]);
        for (int i = 0; i < 128; ++i) {
            const float* wrow = wsp + (size_t)(h * 128 + i) * 128;
            float a0 = 0.f, a1 = 0.f, a2 = 0.f, a3 = 0.f;
#pragma unroll
            for (int j = 0; j < 128; j += 4) { a0 += wrow[j] * vn[j]; a1 += wrow[j + 1] * vn[j + 1]; a2 += wrow[j + 2] * vn[j + 2]; a3 += wrow[j + 3] * vn[j + 3]; }
            const float mixed = (a0 + a1) + (a2 + a3) + sb[h * 128 + i];
            bf16* yp = Y + (t0 + i) * DM + 512 + c; *yp = f2bf1(bf1(*yp) * mixed);
        }
    }
}
__device__ __forceinline__ void attn_naive_phase(const Frame& F, const bf16* QKV, const float* sinks, bf16* AO) {
    LAS unsigned char* Ks = F.lds; LAS unsigned char* Vs = F.lds + 256 * 144;
    for (int unit = F.vcu; unit < 8 * 64 * 2; unit += F.G) {
        const int b = unit >> 7, n = (unit >> 1) & 63, hk = unit & 1;
        const size_t tb = (size_t)b * SEQ;
#pragma unroll
        for (int i = 0; i < 4; ++i) { const int p = F.tid + 512 * i, key = p >> 3, ch = p & 7;
            const int kt = (n == 0 && key < 128) ? key : (n - 1) * 128 + key;
            const bf16* src = QKV + (tb + kt) * QKVD + 1024 + hk * 64 + ch * 8;
            *(LAS v4u*)(Ks + key * 144 + ch * 16) = *(const GAS v4u*)src; *(LAS v4u*)(Vs + key * 144 + ch * 16) = *(const GAS v4u*)(src + 128); }
        __syncthreads();
#pragma unroll 1
        for (int it = 0; it < 2; ++it) {
            const int q = F.tid & 127, head = hk * 8 + (F.tid >> 7) + 4 * it;
            const size_t qrow = tb + (size_t)n * 128 + q;
            float qv[64], o[64];
#pragma unroll
            for (int c = 0; c < 8; ++c) { float f[8]; unpack8(*(const GAS v4u*)(QKV + qrow * QKVD + head * 64 + c * 8), f);
#pragma unroll
                for (int j = 0; j < 8; ++j) { qv[c * 8 + j] = f[j]; o[c * 8 + j] = 0.f; } }
            float mx = sinks[head] * LOG2E, l = 1.0f;
            for (int k = 1; k <= 128; ++k) {
                const int s = q + k;
                if (n == 0 && s < 128) continue;
                float d0 = 0.f, d1 = 0.f;
#pragma unroll
                for (int c = 0; c < 8; ++c) { float f[8]; unpack8(*(const LAS v4u*)(Ks + s * 144 + c * 16), f);
#pragma unroll
                    for (int j = 0; j < 8; j += 2) { d0 += qv[c * 8 + j] * f[j]; d1 += qv[c * 8 + j + 1] * f[j + 1]; } }
                const float sc = d0 + d1, mn = fmaxf(mx, sc), al = __builtin_amdgcn_exp2f(mx - mn), p = __builtin_amdgcn_exp2f(sc - mn);
                l = l * al + p; mx = mn;
#pragma unroll
                for (int c = 0; c < 8; ++c) { float f[8]; unpack8(*(const LAS v4u*)(Vs + s * 144 + c * 16), f);
#pragma unroll
                    for (int j = 0; j < 8; ++j) o[c * 8 + j] = o[c * 8 + j] * al + p * f[j]; }
            }
            const float il = 1.0f / l;
#pragma unroll
            for (int c = 0; c < 8; ++c) { float f[8];
#pragma unroll
                for (int j = 0; j < 8; ++j) f[j] = o[c * 8 + j] * il;
                *(GAS v4u*)(AO + qrow * DM + head * 64 + c * 8) = pack8f(f); }
        }
        __syncthreads();
    }
}

struct Args {
    const float* x; const int* pos; const float* fng;
    const float *e_n1, *e_win, *e_conv, *e_lng, *e_lnb, *e_sw, *e_sb, *e_wout, *e_n2, *e_wg, *e_wu, *e_wd;
    const float *o_n1, *o_wqkv, *o_bqkv, *o_sinks, *o_wo, *o_bo, *o_n2, *o_rw, *o_ewg, *o_ewu, *o_ewd;
    float* out; unsigned char* ws; int lo, hi, li, pad;
};
constexpr int PH_PER_PAIR = 19;
constexpr int N_PHASES = 1 + 2 * PH_PER_PAIR + 1;

typedef const __attribute__((address_space(4))) Args* ArgsP;
#define PH_ARGS(ap) ArgsP ap = (ArgsP)__builtin_amdgcn_kernarg_segment_ptr(); asm volatile("" : "+s"(ap))
__device__ __forceinline__ Frame make_frame(LAS unsigned char* lds) {
    Frame F; int tid = threadIdx.x; asm volatile("" : "+v"(tid));
    F.lds = lds; F.tid = tid; F.lane = tid & 63; F.wave = __builtin_amdgcn_readfirstlane(tid >> 6);
    F.G = gridDim.x; { const int bx = blockIdx.x; F.vcu = (F.G % 8 == 0) ? (bx % 8) * (F.G / 8) + bx / 8 : bx; }
    return F;
}
__global__ void __launch_bounds__(NWAVES * 64, 2) fwd(Args A_unused) {
    extern __shared__ __attribute__((aligned(16))) unsigned char lds_raw[];
    LAS unsigned char* const lds = (LAS unsigned char*)lds_raw;
    for (int u = threadIdx.x; u < (LDS_BYTES - LDSCTL_OFF) / 4; u += NWAVES * 64) ((LAS unsigned*)(lds + LDSCTL_OFF))[u] = 0u;
    __syncthreads();
    int lo, hi;
    { PH_ARGS(ap); lo = ap->lo; hi = ap->hi; }
#if MK_ONE_LAUNCH
    XcdBarrier bar;
    { PH_ARGS(ap); bar = xcd_barrier_post((unsigned*)(ap->ws + WS_CTL) + CW_BAR, (volatile LAS unsigned*)(lds + MISC_OFF) + 8); }
#define GRID_BAR() xcd_barrier(bar)
#else
#define GRID_BAR() do { } while (0)
#endif
#ifndef PHMASK
#define PHMASK 0xFFFFFFFFu
#endif
#define PHEN(k) (((PHMASK) >> (k)) & 1u)
#define IN(k) (lo <= (k) && (k) < hi)
#define SEAM(k) do { if (IN(k) && IN((k) + 1)) GRID_BAR(); } while (0)
#define PH_BEGIN() PH_ARGS(ap); const Frame F = make_frame(lds); unsigned char* const ws = ap->ws; const int G = F.G, cblk = (int)blockIdx.x; (void)G; (void)cblk

    if (IN(0) && PHEN(16)) { PH_BEGIN(); rope_table_phase(F, ap->pos, (float*)(ws + WS_CS)); } SEAM(0);

#pragma unroll 1
    for (int i = 0; i < 2; ++i) {
        const int pb = 1 + i * PH_PER_PAIR;
        if (IN(pb + 0) && PHEN(0)) { PH_BEGIN(); conv_even_phase(F, ap->e_win + (size_t)i * DM * MIXIN, ap->e_wout + (size_t)i * DM * DM, ap->e_wg + (size_t)i * DM * FFN, ap->e_wu + (size_t)i * DM * FFN, ap->e_wd + (size_t)i * FFN * DM, ap->e_sw + (size_t)i * 4 * 128 * 128, ws);
                          rms_phase(F, (i == 0) ? ap->x : ap->out, ap->e_n1 + i * DM, (bf16*)(ws + WS_XN)); } SEAM(pb + 0);
        if (IN(pb + 1) && PHEN(1)) { PH_BEGIN(); pg8::Gemm g{(const bf16*)(ws + WS_XN), (const bf16*)(ws + WS_WIN), DM, 0}; pg8::StaticOrder S; S.init(NTOK, MIXIN, G, cblk); pg8::EpiBf16Plain E{(bf16*)(ws + WS_BIG), MIXIN};
                          pg8::gemm_phase<pg8::EpiBf16Plain, pg8::StaticOrder, true, true>(F.lds, g, S, E); } SEAM(pb + 1);
        if (IN(pb + 2) && PHEN(2)) { PH_BEGIN(); mixer_token_phase(F, (bf16*)(ws + WS_BIG), (bf16*)(ws + WS_XN), ap->e_conv + i * 512 * 3, ap->e_lng + i * 512, ap->e_lnb + i * 512); } SEAM(pb + 2);
        if (IN(pb + 3) && PHEN(3)) { PH_BEGIN(); spatial_naive_phase(F, (const bf16*)(ws + WS_BIG), (bf16*)(ws + WS_XN), (const float*)(ws + WS_WSP), ap->e_sb + i * 4 * 128); } SEAM(pb + 3);
        if (IN(pb + 4) && PHEN(4)) { PH_BEGIN(); pg8::Gemm g{(const bf16*)(ws + WS_XN), (const bf16*)(ws + WS_WOUT), DM, 0}; pg8::StaticOrder S; S.init(NTOK, DM, G, cblk); pg8::EpiResF32 E{(i == 0) ? ap->x : ap->out, ap->out, DM, nullptr};
                          pg8::gemm_phase<pg8::EpiResF32, pg8::StaticOrder, true, true>(F.lds, g, S, E); } SEAM(pb + 4);
        if (IN(pb + 5) && PHEN(5)) { PH_BEGIN(); rms_phase(F, ap->out, ap->e_n2 + i * DM, (bf16*)(ws + WS_XN)); } SEAM(pb + 5);
        if (IN(pb + 6) && PHEN(6)) { PH_BEGIN(); pg8::Gemm g{(const bf16*)(ws + WS_XN), (const bf16*)(ws + WS_FGU), DM, 0}; pg8::StaticOrder S; S.init(NTOK, 2 * FFN, G, cblk); pg8::EpiSwiGLU E{(bf16*)(ws + WS_BIG), FFN};
                          pg8::gemm_phase<pg8::EpiSwiGLU, pg8::StaticOrder, true, true>(F.lds, g, S, E); } SEAM(pb + 6);
        if (IN(pb + 7) && PHEN(7)) { PH_BEGIN(); pg8::Gemm g{(const bf16*)(ws + WS_BIG), (const bf16*)(ws + WS_FD), FFN, 0}; pg8::StaticOrder S; S.init(NTOK, DM, G, cblk); pg8::EpiResF32 E{ap->out, ap->out, DM, nullptr};
                          pg8::gemm_phase<pg8::EpiResF32, pg8::StaticOrder, true, true>(F.lds, g, S, E); } SEAM(pb + 7);
        if (IN(pb + 8) && PHEN(8)) { PH_BEGIN(); conv_odd_phase(F, ap->o_wqkv + (size_t)i * DM * QKVD, ap->o_wo + (size_t)i * DM * DM, ap->o_ewg + (size_t)i * NEXP * DM * EXPD, ap->o_ewu + (size_t)i * NEXP * DM * EXPD, ap->o_ewd + (size_t)i * NEXP * EXPD * DM, ws);
                          rms_phase(F, ap->out, ap->o_n1 + i * DM, (bf16*)(ws + WS_XN)); } SEAM(pb + 8);
        if (IN(pb + 9) && PHEN(9)) { PH_BEGIN(); pg8::Gemm g{(const bf16*)(ws + WS_XN), (const bf16*)(ws + WS_WQKV), DM, 0}; pg8::StaticOrder S; S.init(NTOK, QKVD, G, cblk); pg8::EpiQKV E{(bf16*)(ws + WS_BIG), ap->o_bqkv + i * QKVD, (const float*)(ws + WS_CS), QSCALE};
                          pg8::gemm_phase<pg8::EpiQKV, pg8::StaticOrder, true, true>(F.lds, g, S, E); } SEAM(pb + 9);
        if (IN(pb + 10) && PHEN(10)) { PH_BEGIN(); attn_naive_phase(F, (const bf16*)(ws + WS_BIG), ap->o_sinks + i * 16, (bf16*)(ws + WS_XN)); } SEAM(pb + 10);
        if (IN(pb + 11) && PHEN(11)) { PH_BEGIN(); pg8::Gemm g{(const bf16*)(ws + WS_XN), (const bf16*)(ws + WS_WO), DM, 0}; pg8::StaticOrder S; S.init(NTOK, DM, G, cblk); pg8::EpiResF32 E{ap->out, ap->out, DM, ap->o_bo + i * DM};
                           pg8::gemm_phase<pg8::EpiResF32, pg8::StaticOrder, true, true>(F.lds, g, S, E); } SEAM(pb + 11);
        if (IN(pb + 12) && PHEN(12)) { PH_BEGIN(); rms_router_phase(F, ap->out, ap->o_n2 + i * DM, ap->o_rw + (size_t)i * DM * NEXP, (bf16*)(ws + WS_XN), (unsigned*)(ws + WS_CTL) + CW_CNT + 64 * i, (unsigned*)(ws + WS_TOKINFO), (int*)(ws + WS_ROWTOK)); } SEAM(pb + 12);
#pragma unroll 1
        for (int s = 0; s < 2; ++s) {
            const int ps = pb + 13 + 3 * s;
            if (IN(ps + 0) && PHEN(13)) { PH_BEGIN(); gather_phase(F, s, (const unsigned*)(ws + WS_CTL) + CW_CNT + 64 * i, (const unsigned*)(ws + WS_TOKINFO), (const bf16*)(ws + WS_XN), (bf16*)(ws + WS_XG), (int*)(ws + WS_ROWTOK), (float*)(ws + WS_ROWGATE)); } SEAM(ps + 0);
            if (IN(ps + 1) && PHEN(14)) { PH_BEGIN(); int pend[8]; moe_prefix((const unsigned*)(ws + WS_CTL) + CW_CNT + 64 * i + 8 * s, pend);
                pg8::MoeOrder S; S.nM = pend[7]; S.nN = 2 * EXPD / 256; S.nwg = S.nM * S.nN; S.G = G; S.c = cblk; S.p0 = pend[0]; S.p1 = pend[1]; S.p2 = pend[2]; S.p3 = pend[3]; S.p4 = pend[4]; S.p5 = pend[5]; S.p6 = pend[6];
                pg8::Gemm g{(const bf16*)(ws + WS_XG), (const bf16*)(ws + WS_MGU), DM, (size_t)2 * EXPD * DM * 2}; pg8::EpiSwiGLU E{(bf16*)(ws + WS_BIG), EXPD};
                pg8::gemm_phase<pg8::EpiSwiGLU, pg8::MoeOrder, true, true>(F.lds, g, S, E); } SEAM(ps + 1);
            if (IN(ps + 2) && PHEN(15)) { PH_BEGIN(); int pend[8]; moe_prefix((const unsigned*)(ws + WS_CTL) + CW_CNT + 64 * i + 8 * s, pend);
                pg8::MoeOrder S; S.nM = pend[7]; S.nN = DM / 256; S.nwg = S.nM * S.nN; S.G = G; S.c = cblk; S.p0 = pend[0]; S.p1 = pend[1]; S.p2 = pend[2]; S.p3 = pend[3]; S.p4 = pend[4]; S.p5 = pend[5]; S.p6 = pend[6];
                pg8::Gemm g{(const bf16*)(ws + WS_BIG), (const bf16*)(ws + WS_MD), EXPD, (size_t)DM * EXPD * 2}; pg8::EpiMoeDown E{(const int*)(ws + WS_ROWTOK) + (size_t)s * SETROWS, (const float*)(ws + WS_ROWGATE) + (size_t)s * SETROWS, ap->out};
                pg8::gemm_phase<pg8::EpiMoeDown, pg8::MoeOrder, true, true>(F.lds, g, S, E); } SEAM(ps + 2);
        }
    }
    if (IN(N_PHASES - 1) && PHEN(17)) { PH_BEGIN(); rms_final_phase(F, ap->out, ap->fng); }
#undef IN
#undef SEAM
}

extern "C" void kernel_launch(void* const* d_in, const int* in_sizes, int n_in, void* d_out, int out_size, void* d_ws, size_t ws_size, hipStream_t stream) {
    static int grid = 0;
    if (grid == 0) {
        if (n_in != 26 || in_sizes[0] != NTOK * DM || out_size != NTOK * DM || ws_size < WS_END) { fprintf(stderr, "kernel_launch: unexpected shapes: n_in %d in0 %d out %d ws %zu (need %zu)\n", n_in, n_in > 0 ? in_sizes[0] : -1, out_size, ws_size, (size_t)WS_END); grid = -1; return; }
        int dev = 0, cus = 0, per_cu = 0;
        if (hipGetDevice(&dev) != hipSuccess || hipDeviceGetAttribute(&cus, hipDeviceAttributeMultiprocessorCount, dev) != hipSuccess) { grid = -1; return; }
        if (hipFuncSetAttribute((const void*)fwd, hipFuncAttributeMaxDynamicSharedMemorySize, LDS_BYTES) != hipSuccess) { fprintf(stderr, "kernel_launch: hipFuncSetAttribute failed\n"); grid = -1; return; }
        if (hipOccupancyMaxActiveBlocksPerMultiprocessor(&per_cu, (const void*)fwd, NWAVES * 64, LDS_BYTES) != hipSuccess || per_cu < 1) fprintf(stderr, "kernel_launch: occupancy query reports %d\n", per_cu);
        (void)hipGetLastError();
        grid = cus;
    }
    if (grid < 0) return;
    (void)hipMemsetAsync((char*)d_ws + WS_CTL, 0, CTL_ZERO_BYTES, stream);
    Args a{};
    a.x = (const float*)d_in[0]; a.pos = (const int*)d_in[1]; a.fng = (const float*)d_in[2];
    a.e_n1 = (const float*)d_in[3]; a.e_win = (const float*)d_in[4]; a.e_conv = (const float*)d_in[5]; a.e_lng = (const float*)d_in[6]; a.e_lnb = (const float*)d_in[7];
    a.e_sw = (const float*)d_in[8]; a.e_sb = (const float*)d_in[9]; a.e_wout = (const float*)d_in[10]; a.e_n2 = (const float*)d_in[11];
    a.e_wg = (const float*)d_in[12]; a.e_wu = (const float*)d_in[13]; a.e_wd = (const float*)d_in[14];
    a.o_n1 = (const float*)d_in[15]; a.o_wqkv = (const float*)d_in[16]; a.o_bqkv = (const float*)d_in[17]; a.o_sinks = (const float*)d_in[18]; a.o_wo = (const float*)d_in[19]; a.o_bo = (const float*)d_in[20];
    a.o_n2 = (const float*)d_in[21]; a.o_rw = (const float*)d_in[22]; a.o_ewg = (const float*)d_in[23]; a.o_ewu = (const float*)d_in[24]; a.o_ewd = (const float*)d_in[25];
    a.out = (float*)d_out; a.ws = (unsigned char*)d_ws;
#if MK_ONE_LAUNCH
    a.lo = 0; a.hi = N_PHASES; a.li = 0;
    hipLaunchKernelGGL(fwd, dim3(grid), dim3(NWAVES * 64), LDS_BYTES, stream, a);
#else
    for (int p = 0; p < N_PHASES; ++p) { a.lo = p; a.hi = p + 1; a.li = p; hipLaunchKernelGGL(fwd, dim3(grid), dim3(NWAVES * 64), LDS_BYTES, stream, a); }
#endif
}
```

```cpp
#include <hip/hip_runtime.h>
#include <cstdio>
#include <cstdint>
#ifndef MK_ONE_LAUNCH
#define MK_ONE_LAUNCH 1
#endif
namespace pg8 {
#define PG8_LAS __attribute__((address_space(3)))
typedef unsigned short bf16_t;
typedef short bf16x8 __attribute__((ext_vector_type(8)));
typedef float f32x4 __attribute__((ext_vector_type(4)));
typedef unsigned u32x4 __attribute__((ext_vector_type(4)));
constexpr int BM = 256, BK = 64, HALF = 128, HTB = HALF * BK * 2  , STAGE_BYTES = 8 * HTB, NXCD = 8, WGM = 8;

__host__ __device__ __forceinline__ int lds_byte(int r, int c) { const int st = (r >> 4) * 2 + (c >> 5), rr = r & 15, cc = c & 31, ob = rr * 64 + cc * 2; return st * 1024 + (ob ^ (((ob >> 9) & 1) << 5)); }
__host__ __device__ __forceinline__ void stage_rc(int b, int& R, int& C) { const int st = b / 1024, sb = b % 1024, swz = sb ^ (((sb >> 9) & 1) << 5); R = (st >> 1) * 16 + swz / 64; C = (st & 1) * 32 + (swz % 64) / 2; }
__host__ __device__ __forceinline__ int perm32(int rho) { const int n = rho >> 4, i = rho & 15; return 8 * (i >> 2) + 4 * n + (i & 3); }

struct Unit { int pm, pn, e; };
struct Gemm { const bf16_t* A; const bf16_t* Bt; int K; size_t estride; };

struct StaticOrder {
    int nM, nN, nwg, G, c;
    __host__ __device__ void init(int M, int N, int G_, int c_) { nM = M / BM; nN = N / BM; nwg = nM * nN; G = G_; c = c_; }
    __host__ __device__ bool next(int i, Unit& u) const {
        const long L = (long)i * G + c; if (L >= nwg) return false;
        int wgid = (int)L; { const int q = nwg / NXCD, r = nwg % NXCD, xcd = wgid % NXCD, off = wgid / NXCD; wgid = (xcd < r ? xcd * (q + 1) : r * (q + 1) + (xcd - r) * q) + off; }
        const int nig = WGM * nN, gid = wgid / nig, fm = gid * WGM, gsz = (nM - fm) < WGM ? (nM - fm) : WGM;
        u.pm = fm + ((wgid % nig) % gsz); u.pn = (wgid % nig) / gsz; u.e = 0; return true;
    }
};
struct MoeOrder {
    int nM, nN, nwg, G, c; int p0, p1, p2, p3, p4, p5, p6;
    __device__ bool next(int i, Unit& u) const {
        const long L = (long)i * G + c; if (L >= nwg) return false;
        int wgid = (int)L; { const int q = nwg / NXCD, r = nwg % NXCD, xcd = wgid % NXCD, off = wgid / NXCD; wgid = (xcd < r ? xcd * (q + 1) : r * (q + 1) + (xcd - r) * q) + off; }
        const int nig = WGM * nN, gid = wgid / nig, fm = gid * WGM, gsz = (nM - fm) < WGM ? (nM - fm) : WGM;
        u.pm = fm + ((wgid % nig) % gsz); u.pn = (wgid % nig) / gsz;
        u.e = (u.pm >= p0) + (u.pm >= p1) + (u.pm >= p2) + (u.pm >= p3) + (u.pm >= p4) + (u.pm >= p5) + (u.pm >= p6); return true;
    }
};

__device__ __forceinline__ unsigned cvt_pk_bf16(float lo, float hi) { unsigned r; asm volatile("v_cvt_pk_bf16_f32 %0, %1, %2" : "=v"(r) : "v"(lo), "v"(hi)); return r; }
__device__ __forceinline__ u32x4 pack8(const f32x4 v0, const f32x4 v1) { u32x4 w; w.x = cvt_pk_bf16(v0[0], v0[1]); w.y = cvt_pk_bf16(v0[2], v0[3]); w.z = cvt_pk_bf16(v1[0], v1[1]); w.w = cvt_pk_bf16(v1[2], v1[3]); return w; }

struct EpiBf16Plain {
    static constexpr bool PERM = true;
    bf16_t* O; int ldc;
    __device__ __forceinline__ void operator()(const f32x4 (&acc)[2][2][4][2], const Unit& u, int wr, int wc, int fr, int fq) const {
        const int row0 = u.pm * BM + wr * 64 + fr, col0 = u.pn * BM + wc * 32 + 8 * fq;
#pragma unroll
        for (int ai = 0; ai < 2; ++ai)
#pragma unroll
            for (int m = 0; m < 4; ++m) { bf16_t* rowp = O + (size_t)(row0 + ai * HALF + m * 16) * ldc + col0;
#pragma unroll
                for (int bj = 0; bj < 2; ++bj) *(u32x4*)(rowp + bj * HALF) = pack8(acc[ai][bj][m][0], acc[ai][bj][m][1]); }
    }
};
__device__ __forceinline__ float silu_mul(float g, float u) { return g * u * __builtin_amdgcn_rcpf(1.0f + __builtin_amdgcn_exp2f(-1.4426950408889634f * g)); }
struct EpiSwiGLU {
    static constexpr bool PERM = true;
    bf16_t* O; int ldc;
    __device__ __forceinline__ void operator()(const f32x4 (&acc)[2][2][4][2], const Unit& u, int wr, int wc, int fr, int fq) const {
        const int row0 = u.pm * BM + wr * 64 + fr, col0 = u.pn * HALF + wc * 32 + 8 * fq;
#pragma unroll
        for (int ai = 0; ai < 2; ++ai)
#pragma unroll
            for (int m = 0; m < 4; ++m) { bf16_t* rowp = O + (size_t)(row0 + ai * HALF + m * 16) * ldc + col0;
                f32x4 v0, v1;
#pragma unroll
                for (int j = 0; j < 4; ++j) { v0[j] = silu_mul(acc[ai][0][m][0][j], acc[ai][1][m][0][j]); v1[j] = silu_mul(acc[ai][0][m][1][j], acc[ai][1][m][1][j]); }
                *(u32x4*)rowp = pack8(v0, v1); }
    }
};
struct EpiResF32 {
    static constexpr bool PERM = false;
    const float* base; float* out; int ldc; const float* bias;
    __device__ __forceinline__ void operator()(const f32x4 (&acc)[2][2][4][2], const Unit& u, int wr, int wc, int fr, int fq) const {
        const int row0 = u.pm * BM + wr * 64 + fr, col0 = u.pn * BM + wc * 32 + 4 * fq;
        f32x4 bv[2][2];
#pragma unroll
        for (int bj = 0; bj < 2; ++bj)
#pragma unroll
            for (int n = 0; n < 2; ++n) bv[bj][n] = bias ? *(const f32x4*)(bias + col0 + bj * HALF + n * 16) : (f32x4){0.f, 0.f, 0.f, 0.f};
#pragma unroll
        for (int ai = 0; ai < 2; ++ai)
#pragma unroll
            for (int m = 0; m < 4; ++m) { const size_t off = (size_t)(row0 + ai * HALF + m * 16) * ldc + col0;
#pragma unroll
                for (int bj = 0; bj < 2; ++bj)
#pragma unroll
                    for (int n = 0; n < 2; ++n) { const f32x4 b = *(const f32x4*)(base + off + bj * HALF + n * 16); *(f32x4*)(out + off + bj * HALF + n * 16) = b + acc[ai][bj][m][n] + bv[bj][n]; }
                asm volatile("" ::: "memory"); }
    }
};
struct EpiQKV {
    static constexpr bool PERM = true;
    bf16_t* O; const float* bias; const float* cs; float qscale;
    __device__ __forceinline__ void operator()(const f32x4 (&acc)[2][2][4][2], const Unit& u, int wr, int wc, int fr, int fq) const {
        const int row0 = u.pm * BM + wr * 64 + fr, colt = u.pn * BM, col0 = colt + wc * 32 + 8 * fq;
        const bool ropew = ((wc & 1) == 0);
        f32x4 bv[2][2];
#pragma unroll
        for (int bj = 0; bj < 2; ++bj)
#pragma unroll
            for (int n = 0; n < 2; ++n) bv[bj][n] = *(const f32x4*)(bias + col0 + bj * HALF + 4 * n);
        const float sgn = (fq == 0) ? -1.f : 1.f;
#pragma unroll
        for (int ai = 0; ai < 2; ++ai)
#pragma unroll
            for (int m = 0; m < 4; ++m) { const int row = row0 + ai * HALF + m * 16; bf16_t* rowp = O + (size_t)row * 1280 + col0;
                f32x4 c0 = (f32x4){1.f, 1.f, 1.f, 1.f}, c1 = c0, s0 = (f32x4){0.f, 0.f, 0.f, 0.f}, s1 = s0;
                if (ropew && fq < 2) { const f32x4* cp = (const f32x4*)(cs + (size_t)row * 16); c0 = cp[0]; c1 = cp[1]; s0 = cp[2] * sgn; s1 = cp[3] * sgn; }
#pragma unroll
                for (int bj = 0; bj < 2; ++bj) { f32x4 v0 = acc[ai][bj][m][0] + bv[bj][0], v1 = acc[ai][bj][m][1] + bv[bj][1];
                    const int gc = colt + bj * HALF;
                    if (ropew && gc < 1152) { f32x4 p0, p1;
#pragma unroll
                        for (int j = 0; j < 4; ++j) { p0[j] = __shfl_xor(v0[j], 16); p1[j] = __shfl_xor(v1[j], 16); }
                        v0 = v0 * c0 + p0 * s0; v1 = v1 * c1 + p1 * s1; }
                    if (gc < 1024) { v0 = v0 * qscale; v1 = v1 * qscale; }
                    *(u32x4*)(rowp + bj * HALF) = pack8(v0, v1); } }
    }
};
struct EpiMoeDown {
    static constexpr bool PERM = false;
    const int* rowtok; const float* rowgate; float* out;
    __device__ __forceinline__ void operator()(const f32x4 (&acc)[2][2][4][2], const Unit& u, int wr, int wc, int fr, int fq) const {
        const int slot0 = u.pm * BM + wr * 64 + fr, col0 = u.pn * BM + wc * 32 + 4 * fq;
#pragma unroll
        for (int ai = 0; ai < 2; ++ai)
#pragma unroll
            for (int m = 0; m < 4; ++m) { const int slot = slot0 + ai * HALF + m * 16; const int tok = rowtok[slot]; const float gate = rowgate[slot];
                if (tok >= 0) { float* rowp = out + (size_t)tok * 1024 + col0;
#pragma unroll
                    for (int bj = 0; bj < 2; ++bj)
#pragma unroll
                        for (int n = 0; n < 2; ++n) { const f32x4 b = *(const f32x4*)(rowp + bj * HALF + n * 16); *(f32x4*)(rowp + bj * HALF + n * 16) = b + acc[ai][bj][m][n] * gate; } }
                asm volatile("" ::: "memory"); }
    }
};

template <class Epi, class Sched, bool ALIGN_EPI = false, bool SP2 = false>
__device__ __forceinline__ void gemm_phase(PG8_LAS unsigned char* lds, const Gemm g, const Sched& S, const Epi& E) {
    int tid_ = threadIdx.x; asm volatile("" : "+v"(tid_));
    const int tid = tid_, wid = __builtin_amdgcn_readfirstlane(tid >> 6), lane = tid & 63, wr = wid >> 2, wc = wid & 3, fr = lane & 15, fq = lane >> 4;
    const int K = g.K, nt = K / BK;
    unsigned voffA[2], voffB[2];
#pragma unroll
    for (int i = 0; i < 2; ++i) { int R, C; stage_rc(tid * 16 + i * 8192, R, C); const int Rb = Epi::PERM ? ((R & ~31) + perm32(R & 31)) : R;
        voffA[i] = (unsigned)(R * K + C) * 2u; voffB[i] = (unsigned)(Rb * K + C) * 2u; }
    const size_t kstep = (size_t)(BK * 2);
    const size_t hstep = (size_t)HALF * K * 2;
    const size_t tstep = 2 * hstep;
    const unsigned ldsw = (unsigned)wid * 1024u;
    const int aoff = lds_byte(wr * 64 + fr, fq * 8), boff = lds_byte(wc * 32 + fr, fq * 8);
#define PG8_SA(b, h) (((b) * 2 + (h)) * HTB)
#define PG8_SB(b, h) ((4 + (b) * 2 + (h)) * HTB)
#define PG8_STAGE(bufoff, gbase, voff) do { _Pragma("unroll") for (int _i = 0; _i < 2; ++_i) \
        __builtin_amdgcn_global_load_lds((const unsigned*)((const char*)(gbase) + (voff)[_i]), (PG8_LAS unsigned*)(lds + (bufoff) + ldsw + _i * 8192), 16, 0, 0); } while (0)
#define PG8_LDA(dst, b, h) do { _Pragma("unroll") for (int m = 0; m < 4; ++m) _Pragma("unroll") for (int k = 0; k < 2; ++k) dst[m][k] = *(const PG8_LAS bf16x8*)(lds + PG8_SA(b, h) + aoff + m * 2048 + k * 1024); } while (0)
#define PG8_LDB(dst, b, h) do { _Pragma("unroll") for (int n = 0; n < 2; ++n) _Pragma("unroll") for (int k = 0; k < 2; ++k) dst[n][k] = *(const PG8_LAS bf16x8*)(lds + PG8_SB(b, h) + boff + n * 2048 + k * 1024); } while (0)
#define PG8_MMA(ai, bj, At, Bt) do { __builtin_amdgcn_s_setprio(1); _Pragma("unroll") for (int m = 0; m < 4; ++m) _Pragma("unroll") for (int n = 0; n < 2; ++n) _Pragma("unroll") for (int k = 0; k < 2; ++k) \
        acc[ai][bj][m][n] = __builtin_amdgcn_mfma_f32_16x16x32_bf16(Bt[n][k], At[m][k], acc[ai][bj][m][n], 0, 0, 0); __builtin_amdgcn_s_setprio(0); } while (0)
#define PG8_WAIT_V(n) asm volatile("s_waitcnt vmcnt(" #n ")" ::: "memory")
#define PG8_WAIT_L(n) asm volatile("s_waitcnt lgkmcnt(" #n ")" ::: "memory")
#define PG8_BAR __builtin_amdgcn_s_barrier()
#define PG8_SCHED __builtin_amdgcn_sched_barrier(0)
    Unit cur, nxt; int ui = 0;
    if (!S.next(0, cur)) return;
    f32x4 acc[2][2][4][2];
#pragma unroll
    for (int a = 0; a < 2; ++a)
#pragma unroll
        for (int b = 0; b < 2; ++b)
#pragma unroll
            for (int m = 0; m < 4; ++m)
#pragma unroll
                for (int n = 0; n < 2; ++n) acc[a][b][m][n] = (f32x4){0.f, 0.f, 0.f, 0.f};
    bf16x8 At[4][2], B0[2][2], B1[2][2];
    const char* cA = (const char*)g.A + (size_t)cur.pm * tstep; const char* cB = (const char*)g.Bt + (size_t)cur.e * g.estride + (size_t)cur.pn * tstep;
    if constexpr (SP2) {
        PG8_STAGE(PG8_SB(0, 0), cB, voffB); PG8_STAGE(PG8_SB(0, 1), cB + hstep, voffB); PG8_STAGE(PG8_SA(0, 0), cA, voffA); PG8_STAGE(PG8_SA(0, 1), cA + hstep, voffA);
        if (wr == 1) PG8_BAR;
        PG8_WAIT_V(2); PG8_BAR;
        PG8_STAGE(PG8_SB(1, 0), cB + kstep, voffB); PG8_STAGE(PG8_SA(1, 0), cA + kstep, voffA); PG8_STAGE(PG8_SB(1, 1), cB + hstep + kstep, voffB);
        PG8_WAIT_V(6); PG8_BAR;
    } else {
        PG8_STAGE(PG8_SB(0, 0), cB, voffB); PG8_STAGE(PG8_SA(0, 0), cA, voffA); PG8_STAGE(PG8_SB(0, 1), cB + hstep, voffB); PG8_STAGE(PG8_SA(0, 1), cA + hstep, voffA);
        if (wr == 1) PG8_BAR;
        PG8_WAIT_V(4); PG8_BAR;
        PG8_STAGE(PG8_SB(1, 0), cB + kstep, voffB); PG8_STAGE(PG8_SA(1, 0), cA + kstep, voffA); PG8_STAGE(PG8_SB(1, 1), cB + hstep + kstep, voffB);
        PG8_WAIT_V(6); PG8_BAR;
    }
    for (;;) {
        const bool has_next = S.next(ui + 1, nxt);
        const char* nA = has_next ? (const char*)g.A + (size_t)nxt.pm * tstep : cA; const char* nB = has_next ? (const char*)g.Bt + (size_t)nxt.e * g.estride + (size_t)nxt.pn * tstep : cB;
        for (int t = 0; t < nt; t += 2) {
            const bool last = (t == nt - 2);
            const char* a1 = cA + (size_t)(t + 1) * kstep;
            const char* a2 = last ? nA : cA + (size_t)(t + 2) * kstep; const char* b2 = last ? nB : cB + (size_t)(t + 2) * kstep;
            const char* a3 = a2 + kstep; const char* b3 = b2 + kstep;
            if constexpr (SP2) {
            PG8_LDB(B0, 0, 0); PG8_LDB(B1, 0, 1); PG8_SCHED; PG8_LDA(At, 0, 0); PG8_STAGE(PG8_SA(1, 1), a1 + hstep, voffA);
            PG8_WAIT_V(8); PG8_WAIT_L(0); PG8_BAR; PG8_MMA(0, 0, At, B0); PG8_MMA(0, 1, At, B1); PG8_BAR; PG8_SCHED;
            PG8_LDA(At, 0, 1); PG8_STAGE(PG8_SB(0, 0), b2, voffB); PG8_STAGE(PG8_SB(0, 1), b2 + hstep, voffB); PG8_STAGE(PG8_SA(0, 0), a2, voffA);
            PG8_WAIT_V(8); PG8_WAIT_L(0); PG8_BAR; PG8_MMA(1, 0, At, B0); PG8_MMA(1, 1, At, B1); PG8_BAR; PG8_SCHED;
            PG8_LDB(B0, 1, 0); PG8_LDB(B1, 1, 1); PG8_SCHED; PG8_LDA(At, 1, 0); PG8_STAGE(PG8_SA(0, 1), a2 + hstep, voffA);
            PG8_WAIT_V(8); PG8_WAIT_L(0); PG8_BAR; PG8_MMA(0, 0, At, B0); PG8_MMA(0, 1, At, B1); PG8_BAR; PG8_SCHED;
            PG8_LDA(At, 1, 1); PG8_STAGE(PG8_SB(1, 0), b3, voffB); PG8_STAGE(PG8_SB(1, 1), b3 + hstep, voffB); PG8_STAGE(PG8_SA(1, 0), a3, voffA);
            PG8_WAIT_V(8); PG8_WAIT_L(0); PG8_BAR; PG8_MMA(1, 0, At, B0); PG8_MMA(1, 1, At, B1); PG8_BAR; PG8_SCHED;
            } else {
            PG8_LDB(B0, 0, 0); PG8_SCHED; PG8_LDA(At, 0, 0); PG8_STAGE(PG8_SA(1, 1), a1 + hstep, voffA);
            PG8_WAIT_L(8); PG8_BAR; PG8_WAIT_L(0); PG8_MMA(0, 0, At, B0); PG8_BAR; PG8_SCHED;
            PG8_LDB(B1, 0, 1); PG8_STAGE(PG8_SB(0, 0), b2, voffB);
            PG8_BAR; PG8_WAIT_L(0); PG8_MMA(0, 1, At, B1); PG8_BAR;
            PG8_LDA(At, 0, 1); PG8_STAGE(PG8_SA(0, 0), a2, voffA);
            PG8_BAR; PG8_WAIT_L(0); PG8_MMA(1, 0, At, B0); PG8_BAR; PG8_SCHED;
            PG8_STAGE(PG8_SB(0, 1), b2 + hstep, voffB);
            PG8_WAIT_V(6); PG8_BAR; PG8_MMA(1, 1, At, B1); PG8_BAR;
            PG8_LDB(B0, 1, 0); PG8_SCHED; PG8_LDA(At, 1, 0); PG8_STAGE(PG8_SA(0, 1), a2 + hstep, voffA);
            PG8_WAIT_L(8); PG8_BAR; PG8_WAIT_L(0); PG8_MMA(0, 0, At, B0); PG8_BAR; PG8_SCHED;
            PG8_LDB(B1, 1, 1); PG8_STAGE(PG8_SB(1, 0), b3, voffB);
            PG8_BAR; PG8_WAIT_L(0); PG8_MMA(0, 1, At, B1); PG8_BAR;
            PG8_LDA(At, 1, 1); PG8_STAGE(PG8_SA(1, 0), a3, voffA);
            PG8_BAR; PG8_WAIT_L(0); PG8_MMA(1, 0, At, B0); PG8_BAR; PG8_SCHED;
            PG8_STAGE(PG8_SB(1, 1), b3 + hstep, voffB);
            PG8_WAIT_V(6); PG8_BAR; PG8_MMA(1, 1, At, B1); PG8_BAR;
            }
        }
        if constexpr (ALIGN_EPI) { if (wr == 0) PG8_BAR; }
        E(acc, cur, wr, wc, fr, fq);
        if (!has_next) break;
#pragma unroll
        for (int a = 0; a < 2; ++a)
#pragma unroll
            for (int b = 0; b < 2; ++b)
#pragma unroll
                for (int m = 0; m < 4; ++m)
#pragma unroll
                    for (int n = 0; n < 2; ++n) acc[a][b][m][n] = (f32x4){0.f, 0.f, 0.f, 0.f};
        cur = nxt; cA = nA; cB = nB; ++ui;
        if constexpr (ALIGN_EPI) { if (wr == 1) PG8_BAR; }
    }
    PG8_WAIT_V(0);
    if constexpr (!ALIGN_EPI) { if (wr == 0) PG8_BAR; }
    PG8_BAR;
#undef PG8_SA
#undef PG8_SB
#undef PG8_STAGE
#undef PG8_LDA
#undef PG8_LDB
#undef PG8_MMA
#undef PG8_WAIT_V
#undef PG8_WAIT_L
#undef PG8_BAR
#undef PG8_SCHED
}
}

constexpr int NWAVES = 8;
constexpr int NTOK = 65536, DM = 1024, SEQ = 8192;
constexpr int MIXIN = 2560, FFN = 2816, QKVD = 1280, EXPD = 3584, NEXP = 8;
constexpr int SETROWS = NTOK + NEXP * 256;
constexpr float EPS = 1e-5f;
constexpr float LOG2E = 1.4426950408889634f;
constexpr float QSCALE = 0.125f * LOG2E;

constexpr size_t MiB = 1u << 20;
constexpr size_t WS_CTL = 0, CTL_ZERO_BYTES = 1 * MiB;
constexpr size_t WS_CS = 1 * MiB;
constexpr size_t WS_TOKINFO = 5 * MiB;
constexpr size_t WS_ROWTOK = 7 * MiB;
constexpr size_t WS_ROWGATE = 8 * MiB;
constexpr size_t WS_WSP = 9 * MiB;
constexpr size_t WS_WIN = 16 * MiB, WS_WOUT = 21 * MiB, WS_FGU = 23 * MiB, WS_FD = 34 * MiB;
constexpr size_t WS_WQKV = 40 * MiB, WS_WO = 43 * MiB, WS_MGU = 45 * MiB, WS_MD = 157 * MiB;
constexpr size_t WS_XN = 216 * MiB;
constexpr size_t WS_XG = 344 * MiB;
constexpr size_t WS_BIG = 476 * MiB;
constexpr size_t WS_END = WS_BIG + (size_t)SETROWS * EXPD * 2;
static_assert(WS_MD + (size_t)NEXP * DM * EXPD * 2 <= WS_XN && WS_XN + (size_t)NTOK * DM * 2 <= WS_XG && WS_XG + (size_t)SETROWS * DM * 2 <= WS_BIG, "d_ws map");
static_assert(WS_FD + (size_t)DM * FFN * 2 <= WS_WQKV && WS_MGU + (size_t)NEXP * 2 * EXPD * DM * 2 <= WS_MD, "d_ws map (weights)");
constexpr int CW_BAR = 4096;
constexpr int CW_CNT = 16384;

constexpr int RING_BYTES = 131072;
constexpr int LDSCTL_OFF = RING_BYTES, MISC_OFF = LDSCTL_OFF + 320;
constexpr int LDS_BYTES = 147456;

#define GAS __attribute__((address_space(1)))
#define LAS __attribute__((address_space(3)))
typedef unsigned short bf16;
typedef unsigned v4u __attribute__((ext_vector_type(4)));
typedef unsigned v2u __attribute__((ext_vector_type(2)));
typedef float f32x4 __attribute__((ext_vector_type(4)));
typedef GAS unsigned gu32;
#define RLX_AGENT __ATOMIC_RELAXED, __HIP_MEMORY_SCOPE_AGENT
#define LDS_WAIT() asm volatile("s_waitcnt lgkmcnt(0)" ::: "memory")
#define VM_WAIT() asm volatile("s_waitcnt vmcnt(0)" ::: "memory")
__device__ __forceinline__ unsigned pk2(float lo, float hi) { return pg8::cvt_pk_bf16(lo, hi); }
__device__ __forceinline__ float bflo(unsigned w) { return __uint_as_float(w << 16); }
__device__ __forceinline__ float bfhi(unsigned w) { return __uint_as_float(w & 0xffff0000u); }
__device__ __forceinline__ float bf1(bf16 h) { return __uint_as_float(((unsigned)h) << 16); }
__device__ __forceinline__ bf16 f2bf1(float f) { return (bf16)(pk2(f, 0.f) & 0xffffu); }
__device__ __forceinline__ void unpack8(const v4u w, float (&f)[8]) { f[0] = bflo(w.x); f[1] = bfhi(w.x); f[2] = bflo(w.y); f[3] = bfhi(w.y); f[4] = bflo(w.z); f[5] = bfhi(w.z); f[6] = bflo(w.w); f[7] = bfhi(w.w); }
__device__ __forceinline__ v4u pack8f(const float (&f)[8]) { v4u w; w.x = pk2(f[0], f[1]); w.y = pk2(f[2], f[3]); w.z = pk2(f[4], f[5]); w.w = pk2(f[6], f[7]); return w; }
__device__ __forceinline__ float gelu_erf(float v) { return 0.5f * v * (1.0f + erff(v * 0.70710678118654752f)); }

#define XB_TMO      128
#define XB_XCNT(j)  (256  + 64 * (j))
#define XB_XSUB(j)  (1280 + 64 * (j))
#define XB_XGEN(j)  (2304 + 64 * (j))
#define XB_TOP      3328
#define XB_TOPGEN   3392
#define XCD_BAR_WORDS 3456
#define XB_SPIN_CAP (1u << 18)

__device__ __forceinline__ unsigned xb_ld(unsigned* p)              { return __hip_atomic_load(p, __ATOMIC_RELAXED, __HIP_MEMORY_SCOPE_AGENT); }
__device__ __forceinline__ unsigned xb_add(unsigned* p, unsigned v) { return __hip_atomic_fetch_add(p, v, __ATOMIC_RELAXED, __HIP_MEMORY_SCOPE_AGENT); }
__device__ __forceinline__ unsigned xb_xcc_id() { return (unsigned)__builtin_amdgcn_s_getreg((3 << 11) | 20) & 0xFu; }
#define XB_SPIN(cond, bar) do { unsigned _sp = 0; while (cond) { __builtin_amdgcn_s_sleep(1); \
    if ((++_sp & 255u) == 0u) { if (xb_ld(&(bar)[XB_TMO])) break; if (_sp > XB_SPIN_CAP) { atomicAdd(&(bar)[XB_TMO], 1u); break; } } } } while (0)

struct XcdBarrier {
    unsigned* bar; unsigned x;
    volatile LAS unsigned* st;
};

__device__ __forceinline__ XcdBarrier xcd_barrier_post(unsigned* bar, volatile LAS unsigned* st) {
    XcdBarrier b; b.bar = bar; b.x = xb_xcc_id(); b.st = st;
    if (threadIdx.x == 0) (void)xb_add(&bar[XB_XCNT(b.x)], 1u);
    return b;
}
__device__ __forceinline__ void xcd_barrier_complete(unsigned* bar, unsigned x, unsigned& nloc, unsigned& nx) {
    const unsigned G = gridDim.x * gridDim.y * gridDim.z;
    unsigned sum, cnt, mine, sp = 0u;
    for (;;) {
        sum = 0u; cnt = 0u; mine = 0u;
#pragma unroll
        for (unsigned j = 0; j < 16; ++j) { const unsigned c = xb_ld(&bar[XB_XCNT(j)]); sum += c; cnt += (c > 0u) ? 1u : 0u; mine = (j == x) ? c : mine; }
        if (sum == G) break;
        __builtin_amdgcn_s_sleep(1);
        if ((++sp & 255u) == 0u) { if (xb_ld(&bar[XB_TMO])) break; if (sp > XB_SPIN_CAP) { atomicAdd(&bar[XB_TMO], 1u); break; } }
    }
    nloc = mine > 0u ? mine : 1u; nx = cnt > 0u ? cnt : 1u;
}

__device__ __forceinline__ void xcd_barrier(const XcdBarrier& b) {
    asm volatile("s_waitcnt vmcnt(0)" ::: "memory");
    __syncthreads();
    if (threadIdx.x == 0) {
        unsigned* bar = b.bar;
        __builtin_amdgcn_s_waitcnt(0);
        unsigned nloc = b.st[0], nx = b.st[1];
        if (nloc == 0u) { xcd_barrier_complete(bar, b.x, nloc, nx); b.st[0] = nloc; b.st[1] = nx; }
        const unsigned old = xb_add(&bar[XB_XSUB(b.x)], 1u);
        const unsigned gen = old / nloc;
        if (old + 1u == (gen + 1u) * nloc) {
            __builtin_amdgcn_fence(__ATOMIC_RELEASE, "agent");
            asm volatile("s_waitcnt vmcnt(0)" ::: "memory");
            const unsigned og = xb_add(&bar[XB_TOP], 1u);
            const unsigned tg = og / nx;
            if (og + 1u == (tg + 1u) * nx) xb_add(&bar[XB_TOPGEN], 1u);
            else XB_SPIN(xb_ld(&bar[XB_TOPGEN]) == tg, bar);
            __builtin_amdgcn_fence(__ATOMIC_ACQUIRE, "agent");
            xb_add(&bar[XB_XGEN(b.x)], 1u);
            asm volatile("s_waitcnt vmcnt(0)" ::: "memory");
        } else {
            XB_SPIN(xb_ld(&bar[XB_XGEN(b.x)]) == gen, bar);
            __builtin_amdgcn_fence(__ATOMIC_ACQUIRE, "agent");
            asm volatile("s_waitcnt vmcnt(0)" ::: "memory");
        }
    }
    __syncthreads();
}

struct Frame {
    LAS unsigned char* lds;
    int tid, lane, wave;
    int vcu, G;
};
__device__ __forceinline__ float wave_sum(float v) {
#pragma unroll
    for (int o = 1; o < 64; o <<= 1) v += __shfl_xor(v, o);
    return v;
}

__device__ __forceinline__ void tr_item(const float* W, int N, int k0, int n0, bf16* WT, int K, int orow0, LAS float* scr, int lane) {
#pragma unroll 8
    for (int i = 0; i < 32; ++i) { const int kk = 2 * i + (lane >> 5); scr[kk * 33 + (lane & 31)] = W[(size_t)(k0 + kk) * N + n0 + (lane & 31)]; }
    LDS_WAIT(); asm volatile("" ::: "memory");
    const int c = lane & 7;
#pragma unroll
    for (int j = 0; j < 4; ++j) { const int n = (lane >> 3) + 8 * j; const LAS float* s = scr + (8 * c) * 33 + n;
        v4u o; o.x = pk2(s[0 * 33], s[1 * 33]); o.y = pk2(s[2 * 33], s[3 * 33]); o.z = pk2(s[4 * 33], s[5 * 33]); o.w = pk2(s[6 * 33], s[7 * 33]);
        *(GAS v4u*)(WT + (size_t)(orow0 + n) * K + k0 + 8 * c) = o; }
    LDS_WAIT(); asm volatile("" ::: "memory");
}
__device__ __forceinline__ void tr_plain(const float* W, int K, int N, bf16* WT, int item, LAS float* scr, int lane) {
    const int nblk = N / 32, kb = item / nblk, nb = item % nblk; tr_item(W, N, 64 * kb, 32 * nb, WT, K, 32 * nb, scr, lane);
}
__device__ __forceinline__ void tr_gu(const float* W, int K, int N, bf16* WT, int up, int item, LAS float* scr, int lane) {
    const int nblk = N / 32, kb = item / nblk, nb = item % nblk, n0 = 32 * nb; tr_item(W, N, 64 * kb, n0, WT, K, 256 * (n0 / 128) + 128 * up + (n0 % 128), scr, lane);
}

__device__ __forceinline__ void conv_even_phase(const Frame& F, const float* w_in, const float* w_out, const float* wg, const float* wu, const float* wd, const float* sw, unsigned char* ws) {
    LAS float* scr = (LAS float*)(F.lds + F.wave * 16384);
    const int gw = F.vcu * NWAVES + F.wave, NGW = F.G * NWAVES;
    constexpr int I_IN = (DM / 64) * (MIXIN / 32), I_OUT = (DM / 64) * (DM / 32), I_G = (DM / 64) * (FFN / 32), I_D = (FFN / 64) * (DM / 32);
    constexpr int NITEMS = I_IN + I_OUT + 2 * I_G + I_D;
    for (int it = gw; it < NITEMS; it += NGW) {
        int r = it;
        if (r < I_IN) { tr_plain(w_in, DM, MIXIN, (bf16*)(ws + WS_WIN), r, scr, F.lane); continue; } r -= I_IN;
        if (r < I_OUT) { tr_plain(w_out, DM, DM, (bf16*)(ws + WS_WOUT), r, scr, F.lane); continue; } r -= I_OUT;
        if (r < I_G) { tr_gu(wg, DM, FFN, (bf16*)(ws + WS_FGU), 0, r, scr, F.lane); continue; } r -= I_G;
        if (r < I_G) { tr_gu(wu, DM, FFN, (bf16*)(ws + WS_FGU), 1, r, scr, F.lane); continue; } r -= I_G;
        tr_plain(wd, FFN, DM, (bf16*)(ws + WS_FD), r, scr, F.lane);
    }
    float* wsp = (float*)(ws + WS_WSP);
    for (int idx = (F.vcu * NWAVES * 64) + F.tid; idx < 4 * 128 * 128; idx += F.G * NWAVES * 64) { const int ii = (idx >> 7) & 127, jj = idx & 127; wsp[idx] = (jj <= ii) ? sw[idx] : 0.f; }
}
__device__ __forceinline__ void conv_odd_phase(const Frame& F, const float* wqkv, const float* wo, const float* ewg, const float* ewu, const float* ewd, unsigned char* ws) {
    LAS float* scr = (LAS float*)(F.lds + F.wave * 16384);
    const int gw = F.vcu * NWAVES + F.wave, NGW = F.G * NWAVES;
    constexpr int I_Q = (DM / 64) * (QKVD / 32), I_O = (DM / 64) * (DM / 32), I_G = (DM / 64) * (EXPD / 32), I_D = (EXPD / 64) * (DM / 32);
    constexpr int NITEMS = I_Q + I_O + NEXP * (2 * I_G + I_D);
    for (int it = gw; it < NITEMS; it += NGW) {
        int r = it;
        if (r < I_Q) { tr_plain(wqkv, DM, QKVD, (bf16*)(ws + WS_WQKV), r, scr, F.lane); continue; } r -= I_Q;
        if (r < I_O) { tr_plain(wo, DM, DM, (bf16*)(ws + WS_WO), r, scr, F.lane); continue; } r -= I_O;
        const int e = r / (2 * I_G + I_D); r -= e * (2 * I_G + I_D);
        bf16* gu = (bf16*)(ws + WS_MGU) + (size_t)e * 2 * EXPD * DM; bf16* dd = (bf16*)(ws + WS_MD) + (size_t)e * DM * EXPD;
        if (r < I_G) { tr_gu(ewg + (size_t)e * DM * EXPD, DM, EXPD, gu, 0, r, scr, F.lane); continue; } r -= I_G;
        if (r < I_G) { tr_gu(ewu + (size_t)e * DM * EXPD, DM, EXPD, gu, 1, r, scr, F.lane); continue; } r -= I_G;
        tr_plain(ewd + (size_t)e * EXPD * DM, EXPD, DM, dd, r, scr, F.lane);
    }
}
__device__ __forceinline__ void rope_table_phase(const Frame& F, const int* pos, float* cs) {
    for (int idx = (F.vcu * NWAVES * 64) + F.tid; idx < NTOK * 8; idx += F.G * NWAVES * 64) {
        const int t = idx >> 3, i = idx & 7;
        const float inv = (float)exp(-log(500000.0) * (double)(2 * i) / 16.0);
        const float ang = (float)pos[t] * inv;
        cs[(size_t)t * 16 + i] = (float)cos((double)ang); cs[(size_t)t * 16 + 8 + i] = (float)sin((double)ang);
    }
}
__device__ __forceinline__ void rms_phase(const Frame& F, const float* hin, const float* g, bf16* XN) {
    const int gw = F.vcu * NWAVES + F.wave, NGW = F.G * NWAVES;
    f32x4 gv[4];
#pragma unroll
    for (int j = 0; j < 4; ++j) gv[j] = ((const f32x4*)g)[F.lane + 64 * j];
    for (int m = gw; m < NTOK; m += NGW) {
        const GAS f32x4* xr = (const GAS f32x4*)(hin + (size_t)m * DM) + F.lane;
        f32x4 v[4]; float s = 0.f;
#pragma unroll
        for (int j = 0; j < 4; ++j) { v[j] = xr[64 * j]; s += (v[j].x * v[j].x + v[j].y * v[j].y) + (v[j].z * v[j].z + v[j].w * v[j].w); }
        const float rstd = 1.0f / sqrtf(wave_sum(s) * (1.f / DM) + EPS);
        GAS v2u* o8 = (GAS v2u*)(XN + (size_t)m * DM) + F.lane;
#pragma unroll
        for (int j = 0; j < 4; ++j) { const f32x4 y = v[j] * rstd * gv[j]; v2u w; w.x = pk2(y.x, y.y); w.y = pk2(y.z, y.w); o8[64 * j] = w; }
    }
}
__device__ __forceinline__ void rms_final_phase(const Frame& F, float* h, const float* g) {
    const int gw = F.vcu * NWAVES + F.wave, NGW = F.G * NWAVES;
    f32x4 gv[4];
#pragma unroll
    for (int j = 0; j < 4; ++j) gv[j] = ((const f32x4*)g)[F.lane + 64 * j];
    for (int m = gw; m < NTOK; m += NGW) {
        GAS f32x4* xr = (GAS f32x4*)(h + (size_t)m * DM) + F.lane;
        f32x4 v[4]; float s = 0.f;
#pragma unroll
        for (int j = 0; j < 4; ++j) { v[j] = xr[64 * j]; s += (v[j].x * v[j].x + v[j].y * v[j].y) + (v[j].z * v[j].z + v[j].w * v[j].w); }
        const float rstd = 1.0f / sqrtf(wave_sum(s) * (1.f / DM) + EPS);
#pragma unroll
        for (int j = 0; j < 4; ++j) xr[64 * j] = v[j] * rstd * gv[j];
    }
}
__device__ __forceinline__ void rms_router_phase(const Frame& F, const float* h, const float* g, const float* rw, bf16* XN, unsigned* gcnt, unsigned* tokinfo, int* rowtok) {
    for (int idx = (F.vcu * NWAVES * 64) + F.tid; idx < 2 * SETROWS; idx += F.G * NWAVES * 64) rowtok[idx] = -1;
    LAS unsigned* lcnt = (LAS unsigned*)F.lds;
    LAS unsigned* lbase = lcnt + 16;
    LAS unsigned* rec = lcnt + 64;
    f32x4 gv[4];
#pragma unroll
    for (int j = 0; j < 4; ++j) gv[j] = ((const f32x4*)g)[F.lane + 64 * j];
    f32x4 rwv[4][4][2];
#pragma unroll
    for (int j = 0; j < 4; ++j)
#pragma unroll
        for (int c = 0; c < 4; ++c) { const f32x4* p = (const f32x4*)(rw + (size_t)(256 * j + 4 * F.lane + c) * 8); rwv[j][c][0] = p[0]; rwv[j][c][1] = p[1]; }
    for (int panel = F.vcu; panel < NTOK / 256; panel += F.G) {
        if (F.tid < 16) lcnt[F.tid] = 0u;
        __syncthreads();
        for (int r = 0; r < 32; ++r) {
            const int lrow = F.wave * 32 + r, m = panel * 256 + lrow;
            const GAS f32x4* xr = (const GAS f32x4*)(h + (size_t)m * DM) + F.lane;
            f32x4 v[4]; float s = 0.f;
#pragma unroll
            for (int j = 0; j < 4; ++j) { v[j] = xr[64 * j]; s += (v[j].x * v[j].x + v[j].y * v[j].y) + (v[j].z * v[j].z + v[j].w * v[j].w); }
            const float rstd = 1.0f / sqrtf(wave_sum(s) * (1.f / DM) + EPS);
            GAS v2u* o8 = (GAS v2u*)(XN + (size_t)m * DM) + F.lane;
            f32x4 l0 = (f32x4){0.f, 0.f, 0.f, 0.f}, l1 = l0;
#pragma unroll
            for (int j = 0; j < 4; ++j) { const f32x4 y = v[j] * rstd * gv[j]; v2u w; w.x = pk2(y.x, y.y); w.y = pk2(y.z, y.w); o8[64 * j] = w;
                l0 += rwv[j][0][0] * y.x + rwv[j][1][0] * y.y + rwv[j][2][0] * y.z + rwv[j][3][0] * y.w;
                l1 += rwv[j][0][1] * y.x + rwv[j][1][1] * y.y + rwv[j][2][1] * y.z + rwv[j][3][1] * y.w; }
            float lg[8];
#pragma unroll
            for (int e = 0; e < 4; ++e) { lg[e] = wave_sum(l0[e]); lg[4 + e] = wave_sum(l1[e]); }
            int e1 = 0; float v1 = lg[0];
#pragma unroll
            for (int e = 1; e < 8; ++e) if (lg[e] > v1) { v1 = lg[e]; e1 = e; }
            int e2 = -1; float v2 = -INFINITY;
#pragma unroll
            for (int e = 0; e < 8; ++e) if (e != e1 && (e2 < 0 || lg[e] > v2)) { v2 = lg[e]; e2 = e; }
            const float g2 = 1.0f / (1.0f + expf(v1 - v2)), g1 = 1.0f - g2;
            if (F.lane == 0) {
                const unsigned p1 = atomicAdd((unsigned*)(lcnt + e1), 1u), p2 = atomicAdd((unsigned*)(lcnt + 8 + e2), 1u);
                LAS unsigned* rr = rec + lrow * 8; rr[0] = (unsigned)e1; rr[1] = p1; rr[2] = __float_as_uint(g1); rr[3] = (unsigned)e2; rr[4] = p2; rr[5] = __float_as_uint(g2);
            }
        }
        __syncthreads();
        if (F.tid < 16) lbase[F.tid] = __hip_atomic_fetch_add(gcnt + F.tid, lcnt[F.tid], RLX_AGENT);
        __syncthreads();
        if (F.tid < 256) { const LAS unsigned* rr = rec + F.tid * 8; v4u a, b; a.x = rr[0]; a.y = rr[1] + lbase[rr[0]]; a.z = rr[2]; a.w = rr[3]; b.x = rr[4] + lbase[8 + rr[3]]; b.y = rr[5]; b.z = 0u; b.w = 0u;
            GAS v4u* ti = (GAS v4u*)(tokinfo + (size_t)(panel * 256 + F.tid) * 8); ti[0] = a; ti[1] = b; }
        __syncthreads();
    }
}
__device__ __forceinline__ void moe_prefix(const unsigned* gcnt_set, int (&pend)[8]) {
    int acc = 0;
#pragma unroll
    for (int e = 0; e < 8; ++e) { const unsigned c = __hip_atomic_load(gcnt_set + e, RLX_AGENT); acc += (int)((c + 255u) >> 8); pend[e] = acc; }
}
__device__ __forceinline__ void gather_phase(const Frame& F, int s, const unsigned* gcnt, const unsigned* tokinfo, const bf16* XN, bf16* XG, int* rowtok, float* rowgate) {
    int pend[8]; moe_prefix(gcnt + 8 * s, pend);
    const int gw = F.vcu * NWAVES + F.wave, NGW = F.G * NWAVES;
    for (int t = gw; t < NTOK; t += NGW) {
        const unsigned* ti = tokinfo + (size_t)t * 8 + 3 * s;
        const int e = (int)ti[0]; const unsigned pos = (s == 0) ? ti[1] : ti[1]; const unsigned gb = ti[2];
        int pstart = 0;
#pragma unroll
        for (int k = 0; k < 7; ++k) pstart = (e == k + 1) ? pend[k] : pstart;
        const size_t slot = (size_t)pstart * 256 + pos;
        const GAS v4u* src = (const GAS v4u*)(XN + (size_t)t * DM); GAS v4u* dst = (GAS v4u*)(XG + slot * DM);
        const v4u a = src[F.lane], b = src[64 + F.lane]; dst[F.lane] = a; dst[64 + F.lane] = b;
        if (F.lane == 0) { rowtok[(size_t)s * SETROWS + slot] = t; rowgate[(size_t)s * SETROWS + slot] = __uint_as_float(gb); }
    }
}

__device__ __forceinline__ void mixer_token_phase(const Frame& F, bf16* Z, bf16* Y, const float* convw, const float* lng, const float* lnb) {
    const int gw = F.vcu * NWAVES + F.wave, NGW = F.G * NWAVES, c8 = 8 * F.lane;
    float cw0[8], cw1[8], cw2[8], lg[8], lb[8];
#pragma unroll
    for (int j = 0; j < 8; ++j) { cw0[j] = convw[(c8 + j) * 3 + 0]; cw1[j] = convw[(c8 + j) * 3 + 1]; cw2[j] = convw[(c8 + j) * 3 + 2]; lg[j] = lng[c8 + j]; lb[j] = lnb[c8 + j]; }
    for (int base = gw * 32; base < NTOK; base += NGW * 32) {
        float cx1[8], cx2[8];
        if ((base % SEQ) != 0) {
            float a[8], b[8];
            unpack8(*(const GAS v4u*)(Z + (size_t)(base - 1) * MIXIN + 512 + c8), a); unpack8(*(const GAS v4u*)(Z + (size_t)(base - 1) * MIXIN + 1024 + c8), b);
#pragma unroll
            for (int j = 0; j < 8; ++j) cx1[j] = a[j] * b[j];
            unpack8(*(const GAS v4u*)(Z + (size_t)(base - 2) * MIXIN + 512 + c8), a); unpack8(*(const GAS v4u*)(Z + (size_t)(base - 2) * MIXIN + 1024 + c8), b);
#pragma unroll
            for (int j = 0; j < 8; ++j) cx2[j] = a[j] * b[j];
        } else {
#pragma unroll
            for (int j = 0; j < 8; ++j) { cx1[j] = 0.f; cx2[j] = 0.f; }
        }
        for (int r = 0; r < 32; ++r) {
            const size_t t = (size_t)(base + r);
            bf16* zr = Z + t * MIXIN; bf16* yr = Y + t * DM;
            float ab[8], ac[8], ax[8], bu[8], bv[8];
            unpack8(*(const GAS v4u*)(zr + c8), ab); unpack8(*(const GAS v4u*)(zr + 512 + c8), ac); unpack8(*(const GAS v4u*)(zr + 1024 + c8), ax);
            unpack8(*(const GAS v4u*)(zr + 1536 + c8), bu); unpack8(*(const GAS v4u*)(zr + 2048 + c8), bv);
            float ya[8], uu[8], vv[8]; float s = 0.f;
#pragma unroll
            for (int j = 0; j < 8; ++j) { const float cx0 = ac[j] * ax[j]; ya[j] = ab[j] * (cw0[j] * cx2[j] + cw1[j] * cx1[j] + cw2[j] * cx0); cx2[j] = cx1[j]; cx1[j] = cx0;
                uu[j] = gelu_erf(bu[j]); vv[j] = gelu_erf(bv[j]); s += vv[j]; }
            const float mu = wave_sum(s) * (1.f / 512.f); float q = 0.f;
#pragma unroll
            for (int j = 0; j < 8; ++j) { vv[j] -= mu; q += vv[j] * vv[j]; }
            const float rstd = 1.0f / sqrtf(wave_sum(q) * (1.f / 512.f) + EPS);
#pragma unroll
            for (int j = 0; j < 8; ++j) vv[j] = vv[j] * rstd * lg[j] + lb[j];
            *(GAS v4u*)(yr + c8) = pack8f(ya); *(GAS v4u*)(yr + 512 + c8) = pack8f(uu); *(GAS v4u*)(zr + 2048 + c8) = pack8f(vv);
        }
    }
}
__device__ __forceinline__ void spatial_naive_phase(const Frame& F, const bf16* Z, bf16* Y, const float* wsp, const float* sb) {
    const int c = F.tid, h = __builtin_amdgcn_readfirstlane(F.tid >> 7);
    for (int unit = F.vcu; unit < NTOK / 128; unit += F.G) {
        const size_t t0 = (size_t)unit * 128;
        float vn[128];
#pragma unroll
        for (int j = 0; j < 128; ++j) vn[j] = bf1(Z[(t0 + j) * MIXIN + 2048 + c]);
        for (int i = 0; i < 128; ++i) {
            const float* wrow = wsp + (size_t)(h * 128 + i) * 128;
            float a0 = 0.f, a1 = 0.f, a2 = 0.f, a3 = 0.f;
#pragma unroll
            for (int j = 0; j < 128; j += 4) { a0 += wrow[j] * vn[j]; a1 += wrow[j + 1] * vn[j + 1]; a2 += wrow[j + 2] * vn[j + 2]; a3 += wrow[j + 3] * vn[j + 3]; }
            const float mixed = (a0 + a1) + (a2 + a3) + sb[h * 128 + i];
            bf16* yp = Y + (t0 + i) * DM + 512 + c; *yp = f2bf1(bf1(*yp) * mixed);
        }
    }
}
__device__ __forceinline__ void attn_naive_phase(const Frame& F, const bf16* QKV, const float* sinks, bf16* AO) {
    LAS unsigned char* Ks = F.lds; LAS unsigned char* Vs = F.lds + 256 * 144;
    for (int unit = F.vcu; unit < 8 * 64 * 2; unit += F.G) {
        const int b = unit >> 7, n = (unit >> 1) & 63, hk = unit & 1;
        const size_t tb = (size_t)b * SEQ;
#pragma unroll
        for (int i = 0; i < 4; ++i) { const int p = F.tid + 512 * i, key = p >> 3, ch = p & 7;
            const int kt = (n == 0 && key < 128) ? key : (n - 1) * 128 + key;
            const bf16* src = QKV + (tb + kt) * QKVD + 1024 + hk * 64 + ch * 8;
            *(LAS v4u*)(Ks + key * 144 + ch * 16) = *(const GAS v4u*)src; *(LAS v4u*)(Vs + key * 144 + ch * 16) = *(const GAS v4u*)(src + 128); }
        __syncthreads();
#pragma unroll 1
        for (int it = 0; it < 2; ++it) {
            const int q = F.tid & 127, head = hk * 8 + (F.tid >> 7) + 4 * it;
            const size_t qrow = tb + (size_t)n * 128 + q;
            float qv[64], o[64];
#pragma unroll
            for (int c = 0; c < 8; ++c) { float f[8]; unpack8(*(const GAS v4u*)(QKV + qrow * QKVD + head * 64 + c * 8), f);
#pragma unroll
                for (int j = 0; j < 8; ++j) { qv[c * 8 + j] = f[j]; o[c * 8 + j] = 0.f; } }
            float mx = sinks[head] * LOG2E, l = 1.0f;
            for (int k = 1; k <= 128; ++k) {
                const int s = q + k;
                if (n == 0 && s < 128) continue;
                float d0 = 0.f, d1 = 0.f;
#pragma unroll
                for (int c = 0; c < 8; ++c) { float f[8]; unpack8(*(const LAS v4u*)(Ks + s * 144 + c * 16), f);
#pragma unroll
                    for (int j = 0; j < 8; j += 2) { d0 += qv[c * 8 + j] * f[j]; d1 += qv[c * 8 + j + 1] * f[j + 1]; } }
                const float sc = d0 + d1, mn = fmaxf(mx, sc), al = __builtin_amdgcn_exp2f(mx - mn), p = __builtin_amdgcn_exp2f(sc - mn);
                l = l * al + p; mx = mn;
#pragma unroll
                for (int c = 0; c < 8; ++c) { float f[8]; unpack8(*(const LAS v4u*)(Vs + s * 144 + c * 16), f);
#pragma unroll
                    for (int j = 0; j < 8; ++j) o[c * 8 + j] = o[c * 8 + j] * al + p * f[j]; }
            }
            const float il = 1.0f / l;
#pragma unroll
            for (int c = 0; c < 8; ++c) { float f[8];
#pragma unroll
                for (int j = 0; j < 8; ++j) f[j] = o[c * 8 + j] * il;
                *(GAS v4u*)(AO + qrow * DM + head * 64 + c * 8) = pack8f(f); }
        }
        __syncthreads();
    }
}

struct Args {
    const float* x; const int* pos; const float* fng;
    const float *e_n1, *e_win, *e_conv, *e_lng, *e_lnb, *e_sw, *e_sb, *e_wout, *e_n2, *e_wg, *e_wu, *e_wd;
    const float *o_n1, *o_wqkv, *o_bqkv, *o_sinks, *o_wo, *o_bo, *o_n2, *o_rw, *o_ewg, *o_ewu, *o_ewd;
    float* out; unsigned char* ws; int lo, hi, li, pad;
};
constexpr int PH_PER_PAIR = 19;
constexpr int N_PHASES = 1 + 2 * PH_PER_PAIR + 1;

typedef const __attribute__((address_space(4))) Args* ArgsP;
#define PH_ARGS(ap) ArgsP ap = (ArgsP)__builtin_amdgcn_kernarg_segment_ptr(); asm volatile("" : "+s"(ap))
__device__ __forceinline__ Frame make_frame(LAS unsigned char* lds) {
    Frame F; int tid = threadIdx.x; asm volatile("" : "+v"(tid));
    F.lds = lds; F.tid = tid; F.lane = tid & 63; F.wave = __builtin_amdgcn_readfirstlane(tid >> 6);
    F.G = gridDim.x; { const int bx = blockIdx.x; F.vcu = (F.G % 8 == 0) ? (bx % 8) * (F.G / 8) + bx / 8 : bx; }
    return F;
}
__global__ void __launch_bounds__(NWAVES * 64, 2) fwd(Args A_unused) {
    extern __shared__ __attribute__((aligned(16))) unsigned char lds_raw[];
    LAS unsigned char* const lds = (LAS unsigned char*)lds_raw;
    for (int u = threadIdx.x; u < (LDS_BYTES - LDSCTL_OFF) / 4; u += NWAVES * 64) ((LAS unsigned*)(lds + LDSCTL_OFF))[u] = 0u;
    __syncthreads();
    int lo, hi;
    { PH_ARGS(ap); lo = ap->lo; hi = ap->hi; }
#if MK_ONE_LAUNCH
    XcdBarrier bar;
    { PH_ARGS(ap); bar = xcd_barrier_post((unsigned*)(ap->ws + WS_CTL) + CW_BAR, (volatile LAS unsigned*)(lds + MISC_OFF) + 8); }
#define GRID_BAR() xcd_barrier(bar)
#else
#define GRID_BAR() do { } while (0)
#endif
#ifndef PHMASK
#define PHMASK 0xFFFFFFFFu
#endif
#define PHEN(k) (((PHMASK) >> (k)) & 1u)
#define IN(k) (lo <= (k) && (k) < hi)
#define SEAM(k) do { if (IN(k) && IN((k) + 1)) GRID_BAR(); } while (0)
#define PH_BEGIN() PH_ARGS(ap); const Frame F = make_frame(lds); unsigned char* const ws = ap->ws; const int G = F.G, cblk = (int)blockIdx.x; (void)G; (void)cblk

    if (IN(0) && PHEN(16)) { PH_BEGIN(); rope_table_phase(F, ap->pos, (float*)(ws + WS_CS)); } SEAM(0);

#pragma unroll 1
    for (int i = 0; i < 2; ++i) {
        const int pb = 1 + i * PH_PER_PAIR;
        if (IN(pb + 0) && PHEN(0)) { PH_BEGIN(); conv_even_phase(F, ap->e_win + (size_t)i * DM * MIXIN, ap->e_wout + (size_t)i * DM * DM, ap->e_wg + (size_t)i * DM * FFN, ap->e_wu + (size_t)i * DM * FFN, ap->e_wd + (size_t)i * FFN * DM, ap->e_sw + (size_t)i * 4 * 128 * 128, ws);
                          rms_phase(F, (i == 0) ? ap->x : ap->out, ap->e_n1 + i * DM, (bf16*)(ws + WS_XN)); } SEAM(pb + 0);
        if (IN(pb + 1) && PHEN(1)) { PH_BEGIN(); pg8::Gemm g{(const bf16*)(ws + WS_XN), (const bf16*)(ws + WS_WIN), DM, 0}; pg8::StaticOrder S; S.init(NTOK, MIXIN, G, cblk); pg8::EpiBf16Plain E{(bf16*)(ws + WS_BIG), MIXIN};
                          pg8::gemm_phase<pg8::EpiBf16Plain, pg8::StaticOrder, true, true>(F.lds, g, S, E); } SEAM(pb + 1);
        if (IN(pb + 2) && PHEN(2)) { PH_BEGIN(); mixer_token_phase(F, (bf16*)(ws + WS_BIG), (bf16*)(ws + WS_XN), ap->e_conv + i * 512 * 3, ap->e_lng + i * 512, ap->e_lnb + i * 512); } SEAM(pb + 2);
        if (IN(pb + 3) && PHEN(3)) { PH_BEGIN(); spatial_naive_phase(F, (const bf16*)(ws + WS_BIG), (bf16*)(ws + WS_XN), (const float*)(ws + WS_WSP), ap->e_sb + i * 4 * 128); } SEAM(pb + 3);
        if (IN(pb + 4) && PHEN(4)) { PH_BEGIN(); pg8::Gemm g{(const bf16*)(ws + WS_XN), (const bf16*)(ws + WS_WOUT), DM, 0}; pg8::StaticOrder S; S.init(NTOK, DM, G, cblk); pg8::EpiResF32 E{(i == 0) ? ap->x : ap->out, ap->out, DM, nullptr};
                          pg8::gemm_phase<pg8::EpiResF32, pg8::StaticOrder, true, true>(F.lds, g, S, E); } SEAM(pb + 4);
        if (IN(pb + 5) && PHEN(5)) { PH_BEGIN(); rms_phase(F, ap->out, ap->e_n2 + i * DM, (bf16*)(ws + WS_XN)); } SEAM(pb + 5);
        if (IN(pb + 6) && PHEN(6)) { PH_BEGIN(); pg8::Gemm g{(const bf16*)(ws + WS_XN), (const bf16*)(ws + WS_FGU), DM, 0}; pg8::StaticOrder S; S.init(NTOK, 2 * FFN, G, cblk); pg8::EpiSwiGLU E{(bf16*)(ws + WS_BIG), FFN};
                          pg8::gemm_phase<pg8::EpiSwiGLU, pg8::StaticOrder, true, true>(F.lds, g, S, E); } SEAM(pb + 6);
        if (IN(pb + 7) && PHEN(7)) { PH_BEGIN(); pg8::Gemm g{(const bf16*)(ws + WS_BIG), (const bf16*)(ws + WS_FD), FFN, 0}; pg8::StaticOrder S; S.init(NTOK, DM, G, cblk); pg8::EpiResF32 E{ap->out, ap->out, DM, nullptr};
                          pg8::gemm_phase<pg8::EpiResF32, pg8::StaticOrder, true, true>(F.lds, g, S, E); } SEAM(pb + 7);
        if (IN(pb + 8) && PHEN(8)) { PH_BEGIN(); conv_odd_phase(F, ap->o_wqkv + (size_t)i * DM * QKVD, ap->o_wo + (size_t)i * DM * DM, ap->o_ewg + (size_t)i * NEXP * DM * EXPD, ap->o_ewu + (size_t)i * NEXP * DM * EXPD, ap->o_ewd + (size_t)i * NEXP * EXPD * DM, ws);
                          rms_phase(F, ap->out, ap->o_n1 + i * DM, (bf16*)(ws + WS_XN)); } SEAM(pb + 8);
        if (IN(pb + 9) && PHEN(9)) { PH_BEGIN(); pg8::Gemm g{(const bf16*)(ws + WS_XN), (const bf16*)(ws + WS_WQKV), DM, 0}; pg8::StaticOrder S; S.init(NTOK, QKVD, G, cblk); pg8::EpiQKV E{(bf16*)(ws + WS_BIG), ap->o_bqkv + i * QKVD, (const float*)(ws + WS_CS), QSCALE};
                          pg8::gemm_phase<pg8::EpiQKV, pg8::StaticOrder, true, true>(F.lds, g, S, E); } SEAM(pb + 9);
        if (IN(pb + 10) && PHEN(10)) { PH_BEGIN(); attn_naive_phase(F, (const bf16*)(ws + WS_BIG), ap->o_sinks + i * 16, (bf16*)(ws + WS_XN)); } SEAM(pb + 10);
        if (IN(pb + 11) && PHEN(11)) { PH_BEGIN(); pg8::Gemm g{(const bf16*)(ws + WS_XN), (const bf16*)(ws + WS_WO), DM, 0}; pg8::StaticOrder S; S.init(NTOK, DM, G, cblk); pg8::EpiResF32 E{ap->out, ap->out, DM, ap->o_bo + i * DM};
                           pg8::gemm_phase<pg8::EpiResF32, pg8::StaticOrder, true, true>(F.lds, g, S, E); } SEAM(pb + 11);
        if (IN(pb + 12) && PHEN(12)) { PH_BEGIN(); rms_router_phase(F, ap->out, ap->o_n2 + i * DM, ap->o_rw + (size_t)i * DM * NEXP, (bf16*)(ws + WS_XN), (unsigned*)(ws + WS_CTL) + CW_CNT + 64 * i, (unsigned*)(ws + WS_TOKINFO), (int*)(ws + WS_ROWTOK)); } SEAM(pb + 12);
#pragma unroll 1
        for (int s = 0; s < 2; ++s) {
            const int ps = pb + 13 + 3 * s;
            if (IN(ps + 0) && PHEN(13)) { PH_BEGIN(); gather_phase(F, s, (const unsigned*)(ws + WS_CTL) + CW_CNT + 64 * i, (const unsigned*)(ws + WS_TOKINFO), (const bf16*)(ws + WS_XN), (bf16*)(ws + WS_XG), (int*)(ws + WS_ROWTOK), (float*)(ws + WS_ROWGATE)); } SEAM(ps + 0);
            if (IN(ps + 1) && PHEN(14)) { PH_BEGIN(); int pend[8]; moe_prefix((const unsigned*)(ws + WS_CTL) + CW_CNT + 64 * i + 8 * s, pend);
                pg8::MoeOrder S; S.nM = pend[7]; S.nN = 2 * EXPD / 256; S.nwg = S.nM * S.nN; S.G = G; S.c = cblk; S.p0 = pend[0]; S.p1 = pend[1]; S.p2 = pend[2]; S.p3 = pend[3]; S.p4 = pend[4]; S.p5 = pend[5]; S.p6 = pend[6];
                pg8::Gemm g{(const bf16*)(ws + WS_XG), (const bf16*)(ws + WS_MGU), DM, (size_t)2 * EXPD * DM * 2}; pg8::EpiSwiGLU E{(bf16*)(ws + WS_BIG), EXPD};
                pg8::gemm_phase<pg8::EpiSwiGLU, pg8::MoeOrder, true, true>(F.lds, g, S, E); } SEAM(ps + 1);
            if (IN(ps + 2) && PHEN(15)) { PH_BEGIN(); int pend[8]; moe_prefix((const unsigned*)(ws + WS_CTL) + CW_CNT + 64 * i + 8 * s, pend);
                pg8::MoeOrder S; S.nM = pend[7]; S.nN = DM / 256; S.nwg = S.nM * S.nN; S.G = G; S.c = cblk; S.p0 = pend[0]; S.p1 = pend[1]; S.p2 = pend[2]; S.p3 = pend[3]; S.p4 = pend[4]; S.p5 = pend[5]; S.p6 = pend[6];
                pg8::Gemm g{(const bf16*)(ws + WS_BIG), (const bf16*)(ws + WS_MD), EXPD, (size_t)DM * EXPD * 2}; pg8::EpiMoeDown E{(const int*)(ws + WS_ROWTOK) + (size_t)s * SETROWS, (const float*)(ws + WS_ROWGATE) + (size_t)s * SETROWS, ap->out};
                pg8::gemm_phase<pg8::EpiMoeDown, pg8::MoeOrder, true, true>(F.lds, g, S, E); } SEAM(ps + 2);
        }
    }
    if (IN(N_PHASES - 1) && PHEN(17)) { PH_BEGIN(); rms_final_phase(F, ap->out, ap->fng); }
#undef IN
#undef SEAM
}

extern "C" void kernel_launch(void* const* d_in, const int* in_sizes, int n_in, void* d_out, int out_size, void* d_ws, size_t ws_size, hipStream_t stream) {
    static int grid = 0;
    if (grid == 0) {
        if (n_in != 26 || in_sizes[0] != NTOK * DM || out_size != NTOK * DM || ws_size < WS_END) { fprintf(stderr, "kernel_launch: unexpected shapes: n_in %d in0 %d out %d ws %zu (need %zu)\n", n_in, n_in > 0 ? in_sizes[0] : -1, out_size, ws_size, (size_t)WS_END); grid = -1; return; }
        int dev = 0, cus = 0, per_cu = 0;
        if (hipGetDevice(&dev) != hipSuccess || hipDeviceGetAttribute(&cus, hipDeviceAttributeMultiprocessorCount, dev) != hipSuccess) { grid = -1; return; }
        if (hipFuncSetAttribute((const void*)fwd, hipFuncAttributeMaxDynamicSharedMemorySize, LDS_BYTES) != hipSuccess) { fprintf(stderr, "kernel_launch: hipFuncSetAttribute failed\n"); grid = -1; return; }
        if (hipOccupancyMaxActiveBlocksPerMultiprocessor(&per_cu, (const void*)fwd, NWAVES * 64, LDS_BYTES) != hipSuccess || per_cu < 1) fprintf(stderr, "kernel_launch: occupancy query reports %d\n", per_cu);
        (void)hipGetLastError();
        grid = cus;
    }
    if (grid < 0) return;
    (void)hipMemsetAsync((char*)d_ws + WS_CTL, 0, CTL_ZERO_BYTES, stream);
    Args a{};
    a.x = (const float*)d_in[0]; a.pos = (const int*)d_in[1]; a.fng = (const float*)d_in[2];
    a.e_n1 = (const float*)d_in[3]; a.e_win = (const float*)d_in[4]; a.e_conv = (const float*)d_in[5]; a.e_lng = (const float*)d_in[6]; a.e_lnb = (const float*)d_in[7];
    a.e_sw = (const float*)d_in[8]; a.e_sb = (const float*)d_in[9]; a.e_wout = (const float*)d_in[10]; a.e_n2 = (const float*)d_in[11];
    a.e_wg = (const float*)d_in[12]; a.e_wu = (const float*)d_in[13]; a.e_wd = (const float*)d_in[14];
    a.o_n1 = (const float*)d_in[15]; a.o_wqkv = (const float*)d_in[16]; a.o_bqkv = (const float*)d_in[17]; a.o_sinks = (const float*)d_in[18]; a.o_wo = (const float*)d_in[19]; a.o_bo = (const float*)d_in[20];
    a.o_n2 = (const float*)d_in[21]; a.o_rw = (const float*)d_in[22]; a.o_ewg = (const float*)d_in[23]; a.o_ewu = (const float*)d_in[24]; a.o_ewd = (const float*)d_in[25];
    a.out = (float*)d_out; a.ws = (unsigned char*)d_ws;
#if MK_ONE_LAUNCH
    a.lo = 0; a.hi = N_PHASES; a.li = 0;
    hipLaunchKernelGGL(fwd, dim3(grid), dim3(NWAVES * 64), LDS_BYTES, stream, a);
#else
    for (int p = 0; p < N_PHASES; ++p) { a.lo = p; a.hi = p + 1; a.li = p; hipLaunchKernelGGL(fwd, dim3(grid), dim3(NWAVES * 64), LDS_BYTES, stream, a); }
#endif
}
```

```cpp
#include <hip/hip_runtime.h>
#include <cstdio>
#include <cstdint>
#ifndef MK_ONE_LAUNCH
#define MK_ONE_LAUNCH 1
#endif
namespace pg8 {
#define PG8_LAS __attribute__((address_space(3)))
typedef unsigned short bf16_t;
typedef short bf16x8 __attribute__((ext_vector_type(8)));
typedef float f32x4 __attribute__((ext_vector_type(4)));
typedef unsigned u32x4 __attribute__((ext_vector_type(4)));
constexpr int BM = 256, BK = 64, HALF = 128, HTB = HALF * BK * 2  , STAGE_BYTES = 8 * HTB, NXCD = 8, WGM = 8;

__host__ __device__ __forceinline__ int lds_byte(int r, int c) { const int st = (r >> 4) * 2 + (c >> 5), rr = r & 15, cc = c & 31, ob = rr * 64 + cc * 2; return st * 1024 + (ob ^ (((ob >> 9) & 1) << 5)); }
__host__ __device__ __forceinline__ void stage_rc(int b, int& R, int& C) { const int st = b / 1024, sb = b % 1024, swz = sb ^ (((sb >> 9) & 1) << 5); R = (st >> 1) * 16 + swz / 64; C = (st & 1) * 32 + (swz % 64) / 2; }
__host__ __device__ __forceinline__ int perm32(int rho) { const int n = rho >> 4, i = rho & 15; return 8 * (i >> 2) + 4 * n + (i & 3); }

struct Unit { int pm, pn, e; };
struct Gemm { const bf16_t* A; const bf16_t* Bt; int K; size_t estride; };

struct StaticOrder {
    int nM, nN, nwg, G, c;
    __host__ __device__ void init(int M, int N, int G_, int c_) { nM = M / BM; nN = N / BM; nwg = nM * nN; G = G_; c = c_; }
    __host__ __device__ bool next(int i, Unit& u) const {
        const long L = (long)i * G + c; if (L >= nwg) return false;
        int wgid = (int)L; { const int q = nwg / NXCD, r = nwg % NXCD, xcd = wgid % NXCD, off = wgid / NXCD; wgid = (xcd < r ? xcd * (q + 1) : r * (q + 1) + (xcd - r) * q) + off; }
        const int nig = WGM * nN, gid = wgid / nig, fm = gid * WGM, gsz = (nM - fm) < WGM ? (nM - fm) : WGM;
        u.pm = fm + ((wgid % nig) % gsz); u.pn = (wgid % nig) / gsz; u.e = 0; return true;
    }
};
struct MoeOrder {
    int nM, nN, nwg, G, c; int p0, p1, p2, p3, p4, p5, p6;
    __device__ bool next(int i, Unit& u) const {
        const long L = (long)i * G + c; if (L >= nwg) return false;
        int wgid = (int)L; { const int q = nwg / NXCD, r = nwg % NXCD, xcd = wgid % NXCD, off = wgid / NXCD; wgid = (xcd < r ? xcd * (q + 1) : r * (q + 1) + (xcd - r) * q) + off; }
        const int nig = WGM * nN, gid = wgid / nig, fm = gid * WGM, gsz = (nM - fm) < WGM ? (nM - fm) : WGM;
        u.pm = fm + ((wgid % nig) % gsz); u.pn = (wgid % nig) / gsz;
        u.e = (u.pm >= p0) + (u.pm >= p1) + (u.pm >= p2) + (u.pm >= p3) + (u.pm >= p4) + (u.pm >= p5) + (u.pm >= p6); return true;
    }
};

__device__ __forceinline__ unsigned cvt_pk_bf16(float lo, float hi) { unsigned r; asm volatile("v_cvt_pk_bf16_f32 %0, %1, %2" : "=v"(r) : "v"(lo), "v"(hi)); return r; }
__device__ __forceinline__ u32x4 pack8(const f32x4 v0, const f32x4 v1) { u32x4 w; w.x = cvt_pk_bf16(v0[0], v0[1]); w.y = cvt_pk_bf16(v0[2], v0[3]); w.z = cvt_pk_bf16(v1[0], v1[1]); w.w = cvt_pk_bf16(v1[2], v1[3]); return w; }

struct EpiBf16Plain {
    static constexpr bool PERM = true;
    bf16_t* O; int ldc;
    __device__ __forceinline__ void operator()(const f32x4 (&acc)[2][2][4][2], const Unit& u, int wr, int wc, int fr, int fq) const {
        const int row0 = u.pm * BM + wr * 64 + fr, col0 = u.pn * BM + wc * 32 + 8 * fq;
#pragma unroll
        for (int ai = 0; ai < 2; ++ai)
#pragma unroll
            for (int m = 0; m < 4; ++m) { bf16_t* rowp = O + (size_t)(row0 + ai * HALF + m * 16) * ldc + col0;
#pragma unroll
                for (int bj = 0; bj < 2; ++bj) *(u32x4*)(rowp + bj * HALF) = pack8(acc[ai][bj][m][0], acc[ai][bj][m][1]); }
    }
};
__device__ __forceinline__ float silu_mul(float g, float u) { return g * u * __builtin_amdgcn_rcpf(1.0f + __builtin_amdgcn_exp2f(-1.4426950408889634f * g)); }
struct EpiSwiGLU {
    static constexpr bool PERM = true;
    bf16_t* O; int ldc;
    __device__ __forceinline__ void operator()(const f32x4 (&acc)[2][2][4][2], const Unit& u, int wr, int wc, int fr, int fq) const {
        const int row0 = u.pm * BM + wr * 64 + fr, col0 = u.pn * HALF + wc * 32 + 8 * fq;
#pragma unroll
        for (int ai = 0; ai < 2; ++ai)
#pragma unroll
            for (int m = 0; m < 4; ++m) { bf16_t* rowp = O + (size_t)(row0 + ai * HALF + m * 16) * ldc + col0;
                f32x4 v0, v1;
#pragma unroll
                for (int j = 0; j < 4; ++j) { v0[j] = silu_mul(acc[ai][0][m][0][j], acc[ai][1][m][0][j]); v1[j] = silu_mul(acc[ai][0][m][1][j], acc[ai][1][m][1][j]); }
                *(u32x4*)rowp = pack8(v0, v1); }
    }
};
struct EpiResF32 {
    static constexpr bool PERM = false;
    const float* base; float* out; int ldc; const float* bias;
    __device__ __forceinline__ void operator()(const f32x4 (&acc)[2][2][4][2], const Unit& u, int wr, int wc, int fr, int fq) const {
        const int row0 = u.pm * BM + wr * 64 + fr, col0 = u.pn * BM + wc * 32 + 4 * fq;
        f32x4 bv[2][2];
#pragma unroll
        for (int bj = 0; bj < 2; ++bj)
#pragma unroll
            for (int n = 0; n < 2; ++n) bv[bj][n] = bias ? *(const f32x4*)(bias + col0 + bj * HALF + n * 16) : (f32x4){0.f, 0.f, 0.f, 0.f};
#pragma unroll
        for (int ai = 0; ai < 2; ++ai)
#pragma unroll
            for (int m = 0; m < 4; ++m) { const size_t off = (size_t)(row0 + ai * HALF + m * 16) * ldc + col0;
#pragma unroll
                for (int bj = 0; bj < 2; ++bj)
#pragma unroll
                    for (int n = 0; n < 2; ++n) { const f32x4 b = *(const f32x4*)(base + off + bj * HALF + n * 16); *(f32x4*)(out + off + bj * HALF + n * 16) = b + acc[ai][bj][m][n] + bv[bj][n]; }
                asm volatile("" ::: "memory"); }
    }
};
struct EpiQKV {
    static constexpr bool PERM = true;
    bf16_t* O; const float* bias; const float* cs; float qscale;
    __device__ __forceinline__ void operator()(const f32x4 (&acc)[2][2][4][2], const Unit& u, int wr, int wc, int fr, int fq) const {
        const int row0 = u.pm * BM + wr * 64 + fr, colt = u.pn * BM, col0 = colt + wc * 32 + 8 * fq;
        const bool ropew = ((wc & 1) == 0);
        f32x4 bv[2][2];
#pragma unroll
        for (int bj = 0; bj < 2; ++bj)
#pragma unroll
            for (int n = 0; n < 2; ++n) bv[bj][n] = *(const f32x4*)(bias + col0 + bj * HALF + 4 * n);
        const float sgn = (fq == 0) ? -1.f : 1.f;
#pragma unroll
        for (int ai = 0; ai < 2; ++ai)
#pragma unroll
            for (int m = 0; m < 4; ++m) { const int row = row0 + ai * HALF + m * 16; bf16_t* rowp = O + (size_t)row * 1280 + col0;
                f32x4 c0 = (f32x4){1.f, 1.f, 1.f, 1.f}, c1 = c0, s0 = (f32x4){0.f, 0.f, 0.f, 0.f}, s1 = s0;
                if (ropew && fq < 2) { const f32x4* cp = (const f32x4*)(cs + (size_t)row * 16); c0 = cp[0]; c1 = cp[1]; s0 = cp[2] * sgn; s1 = cp[3] * sgn; }
#pragma unroll
                for (int bj = 0; bj < 2; ++bj) { f32x4 v0 = acc[ai][bj][m][0] + bv[bj][0], v1 = acc[ai][bj][m][1] + bv[bj][1];
                    const int gc = colt + bj * HALF;
                    if (ropew && gc < 1152) { f32x4 p0, p1;
#pragma unroll
                        for (int j = 0; j < 4; ++j) { p0[j] = __shfl_xor(v0[j], 16); p1[j] = __shfl_xor(v1[j], 16); }
                        v0 = v0 * c0 + p0 * s0; v1 = v1 * c1 + p1 * s1; }
                    if (gc < 1024) { v0 = v0 * qscale; v1 = v1 * qscale; }
                    *(u32x4*)(rowp + bj * HALF) = pack8(v0, v1); } }
    }
};
struct EpiMoeDown {
    static constexpr bool PERM = false;
    const int* rowtok; const float* rowgate; float* out;
    __device__ __forceinline__ void operator()(const f32x4 (&acc)[2][2][4][2], const Unit& u, int wr, int wc, int fr, int fq) const {
        const int slot0 = u.pm * BM + wr * 64 + fr, col0 = u.pn * BM + wc * 32 + 4 * fq;
#pragma unroll
        for (int ai = 0; ai < 2; ++ai)
#pragma unroll
            for (int m = 0; m < 4; ++m) { const int slot = slot0 + ai * HALF + m * 16; const int tok = rowtok[slot]; const float gate = rowgate[slot];
                if (tok >= 0) { float* rowp = out + (size_t)tok * 1024 + col0;
#pragma unroll
                    for (int bj = 0; bj < 2; ++bj)
#pragma unroll
                        for (int n = 0; n < 2; ++n) { const f32x4 b = *(const f32x4*)(rowp + bj * HALF + n * 16); *(f32x4*)(rowp + bj * HALF + n * 16) = b + acc[ai][bj][m][n] * gate; } }
                asm volatile("" ::: "memory"); }
    }
};

template <class Epi, class Sched, bool ALIGN_EPI = false, bool SP2 = false>
__device__ __forceinline__ void gemm_phase(PG8_LAS unsigned char* lds, const Gemm g, const Sched& S, const Epi& E) {
    int tid_ = threadIdx.x; asm volatile("" : "+v"(tid_));
    const int tid = tid_, wid = __builtin_amdgcn_readfirstlane(tid >> 6), lane = tid & 63, wr = wid >> 2, wc = wid & 3, fr = lane & 15, fq = lane >> 4;
    const int K = g.K, nt = K / BK;
    unsigned voffA[2], voffB[2];
#pragma unroll
    for (int i = 0; i < 2; ++i) { int R, C; stage_rc(tid * 16 + i * 8192, R, C); const int Rb = Epi::PERM ? ((R & ~31) + perm32(R & 31)) : R;
        voffA[i] = (unsigned)(R * K + C) * 2u; voffB[i] = (unsigned)(Rb * K + C) * 2u; }
    const size_t kstep = (size_t)(BK * 2);
    const size_t hstep = (size_t)HALF * K * 2;
    const size_t tstep = 2 * hstep;
    const unsigned ldsw = (unsigned)wid * 1024u;
    const int aoff = lds_byte(wr * 64 + fr, fq * 8), boff = lds_byte(wc * 32 + fr, fq * 8);
#define PG8_SA(b, h) (((b) * 2 + (h)) * HTB)
#define PG8_SB(b, h) ((4 + (b) * 2 + (h)) * HTB)
#define PG8_STAGE(bufoff, gbase, voff) do { _Pragma("unroll") for (int _i = 0; _i < 2; ++_i) \
        __builtin_amdgcn_global_load_lds((const unsigned*)((const char*)(gbase) + (voff)[_i]), (PG8_LAS unsigned*)(lds + (bufoff) + ldsw + _i * 8192), 16, 0, 0); } while (0)
#define PG8_LDA(dst, b, h) do { _Pragma("unroll") for (int m = 0; m < 4; ++m) _Pragma("unroll") for (int k = 0; k < 2; ++k) dst[m][k] = *(const PG8_LAS bf16x8*)(lds + PG8_SA(b, h) + aoff + m * 2048 + k * 1024); } while (0)
#define PG8_LDB(dst, b, h) do { _Pragma("unroll") for (int n = 0; n < 2; ++n) _Pragma("unroll") for (int k = 0; k < 2; ++k) dst[n][k] = *(const PG8_LAS bf16x8*)(lds + PG8_SB(b, h) + boff + n * 2048 + k * 1024); } while (0)
#define PG8_MMA(ai, bj, At, Bt) do { __builtin_amdgcn_s_setprio(1); _Pragma("unroll") for (int m = 0; m < 4; ++m) _Pragma("unroll") for (int n = 0; n < 2; ++n) _Pragma("unroll") for (int k = 0; k < 2; ++k) \
        acc[ai][bj][m][n] = __builtin_amdgcn_mfma_f32_16x16x32_bf16(Bt[n][k], At[m][k], acc[ai][bj][m][n], 0, 0, 0); __builtin_amdgcn_s_setprio(0); } while (0)
#define PG8_WAIT_V(n) asm volatile("s_waitcnt vmcnt(" #n ")" ::: "memory")
#define PG8_WAIT_L(n) asm volatile("s_waitcnt lgkmcnt(" #n ")" ::: "memory")
#define PG8_BAR __builtin_amdgcn_s_barrier()
#define PG8_SCHED __builtin_amdgcn_sched_barrier(0)
    Unit cur, nxt; int ui = 0;
    if (!S.next(0, cur)) return;
    f32x4 acc[2][2][4][2];
#pragma unroll
    for (int a = 0; a < 2; ++a)
#pragma unroll
        for (int b = 0; b < 2; ++b)
#pragma unroll
            for (int m = 0; m < 4; ++m)
#pragma unroll
                for (int n = 0; n < 2; ++n) acc[a][b][m][n] = (f32x4){0.f, 0.f, 0.f, 0.f};
    bf16x8 At[4][2], B0[2][2], B1[2][2];
    const char* cA = (const char*)g.A + (size_t)cur.pm * tstep; const char* cB = (const char*)g.Bt + (size_t)cur.e * g.estride + (size_t)cur.pn * tstep;
    if constexpr (SP2) {
        PG8_STAGE(PG8_SB(0, 0), cB, voffB); PG8_STAGE(PG8_SB(0, 1), cB + hstep, voffB); PG8_STAGE(PG8_SA(0, 0), cA, voffA); PG8_STAGE(PG8_SA(0, 1), cA + hstep, voffA);
        if (wr == 1) PG8_BAR;
        PG8_WAIT_V(2); PG8_BAR;
        PG8_STAGE(PG8_SB(1, 0), cB + kstep, voffB); PG8_STAGE(PG8_SA(1, 0), cA + kstep, voffA); PG8_STAGE(PG8_SB(1, 1), cB + hstep + kstep, voffB);
        PG8_WAIT_V(6); PG8_BAR;
    } else {
        PG8_STAGE(PG8_SB(0, 0), cB, voffB); PG8_STAGE(PG8_SA(0, 0), cA, voffA); PG8_STAGE(PG8_SB(0, 1), cB + hstep, voffB); PG8_STAGE(PG8_SA(0, 1), cA + hstep, voffA);
        if (wr == 1) PG8_BAR;
        PG8_WAIT_V(4); PG8_BAR;
        PG8_STAGE(PG8_SB(1, 0), cB + kstep, voffB); PG8_STAGE(PG8_SA(1, 0), cA + kstep, voffA); PG8_STAGE(PG8_SB(1, 1), cB + hstep + kstep, voffB);
        PG8_WAIT_V(6); PG8_BAR;
    }
    for (;;) {
        const bool has_next = S.next(ui + 1, nxt);
        const char* nA = has_next ? (const char*)g.A + (size_t)nxt.pm * tstep : cA; const char* nB = has_next ? (const char*)g.Bt + (size_t)nxt.e * g.estride + (size_t)nxt.pn * tstep : cB;
        for (int t = 0; t < nt; t += 2) {
            const bool last = (t == nt - 2);
            const char* a1 = cA + (size_t)(t + 1) * kstep;
            const char* a2 = last ? nA : cA + (size_t)(t + 2) * kstep; const char* b2 = last ? nB : cB + (size_t)(t + 2) * kstep;
            const char* a3 = a2 + kstep; const char* b3 = b2 + kstep;
            if constexpr (SP2) {
            PG8_LDB(B0, 0, 0); PG8_LDB(B1, 0, 1); PG8_SCHED; PG8_LDA(At, 0, 0); PG8_STAGE(PG8_SA(1, 1), a1 + hstep, voffA);
            PG8_WAIT_V(8); PG8_WAIT_L(0); PG8_BAR; PG8_MMA(0, 0, At, B0); PG8_MMA(0, 1, At, B1); PG8_BAR; PG8_SCHED;
            PG8_LDA(At, 0, 1); PG8_STAGE(PG8_SB(0, 0), b2, voffB); PG8_STAGE(PG8_SB(0, 1), b2 + hstep, voffB); PG8_STAGE(PG8_SA(0, 0), a2, voffA);
            PG8_WAIT_V(8); PG8_WAIT_L(0); PG8_BAR; PG8_MMA(1, 0, At, B0); PG8_MMA(1, 1, At, B1); PG8_BAR; PG8_SCHED;
            PG8_LDB(B0, 1, 0); PG8_LDB(B1, 1, 1); PG8_SCHED; PG8_LDA(At, 1, 0); PG8_STAGE(PG8_SA(0, 1), a2 + hstep, voffA);
            PG8_WAIT_V(8); PG8_WAIT_L(0); PG8_BAR; PG8_MMA(0, 0, At, B0); PG8_MMA(0, 1, At, B1); PG8_BAR; PG8_SCHED;
            PG8_LDA(At, 1, 1); PG8_STAGE(PG8_SB(1, 0), b3, voffB); PG8_STAGE(PG8_SB(1, 1), b3 + hstep, voffB); PG8_STAGE(PG8_SA(1, 0), a3, voffA);
            PG8_WAIT_V(8); PG8_WAIT_L(0); PG8_BAR; PG8_MMA(1, 0, At, B0); PG8_MMA(1, 1, At, B1); PG8_BAR; PG8_SCHED;
            } else {
            PG8_LDB(B0, 0, 0); PG8_SCHED; PG8_LDA(At, 0, 0); PG8_STAGE(PG8_SA(1, 1), a1 + hstep, voffA);
            PG8_WAIT_L(8); PG8_BAR; PG8_WAIT_L(0); PG8_MMA(0, 0, At, B0); PG8_BAR; PG8_SCHED;
            PG8_LDB(B1, 0, 1); PG8_STAGE(PG8_SB(0, 0), b2, voffB);
            PG8_BAR; PG8_WAIT_L(0); PG8_MMA(0, 1, At, B1); PG8_BAR;
            PG8_LDA(At, 0, 1); PG8_STAGE(PG8_SA(0, 0), a2, voffA);
            PG8_BAR; PG8_WAIT_L(0); PG8_MMA(1, 0, At, B0); PG8_BAR; PG8_SCHED;
            PG8_STAGE(PG8_SB(0, 1), b2 + hstep, voffB);
            PG8_WAIT_V(6); PG8_BAR; PG8_MMA(1, 1, At, B1); PG8_BAR;
            PG8_LDB(B0, 1, 0); PG8_SCHED; PG8_LDA(At, 1, 0); PG8_STAGE(PG8_SA(0, 1), a2 + hstep, voffA);
            PG8_WAIT_L(8); PG8_BAR; PG8_WAIT_L(0); PG8_MMA(0, 0, At, B0); PG8_BAR; PG8_SCHED;
            PG8_LDB(B1, 1, 1); PG8_STAGE(PG8_SB(1, 0), b3, voffB);
            PG8_BAR; PG8_WAIT_L(0); PG8_MMA(0, 1, At, B1); PG8_BAR;
            PG8_LDA(At, 1, 1); PG8_STAGE(PG8_SA(1, 0), a3, voffA);
            PG8_BAR; PG8_WAIT_L(0); PG8_MMA(1, 0, At, B0); PG8_BAR; PG8_SCHED;
            PG8_STAGE(PG8_SB(1, 1), b3 + hstep, voffB);
            PG8_WAIT_V(6); PG8_BAR; PG8_MMA(1, 1, At, B1); PG8_BAR;
            }
        }
        if constexpr (ALIGN_EPI) { if (wr == 0) PG8_BAR; }
        E(acc, cur, wr, wc, fr, fq);
        if (!has_next) break;
#pragma unroll
        for (int a = 0; a < 2; ++a)
#pragma unroll
            for (int b = 0; b < 2; ++b)
#pragma unroll
                for (int m = 0; m < 4; ++m)
#pragma unroll
                    for (int n = 0; n < 2; ++n) acc[a][b][m][n] = (f32x4){0.f, 0.f, 0.f, 0.f};
        cur = nxt; cA = nA; cB = nB; ++ui;
        if constexpr (ALIGN_EPI) { if (wr == 1) PG8_BAR; }
    }
    PG8_WAIT_V(0);
    if constexpr (!ALIGN_EPI) { if (wr == 0) PG8_BAR; }
    PG8_BAR;
#undef PG8_SA
#undef PG8_SB
#undef PG8_STAGE
#undef PG8_LDA
#undef PG8_LDB
#undef PG8_MMA
#undef PG8_WAIT_V
#undef PG8_WAIT_L
#undef PG8_BAR
#undef PG8_SCHED
}
}

constexpr int NWAVES = 8;
constexpr int NTOK = 65536, DM = 1024, SEQ = 8192;
constexpr int MIXIN = 2560, FFN = 2816, QKVD = 1280, EXPD = 3584, NEXP = 8;
constexpr int SETROWS = NTOK + NEXP * 256;
constexpr float EPS = 1e-5f;
constexpr float LOG2E = 1.4426950408889634f;
constexpr float QSCALE = 0.125f * LOG2E;

constexpr size_t MiB = 1u << 20;
constexpr size_t WS_CTL = 0, CTL_ZERO_BYTES = 1 * MiB;
constexpr size_t WS_CS = 1 * MiB;
constexpr size_t WS_TOKINFO = 5 * MiB;
constexpr size_t WS_ROWTOK = 7 * MiB;
constexpr size_t WS_ROWGATE = 8 * MiB;
constexpr size_t WS_WSP = 9 * MiB;
constexpr size_t WS_WIN = 16 * MiB, WS_WOUT = 21 * MiB, WS_FGU = 23 * MiB, WS_FD = 34 * MiB;
constexpr size_t WS_WQKV = 40 * MiB, WS_WO = 43 * MiB, WS_MGU = 45 * MiB, WS_MD = 157 * MiB;
constexpr size_t WS_XN = 216 * MiB;
constexpr size_t WS_XG = 344 * MiB;
constexpr size_t WS_BIG = 476 * MiB;
constexpr size_t WS_END = WS_BIG + (size_t)SETROWS * EXPD * 2;
static_assert(WS_MD + (size_t)NEXP * DM * EXPD * 2 <= WS_XN && WS_XN + (size_t)NTOK * DM * 2 <= WS_XG && WS_XG + (size_t)SETROWS * DM * 2 <= WS_BIG, "d_ws map");
static_assert(WS_FD + (size_t)DM * FFN * 2 <= WS_WQKV && WS_MGU + (size_t)NEXP * 2 * EXPD * DM * 2 <= WS_MD, "d_ws map (weights)");
constexpr int CW_BAR = 4096;
constexpr int CW_CNT = 16384;

constexpr int RING_BYTES = 131072;
constexpr int LDSCTL_OFF = RING_BYTES, MISC_OFF = LDSCTL_OFF + 320;
constexpr int LDS_BYTES = 147456;

#define GAS __attribute__((address_space(1)))
#define LAS __attribute__((address_space(3)))
typedef unsigned short bf16;
typedef unsigned v4u __attribute__((ext_vector_type(4)));
typedef unsigned v2u __attribute__((ext_vector_type(2)));
typedef float f32x4 __attribute__((ext_vector_type(4)));
typedef GAS unsigned gu32;
#define RLX_AGENT __ATOMIC_RELAXED, __HIP_MEMORY_SCOPE_AGENT
#define LDS_WAIT() asm volatile("s_waitcnt lgkmcnt(0)" ::: "memory")
#define VM_WAIT() asm volatile("s_waitcnt vmcnt(0)" ::: "memory")
__device__ __forceinline__ unsigned pk2(float lo, float hi) { return pg8::cvt_pk_bf16(lo, hi); }
__device__ __forceinline__ float bflo(unsigned w) { return __uint_as_float(w << 16); }
__device__ __forceinline__ float bfhi(unsigned w) { return __uint_as_float(w & 0xffff0000u); }
__device__ __forceinline__ float bf1(bf16 h) { return __uint_as_float(((unsigned)h) << 16); }
__device__ __forceinline__ bf16 f2bf1(float f) { return (bf16)(pk2(f, 0.f) & 0xffffu); }
__device__ __forceinline__ void unpack8(const v4u w, float (&f)[8]) { f[0] = bflo(w.x); f[1] = bfhi(w.x); f[2] = bflo(w.y); f[3] = bfhi(w.y); f[4] = bflo(w.z); f[5] = bfhi(w.z); f[6] = bflo(w.w); f[7] = bfhi(w.w); }
__device__ __forceinline__ v4u pack8f(const float (&f)[8]) { v4u w; w.x = pk2(f[0], f[1]); w.y = pk2(f[2], f[3]); w.z = pk2(f[4], f[5]); w.w = pk2(f[6], f[7]); return w; }
__device__ __forceinline__ float gelu_erf(float v) { return 0.5f * v * (1.0f + erff(v * 0.70710678118654752f)); }

#define XB_TMO      128
#define XB_XCNT(j)  (256  + 64 * (j))
#define XB_XSUB(j)  (1280 + 64 * (j))
#define XB_XGEN(j)  (2304 + 64 * (j))
#define XB_TOP      3328
#define XB_TOPGEN   3392
#define XCD_BAR_WORDS 3456
#define XB_SPIN_CAP (1u << 18)

__device__ __forceinline__ unsigned xb_ld(unsigned* p)              { return __hip_atomic_load(p, __ATOMIC_RELAXED, __HIP_MEMORY_SCOPE_AGENT); }
__device__ __forceinline__ unsigned xb_add(unsigned* p, unsigned v) { return __hip_atomic_fetch_add(p, v, __ATOMIC_RELAXED, __HIP_MEMORY_SCOPE_AGENT); }
__device__ __forceinline__ unsigned xb_xcc_id() { return (unsigned)__builtin_amdgcn_s_getreg((3 << 11) | 20) & 0xFu; }
#define XB_SPIN(cond, bar) do { unsigned _sp = 0; while (cond) { __builtin_amdgcn_s_sleep(1); \
    if ((++_sp & 255u) == 0u) { if (xb_ld(&(bar)[XB_TMO])) break; if (_sp > XB_SPIN_CAP) { atomicAdd(&(bar)[XB_TMO], 1u); break; } } } } while (0)

struct XcdBarrier {
    unsigned* bar; unsigned x;
    volatile LAS unsigned* st;
};

__device__ __forceinline__ XcdBarrier xcd_barrier_post(unsigned* bar, volatile LAS unsigned* st) {
    XcdBarrier b; b.bar = bar; b.x = xb_xcc_id(); b.st = st;
    if (threadIdx.x == 0) (void)xb_add(&bar[XB_XCNT(b.x)], 1u);
    return b;
}
__device__ __forceinline__ void xcd_barrier_complete(unsigned* bar, unsigned x, unsigned& nloc, unsigned& nx) {
    const unsigned G = gridDim.x * gridDim.y * gridDim.z;
    unsigned sum, cnt, mine, sp = 0u;
    for (;;) {
        sum = 0u; cnt = 0u; mine = 0u;
#pragma unroll
        for (unsigned j = 0; j < 16; ++j) { const unsigned c = xb_ld(&bar[XB_XCNT(j)]); sum += c; cnt += (c > 0u) ? 1u : 0u; mine = (j == x) ? c : mine; }
        if (sum == G) break;
        __builtin_amdgcn_s_sleep(1);
        if ((++sp & 255u) == 0u) { if (xb_ld(&bar[XB_TMO])) break; if (sp > XB_SPIN_CAP) { atomicAdd(&bar[XB_TMO], 1u); break; } }
    }
    nloc = mine > 0u ? mine : 1u; nx = cnt > 0u ? cnt : 1u;
}

__device__ __forceinline__ void xcd_barrier(const XcdBarrier& b) {
    asm volatile("s_waitcnt vmcnt(0)" ::: "memory");
    __syncthreads();
    if (threadIdx.x == 0) {
        unsigned* bar = b.bar;
        __builtin_amdgcn_s_waitcnt(0);
        unsigned nloc = b.st[0], nx = b.st[1];
        if (nloc == 0u) { xcd_barrier_complete(bar, b.x, nloc, nx); b.st[0] = nloc; b.st[1] = nx; }
        const unsigned old = xb_add(&bar[XB_XSUB(b.x)], 1u);
        const unsigned gen = old / nloc;
        if (old + 1u == (gen + 1u) * nloc) {
            __builtin_amdgcn_fence(__ATOMIC_RELEASE, "agent");
            asm volatile("s_waitcnt vmcnt(0)" ::: "memory");
            const unsigned og = xb_add(&bar[XB_TOP], 1u);
            const unsigned tg = og / nx;
            if (og + 1u == (tg + 1u) * nx) xb_add(&bar[XB_TOPGEN], 1u);
            else XB_SPIN(xb_ld(&bar[XB_TOPGEN]) == tg, bar);
            __builtin_amdgcn_fence(__ATOMIC_ACQUIRE, "agent");
            xb_add(&bar[XB_XGEN(b.x)], 1u);
            asm volatile("s_waitcnt vmcnt(0)" ::: "memory");
        } else {
            XB_SPIN(xb_ld(&bar[XB_XGEN(b.x)]) == gen, bar);
            __builtin_amdgcn_fence(__ATOMIC_ACQUIRE, "agent");
            asm volatile("s_waitcnt vmcnt(0)" ::: "memory");
        }
    }
    __syncthreads();
}

struct Frame {
    LAS unsigned char* lds;
    int tid, lane, wave;
    int vcu, G;
};
__device__ __forceinline__ float wave_sum(float v) {
#pragma unroll
    for (int o = 1; o < 64; o <<= 1) v += __shfl_xor(v, o);
    return v;
}

__device__ __forceinline__ void tr_item(const float* W, int N, int k0, int n0, bf16* WT, int K, int orow0, LAS float* scr, int lane) {
#pragma unroll 8
    for (int i = 0; i < 32; ++i) { const int kk = 2 * i + (lane >> 5); scr[kk * 33 + (lane & 31)] = W[(size_t)(k0 + kk) * N + n0 + (lane & 31)]; }
    LDS_WAIT(); asm volatile("" ::: "memory");
    const int c = lane & 7;
#pragma unroll
    for (int j = 0; j < 4; ++j) { const int n = (lane >> 3) + 8 * j; const LAS float* s = scr + (8 * c) * 33 + n;
        v4u o; o.x = pk2(s[0 * 33], s[1 * 33]); o.y = pk2(s[2 * 33], s[3 * 33]); o.z = pk2(s[4 * 33], s[5 * 33]); o.w = pk2(s[6 * 33], s[7 * 33]);
        *(GAS v4u*)(WT + (size_t)(orow0 + n) * K + k0 + 8 * c) = o; }
    LDS_WAIT(); asm volatile("" ::: "memory");
}
__device__ __forceinline__ void tr_plain(const float* W, int K, int N, bf16* WT, int item, LAS float* scr, int lane) {
    const int nblk = N / 32, kb = item / nblk, nb = item % nblk; tr_item(W, N, 64 * kb, 32 * nb, WT, K, 32 * nb, scr, lane);
}
__device__ __forceinline__ void tr_gu(const float* W, int K, int N, bf16* WT, int up, int item, LAS float* scr, int lane) {
    const int nblk = N / 32, kb = item / nblk, nb = item % nblk, n0 = 32 * nb; tr_item(W, N, 64 * kb, n0, WT, K, 256 * (n0 / 128) + 128 * up + (n0 % 128), scr, lane);
}

__device__ __forceinline__ void conv_even_phase(const Frame& F, const float* w_in, const float* w_out, const float* wg, const float* wu, const float* wd, const float* sw, unsigned char* ws) {
    LAS float* scr = (LAS float*)(F.lds + F.wave * 16384);
    const int gw = F.vcu * NWAVES + F.wave, NGW = F.G * NWAVES;
    constexpr int I_IN = (DM / 64) * (MIXIN / 32), I_OUT = (DM / 64) * (DM / 32), I_G = (DM / 64) * (FFN / 32), I_D = (FFN / 64) * (DM / 32);
    constexpr int NITEMS = I_IN + I_OUT + 2 * I_G + I_D;
    for (int it = gw; it < NITEMS; it += NGW) {
        int r = it;
        if (r < I_IN) { tr_plain(w_in, DM, MIXIN, (bf16*)(ws + WS_WIN), r, scr, F.lane); continue; } r -= I_IN;
        if (r < I_OUT) { tr_plain(w_out, DM, DM, (bf16*)(ws + WS_WOUT), r, scr, F.lane); continue; } r -= I_OUT;
        if (r < I_G) { tr_gu(wg, DM, FFN, (bf16*)(ws + WS_FGU), 0, r, scr, F.lane); continue; } r -= I_G;
        if (r < I_G) { tr_gu(wu, DM, FFN, (bf16*)(ws + WS_FGU), 1, r, scr, F.lane); continue; } r -= I_G;
        tr_plain(wd, FFN, DM, (bf16*)(ws + WS_FD), r, scr, F.lane);
    }
    bf16* wsp = (bf16*)(ws + WS_WSP);
    for (int idx = (F.vcu * NWAVES * 64) + F.tid; idx < 4 * 128 * 128; idx += F.G * NWAVES * 64) { const int ii = (idx >> 7) & 127, jj = idx & 127; wsp[idx] = f2bf1((jj <= ii) ? sw[idx] : 0.f); }
}
__device__ __forceinline__ void conv_odd_phase(const Frame& F, const float* wqkv, const float* wo, const float* ewg, const float* ewu, const float* ewd, unsigned char* ws) {
    LAS float* scr = (LAS float*)(F.lds + F.wave * 16384);
    const int gw = F.vcu * NWAVES + F.wave, NGW = F.G * NWAVES;
    constexpr int I_Q = (DM / 64) * (QKVD / 32), I_O = (DM / 64) * (DM / 32), I_G = (DM / 64) * (EXPD / 32), I_D = (EXPD / 64) * (DM / 32);
    constexpr int NITEMS = I_Q + I_O + NEXP * (2 * I_G + I_D);
    for (int it = gw; it < NITEMS; it += NGW) {
        int r = it;
        if (r < I_Q) { tr_plain(wqkv, DM, QKVD, (bf16*)(ws + WS_WQKV), r, scr, F.lane); continue; } r -= I_Q;
        if (r < I_O) { tr_plain(wo, DM, DM, (bf16*)(ws + WS_WO), r, scr, F.lane); continue; } r -= I_O;
        const int e = r / (2 * I_G + I_D); r -= e * (2 * I_G + I_D);
        bf16* gu = (bf16*)(ws + WS_MGU) + (size_t)e * 2 * EXPD * DM; bf16* dd = (bf16*)(ws + WS_MD) + (size_t)e * DM * EXPD;
        if (r < I_G) { tr_gu(ewg + (size_t)e * DM * EXPD, DM, EXPD, gu, 0, r, scr, F.lane); continue; } r -= I_G;
        if (r < I_G) { tr_gu(ewu + (size_t)e * DM * EXPD, DM, EXPD, gu, 1, r, scr, F.lane); continue; } r -= I_G;
        tr_plain(ewd + (size_t)e * EXPD * DM, EXPD, DM, dd, r, scr, F.lane);
    }
}
__device__ __forceinline__ void rope_table_phase(const Frame& F, const int* pos, float* cs) {
    for (int idx = (F.vcu * NWAVES * 64) + F.tid; idx < NTOK * 8; idx += F.G * NWAVES * 64) {
        const int t = idx >> 3, i = idx & 7;
        const float inv = (float)exp(-log(500000.0) * (double)(2 * i) / 16.0);
        const float ang = (float)pos[t] * inv;
        cs[(size_t)t * 16 + i] = (float)cos((double)ang); cs[(size_t)t * 16 + 8 + i] = (float)sin((double)ang);
    }
}
__device__ __forceinline__ void rms_phase(const Frame& F, const float* hin, const float* g, bf16* XN) {
    const int gw = F.vcu * NWAVES + F.wave, NGW = F.G * NWAVES;
    f32x4 gv[4];
#pragma unroll
    for (int j = 0; j < 4; ++j) gv[j] = ((const f32x4*)g)[F.lane + 64 * j];
    for (int m = gw; m < NTOK; m += NGW) {
        const GAS f32x4* xr = (const GAS f32x4*)(hin + (size_t)m * DM) + F.lane;
        f32x4 v[4]; float s = 0.f;
#pragma unroll
        for (int j = 0; j < 4; ++j) { v[j] = xr[64 * j]; s += (v[j].x * v[j].x + v[j].y * v[j].y) + (v[j].z * v[j].z + v[j].w * v[j].w); }
        const float rstd = 1.0f / sqrtf(wave_sum(s) * (1.f / DM) + EPS);
        GAS v2u* o8 = (GAS v2u*)(XN + (size_t)m * DM) + F.lane;
#pragma unroll
        for (int j = 0; j < 4; ++j) { const f32x4 y = v[j] * rstd * gv[j]; v2u w; w.x = pk2(y.x, y.y); w.y = pk2(y.z, y.w); o8[64 * j] = w; }
    }
}
__device__ __forceinline__ void rms_final_phase(const Frame& F, float* h, const float* g) {
    const int gw = F.vcu * NWAVES + F.wave, NGW = F.G * NWAVES;
    f32x4 gv[4];
#pragma unroll
    for (int j = 0; j < 4; ++j) gv[j] = ((const f32x4*)g)[F.lane + 64 * j];
    for (int m = gw; m < NTOK; m += NGW) {
        GAS f32x4* xr = (GAS f32x4*)(h + (size_t)m * DM) + F.lane;
        f32x4 v[4]; float s = 0.f;
#pragma unroll
        for (int j = 0; j < 4; ++j) { v[j] = xr[64 * j]; s += (v[j].x * v[j].x + v[j].y * v[j].y) + (v[j].z * v[j].z + v[j].w * v[j].w); }
        const float rstd = 1.0f / sqrtf(wave_sum(s) * (1.f / DM) + EPS);
#pragma unroll
        for (int j = 0; j < 4; ++j) xr[64 * j] = v[j] * rstd * gv[j];
    }
}
__device__ __forceinline__ void rms_router_phase(const Frame& F, const float* h, const float* g, const float* rw, bf16* XN, unsigned* gcnt, unsigned* tokinfo, int* rowtok) {
    for (int idx = (F.vcu * NWAVES * 64) + F.tid; idx < 2 * SETROWS; idx += F.G * NWAVES * 64) rowtok[idx] = -1;
    LAS unsigned* lcnt = (LAS unsigned*)F.lds;
    LAS unsigned* lbase = lcnt + 16;
    LAS unsigned* rec = lcnt + 64;
    f32x4 gv[4];
#pragma unroll
    for (int j = 0; j < 4; ++j) gv[j] = ((const f32x4*)g)[F.lane + 64 * j];
    f32x4 rwv[4][4][2];
#pragma unroll
    for (int j = 0; j < 4; ++j)
#pragma unroll
        for (int c = 0; c < 4; ++c) { const f32x4* p = (const f32x4*)(rw + (size_t)(256 * j + 4 * F.lane + c) * 8); rwv[j][c][0] = p[0]; rwv[j][c][1] = p[1]; }
    for (int panel = F.vcu; panel < NTOK / 256; panel += F.G) {
        if (F.tid < 16) lcnt[F.tid] = 0u;
        __syncthreads();
        for (int r = 0; r < 32; ++r) {
            const int lrow = F.wave * 32 + r, m = panel * 256 + lrow;
            const GAS f32x4* xr = (const GAS f32x4*)(h + (size_t)m * DM) + F.lane;
            f32x4 v[4]; float s = 0.f;
#pragma unroll
            for (int j = 0; j < 4; ++j) { v[j] = xr[64 * j]; s += (v[j].x * v[j].x + v[j].y * v[j].y) + (v[j].z * v[j].z + v[j].w * v[j].w); }
            const float rstd = 1.0f / sqrtf(wave_sum(s) * (1.f / DM) + EPS);
            GAS v2u* o8 = (GAS v2u*)(XN + (size_t)m * DM) + F.lane;
            f32x4 l0 = (f32x4){0.f, 0.f, 0.f, 0.f}, l1 = l0;
#pragma unroll
            for (int j = 0; j < 4; ++j) { const f32x4 y = v[j] * rstd * gv[j]; v2u w; w.x = pk2(y.x, y.y); w.y = pk2(y.z, y.w); o8[64 * j] = w;
                l0 += rwv[j][0][0] * y.x + rwv[j][1][0] * y.y + rwv[j][2][0] * y.z + rwv[j][3][0] * y.w;
                l1 += rwv[j][0][1] * y.x + rwv[j][1][1] * y.y + rwv[j][2][1] * y.z + rwv[j][3][1] * y.w; }
            float lg[8];
#pragma unroll
            for (int e = 0; e < 4; ++e) { lg[e] = wave_sum(l0[e]); lg[4 + e] = wave_sum(l1[e]); }
            int e1 = 0; float v1 = lg[0];
#pragma unroll
            for (int e = 1; e < 8; ++e) if (lg[e] > v1) { v1 = lg[e]; e1 = e; }
            int e2 = -1; float v2 = -INFINITY;
#pragma unroll
            for (int e = 0; e < 8; ++e) if (e != e1 && (e2 < 0 || lg[e] > v2)) { v2 = lg[e]; e2 = e; }
            const float g2 = 1.0f / (1.0f + expf(v1 - v2)), g1 = 1.0f - g2;
            if (F.lane == 0) {
                const unsigned p1 = atomicAdd((unsigned*)(lcnt + e1), 1u), p2 = atomicAdd((unsigned*)(lcnt + 8 + e2), 1u);
                LAS unsigned* rr = rec + lrow * 8; rr[0] = (unsigned)e1; rr[1] = p1; rr[2] = __float_as_uint(g1); rr[3] = (unsigned)e2; rr[4] = p2; rr[5] = __float_as_uint(g2);
            }
        }
        __syncthreads();
        if (F.tid < 16) lbase[F.tid] = __hip_atomic_fetch_add(gcnt + F.tid, lcnt[F.tid], RLX_AGENT);
        __syncthreads();
        if (F.tid < 256) { const LAS unsigned* rr = rec + F.tid * 8; v4u a, b; a.x = rr[0]; a.y = rr[1] + lbase[rr[0]]; a.z = rr[2]; a.w = rr[3]; b.x = rr[4] + lbase[8 + rr[3]]; b.y = rr[5]; b.z = 0u; b.w = 0u;
            GAS v4u* ti = (GAS v4u*)(tokinfo + (size_t)(panel * 256 + F.tid) * 8); ti[0] = a; ti[1] = b; }
        __syncthreads();
    }
}
__device__ __forceinline__ void moe_prefix(const unsigned* gcnt_set, int (&pend)[8]) {
    int acc = 0;
#pragma unroll
    for (int e = 0; e < 8; ++e) { const unsigned c = __hip_atomic_load(gcnt_set + e, RLX_AGENT); acc += (int)((c + 255u) >> 8); pend[e] = acc; }
}
__device__ __forceinline__ void gather_phase(const Frame& F, int s, const unsigned* gcnt, const unsigned* tokinfo, const bf16* XN, bf16* XG, int* rowtok, float* rowgate) {
    int pend[8]; moe_prefix(gcnt + 8 * s, pend);
    const int gw = F.vcu * NWAVES + F.wave, NGW = F.G * NWAVES;
    for (int t = gw; t < NTOK; t += NGW) {
        const unsigned* ti = tokinfo + (size_t)t * 8 + 3 * s;
        const int e = (int)ti[0]; const unsigned pos = (s == 0) ? ti[1] : ti[1]; const unsigned gb = ti[2];
        int pstart = 0;
#pragma unroll
        for (int k = 0; k < 7; ++k) pstart = (e == k + 1) ? pend[k] : pstart;
        const size_t slot = (size_t)pstart * 256 + pos;
        const GAS v4u* src = (const GAS v4u*)(XN + (size_t)t * DM); GAS v4u* dst = (GAS v4u*)(XG + slot * DM);
        const v4u a = src[F.lane], b = src[64 + F.lane]; dst[F.lane] = a; dst[64 + F.lane] = b;
        if (F.lane == 0) { rowtok[(size_t)s * SETROWS + slot] = t; rowgate[(size_t)s * SETROWS + slot] = __uint_as_float(gb); }
    }
}

typedef short bf16x8v __attribute__((ext_vector_type(8)));
typedef float f32x16 __attribute__((ext_vector_type(16)));
constexpr int AT_KP = 144, AT_VP = 528, AT_VOFF = 256 * AT_KP;
__device__ __forceinline__ void attn_mfma_phase(const Frame& F, const bf16* QKV, const float* sinks, bf16* AO) {
    LAS unsigned char* Ks = F.lds; LAS unsigned char* Vt = F.lds + AT_VOFF;
    const int q = F.lane & 31, hi = F.lane >> 5;
    for (int unit = F.vcu; unit < 8 * 64 * 2; unit += F.G) {
        const int b = unit >> 7, n = (unit >> 1) & 63, hk = unit & 1;
        const size_t tb = (size_t)b * SEQ;
#pragma unroll
        for (int i = 0; i < 4; ++i) { const int p = F.tid + 512 * i, key = p >> 3, ch = p & 7;
            const int kt = (n == 0 && key < 128) ? key : (n - 1) * 128 + key;
            const bf16* src = QKV + (tb + kt) * QKVD + 1024 + hk * 64 + ch * 8;
            *(LAS v4u*)(Ks + key * AT_KP + ch * 16) = *(const GAS v4u*)src;
            const v4u v = *(const GAS v4u*)(src + 128);
            const int kg = key & 15, kpos = (key & ~15) + (kg & 3) + ((kg >> 3) & 1) * 4 + ((kg >> 2) & 1) * 8;
            LAS unsigned short* vp = (LAS unsigned short*)(Vt + (ch * 8) * AT_VP + kpos * 2);
            vp[0 * (AT_VP / 2)] = (unsigned short)(v.x & 0xffffu); vp[1 * (AT_VP / 2)] = (unsigned short)(v.x >> 16); vp[2 * (AT_VP / 2)] = (unsigned short)(v.y & 0xffffu); vp[3 * (AT_VP / 2)] = (unsigned short)(v.y >> 16);
            vp[4 * (AT_VP / 2)] = (unsigned short)(v.z & 0xffffu); vp[5 * (AT_VP / 2)] = (unsigned short)(v.z >> 16); vp[6 * (AT_VP / 2)] = (unsigned short)(v.w & 0xffffu); vp[7 * (AT_VP / 2)] = (unsigned short)(v.w >> 16); }
        __syncthreads();
        const int head = hk * 8 + F.wave; const float sk = sinks[head] * LOG2E;
#pragma unroll 1
        for (int qt = 0; qt < 4; ++qt) {
            const size_t qrow = tb + (size_t)n * 128 + qt * 32 + q;
            bf16x8v qf[4];
#pragma unroll
            for (int d0 = 0; d0 < 4; ++d0) qf[d0] = *(const GAS bf16x8v*)(QKV + qrow * QKVD + head * 64 + 16 * d0 + 8 * hi);
            f32x16 p[5];
#pragma unroll
            for (int j = 0; j < 5; ++j) {
                const int kt = qt + j;
                if (n == 0 && kt < 4) {
#pragma unroll
                    for (int r = 0; r < 16; ++r) p[j][r] = -INFINITY;
                } else {
                    f32x16 a = {0.f, 0.f, 0.f, 0.f, 0.f, 0.f, 0.f, 0.f, 0.f, 0.f, 0.f, 0.f, 0.f, 0.f, 0.f, 0.f};
                    const LAS unsigned char* kp = Ks + (32 * kt + q) * AT_KP + 16 * hi;
#pragma unroll
                    for (int d0 = 0; d0 < 4; ++d0) a = __builtin_amdgcn_mfma_f32_32x32x16_bf16(*(const LAS bf16x8v*)(kp + 32 * d0), qf[d0], a, 0, 0, 0);
                    p[j] = a;
                }
            }
#pragma unroll
            for (int r = 0; r < 16; ++r) { const int key = (r & 3) + 8 * (r >> 2) + 4 * hi; if (key <= q) p[0][r] = -INFINITY; if (key > q) p[4][r] = -INFINITY; }
            float mx = sk;
#pragma unroll
            for (int j = 0; j < 5; ++j)
#pragma unroll
                for (int r = 0; r < 16; ++r) mx = fmaxf(mx, p[j][r]);
            mx = fmaxf(mx, __shfl_xor(mx, 32));
            float ls = 0.f;
#pragma unroll
            for (int j = 0; j < 5; ++j)
#pragma unroll
                for (int r = 0; r < 16; ++r) { p[j][r] = __builtin_amdgcn_exp2f(p[j][r] - mx); ls += p[j][r]; }
            ls += __shfl_xor(ls, 32); ls += __builtin_amdgcn_exp2f(sk - mx);
            f32x16 o0 = {0.f, 0.f, 0.f, 0.f, 0.f, 0.f, 0.f, 0.f, 0.f, 0.f, 0.f, 0.f, 0.f, 0.f, 0.f, 0.f}, o1 = o0;
#pragma unroll
            for (int j = 0; j < 5; ++j) {
                const int kt = qt + j;
                if (!(n == 0 && kt < 4)) {
#pragma unroll
                    for (int ks = 0; ks < 2; ++ks) {
                        v4u pw; pw.x = pk2(p[j][8 * ks + 0], p[j][8 * ks + 1]); pw.y = pk2(p[j][8 * ks + 2], p[j][8 * ks + 3]); pw.z = pk2(p[j][8 * ks + 4], p[j][8 * ks + 5]); pw.w = pk2(p[j][8 * ks + 6], p[j][8 * ks + 7]);
                        const bf16x8v pf = __builtin_bit_cast(bf16x8v, pw);
                        const LAS unsigned char* vp = Vt + q * AT_VP + (32 * kt + 16 * ks + 8 * hi) * 2;
                        o0 = __builtin_amdgcn_mfma_f32_32x32x16_bf16(*(const LAS bf16x8v*)vp, pf, o0, 0, 0, 0);
                        o1 = __builtin_amdgcn_mfma_f32_32x32x16_bf16(*(const LAS bf16x8v*)(vp + 32 * AT_VP), pf, o1, 0, 0, 0);
                    }
                }
            }
            const float il = 1.0f / ls;
            bf16* orow = AO + qrow * DM + head * 64 + 4 * hi;
#pragma unroll
            for (int jg = 0; jg < 4; ++jg) { v2u w0, w1;
                w0.x = pk2(o0[4 * jg] * il, o0[4 * jg + 1] * il); w0.y = pk2(o0[4 * jg + 2] * il, o0[4 * jg + 3] * il);
                w1.x = pk2(o1[4 * jg] * il, o1[4 * jg + 1] * il); w1.y = pk2(o1[4 * jg + 2] * il, o1[4 * jg + 3] * il);
                *(GAS v2u*)(orow + 8 * jg) = w0; *(GAS v2u*)(orow + 32 + 8 * jg) = w1; }
        }
        __syncthreads();
    }
}

typedef float f32x2 __attribute__((ext_vector_type(2)));
__device__ __forceinline__ f32x2 gelu_pk(f32x2 v) {
    const f32x2 av = __builtin_elementwise_abs(v), d = av * 0.2316418882f + 1.0f;
    f32x2 t; t.x = __builtin_amdgcn_rcpf(d.x); t.y = __builtin_amdgcn_rcpf(d.y);
    f32x2 q = t * 0.5307027145f + (-0.7265760135f); q = q * t + 0.7107068705f; q = q * t + (-0.142248368f); q = q * t + 0.127414796f; q = q * t;
    const f32x2 s = (v * v) * (-0.72134752044f);
    f32x2 e; e.x = __builtin_amdgcn_exp2f(s.x); e.y = __builtin_amdgcn_exp2f(s.y);
    const f32x2 m = v * (q * e), r = v - m;
    f32x2 o; o.x = v.x < 0.f ? m.x : r.x; o.y = v.y < 0.f ? m.y : r.y; return o;
}
__device__ __forceinline__ int mx_swz(int row) { return (row ^ (row >> 4)) & 15; }
__device__ __forceinline__ void mixer_fused_phase(const Frame& F, const bf16* Z, bf16* Y, const float* convw, const float* lng, const float* lnb, const bf16* Wb, const float* sb) {
    LAS unsigned char* vt = F.lds;
    const int c8 = 8 * F.lane, q = F.lane & 31, hi = F.lane >> 5;
    for (int unit = F.vcu; unit < NTOK / 128; unit += F.G) {
        const size_t t0 = (size_t)unit * 128;
        {
            float cw0[8], cw1[8], cw2[8], lg[8], lb[8];
#pragma unroll
            for (int j = 0; j < 8; ++j) { cw0[j] = convw[(c8 + j) * 3 + 0]; cw1[j] = convw[(c8 + j) * 3 + 1]; cw2[j] = convw[(c8 + j) * 3 + 2]; lg[j] = lng[c8 + j]; lb[j] = lnb[c8 + j]; }
            const size_t tw = t0 + 16 * F.wave;
            float cx1[8], cx2[8];
            if ((tw % SEQ) != 0) {
                float a[8], b[8];
                unpack8(*(const GAS v4u*)(Z + (tw - 1) * MIXIN + 512 + c8), a); unpack8(*(const GAS v4u*)(Z + (tw - 1) * MIXIN + 1024 + c8), b);
#pragma unroll
                for (int j = 0; j < 8; ++j) cx1[j] = a[j] * b[j];
                unpack8(*(const GAS v4u*)(Z + (tw - 2) * MIXIN + 512 + c8), a); unpack8(*(const GAS v4u*)(Z + (tw - 2) * MIXIN + 1024 + c8), b);
#pragma unroll
                for (int j = 0; j < 8; ++j) cx2[j] = a[j] * b[j];
            } else {
#pragma unroll
                for (int j = 0; j < 8; ++j) { cx1[j] = 0.f; cx2[j] = 0.f; }
            }
#pragma unroll 2
            for (int r = 0; r < 16; ++r) {
                const size_t t = tw + r; const int jl = 16 * F.wave + r;
                const bf16* zr = Z + t * MIXIN;
                float ab[8], ac[8], ax[8], bv[8];
                unpack8(*(const GAS v4u*)(zr + c8), ab); unpack8(*(const GAS v4u*)(zr + 512 + c8), ac); unpack8(*(const GAS v4u*)(zr + 1024 + c8), ax); unpack8(*(const GAS v4u*)(zr + 2048 + c8), bv);
                float ya[8], vv[8]; float s = 0.f;
#pragma unroll
                for (int j = 0; j < 8; ++j) { const float cx0 = ac[j] * ax[j]; ya[j] = ab[j] * (cw0[j] * cx2[j] + cw1[j] * cx1[j] + cw2[j] * cx0); cx2[j] = cx1[j]; cx1[j] = cx0; }
#pragma unroll
                for (int j = 0; j < 8; j += 2) { const f32x2 gv = gelu_pk((f32x2){bv[j], bv[j + 1]}); vv[j] = gv.x; vv[j + 1] = gv.y; s += gv.x + gv.y; }
                *(GAS v4u*)(Y + t * DM + c8) = pack8f(ya);
                const float mu = wave_sum(s) * (1.f / 512.f); float qq = 0.f;
#pragma unroll
                for (int j = 0; j < 8; ++j) { vv[j] -= mu; qq += vv[j] * vv[j]; }
                const float rstd = 1.0f / sqrtf(wave_sum(qq) * (1.f / 512.f) + EPS);
#pragma unroll
                for (int j = 0; j < 8; ++j) { const int row = c8 + j; const float y = vv[j] * rstd * lg[j] + lb[j];
                    *(LAS unsigned short*)(vt + row * 256 + (((jl >> 3) ^ mx_swz(row)) << 4) + (jl & 7) * 2) = f2bf1(y); }
            }
        }
        __syncthreads();
        {
            const int h = F.wave >> 1, dt0 = 2 * (F.wave & 1);
#pragma unroll
            for (int it = 0; it < 4; ++it) {
                bf16x8v wf[8];
                const bf16* wrow = Wb + (size_t)(h * 128 + 32 * it + q) * 128 + 8 * hi;
#pragma unroll
                for (int ks = 0; ks < 2 * (it + 1); ++ks) wf[ks] = *(const GAS bf16x8v*)(wrow + 16 * ks);
                const size_t tok = t0 + 32 * it + q; const float sbv = sb[h * 128 + 32 * it + q];
#pragma unroll
                for (int dl = 0; dl < 2; ++dl) {
                    const int dt = dt0 + dl, row = h * 128 + 32 * dt + q; const LAS unsigned char* ap = vt + row * 256; const int sw = mx_swz(row);
                    f32x16 acc = {0.f, 0.f, 0.f, 0.f, 0.f, 0.f, 0.f, 0.f, 0.f, 0.f, 0.f, 0.f, 0.f, 0.f, 0.f, 0.f};
#pragma unroll
                    for (int ks = 0; ks < 2 * (it + 1); ++ks) acc = __builtin_amdgcn_mfma_f32_32x32x16_bf16(*(const LAS bf16x8v*)(ap + (((2 * ks + hi) ^ sw) << 4)), wf[ks], acc, 0, 0, 0);
                    const int cb = h * 128 + 32 * dt + 4 * hi;
#pragma unroll
                    for (int jg = 0; jg < 4; ++jg) { const v2u bw = *(const GAS v2u*)(Z + tok * MIXIN + 1536 + cb + 8 * jg);
                        const f32x2 u0 = gelu_pk((f32x2){bflo(bw.x), bfhi(bw.x)}), u1 = gelu_pk((f32x2){bflo(bw.y), bfhi(bw.y)});
                        v2u w; w.x = pk2(u0.x * (acc[4 * jg] + sbv), u0.y * (acc[4 * jg + 1] + sbv)); w.y = pk2(u1.x * (acc[4 * jg + 2] + sbv), u1.y * (acc[4 * jg + 3] + sbv));
                        *(GAS v2u*)(Y + tok * DM + 512 + cb + 8 * jg) = w; }
                }
            }
        }
        __syncthreads();
    }
}

struct Args {
    const float* x; const int* pos; const float* fng;
    const float *e_n1, *e_win, *e_conv, *e_lng, *e_lnb, *e_sw, *e_sb, *e_wout, *e_n2, *e_wg, *e_wu, *e_wd;
    const float *o_n1, *o_wqkv, *o_bqkv, *o_sinks, *o_wo, *o_bo, *o_n2, *o_rw, *o_ewg, *o_ewu, *o_ewd;
    float* out; unsigned char* ws; int lo, hi, li, pad;
};
constexpr int PH_PER_PAIR = 18;
constexpr int N_PHASES = 1 + 2 * PH_PER_PAIR + 1;

typedef const __attribute__((address_space(4))) Args* ArgsP;
#define PH_ARGS(ap) ArgsP ap = (ArgsP)__builtin_amdgcn_kernarg_segment_ptr(); asm volatile("" : "+s"(ap))
__device__ __forceinline__ Frame make_frame(LAS unsigned char* lds) {
    Frame F; int tid = threadIdx.x; asm volatile("" : "+v"(tid));
    F.lds = lds; F.tid = tid; F.lane = tid & 63; F.wave = __builtin_amdgcn_readfirstlane(tid >> 6);
    F.G = gridDim.x; { const int bx = blockIdx.x; F.vcu = (F.G % 8 == 0) ? (bx % 8) * (F.G / 8) + bx / 8 : bx; }
    return F;
}
__global__ void __launch_bounds__(NWAVES * 64, 2) fwd(Args A_unused) {
    extern __shared__ __attribute__((aligned(16))) unsigned char lds_raw[];
    LAS unsigned char* const lds = (LAS unsigned char*)lds_raw;
    for (int u = threadIdx.x; u < (LDS_BYTES - LDSCTL_OFF) / 4; u += NWAVES * 64) ((LAS unsigned*)(lds + LDSCTL_OFF))[u] = 0u;
    __syncthreads();
    int lo, hi;
    { PH_ARGS(ap); lo = ap->lo; hi = ap->hi; }
#if MK_ONE_LAUNCH
    XcdBarrier bar;
    { PH_ARGS(ap); bar = xcd_barrier_post((unsigned*)(ap->ws + WS_CTL) + CW_BAR, (volatile LAS unsigned*)(lds + MISC_OFF) + 8); }
#define GRID_BAR() xcd_barrier(bar)
#else
#define GRID_BAR() do { } while (0)
#endif
#ifndef PHMASK
#define PHMASK 0xFFFFFFFFu
#endif
#define PHEN(k) (((PHMASK) >> (k)) & 1u)
#define IN(k) (lo <= (k) && (k) < hi)
#define SEAM(k) do { if (IN(k) && IN((k) + 1)) GRID_BAR(); } while (0)
#define PH_BEGIN() PH_ARGS(ap); const Frame F = make_frame(lds); unsigned char* const ws = ap->ws; const int G = F.G, cblk = (int)blockIdx.x; (void)G; (void)cblk

    if (IN(0) && PHEN(16)) { PH_BEGIN(); rope_table_phase(F, ap->pos, (float*)(ws + WS_CS)); } SEAM(0);

#pragma unroll 1
    for (int i = 0; i < 2; ++i) {
        const int pb = 1 + i * PH_PER_PAIR;
        if (IN(pb + 0) && PHEN(0)) { PH_BEGIN(); conv_even_phase(F, ap->e_win + (size_t)i * DM * MIXIN, ap->e_wout + (size_t)i * DM * DM, ap->e_wg + (size_t)i * DM * FFN, ap->e_wu + (size_t)i * DM * FFN, ap->e_wd + (size_t)i * FFN * DM, ap->e_sw + (size_t)i * 4 * 128 * 128, ws);
                          rms_phase(F, (i == 0) ? ap->x : ap->out, ap->e_n1 + i * DM, (bf16*)(ws + WS_XN)); } SEAM(pb + 0);
        if (IN(pb + 1) && PHEN(1)) { PH_BEGIN(); pg8::Gemm g{(const bf16*)(ws + WS_XN), (const bf16*)(ws + WS_WIN), DM, 0}; pg8::StaticOrder S; S.init(NTOK, MIXIN, G, cblk); pg8::EpiBf16Plain E{(bf16*)(ws + WS_BIG), MIXIN};
                          pg8::gemm_phase<pg8::EpiBf16Plain, pg8::StaticOrder, true, true>(F.lds, g, S, E); } SEAM(pb + 1);
        if (IN(pb + 2) && PHEN(2)) { PH_BEGIN(); mixer_fused_phase(F, (const bf16*)(ws + WS_BIG), (bf16*)(ws + WS_XN), ap->e_conv + i * 512 * 3, ap->e_lng + i * 512, ap->e_lnb + i * 512, (const bf16*)(ws + WS_WSP), ap->e_sb + i * 4 * 128); } SEAM(pb + 2);
        if (IN(pb + 3) && PHEN(4)) { PH_BEGIN(); pg8::Gemm g{(const bf16*)(ws + WS_XN), (const bf16*)(ws + WS_WOUT), DM, 0}; pg8::StaticOrder S; S.init(NTOK, DM, G, cblk); pg8::EpiResF32 E{(i == 0) ? ap->x : ap->out, ap->out, DM, nullptr};
                          pg8::gemm_phase<pg8::EpiResF32, pg8::StaticOrder, true, true>(F.lds, g, S, E); } SEAM(pb + 3);
        if (IN(pb + 4) && PHEN(5)) { PH_BEGIN(); rms_phase(F, ap->out, ap->e_n2 + i * DM, (bf16*)(ws + WS_XN)); } SEAM(pb + 4);
        if (IN(pb + 5) && PHEN(6)) { PH_BEGIN(); pg8::Gemm g{(const bf16*)(ws + WS_XN), (const bf16*)(ws + WS_FGU), DM, 0}; pg8::StaticOrder S; S.init(NTOK, 2 * FFN, G, cblk); pg8::EpiSwiGLU E{(bf16*)(ws + WS_BIG), FFN};
                          pg8::gemm_phase<pg8::EpiSwiGLU, pg8::StaticOrder, true, true>(F.lds, g, S, E); } SEAM(pb + 5);
        if (IN(pb + 6) && PHEN(7)) { PH_BEGIN(); pg8::Gemm g{(const bf16*)(ws + WS_BIG), (const bf16*)(ws + WS_FD), FFN, 0}; pg8::StaticOrder S; S.init(NTOK, DM, G, cblk); pg8::EpiResF32 E{ap->out, ap->out, DM, nullptr};
                          pg8::gemm_phase<pg8::EpiResF32, pg8::StaticOrder, true, true>(F.lds, g, S, E); } SEAM(pb + 6);
        if (IN(pb + 7) && PHEN(8)) { PH_BEGIN(); conv_odd_phase(F, ap->o_wqkv + (size_t)i * DM * QKVD, ap->o_wo + (size_t)i * DM * DM, ap->o_ewg + (size_t)i * NEXP * DM * EXPD, ap->o_ewu + (size_t)i * NEXP * DM * EXPD, ap->o_ewd + (size_t)i * NEXP * EXPD * DM, ws);
                          rms_phase(F, ap->out, ap->o_n1 + i * DM, (bf16*)(ws + WS_XN)); } SEAM(pb + 7);
        if (IN(pb + 8) && PHEN(9)) { PH_BEGIN(); pg8::Gemm g{(const bf16*)(ws + WS_XN), (const bf16*)(ws + WS_WQKV), DM, 0}; pg8::StaticOrder S; S.init(NTOK, QKVD, G, cblk); pg8::EpiQKV E{(bf16*)(ws + WS_BIG), ap->o_bqkv + i * QKVD, (const float*)(ws + WS_CS), QSCALE};
                          pg8::gemm_phase<pg8::EpiQKV, pg8::StaticOrder, true, true>(F.lds, g, S, E); } SEAM(pb + 8);
        if (IN(pb + 9) && PHEN(10)) { PH_BEGIN(); attn_mfma_phase(F, (const bf16*)(ws + WS_BIG), ap->o_sinks + i * 16, (bf16*)(ws + WS_XN)); } SEAM(pb + 9);
        if (IN(pb + 10) && PHEN(11)) { PH_BEGIN(); pg8::Gemm g{(const bf16*)(ws + WS_XN), (const bf16*)(ws + WS_WO), DM, 0}; pg8::StaticOrder S; S.init(NTOK, DM, G, cblk); pg8::EpiResF32 E{ap->out, ap->out, DM, ap->o_bo + i * DM};
                           pg8::gemm_phase<pg8::EpiResF32, pg8::StaticOrder, true, true>(F.lds, g, S, E); } SEAM(pb + 10);
        if (IN(pb + 11) && PHEN(12)) { PH_BEGIN(); rms_router_phase(F, ap->out, ap->o_n2 + i * DM, ap->o_rw + (size_t)i * DM * NEXP, (bf16*)(ws + WS_XN), (unsigned*)(ws + WS_CTL) + CW_CNT + 64 * i, (unsigned*)(ws + WS_TOKINFO), (int*)(ws + WS_ROWTOK)); } SEAM(pb + 11);
#pragma unroll 1
        for (int s = 0; s < 2; ++s) {
            const int ps = pb + 12 + 3 * s;
            if (IN(ps + 0) && PHEN(13)) { PH_BEGIN(); gather_phase(F, s, (const unsigned*)(ws + WS_CTL) + CW_CNT + 64 * i, (const unsigned*)(ws + WS_TOKINFO), (const bf16*)(ws + WS_XN), (bf16*)(ws + WS_XG), (int*)(ws + WS_ROWTOK), (float*)(ws + WS_ROWGATE)); } SEAM(ps + 0);
            if (IN(ps + 1) && PHEN(14)) { PH_BEGIN(); int pend[8]; moe_prefix((const unsigned*)(ws + WS_CTL) + CW_CNT + 64 * i + 8 * s, pend);
                pg8::MoeOrder S; S.nM = pend[7]; S.nN = 2 * EXPD / 256; S.nwg = S.nM * S.nN; S.G = G; S.c = cblk; S.p0 = pend[0]; S.p1 = pend[1]; S.p2 = pend[2]; S.p3 = pend[3]; S.p4 = pend[4]; S.p5 = pend[5]; S.p6 = pend[6];
                pg8::Gemm g{(const bf16*)(ws + WS_XG), (const bf16*)(ws + WS_MGU), DM, (size_t)2 * EXPD * DM * 2}; pg8::EpiSwiGLU E{(bf16*)(ws + WS_BIG), EXPD};
                pg8::gemm_phase<pg8::EpiSwiGLU, pg8::MoeOrder, true, true>(F.lds, g, S, E); } SEAM(ps + 1);
            if (IN(ps + 2) && PHEN(15)) { PH_BEGIN(); int pend[8]; moe_prefix((const unsigned*)(ws + WS_CTL) + CW_CNT + 64 * i + 8 * s, pend);
                pg8::MoeOrder S; S.nM = pend[7]; S.nN = DM / 256; S.nwg = S.nM * S.nN; S.G = G; S.c = cblk; S.p0 = pend[0]; S.p1 = pend[1]; S.p2 = pend[2]; S.p3 = pend[3]; S.p4 = pend[4]; S.p5 = pend[5]; S.p6 = pend[6];
                pg8::Gemm g{(const bf16*)(ws + WS_BIG), (const bf16*)(ws + WS_MD), EXPD, (size_t)DM * EXPD * 2}; pg8::EpiMoeDown E{(const int*)(ws + WS_ROWTOK) + (size_t)s * SETROWS, (const float*)(ws + WS_ROWGATE) + (size_t)s * SETROWS, ap->out};
                pg8::gemm_phase<pg8::EpiMoeDown, pg8::MoeOrder, true, true>(F.lds, g, S, E); } SEAM(ps + 2);
        }
    }
    if (IN(N_PHASES - 1) && PHEN(17)) { PH_BEGIN(); rms_final_phase(F, ap->out, ap->fng); }
#undef IN
#undef SEAM
}

extern "C" void kernel_launch(void* const* d_in, const int* in_sizes, int n_in, void* d_out, int out_size, void* d_ws, size_t ws_size, hipStream_t stream) {
    static int grid = 0;
    if (grid == 0) {
        if (n_in != 26 || in_sizes[0] != NTOK * DM || out_size != NTOK * DM || ws_size < WS_END) { fprintf(stderr, "kernel_launch: unexpected shapes: n_in %d in0 %d out %d ws %zu (need %zu)\n", n_in, n_in > 0 ? in_sizes[0] : -1, out_size, ws_size, (size_t)WS_END); grid = -1; return; }
        int dev = 0, cus = 0, per_cu = 0;
        if (hipGetDevice(&dev) != hipSuccess || hipDeviceGetAttribute(&cus, hipDeviceAttributeMultiprocessorCount, dev) != hipSuccess) { grid = -1; return; }
        if (hipFuncSetAttribute((const void*)fwd, hipFuncAttributeMaxDynamicSharedMemorySize, LDS_BYTES) != hipSuccess) { fprintf(stderr, "kernel_launch: hipFuncSetAttribute failed\n"); grid = -1; return; }
        if (hipOccupancyMaxActiveBlocksPerMultiprocessor(&per_cu, (const void*)fwd, NWAVES * 64, LDS_BYTES) != hipSuccess || per_cu < 1) fprintf(stderr, "kernel_launch: occupancy query reports %d\n", per_cu);
        (void)hipGetLastError();
        grid = cus;
    }
    if (grid < 0) return;
    (void)hipMemsetAsync((char*)d_ws + WS_CTL, 0, CTL_ZERO_BYTES, stream);
    Args a{};
    a.x = (const float*)d_in[0]; a.pos = (const int*)d_in[1]; a.fng = (const float*)d_in[2];
    a.e_n1 = (const float*)d_in[3]; a.e_win = (const float*)d_in[4]; a.e_conv = (const float*)d_in[5]; a.e_lng = (const float*)d_in[6]; a.e_lnb = (const float*)d_in[7];
    a.e_sw = (const float*)d_in[8]; a.e_sb = (const float*)d_in[9]; a.e_wout = (const float*)d_in[10]; a.e_n2 = (const float*)d_in[11];
    a.e_wg = (const float*)d_in[12]; a.e_wu = (const float*)d_in[13]; a.e_wd = (const float*)d_in[14];
    a.o_n1 = (const float*)d_in[15]; a.o_wqkv = (const float*)d_in[16]; a.o_bqkv = (const float*)d_in[17]; a.o_sinks = (const float*)d_in[18]; a.o_wo = (const float*)d_in[19]; a.o_bo = (const float*)d_in[20];
    a.o_n2 = (const float*)d_in[21]; a.o_rw = (const float*)d_in[22]; a.o_ewg = (const float*)d_in[23]; a.o_ewu = (const float*)d_in[24]; a.o_ewd = (const float*)d_in[25];
    a.out = (float*)d_out; a.ws = (unsigned char*)d_ws;
#if MK_ONE_LAUNCH
    a.lo = 0; a.hi = N_PHASES; a.li = 0;
    hipLaunchKernelGGL(fwd, dim3(grid), dim3(NWAVES * 64), LDS_BYTES, stream, a);
#else
    for (int p = 0; p < N_PHASES; ++p) { a.lo = p; a.hi = p + 1; a.li = p; hipLaunchKernelGGL(fwd, dim3(grid), dim3(NWAVES * 64), LDS_BYTES, stream, a); }
#endif
}
```

```cpp
#include <hip/hip_runtime.h>
#include <cstdio>
#include <cstdint>
#ifndef MK_ONE_LAUNCH
#define MK_ONE_LAUNCH 1
#endif
namespace pg8 {
#define PG8_LAS __attribute__((address_space(3)))
typedef unsigned short bf16_t;
typedef short bf16x8 __attribute__((ext_vector_type(8)));
typedef float f32x4 __attribute__((ext_vector_type(4)));
typedef unsigned u32x4 __attribute__((ext_vector_type(4)));
constexpr int BM = 256, BK = 64, HALF = 128, HTB = HALF * BK * 2  , STAGE_BYTES = 8 * HTB, NXCD = 8, WGM = 8;

__host__ __device__ __forceinline__ int lds_byte(int r, int c) { const int st = (r >> 4) * 2 + (c >> 5), rr = r & 15, cc = c & 31, ob = rr * 64 + cc * 2; return st * 1024 + (ob ^ (((ob >> 9) & 1) << 5)); }
__host__ __device__ __forceinline__ void stage_rc(int b, int& R, int& C) { const int st = b / 1024, sb = b % 1024, swz = sb ^ (((sb >> 9) & 1) << 5); R = (st >> 1) * 16 + swz / 64; C = (st & 1) * 32 + (swz % 64) / 2; }
__host__ __device__ __forceinline__ int perm32(int rho) { const int n = rho >> 4, i = rho & 15; return 8 * (i >> 2) + 4 * n + (i & 3); }

struct Unit { int pm, pn, e, kt0, nt, split; };
struct Gemm { const bf16_t* A; const bf16_t* Bt; int K; size_t estride; };

struct StaticOrder {
    int nM, nN, nwg, G, c;
    __host__ __device__ void init(int M, int N, int G_, int c_) { nM = M / BM; nN = N / BM; nwg = nM * nN; G = G_; c = c_; }
    __host__ __device__ bool next(int i, Unit& u) const {
        const long L = (long)i * G + c; if (L >= nwg) return false;
        int wgid = (int)L; { const int q = nwg / NXCD, r = nwg % NXCD, xcd = wgid % NXCD, off = wgid / NXCD; wgid = (xcd < r ? xcd * (q + 1) : r * (q + 1) + (xcd - r) * q) + off; }
        const int nig = WGM * nN, gid = wgid / nig, fm = gid * WGM, gsz = (nM - fm) < WGM ? (nM - fm) : WGM;
        u.pm = fm + ((wgid % nig) % gsz); u.pn = (wgid % nig) / gsz; u.e = 0; u.kt0 = 0; u.nt = 0; u.split = 0; return true;
    }
};
struct MoeOrder {
    int nM, nN, nwg, G, c, NT; bool splitk; int p0, p1, p2, p3, p4, p5, p6;
    __device__ bool next(int i, Unit& u) const {
        long L = (long)i * G + c; u.kt0 = 0; u.nt = NT; u.split = 0;
        const int rfull = nwg / G, tail = nwg - rfull * G;
        if (splitk && tail > 0 && tail * 4 <= G) {
            if (i > rfull) return false;
            if (i == rfull) { if (c >= tail * 4) return false; L = (long)rfull * G + (c >> 2); u.kt0 = (c & 3) * (NT / 4); u.nt = NT / 4; u.split = 1; }
        } else if (L >= nwg) return false;
        int wgid = (int)L; { const int q = nwg / NXCD, r = nwg % NXCD, xcd = wgid % NXCD, off = wgid / NXCD; wgid = (xcd < r ? xcd * (q + 1) : r * (q + 1) + (xcd - r) * q) + off; }
        const int nig = WGM * nN, gid = wgid / nig, fm = gid * WGM, gsz = (nM - fm) < WGM ? (nM - fm) : WGM;
        u.pm = fm + ((wgid % nig) % gsz); u.pn = (wgid % nig) / gsz;
        u.e = (u.pm >= p0) + (u.pm >= p1) + (u.pm >= p2) + (u.pm >= p3) + (u.pm >= p4) + (u.pm >= p5) + (u.pm >= p6); return true;
    }
};

struct TabOrder {
    const PG8_LAS unsigned* t; int n;
    __device__ __forceinline__ static void put(PG8_LAS unsigned* t, int i, const Unit& u) { t[2 * i] = (unsigned)u.pm | ((unsigned)u.pn << 16); t[2 * i + 1] = (unsigned)u.e | ((unsigned)u.kt0 << 8) | ((unsigned)u.nt << 16) | ((unsigned)u.split << 24); }
    __device__ __forceinline__ bool next(int i, Unit& u) const {
        if (i >= n) return false;
        const unsigned w0 = __builtin_amdgcn_readfirstlane(t[2 * i]), w1 = __builtin_amdgcn_readfirstlane(t[2 * i + 1]);
        u.pm = (int)(w0 & 0xffffu); u.pn = (int)(w0 >> 16); u.e = (int)(w1 & 0xffu); u.kt0 = (int)((w1 >> 8) & 0xffu); u.nt = (int)((w1 >> 16) & 0xffu); u.split = (int)(w1 >> 24); return true;
    }
};

__device__ __forceinline__ unsigned cvt_pk_bf16(float lo, float hi) { unsigned r; asm volatile("v_cvt_pk_bf16_f32 %0, %1, %2" : "=v"(r) : "v"(lo), "v"(hi)); return r; }
__device__ __forceinline__ u32x4 pack8(const f32x4 v0, const f32x4 v1) { u32x4 w; w.x = cvt_pk_bf16(v0[0], v0[1]); w.y = cvt_pk_bf16(v0[2], v0[3]); w.z = cvt_pk_bf16(v1[0], v1[1]); w.w = cvt_pk_bf16(v1[2], v1[3]); return w; }

struct EpiBf16Plain {
    static constexpr bool PERM = true;
    bf16_t* O; int ldc;
    __device__ __forceinline__ void operator()(const f32x4 (&acc)[2][2][4][2], const Unit& u, int wr, int wc, int fr, int fq) const {
        const int row0 = u.pm * BM + wr * 64 + fr, col0 = u.pn * BM + wc * 32 + 8 * fq;
#pragma unroll
        for (int ai = 0; ai < 2; ++ai)
#pragma unroll
            for (int m = 0; m < 4; ++m) { bf16_t* rowp = O + (size_t)(row0 + ai * HALF + m * 16) * ldc + col0;
#pragma unroll
                for (int bj = 0; bj < 2; ++bj) *(u32x4*)(rowp + bj * HALF) = pack8(acc[ai][bj][m][0], acc[ai][bj][m][1]); }
    }
};
struct EpiNull {
    static constexpr bool PERM = true;
    float* O;
    __device__ __forceinline__ void operator()(const f32x4 (&acc)[2][2][4][2], const Unit& u, int wr, int wc, int fr, int fq) const {
        f32x4 s = (f32x4){0.f, 0.f, 0.f, 0.f};
#pragma unroll
        for (int ai = 0; ai < 2; ++ai)
#pragma unroll
            for (int bj = 0; bj < 2; ++bj)
#pragma unroll
                for (int m = 0; m < 4; ++m)
#pragma unroll
                    for (int n = 0; n < 2; ++n) s += acc[ai][bj][m][n];
        if (s[0] + s[1] + s[2] + s[3] == 12345.678f) O[u.pm + wr + wc + fr + fq] = s[0];
    }
};
typedef float f32x2 __attribute__((ext_vector_type(2)));
__device__ __forceinline__ f32x2 silu_mul2(f32x2 g, f32x2 u) {
    f32x2 e; e.x = __builtin_amdgcn_exp2f(-g.x); e.y = __builtin_amdgcn_exp2f(-g.y);
    const f32x2 d = e + 1.0f; f32x2 r; r.x = __builtin_amdgcn_rcpf(d.x); r.y = __builtin_amdgcn_rcpf(d.y);
    return (g * u) * r;
}
struct EpiSwiGLU {
    static constexpr bool PERM = true;
    bf16_t* O; int ldc;
    __device__ __forceinline__ void operator()(const f32x4 (&acc)[2][2][4][2], const Unit& u, int wr, int wc, int fr, int fq) const {
        const int row0 = u.pm * BM + wr * 64 + fr, col0 = u.pn * HALF + wc * 32 + 8 * fq;
#pragma unroll
        for (int ai = 0; ai < 2; ++ai)
#pragma unroll
            for (int m = 0; m < 4; ++m) { bf16_t* rowp = O + (size_t)(row0 + ai * HALF + m * 16) * ldc + col0;
                const f32x4 g0 = acc[ai][0][m][0], g1 = acc[ai][0][m][1], u0 = acc[ai][1][m][0], u1 = acc[ai][1][m][1];
                const f32x2 a = silu_mul2((f32x2){g0[0], g0[1]}, (f32x2){u0[0], u0[1]}), b = silu_mul2((f32x2){g0[2], g0[3]}, (f32x2){u0[2], u0[3]});
                const f32x2 c = silu_mul2((f32x2){g1[0], g1[1]}, (f32x2){u1[0], u1[1]}), d = silu_mul2((f32x2){g1[2], g1[3]}, (f32x2){u1[2], u1[3]});
                u32x4 w; w.x = cvt_pk_bf16(a.x, a.y); w.y = cvt_pk_bf16(b.x, b.y); w.z = cvt_pk_bf16(c.x, c.y); w.w = cvt_pk_bf16(d.x, d.y);
                *(u32x4*)rowp = w; }
    }
};
struct EpiResF32 {
    static constexpr bool PERM = false;
    const float* base; float* out; int ldc; const float* bias;
    __device__ __forceinline__ void operator()(const f32x4 (&acc)[2][2][4][2], const Unit& u, int wr, int wc, int fr, int fq) const {
        const int row0 = u.pm * BM + wr * 64 + fr, col0 = u.pn * BM + wc * 32 + 4 * fq;
        f32x4 bv[2][2];
#pragma unroll
        for (int bj = 0; bj < 2; ++bj)
#pragma unroll
            for (int n = 0; n < 2; ++n) bv[bj][n] = bias ? *(const f32x4*)(bias + col0 + bj * HALF + n * 16) : (f32x4){0.f, 0.f, 0.f, 0.f};
#pragma unroll
        for (int ai = 0; ai < 2; ++ai) {
            f32x4 b[4][2][2];
#pragma unroll
            for (int m = 0; m < 4; ++m) { const size_t off = (size_t)(row0 + ai * HALF + m * 16) * ldc + col0;
#pragma unroll
                for (int bj = 0; bj < 2; ++bj)
#pragma unroll
                    for (int n = 0; n < 2; ++n) b[m][bj][n] = *(const f32x4*)(base + off + bj * HALF + n * 16); }
            asm volatile("" ::: "memory");
#pragma unroll
            for (int m = 0; m < 4; ++m) { const size_t off = (size_t)(row0 + ai * HALF + m * 16) * ldc + col0;
#pragma unroll
                for (int bj = 0; bj < 2; ++bj)
#pragma unroll
                    for (int n = 0; n < 2; ++n) *(f32x4*)(out + off + bj * HALF + n * 16) = b[m][bj][n] + acc[ai][bj][m][n] + bv[bj][n]; }
            asm volatile("" ::: "memory");
        }
    }
};
struct EpiQKV {
    static constexpr bool PERM = true;
    bf16_t* O; const float* bias; const float* cs; float qscale;
    __device__ __forceinline__ void operator()(const f32x4 (&acc)[2][2][4][2], const Unit& u, int wr, int wc, int fr, int fq) const {
        const int row0 = u.pm * BM + wr * 64 + fr, colt = u.pn * BM, col0 = colt + wc * 32 + 8 * fq;
        const bool ropew = ((wc & 1) == 0);
        f32x4 bv[2][2];
#pragma unroll
        for (int bj = 0; bj < 2; ++bj)
#pragma unroll
            for (int n = 0; n < 2; ++n) bv[bj][n] = *(const f32x4*)(bias + col0 + bj * HALF + 4 * n);
        const float sgn = (fq == 0) ? -1.f : 1.f;
#pragma unroll
        for (int ai = 0; ai < 2; ++ai)
#pragma unroll
            for (int m = 0; m < 4; ++m) { const int row = row0 + ai * HALF + m * 16; bf16_t* rowp = O + (size_t)row * 1280 + col0;
                f32x4 c0 = (f32x4){1.f, 1.f, 1.f, 1.f}, c1 = c0, s0 = (f32x4){0.f, 0.f, 0.f, 0.f}, s1 = s0;
                if (ropew && fq < 2) { const f32x4* cp = (const f32x4*)(cs + (size_t)row * 16); c0 = cp[0]; c1 = cp[1]; s0 = cp[2] * sgn; s1 = cp[3] * sgn; }
#pragma unroll
                for (int bj = 0; bj < 2; ++bj) { f32x4 v0 = acc[ai][bj][m][0] + bv[bj][0], v1 = acc[ai][bj][m][1] + bv[bj][1];
                    const int gc = colt + bj * HALF;
                    if (ropew && gc < 1152) { f32x4 p0, p1;
#pragma unroll
                        for (int j = 0; j < 4; ++j) { p0[j] = __shfl_xor(v0[j], 16); p1[j] = __shfl_xor(v1[j], 16); }
                        v0 = v0 * c0 + p0 * s0; v1 = v1 * c1 + p1 * s1; }
                    if (gc < 1024) { v0 = v0 * qscale; v1 = v1 * qscale; }
                    *(u32x4*)(rowp + bj * HALF) = pack8(v0, v1); } }
    }
};
struct EpiMoeDown {
    static constexpr bool PERM = false;
    const int* rowtok; const float* rowgate; float* out;
    __device__ __forceinline__ void operator()(const f32x4 (&acc)[2][2][4][2], const Unit& u, int wr, int wc, int fr, int fq) const {
        const int slot0 = u.pm * BM + wr * 64 + fr, col0 = u.pn * BM + wc * 32 + 4 * fq;
#pragma unroll
        for (int ai = 0; ai < 2; ++ai) {
            int tok[4]; float gate[4];
#pragma unroll
            for (int m = 0; m < 4; ++m) { const int slot = slot0 + ai * HALF + m * 16; tok[m] = rowtok[slot]; gate[m] = rowgate[slot]; }
            if (u.split) {
#pragma unroll
                for (int m = 0; m < 4; ++m) { if (tok[m] >= 0) { float* rowp = out + (size_t)tok[m] * 1024 + col0;
#pragma unroll
                    for (int bj = 0; bj < 2; ++bj)
#pragma unroll
                        for (int n = 0; n < 2; ++n)
#pragma unroll
                            for (int j = 0; j < 4; ++j) unsafeAtomicAdd(rowp + bj * HALF + n * 16 + j, acc[ai][bj][m][n][j] * gate[m]); } }
            } else {
                f32x4 b[4][2][2];
#pragma unroll
                for (int m = 0; m < 4; ++m) { const float* rowp = out + (size_t)(tok[m] < 0 ? 0 : tok[m]) * 1024 + col0;
#pragma unroll
                    for (int bj = 0; bj < 2; ++bj)
#pragma unroll
                        for (int n = 0; n < 2; ++n) b[m][bj][n] = *(const f32x4*)(rowp + bj * HALF + n * 16); }
                asm volatile("" ::: "memory");
#pragma unroll
                for (int m = 0; m < 4; ++m) { if (tok[m] >= 0) { float* rowp = out + (size_t)tok[m] * 1024 + col0;
#pragma unroll
                    for (int bj = 0; bj < 2; ++bj)
#pragma unroll
                        for (int n = 0; n < 2; ++n) *(f32x4*)(rowp + bj * HALF + n * 16) = b[m][bj][n] + acc[ai][bj][m][n] * gate[m]; } }
            }
            asm volatile("" ::: "memory");
        }
    }
};

template <class Epi, class Sched, bool ALIGN_EPI = false, bool SP2 = false>
__device__ __forceinline__ void gemm_phase(PG8_LAS unsigned char* lds, const Gemm g, const Sched& S, const Epi& E) {
    int tid_ = threadIdx.x; asm volatile("" : "+v"(tid_));
    const int tid = tid_, wid = __builtin_amdgcn_readfirstlane(tid >> 6), lane = tid & 63, wr = wid >> 2, wc = wid & 3, fr = lane & 15, fq = lane >> 4;
    const int K = g.K, nt = K / BK;
    unsigned voffA[2], voffB[2];
#pragma unroll
    for (int i = 0; i < 2; ++i) { int R, C; stage_rc(tid * 16 + i * 8192, R, C); const int Rb = Epi::PERM ? ((R & ~31) + perm32(R & 31)) : R;
        voffA[i] = (unsigned)(R * K + C) * 2u; voffB[i] = (unsigned)(Rb * K + C) * 2u; }
    const size_t kstep = (size_t)(BK * 2);
    const size_t hstep = (size_t)HALF * K * 2;
    const size_t tstep = 2 * hstep;
    const unsigned ldsw = (unsigned)wid * 1024u;
    const int aoff = lds_byte(wr * 64 + fr, fq * 8), boff = lds_byte(wc * 32 + fr, fq * 8);
#define PG8_SA(b, h) (((b) * 2 + (h)) * HTB)
#define PG8_SB(b, h) ((4 + (b) * 2 + (h)) * HTB)
#define PG8_STAGE(bufoff, gbase, voff) do { _Pragma("unroll") for (int _i = 0; _i < 2; ++_i) \
        __builtin_amdgcn_global_load_lds((const unsigned*)((const char*)(gbase) + (voff)[_i]), (PG8_LAS unsigned*)(lds + (bufoff) + ldsw + _i * 8192), 16, 0, 0); } while (0)
#define PG8_LDA(dst, b, h) do { _Pragma("unroll") for (int m = 0; m < 4; ++m) _Pragma("unroll") for (int k = 0; k < 2; ++k) dst[m][k] = *(const PG8_LAS bf16x8*)(lds + PG8_SA(b, h) + aoff + m * 2048 + k * 1024); } while (0)
#define PG8_LDB(dst, b, h) do { _Pragma("unroll") for (int n = 0; n < 2; ++n) _Pragma("unroll") for (int k = 0; k < 2; ++k) dst[n][k] = *(const PG8_LAS bf16x8*)(lds + PG8_SB(b, h) + boff + n * 2048 + k * 1024); } while (0)
#define PG8_MMA(ai, bj, At, Bt) do { __builtin_amdgcn_s_setprio(1); _Pragma("unroll") for (int m = 0; m < 4; ++m) _Pragma("unroll") for (int n = 0; n < 2; ++n) _Pragma("unroll") for (int k = 0; k < 2; ++k) \
        acc[ai][bj][m][n] = __builtin_amdgcn_mfma_f32_16x16x32_bf16(Bt[n][k], At[m][k], acc[ai][bj][m][n], 0, 0, 0); __builtin_amdgcn_s_setprio(0); } while (0)
#define PG8_WAIT_V(n) asm volatile("s_waitcnt vmcnt(" #n ")" ::: "memory")
#define PG8_WAIT_L(n) asm volatile("s_waitcnt lgkmcnt(" #n ")" ::: "memory")
#define PG8_BAR __builtin_amdgcn_s_barrier()
#define PG8_SCHED __builtin_amdgcn_sched_barrier(0)
    Unit cur, nxt; int ui = 0;
    if (!S.next(0, cur)) return;
    f32x4 acc[2][2][4][2];
#pragma unroll
    for (int a = 0; a < 2; ++a)
#pragma unroll
        for (int b = 0; b < 2; ++b)
#pragma unroll
            for (int m = 0; m < 4; ++m)
#pragma unroll
                for (int n = 0; n < 2; ++n) acc[a][b][m][n] = (f32x4){0.f, 0.f, 0.f, 0.f};
    bf16x8 At[4][2], B0[2][2], B1[2][2];
    const char* cA = (const char*)g.A + (size_t)cur.pm * tstep; const char* cB = (const char*)g.Bt + (size_t)cur.e * g.estride + (size_t)cur.pn * tstep;
    if constexpr (SP2) {
        PG8_STAGE(PG8_SB(0, 0), cB, voffB); PG8_STAGE(PG8_SB(0, 1), cB + hstep, voffB); PG8_STAGE(PG8_SA(0, 0), cA, voffA); PG8_STAGE(PG8_SA(0, 1), cA + hstep, voffA);
        if (wr == 1) PG8_BAR;
        PG8_WAIT_V(2); PG8_BAR;
        PG8_STAGE(PG8_SB(1, 0), cB + kstep, voffB); PG8_STAGE(PG8_SA(1, 0), cA + kstep, voffA); PG8_STAGE(PG8_SB(1, 1), cB + hstep + kstep, voffB);
        PG8_WAIT_V(6); PG8_BAR;
    } else {
        PG8_STAGE(PG8_SB(0, 0), cB, voffB); PG8_STAGE(PG8_SA(0, 0), cA, voffA); PG8_STAGE(PG8_SB(0, 1), cB + hstep, voffB); PG8_STAGE(PG8_SA(0, 1), cA + hstep, voffA);
        if (wr == 1) PG8_BAR;
        PG8_WAIT_V(4); PG8_BAR;
        PG8_STAGE(PG8_SB(1, 0), cB + kstep, voffB); PG8_STAGE(PG8_SA(1, 0), cA + kstep, voffA); PG8_STAGE(PG8_SB(1, 1), cB + hstep + kstep, voffB);
        PG8_WAIT_V(6); PG8_BAR;
    }
    for (;;) {
        const bool has_next = S.next(ui + 1, nxt);
        const char* nA = has_next ? (const char*)g.A + (size_t)nxt.pm * tstep : cA; const char* nB = has_next ? (const char*)g.Bt + (size_t)nxt.e * g.estride + (size_t)nxt.pn * tstep : cB;
        for (int t = 0; t < nt; t += 2) {
            const bool last = (t == nt - 2);
            const char* a1 = cA + (size_t)(t + 1) * kstep;
            const char* a2 = last ? nA : cA + (size_t)(t + 2) * kstep; const char* b2 = last ? nB : cB + (size_t)(t + 2) * kstep;
            const char* a3 = a2 + kstep; const char* b3 = b2 + kstep;
            if constexpr (SP2) {
            PG8_LDB(B0, 0, 0); PG8_LDB(B1, 0, 1); PG8_SCHED; PG8_LDA(At, 0, 0); PG8_STAGE(PG8_SA(1, 1), a1 + hstep, voffA);
            PG8_WAIT_V(8); PG8_WAIT_L(0); PG8_BAR; PG8_MMA(0, 0, At, B0); PG8_MMA(0, 1, At, B1); PG8_BAR; PG8_SCHED;
            PG8_LDA(At, 0, 1); PG8_STAGE(PG8_SB(0, 0), b2, voffB); PG8_STAGE(PG8_SB(0, 1), b2 + hstep, voffB); PG8_STAGE(PG8_SA(0, 0), a2, voffA);
            PG8_WAIT_V(8); PG8_WAIT_L(0); PG8_BAR; PG8_MMA(1, 0, At, B0); PG8_MMA(1, 1, At, B1); PG8_BAR; PG8_SCHED;
            PG8_LDB(B0, 1, 0); PG8_LDB(B1, 1, 1); PG8_SCHED; PG8_LDA(At, 1, 0); PG8_STAGE(PG8_SA(0, 1), a2 + hstep, voffA);
            PG8_WAIT_V(8); PG8_WAIT_L(0); PG8_BAR; PG8_MMA(0, 0, At, B0); PG8_MMA(0, 1, At, B1); PG8_BAR; PG8_SCHED;
            PG8_LDA(At, 1, 1); PG8_STAGE(PG8_SB(1, 0), b3, voffB); PG8_STAGE(PG8_SB(1, 1), b3 + hstep, voffB); PG8_STAGE(PG8_SA(1, 0), a3, voffA);
            PG8_WAIT_V(8); PG8_WAIT_L(0); PG8_BAR; PG8_MMA(1, 0, At, B0); PG8_MMA(1, 1, At, B1); PG8_BAR; PG8_SCHED;
            } else {
            PG8_LDB(B0, 0, 0); PG8_SCHED; PG8_LDA(At, 0, 0); PG8_STAGE(PG8_SA(1, 1), a1 + hstep, voffA);
            PG8_WAIT_L(8); PG8_BAR; PG8_WAIT_L(0); PG8_MMA(0, 0, At, B0); PG8_BAR; PG8_SCHED;
            PG8_LDB(B1, 0, 1); PG8_STAGE(PG8_SB(0, 0), b2, voffB);
            PG8_BAR; PG8_WAIT_L(0); PG8_MMA(0, 1, At, B1); PG8_BAR;
            PG8_LDA(At, 0, 1); PG8_STAGE(PG8_SA(0, 0), a2, voffA);
            PG8_BAR; PG8_WAIT_L(0); PG8_MMA(1, 0, At, B0); PG8_BAR; PG8_SCHED;
            PG8_STAGE(PG8_SB(0, 1), b2 + hstep, voffB);
            PG8_WAIT_V(6); PG8_BAR; PG8_MMA(1, 1, At, B1); PG8_BAR;
            PG8_LDB(B0, 1, 0); PG8_SCHED; PG8_LDA(At, 1, 0); PG8_STAGE(PG8_SA(0, 1), a2 + hstep, voffA);
            PG8_WAIT_L(8); PG8_BAR; PG8_WAIT_L(0); PG8_MMA(0, 0, At, B0); PG8_BAR; PG8_SCHED;
            PG8_LDB(B1, 1, 1); PG8_STAGE(PG8_SB(1, 0), b3, voffB);
            PG8_BAR; PG8_WAIT_L(0); PG8_MMA(0, 1, At, B1); PG8_BAR;
            PG8_LDA(At, 1, 1); PG8_STAGE(PG8_SA(1, 0), a3, voffA);
            PG8_BAR; PG8_WAIT_L(0); PG8_MMA(1, 0, At, B0); PG8_BAR; PG8_SCHED;
            PG8_STAGE(PG8_SB(1, 1), b3 + hstep, voffB);
            PG8_WAIT_V(6); PG8_BAR; PG8_MMA(1, 1, At, B1); PG8_BAR;
            }
        }
        if constexpr (ALIGN_EPI) { if (wr == 0) PG8_BAR; }
        E(acc, cur, wr, wc, fr, fq);
        if (!has_next) break;
#pragma unroll
        for (int a = 0; a < 2; ++a)
#pragma unroll
            for (int b = 0; b < 2; ++b)
#pragma unroll
                for (int m = 0; m < 4; ++m)
#pragma unroll
                    for (int n = 0; n < 2; ++n) acc[a][b][m][n] = (f32x4){0.f, 0.f, 0.f, 0.f};
        cur = nxt; cA = nA; cB = nB; ++ui;
        if constexpr (ALIGN_EPI) { if (wr == 1) PG8_BAR; }
    }
    PG8_WAIT_V(0);
    if constexpr (!ALIGN_EPI) { if (wr == 0) PG8_BAR; }
    PG8_BAR;
#undef PG8_SA
#undef PG8_SB
#undef PG8_STAGE
#undef PG8_LDA
#undef PG8_LDB
#undef PG8_MMA
#undef PG8_WAIT_V
#undef PG8_WAIT_L
#undef PG8_BAR
#undef PG8_SCHED
}

template <class Epi, class Sched, bool GATHER>
__device__ __forceinline__ void gemm_phase2(PG8_LAS unsigned char* lds, const Gemm g, const Sched& S, const Epi& E, const PG8_LAS unsigned short* tab) {
    int tid_ = threadIdx.x; asm volatile("" : "+v"(tid_));
    const int tid = tid_, wid = __builtin_amdgcn_readfirstlane(tid >> 6), lane = tid & 63, wr = wid >> 2, wc = wid & 3, fr = lane & 15, fq = lane >> 4;
    const int K = g.K;
    unsigned cofA[2], voffB[2]; int R0 = 0;
#pragma unroll
    for (int i = 0; i < 2; ++i) { int R, C; stage_rc(tid * 16 + i * 8192, R, C); const int Rb = Epi::PERM ? ((R & ~31) + perm32(R & 31)) : R;
        cofA[i] = GATHER ? (unsigned)(C * 2) : (unsigned)(R * K + C) * 2u; voffB[i] = (unsigned)(Rb * K + C) * 2u; if (i == 0) R0 = R; }
    const unsigned pitchA = (unsigned)K * 2u;
    const size_t kstep = (size_t)(BK * 2), hstep = (size_t)HALF * K * 2, tstep = 2 * hstep, hstepA = GATHER ? 0 : hstep;
    const unsigned ldsw = (unsigned)wid * 1024u;
    const int aoff = lds_byte(wr * 64 + fr, fq * 8), boff = lds_byte(wc * 32 + fr, fq * 8);
#define PG8_SA(b, h) (((b) * 2 + (h)) * HTB)
#define PG8_SB(b, h) ((4 + (b) * 2 + (h)) * HTB)
#define PG8_STAGEB(bufoff, gbase) do { _Pragma("unroll") for (int _i = 0; _i < 2; ++_i) \
        __builtin_amdgcn_global_load_lds((const unsigned*)((const char*)(gbase) + voffB[_i]), (PG8_LAS unsigned*)(lds + (bufoff) + ldsw + _i * 8192), 16, 0, 0); } while (0)
#define PG8_STAGEA(bufoff, gbase, tkw) do { _Pragma("unroll") for (int _i = 0; _i < 2; ++_i) { const unsigned _vo = GATHER ? ((((tkw) >> (16 * _i)) & 0xffffu) * pitchA + cofA[_i]) : cofA[_i]; \
        __builtin_amdgcn_global_load_lds((const unsigned*)((const char*)(gbase) + _vo), (PG8_LAS unsigned*)(lds + (bufoff) + ldsw + _i * 8192), 16, 0, 0); } } while (0)
#define PG8_LOADTK(d0, d1, uidx) do { if constexpr (GATHER) { const PG8_LAS unsigned short* _tp = tab + (uidx) * 256 + R0; d0 = (unsigned)_tp[0] | ((unsigned)_tp[64] << 16); d1 = (unsigned)_tp[128] | ((unsigned)_tp[192] << 16); } } while (0)
#define PG8_LDA(dst, b, h) do { _Pragma("unroll") for (int m = 0; m < 4; ++m) _Pragma("unroll") for (int k = 0; k < 2; ++k) dst[m][k] = *(const PG8_LAS bf16x8*)(lds + PG8_SA(b, h) + aoff + m * 2048 + k * 1024); } while (0)
#define PG8_LDB(dst, b, h) do { _Pragma("unroll") for (int n = 0; n < 2; ++n) _Pragma("unroll") for (int k = 0; k < 2; ++k) dst[n][k] = *(const PG8_LAS bf16x8*)(lds + PG8_SB(b, h) + boff + n * 2048 + k * 1024); } while (0)
#define PG8_MMA(ai, bj, At, Bt) do { __builtin_amdgcn_s_setprio(1); _Pragma("unroll") for (int m = 0; m < 4; ++m) _Pragma("unroll") for (int n = 0; n < 2; ++n) _Pragma("unroll") for (int k = 0; k < 2; ++k) \
        acc[ai][bj][m][n] = __builtin_amdgcn_mfma_f32_16x16x32_bf16(Bt[n][k], At[m][k], acc[ai][bj][m][n], 0, 0, 0); __builtin_amdgcn_s_setprio(0); } while (0)
#define PG8_WAIT_V(n) asm volatile("s_waitcnt vmcnt(" #n ")" ::: "memory")
#define PG8_WAIT_L(n) asm volatile("s_waitcnt lgkmcnt(" #n ")" ::: "memory")
#define PG8_BAR __builtin_amdgcn_s_barrier()
#define PG8_SCHED __builtin_amdgcn_sched_barrier(0)
    Unit cur, nxt; int ui = 0;
    if (!S.next(0, cur)) return;
    f32x4 acc[2][2][4][2];
#pragma unroll
    for (int a = 0; a < 2; ++a)
#pragma unroll
        for (int b = 0; b < 2; ++b)
#pragma unroll
            for (int m = 0; m < 4; ++m)
#pragma unroll
                for (int n = 0; n < 2; ++n) acc[a][b][m][n] = (f32x4){0.f, 0.f, 0.f, 0.f};
    bf16x8 At[4][2], B0[2][2], B1[2][2];
    unsigned tkc0 = 0u, tkc1 = 0u, tkn0 = 0u, tkn1 = 0u;
    PG8_LOADTK(tkc0, tkc1, 0);
    const char* cA = (const char*)g.A + (GATHER ? (size_t)0 : (size_t)cur.pm * tstep) + (size_t)cur.kt0 * kstep;
    const char* cB = (const char*)g.Bt + (size_t)cur.e * g.estride + (size_t)cur.pn * tstep + (size_t)cur.kt0 * kstep;
    PG8_STAGEB(PG8_SB(0, 0), cB); PG8_STAGEB(PG8_SB(0, 1), cB + hstep); PG8_STAGEA(PG8_SA(0, 0), cA, tkc0); PG8_STAGEA(PG8_SA(0, 1), cA + hstepA, tkc1);
    if (wr == 1) PG8_BAR;
    PG8_WAIT_V(2); PG8_BAR;
    PG8_STAGEB(PG8_SB(1, 0), cB + kstep); PG8_STAGEA(PG8_SA(1, 0), cA + kstep, tkc0); PG8_STAGEB(PG8_SB(1, 1), cB + hstep + kstep);
    PG8_WAIT_V(6); PG8_BAR;
    for (;;) {
        const bool has_next = S.next(ui + 1, nxt);
        const char* nA = has_next ? (const char*)g.A + (GATHER ? (size_t)0 : (size_t)nxt.pm * tstep) + (size_t)nxt.kt0 * kstep : cA;
        const char* nB = has_next ? (const char*)g.Bt + (size_t)nxt.e * g.estride + (size_t)nxt.pn * tstep + (size_t)nxt.kt0 * kstep : cB;
        tkn0 = tkc0; tkn1 = tkc1;
        if (has_next) PG8_LOADTK(tkn0, tkn1, ui + 1);
        const int nt = cur.nt;
        for (int t = 0; t < nt; t += 2) {
            const bool last = (t == nt - 2);
            const char* a1 = cA + (size_t)(t + 1) * kstep;
            const char* a2 = last ? nA : cA + (size_t)(t + 2) * kstep; const char* b2 = last ? nB : cB + (size_t)(t + 2) * kstep;
            const char* a3 = a2 + kstep; const char* b3 = b2 + kstep;
            const unsigned t20 = last ? tkn0 : tkc0, t21 = last ? tkn1 : tkc1;
            PG8_LDB(B0, 0, 0); PG8_LDB(B1, 0, 1); PG8_SCHED; PG8_LDA(At, 0, 0); PG8_STAGEA(PG8_SA(1, 1), a1 + hstepA, tkc1);
            PG8_WAIT_V(8); PG8_WAIT_L(0); PG8_BAR; PG8_MMA(0, 0, At, B0); PG8_MMA(0, 1, At, B1); PG8_BAR; PG8_SCHED;
            PG8_LDA(At, 0, 1); PG8_STAGEB(PG8_SB(0, 0), b2); PG8_STAGEB(PG8_SB(0, 1), b2 + hstep); PG8_STAGEA(PG8_SA(0, 0), a2, t20);
            PG8_WAIT_V(8); PG8_WAIT_L(0); PG8_BAR; PG8_MMA(1, 0, At, B0); PG8_MMA(1, 1, At, B1); PG8_BAR; PG8_SCHED;
            PG8_LDB(B0, 1, 0); PG8_LDB(B1, 1, 1); PG8_SCHED; PG8_LDA(At, 1, 0); PG8_STAGEA(PG8_SA(0, 1), a2 + hstepA, t21);
            PG8_WAIT_V(8); PG8_WAIT_L(0); PG8_BAR; PG8_MMA(0, 0, At, B0); PG8_MMA(0, 1, At, B1); PG8_BAR; PG8_SCHED;
            PG8_LDA(At, 1, 1); PG8_STAGEB(PG8_SB(1, 0), b3); PG8_STAGEB(PG8_SB(1, 1), b3 + hstep); PG8_STAGEA(PG8_SA(1, 0), a3, t20);
            PG8_WAIT_V(8); PG8_WAIT_L(0); PG8_BAR; PG8_MMA(1, 0, At, B0); PG8_MMA(1, 1, At, B1); PG8_BAR; PG8_SCHED;
        }
        if (wr == 0) PG8_BAR;
        E(acc, cur, wr, wc, fr, fq);
        if (!has_next) break;
#pragma unroll
        for (int a = 0; a < 2; ++a)
#pragma unroll
            for (int b = 0; b < 2; ++b)
#pragma unroll
                for (int m = 0; m < 4; ++m)
#pragma unroll
                    for (int n = 0; n < 2; ++n) acc[a][b][m][n] = (f32x4){0.f, 0.f, 0.f, 0.f};
        cur = nxt; cA = nA; cB = nB; tkc0 = tkn0; tkc1 = tkn1; ++ui;
        if (wr == 1) PG8_BAR;
    }
    PG8_WAIT_V(0);
    PG8_BAR;
#undef PG8_SA
#undef PG8_SB
#undef PG8_STAGEA
#undef PG8_STAGEB
#undef PG8_LOADTK
#undef PG8_LDA
#undef PG8_LDB
#undef PG8_MMA
#undef PG8_WAIT_V
#undef PG8_WAIT_L
#undef PG8_BAR
#undef PG8_SCHED
}
}

constexpr int NWAVES = 8;
constexpr int NTOK = 65536, DM = 1024, SEQ = 8192;
constexpr int MIXIN = 2560, FFN = 2816, QKVD = 1280, EXPD = 3584, NEXP = 8;
constexpr int SETROWS = NTOK + NEXP * 256;
constexpr float EPS = 1e-5f;
constexpr float LOG2E = 1.4426950408889634f;
constexpr float QSCALE = 0.125f * LOG2E;

constexpr size_t MiB = 1u << 20;
constexpr size_t WS_CTL = 0, CTL_ZERO_BYTES = 1 * MiB;
constexpr size_t WS_CS = 1 * MiB;
constexpr size_t WS_TOKINFO = 5 * MiB;
constexpr size_t WS_ROWTOK = 7 * MiB;
constexpr size_t WS_ROWGATE = 8 * MiB;
constexpr size_t WS_WSP = 9 * MiB;
constexpr size_t WS_WIN = 16 * MiB, WS_WOUT = 21 * MiB, WS_FGU = 23 * MiB, WS_FD = 34 * MiB;
constexpr size_t WS_WQKV = 40 * MiB, WS_WO = 43 * MiB, WS_MGU = 45 * MiB, WS_MD = 157 * MiB;
constexpr size_t WS_XN = 216 * MiB;
constexpr size_t WS_XG = 344 * MiB;
constexpr size_t WS_BIG = 476 * MiB;
constexpr size_t WS_END = WS_BIG + (size_t)SETROWS * EXPD * 2;
static_assert(WS_MD + (size_t)NEXP * DM * EXPD * 2 <= WS_XN && WS_XN + (size_t)NTOK * DM * 2 <= WS_XG && WS_XG + (size_t)SETROWS * DM * 2 <= WS_BIG, "d_ws map");
static_assert(WS_FD + (size_t)DM * FFN * 2 <= WS_WQKV && WS_MGU + (size_t)NEXP * 2 * EXPD * DM * 2 <= WS_MD, "d_ws map (weights)");
constexpr int CW_BAR = 4096;
constexpr int CW_CNT = 16384;

constexpr int RING_BYTES = 131072;
constexpr int TAB_OFF = RING_BYTES, TAB_ROUNDS = 29, TAB_BYTES = TAB_ROUNDS * 512;
constexpr int LDSCTL_OFF = TAB_OFF + TAB_BYTES, MISC_OFF = LDSCTL_OFF + 320;
constexpr int LDS_BYTES = 147456;
static_assert(MISC_OFF + 64 <= LDS_BYTES, "LDS map");

#define GAS __attribute__((address_space(1)))
#define LAS __attribute__((address_space(3)))
typedef unsigned short bf16;
typedef unsigned v4u __attribute__((ext_vector_type(4)));
typedef unsigned v2u __attribute__((ext_vector_type(2)));
typedef float f32x4 __attribute__((ext_vector_type(4)));
typedef GAS unsigned gu32;
#define RLX_AGENT __ATOMIC_RELAXED, __HIP_MEMORY_SCOPE_AGENT
#define LDS_WAIT() asm volatile("s_waitcnt lgkmcnt(0)" ::: "memory")
#define VM_WAIT() asm volatile("s_waitcnt vmcnt(0)" ::: "memory")
__device__ __forceinline__ unsigned pk2(float lo, float hi) { return pg8::cvt_pk_bf16(lo, hi); }
__device__ __forceinline__ float bflo(unsigned w) { return __uint_as_float(w << 16); }
__device__ __forceinline__ float bfhi(unsigned w) { return __uint_as_float(w & 0xffff0000u); }
__device__ __forceinline__ float bf1(bf16 h) { return __uint_as_float(((unsigned)h) << 16); }
__device__ __forceinline__ bf16 f2bf1(float f) { return (bf16)(pk2(f, 0.f) & 0xffffu); }
__device__ __forceinline__ void unpack8(const v4u w, float (&f)[8]) { f[0] = bflo(w.x); f[1] = bfhi(w.x); f[2] = bflo(w.y); f[3] = bfhi(w.y); f[4] = bflo(w.z); f[5] = bfhi(w.z); f[6] = bflo(w.w); f[7] = bfhi(w.w); }
__device__ __forceinline__ v4u pack8f(const float (&f)[8]) { v4u w; w.x = pk2(f[0], f[1]); w.y = pk2(f[2], f[3]); w.z = pk2(f[4], f[5]); w.w = pk2(f[6], f[7]); return w; }
__device__ __forceinline__ float gelu_erf(float v) { return 0.5f * v * (1.0f + erff(v * 0.70710678118654752f)); }

#define XB_TMO      128
#define XB_XCNT(j)  (256  + 64 * (j))
#define XB_XSUB(j)  (1280 + 64 * (j))
#define XB_XGEN(j)  (2304 + 64 * (j))
#define XB_TOP      3328
#define XB_TOPGEN   3392
#define XCD_BAR_WORDS 3456
#define XB_SPIN_CAP (1u << 18)

__device__ __forceinline__ unsigned xb_ld(unsigned* p)              { return __hip_atomic_load(p, __ATOMIC_RELAXED, __HIP_MEMORY_SCOPE_AGENT); }
__device__ __forceinline__ unsigned xb_add(unsigned* p, unsigned v) { return __hip_atomic_fetch_add(p, v, __ATOMIC_RELAXED, __HIP_MEMORY_SCOPE_AGENT); }
__device__ __forceinline__ unsigned xb_xcc_id() { return (unsigned)__builtin_amdgcn_s_getreg((3 << 11) | 20) & 0xFu; }
#define XB_SPIN(cond, bar) do { unsigned _sp = 0; while (cond) { __builtin_amdgcn_s_sleep(1); \
    if ((++_sp & 255u) == 0u) { if (xb_ld(&(bar)[XB_TMO])) break; if (_sp > XB_SPIN_CAP) { atomicAdd(&(bar)[XB_TMO], 1u); break; } } } } while (0)

struct XcdBarrier {
    unsigned* bar; unsigned x;
    volatile LAS unsigned* st;
};

__device__ __forceinline__ XcdBarrier xcd_barrier_post(unsigned* bar, volatile LAS unsigned* st) {
    XcdBarrier b; b.bar = bar; b.x = xb_xcc_id(); b.st = st;
    if (threadIdx.x == 0) (void)xb_add(&bar[XB_XCNT(b.x)], 1u);
    return b;
}
__device__ __forceinline__ void xcd_barrier_complete(unsigned* bar, unsigned x, unsigned& nloc, unsigned& nx) {
    const unsigned G = gridDim.x * gridDim.y * gridDim.z;
    unsigned sum, cnt, mine, sp = 0u;
    for (;;) {
        sum = 0u; cnt = 0u; mine = 0u;
#pragma unroll
        for (unsigned j = 0; j < 16; ++j) { const unsigned c = xb_ld(&bar[XB_XCNT(j)]); sum += c; cnt += (c > 0u) ? 1u : 0u; mine = (j == x) ? c : mine; }
        if (sum == G) break;
        __builtin_amdgcn_s_sleep(1);
        if ((++sp & 255u) == 0u) { if (xb_ld(&bar[XB_TMO])) break; if (sp > XB_SPIN_CAP) { atomicAdd(&bar[XB_TMO], 1u); break; } }
    }
    nloc = mine > 0u ? mine : 1u; nx = cnt > 0u ? cnt : 1u;
}

__device__ __forceinline__ void xcd_barrier(const XcdBarrier& b) {
    asm volatile("s_waitcnt vmcnt(0)" ::: "memory");
    __syncthreads();
    if (threadIdx.x == 0) {
        unsigned* bar = b.bar;
        __builtin_amdgcn_s_waitcnt(0);
        unsigned nloc = b.st[0], nx = b.st[1];
        if (nloc == 0u) { xcd_barrier_complete(bar, b.x, nloc, nx); b.st[0] = nloc; b.st[1] = nx; }
        const unsigned old = xb_add(&bar[XB_XSUB(b.x)], 1u);
        const unsigned gen = old / nloc;
        if (old + 1u == (gen + 1u) * nloc) {
            __builtin_amdgcn_fence(__ATOMIC_RELEASE, "agent");
            asm volatile("s_waitcnt vmcnt(0)" ::: "memory");
            const unsigned og = xb_add(&bar[XB_TOP], 1u);
            const unsigned tg = og / nx;
            if (og + 1u == (tg + 1u) * nx) xb_add(&bar[XB_TOPGEN], 1u);
            else XB_SPIN(xb_ld(&bar[XB_TOPGEN]) == tg, bar);
            __builtin_amdgcn_fence(__ATOMIC_ACQUIRE, "agent");
            xb_add(&bar[XB_XGEN(b.x)], 1u);
            asm volatile("s_waitcnt vmcnt(0)" ::: "memory");
        } else {
            XB_SPIN(xb_ld(&bar[XB_XGEN(b.x)]) == gen, bar);
            __builtin_amdgcn_fence(__ATOMIC_ACQUIRE, "agent");
            asm volatile("s_waitcnt vmcnt(0)" ::: "memory");
        }
    }
    __syncthreads();
}

struct Frame {
    LAS unsigned char* lds;
    int tid, lane, wave;
    int vcu, G;
};
__device__ __forceinline__ float wave_sum(float v) {
#pragma unroll
    for (int o = 1; o < 64; o <<= 1) v += __shfl_xor(v, o);
    return v;
}

__device__ __forceinline__ void tr_item(const float* W, int N, int k0, int n0, bf16* WT, int K, int orow0, LAS float* scr, int lane, float scale = 1.0f) {
#pragma unroll 8
    for (int i = 0; i < 32; ++i) { const int kk = 2 * i + (lane >> 5); scr[kk * 33 + (lane & 31)] = W[(size_t)(k0 + kk) * N + n0 + (lane & 31)] * scale; }
    LDS_WAIT(); asm volatile("" ::: "memory");
    const int c = lane & 7;
#pragma unroll
    for (int j = 0; j < 4; ++j) { const int n = (lane >> 3) + 8 * j; const LAS float* s = scr + (8 * c) * 33 + n;
        v4u o; o.x = pk2(s[0 * 33], s[1 * 33]); o.y = pk2(s[2 * 33], s[3 * 33]); o.z = pk2(s[4 * 33], s[5 * 33]); o.w = pk2(s[6 * 33], s[7 * 33]);
        *(GAS v4u*)(WT + (size_t)(orow0 + n) * K + k0 + 8 * c) = o; }
    LDS_WAIT(); asm volatile("" ::: "memory");
}
__device__ __forceinline__ void tr_plain(const float* W, int K, int N, bf16* WT, int item, LAS float* scr, int lane) {
    const int nblk = N / 32, kb = item / nblk, nb = item % nblk; tr_item(W, N, 64 * kb, 32 * nb, WT, K, 32 * nb, scr, lane);
}
__device__ __forceinline__ void tr_gu(const float* W, int K, int N, bf16* WT, int up, int item, LAS float* scr, int lane) {
    const int nblk = N / 32, kb = item / nblk, nb = item % nblk, n0 = 32 * nb; tr_item(W, N, 64 * kb, n0, WT, K, 256 * (n0 / 128) + 128 * up + (n0 % 128), scr, lane, up ? 0.6931471805599453f : 1.4426950408889634f);
}

__device__ __forceinline__ void conv_even_phase(const Frame& F, const float* w_in, const float* w_out, const float* wg, const float* wu, const float* wd, const float* sw, unsigned char* ws) {
    LAS float* scr = (LAS float*)(F.lds + F.wave * 16384);
    const int gw = F.vcu * NWAVES + F.wave, NGW = F.G * NWAVES;
    constexpr int I_IN = (DM / 64) * (MIXIN / 32), I_OUT = (DM / 64) * (DM / 32), I_G = (DM / 64) * (FFN / 32), I_D = (FFN / 64) * (DM / 32);
    constexpr int NITEMS = I_IN + I_OUT + 2 * I_G + I_D;
    for (int it = gw; it < NITEMS; it += NGW) {
        int r = it;
        if (r < I_IN) { tr_plain(w_in, DM, MIXIN, (bf16*)(ws + WS_WIN), r, scr, F.lane); continue; } r -= I_IN;
        if (r < I_OUT) { tr_plain(w_out, DM, DM, (bf16*)(ws + WS_WOUT), r, scr, F.lane); continue; } r -= I_OUT;
        if (r < I_G) { tr_gu(wg, DM, FFN, (bf16*)(ws + WS_FGU), 0, r, scr, F.lane); continue; } r -= I_G;
        if (r < I_G) { tr_gu(wu, DM, FFN, (bf16*)(ws + WS_FGU), 1, r, scr, F.lane); continue; } r -= I_G;
        tr_plain(wd, FFN, DM, (bf16*)(ws + WS_FD), r, scr, F.lane);
    }
    bf16* wsp = (bf16*)(ws + WS_WSP);
    for (int idx = (F.vcu * NWAVES * 64) + F.tid; idx < 4 * 128 * 128; idx += F.G * NWAVES * 64) { const int ii = (idx >> 7) & 127, jj = idx & 127; wsp[idx] = f2bf1((jj <= ii) ? sw[idx] : 0.f); }
}
__device__ __forceinline__ void conv_odd_phase(const Frame& F, const float* wqkv, const float* wo, const float* ewg, const float* ewu, const float* ewd, unsigned char* ws) {
    LAS float* scr = (LAS float*)(F.lds + F.wave * 16384);
    const int gw = F.vcu * NWAVES + F.wave, NGW = F.G * NWAVES;
    constexpr int I_Q = (DM / 64) * (QKVD / 32), I_O = (DM / 64) * (DM / 32), I_G = (DM / 64) * (EXPD / 32), I_D = (EXPD / 64) * (DM / 32);
    constexpr int NITEMS = I_Q + I_O + NEXP * (2 * I_G + I_D);
    for (int it = gw; it < NITEMS; it += NGW) {
        int r = it;
        if (r < I_Q) { tr_plain(wqkv, DM, QKVD, (bf16*)(ws + WS_WQKV), r, scr, F.lane); continue; } r -= I_Q;
        if (r < I_O) { tr_plain(wo, DM, DM, (bf16*)(ws + WS_WO), r, scr, F.lane); continue; } r -= I_O;
        const int e = r / (2 * I_G + I_D); r -= e * (2 * I_G + I_D);
        bf16* gu = (bf16*)(ws + WS_MGU) + (size_t)e * 2 * EXPD * DM; bf16* dd = (bf16*)(ws + WS_MD) + (size_t)e * DM * EXPD;
        if (r < I_G) { tr_gu(ewg + (size_t)e * DM * EXPD, DM, EXPD, gu, 0, r, scr, F.lane); continue; } r -= I_G;
        if (r < I_G) { tr_gu(ewu + (size_t)e * DM * EXPD, DM, EXPD, gu, 1, r, scr, F.lane); continue; } r -= I_G;
        tr_plain(ewd + (size_t)e * EXPD * DM, EXPD, DM, dd, r, scr, F.lane);
    }
}
__device__ __forceinline__ void rope_table_phase(const Frame& F, const int* pos, float* cs) {
    for (int idx = (F.vcu * NWAVES * 64) + F.tid; idx < NTOK * 8; idx += F.G * NWAVES * 64) {
        const int t = idx >> 3, i = idx & 7;
        const float inv = (float)exp(-log(500000.0) * (double)(2 * i) / 16.0);
        const float ang = (float)pos[t] * inv;
        cs[(size_t)t * 16 + i] = (float)cos((double)ang); cs[(size_t)t * 16 + 8 + i] = (float)sin((double)ang);
    }
}
__device__ __forceinline__ void rms_phase(const Frame& F, const float* hin, const float* g, bf16* XN) {
    const int gw = F.vcu * NWAVES + F.wave, NGW = F.G * NWAVES;
    f32x4 gv[4];
#pragma unroll
    for (int j = 0; j < 4; ++j) gv[j] = ((const f32x4*)g)[F.lane + 64 * j];
    for (int m = gw; m < NTOK; m += NGW) {
        const GAS f32x4* xr = (const GAS f32x4*)(hin + (size_t)m * DM) + F.lane;
        f32x4 v[4]; float s = 0.f;
#pragma unroll
        for (int j = 0; j < 4; ++j) { v[j] = xr[64 * j]; s += (v[j].x * v[j].x + v[j].y * v[j].y) + (v[j].z * v[j].z + v[j].w * v[j].w); }
        const float rstd = 1.0f / sqrtf(wave_sum(s) * (1.f / DM) + EPS);
        GAS v2u* o8 = (GAS v2u*)(XN + (size_t)m * DM) + F.lane;
#pragma unroll
        for (int j = 0; j < 4; ++j) { const f32x4 y = v[j] * rstd * gv[j]; v2u w; w.x = pk2(y.x, y.y); w.y = pk2(y.z, y.w); o8[64 * j] = w; }
    }
}
__device__ __forceinline__ void rms_final_phase(const Frame& F, float* h, const float* g) {
    const int gw = F.vcu * NWAVES + F.wave, NGW = F.G * NWAVES;
    f32x4 gv[4];
#pragma unroll
    for (int j = 0; j < 4; ++j) gv[j] = ((const f32x4*)g)[F.lane + 64 * j];
    for (int m = gw; m < NTOK; m += NGW) {
        GAS f32x4* xr = (GAS f32x4*)(h + (size_t)m * DM) + F.lane;
        f32x4 v[4]; float s = 0.f;
#pragma unroll
        for (int j = 0; j < 4; ++j) { v[j] = xr[64 * j]; s += (v[j].x * v[j].x + v[j].y * v[j].y) + (v[j].z * v[j].z + v[j].w * v[j].w); }
        const float rstd = 1.0f / sqrtf(wave_sum(s) * (1.f / DM) + EPS);
#pragma unroll
        for (int j = 0; j < 4; ++j) xr[64 * j] = v[j] * rstd * gv[j];
    }
}
__device__ __forceinline__ void rms_router_phase(const Frame& F, const float* h, const float* g, const float* rw, bf16* XN, unsigned* gcnt, unsigned* tokinfo, int* rowtok) {
    for (int idx = (F.vcu * NWAVES * 64) + F.tid; idx < 2 * SETROWS; idx += F.G * NWAVES * 64) rowtok[idx] = -1;
    LAS unsigned* lcnt = (LAS unsigned*)F.lds;
    LAS unsigned* lbase = lcnt + 16;
    LAS unsigned* rec = lcnt + 64;
    f32x4 gv[4];
#pragma unroll
    for (int j = 0; j < 4; ++j) gv[j] = ((const f32x4*)g)[F.lane + 64 * j];
    f32x4 rwv[4][4][2];
#pragma unroll
    for (int j = 0; j < 4; ++j)
#pragma unroll
        for (int c = 0; c < 4; ++c) { const f32x4* p = (const f32x4*)(rw + (size_t)(256 * j + 4 * F.lane + c) * 8); rwv[j][c][0] = p[0]; rwv[j][c][1] = p[1]; }
    for (int panel = F.vcu; panel < NTOK / 256; panel += F.G) {
        if (F.tid < 16) lcnt[F.tid] = 0u;
        __syncthreads();
        for (int r = 0; r < 32; ++r) {
            const int lrow = F.wave * 32 + r, m = panel * 256 + lrow;
            const GAS f32x4* xr = (const GAS f32x4*)(h + (size_t)m * DM) + F.lane;
            f32x4 v[4]; float s = 0.f;
#pragma unroll
            for (int j = 0; j < 4; ++j) { v[j] = xr[64 * j]; s += (v[j].x * v[j].x + v[j].y * v[j].y) + (v[j].z * v[j].z + v[j].w * v[j].w); }
            const float rstd = 1.0f / sqrtf(wave_sum(s) * (1.f / DM) + EPS);
            GAS v2u* o8 = (GAS v2u*)(XN + (size_t)m * DM) + F.lane;
            f32x4 l0 = (f32x4){0.f, 0.f, 0.f, 0.f}, l1 = l0;
#pragma unroll
            for (int j = 0; j < 4; ++j) { const f32x4 y = v[j] * rstd * gv[j]; v2u w; w.x = pk2(y.x, y.y); w.y = pk2(y.z, y.w); o8[64 * j] = w;
                l0 += rwv[j][0][0] * y.x + rwv[j][1][0] * y.y + rwv[j][2][0] * y.z + rwv[j][3][0] * y.w;
                l1 += rwv[j][0][1] * y.x + rwv[j][1][1] * y.y + rwv[j][2][1] * y.z + rwv[j][3][1] * y.w; }
            float lg[8];
#pragma unroll
            for (int e = 0; e < 4; ++e) { lg[e] = wave_sum(l0[e]); lg[4 + e] = wave_sum(l1[e]); }
            int e1 = 0; float v1 = lg[0];
#pragma unroll
            for (int e = 1; e < 8; ++e) if (lg[e] > v1) { v1 = lg[e]; e1 = e; }
            int e2 = -1; float v2 = -INFINITY;
#pragma unroll
            for (int e = 0; e < 8; ++e) if (e != e1 && (e2 < 0 || lg[e] > v2)) { v2 = lg[e]; e2 = e; }
            const float g2 = 1.0f / (1.0f + expf(v1 - v2)), g1 = 1.0f - g2;
            if (F.lane == 0) {
                const unsigned p1 = atomicAdd((unsigned*)(lcnt + e1), 1u), p2 = atomicAdd((unsigned*)(lcnt + 8 + e2), 1u);
                LAS unsigned* rr = rec + lrow * 8; rr[0] = (unsigned)e1; rr[1] = p1; rr[2] = __float_as_uint(g1); rr[3] = (unsigned)e2; rr[4] = p2; rr[5] = __float_as_uint(g2);
            }
        }
        __syncthreads();
        if (F.tid < 16) lbase[F.tid] = __hip_atomic_fetch_add(gcnt + F.tid, lcnt[F.tid], RLX_AGENT);
        __syncthreads();
        if (F.tid < 256) { const LAS unsigned* rr = rec + F.tid * 8; v4u a, b; a.x = rr[0]; a.y = rr[1] + lbase[rr[0]]; a.z = rr[2]; a.w = rr[3]; b.x = rr[4] + lbase[8 + rr[3]]; b.y = rr[5]; b.z = 0u; b.w = 0u;
            GAS v4u* ti = (GAS v4u*)(tokinfo + (size_t)(panel * 256 + F.tid) * 8); ti[0] = a; ti[1] = b; }
        __syncthreads();
    }
}
__device__ __forceinline__ void moe_prefix(const unsigned* gcnt_set, int (&pend)[8]) {
    int acc = 0;
#pragma unroll
    for (int e = 0; e < 8; ++e) { const unsigned c = __hip_atomic_load(gcnt_set + e, RLX_AGENT); acc += (int)((c + 255u) >> 8); pend[e] = acc; }
}
__device__ __forceinline__ void slots_phase(const Frame& F, const unsigned* gcnt, const unsigned* tokinfo, int* rowtok, float* rowgate) {
    int pe0[8], pe1[8]; moe_prefix(gcnt, pe0); moe_prefix(gcnt + 8, pe1);
    for (int t = F.vcu * NWAVES * 64 + F.tid; t < NTOK; t += F.G * NWAVES * 64) {
        const v4u a = *(const GAS v4u*)(tokinfo + (size_t)t * 8), b = *(const GAS v4u*)(tokinfo + (size_t)t * 8 + 4);
        const int e1 = (int)a.x, e2 = (int)a.w; int s1 = 0, s2 = 0;
#pragma unroll
        for (int k = 0; k < 7; ++k) { s1 = (e1 == k + 1) ? pe0[k] : s1; s2 = (e2 == k + 1) ? pe1[k] : s2; }
        const size_t slot1 = (size_t)s1 * 256 + a.y, slot2 = (size_t)SETROWS + (size_t)s2 * 256 + b.x;
        rowtok[slot1] = t; rowgate[slot1] = __uint_as_float(a.z); rowtok[slot2] = t; rowgate[slot2] = __uint_as_float(b.y);
    }
}

typedef short bf16x8v __attribute__((ext_vector_type(8)));
typedef float f32x16 __attribute__((ext_vector_type(16)));
constexpr int AT_KP = 144, AT_VP = 528, AT_VOFF = 256 * AT_KP;
__device__ __forceinline__ void attn_mfma_phase(const Frame& F, const bf16* QKV, const float* sinks, bf16* AO) {
    LAS unsigned char* Ks = F.lds; LAS unsigned char* Vt = F.lds + AT_VOFF;
    const int q = F.lane & 31, hi = F.lane >> 5;
    for (int unit = F.vcu; unit < 8 * 64 * 2; unit += F.G) {
        const int b = unit >> 7, n = (unit >> 1) & 63, hk = unit & 1;
        const size_t tb = (size_t)b * SEQ;
#pragma unroll
        for (int i = 0; i < 4; ++i) { const int p = F.tid + 512 * i, key = p >> 3, ch = p & 7;
            const int kt = (n == 0 && key < 128) ? key : (n - 1) * 128 + key;
            const bf16* src = QKV + (tb + kt) * QKVD + 1024 + hk * 64 + ch * 8;
            *(LAS v4u*)(Ks + key * AT_KP + ch * 16) = *(const GAS v4u*)src;
            const v4u v = *(const GAS v4u*)(src + 128);
            const int kg = key & 15, kpos = (key & ~15) + (kg & 3) + ((kg >> 3) & 1) * 4 + ((kg >> 2) & 1) * 8;
            LAS unsigned short* vp = (LAS unsigned short*)(Vt + (ch * 8) * AT_VP + kpos * 2);
            vp[0 * (AT_VP / 2)] = (unsigned short)(v.x & 0xffffu); vp[1 * (AT_VP / 2)] = (unsigned short)(v.x >> 16); vp[2 * (AT_VP / 2)] = (unsigned short)(v.y & 0xffffu); vp[3 * (AT_VP / 2)] = (unsigned short)(v.y >> 16);
            vp[4 * (AT_VP / 2)] = (unsigned short)(v.z & 0xffffu); vp[5 * (AT_VP / 2)] = (unsigned short)(v.z >> 16); vp[6 * (AT_VP / 2)] = (unsigned short)(v.w & 0xffffu); vp[7 * (AT_VP / 2)] = (unsigned short)(v.w >> 16); }
        __syncthreads();
        const int head = hk * 8 + F.wave; const float sk = sinks[head] * LOG2E;
#pragma unroll 1
        for (int qt = 0; qt < 4; ++qt) {
            const size_t qrow = tb + (size_t)n * 128 + qt * 32 + q;
            bf16x8v qf[4];
#pragma unroll
            for (int d0 = 0; d0 < 4; ++d0) qf[d0] = *(const GAS bf16x8v*)(QKV + qrow * QKVD + head * 64 + 16 * d0 + 8 * hi);
            f32x16 p[5];
#pragma unroll
            for (int j = 0; j < 5; ++j) {
                const int kt = qt + j;
                if (n == 0 && kt < 4) {
#pragma unroll
                    for (int r = 0; r < 16; ++r) p[j][r] = -INFINITY;
                } else {
                    f32x16 a = {0.f, 0.f, 0.f, 0.f, 0.f, 0.f, 0.f, 0.f, 0.f, 0.f, 0.f, 0.f, 0.f, 0.f, 0.f, 0.f};
                    const LAS unsigned char* kp = Ks + (32 * kt + q) * AT_KP + 16 * hi;
#pragma unroll
                    for (int d0 = 0; d0 < 4; ++d0) a = __builtin_amdgcn_mfma_f32_32x32x16_bf16(*(const LAS bf16x8v*)(kp + 32 * d0), qf[d0], a, 0, 0, 0);
                    p[j] = a;
                }
            }
#pragma unroll
            for (int r = 0; r < 16; ++r) { const int key = (r & 3) + 8 * (r >> 2) + 4 * hi; if (key <= q) p[0][r] = -INFINITY; if (key > q) p[4][r] = -INFINITY; }
            float mx = sk;
#pragma unroll
            for (int j = 0; j < 5; ++j)
#pragma unroll
                for (int r = 0; r < 16; ++r) mx = fmaxf(mx, p[j][r]);
            mx = fmaxf(mx, __shfl_xor(mx, 32));
            float ls = 0.f;
#pragma unroll
            for (int j = 0; j < 5; ++j)
#pragma unroll
                for (int r = 0; r < 16; ++r) { p[j][r] = __builtin_amdgcn_exp2f(p[j][r] - mx); ls += p[j][r]; }
            ls += __shfl_xor(ls, 32); ls += __builtin_amdgcn_exp2f(sk - mx);
            f32x16 o0 = {0.f, 0.f, 0.f, 0.f, 0.f, 0.f, 0.f, 0.f, 0.f, 0.f, 0.f, 0.f, 0.f, 0.f, 0.f, 0.f}, o1 = o0;
#pragma unroll
            for (int j = 0; j < 5; ++j) {
                const int kt = qt + j;
                if (!(n == 0 && kt < 4)) {
#pragma unroll
                    for (int ks = 0; ks < 2; ++ks) {
                        v4u pw; pw.x = pk2(p[j][8 * ks + 0], p[j][8 * ks + 1]); pw.y = pk2(p[j][8 * ks + 2], p[j][8 * ks + 3]); pw.z = pk2(p[j][8 * ks + 4], p[j][8 * ks + 5]); pw.w = pk2(p[j][8 * ks + 6], p[j][8 * ks + 7]);
                        const bf16x8v pf = __builtin_bit_cast(bf16x8v, pw);
                        const LAS unsigned char* vp = Vt + q * AT_VP + (32 * kt + 16 * ks + 8 * hi) * 2;
                        o0 = __builtin_amdgcn_mfma_f32_32x32x16_bf16(*(const LAS bf16x8v*)vp, pf, o0, 0, 0, 0);
                        o1 = __builtin_amdgcn_mfma_f32_32x32x16_bf16(*(const LAS bf16x8v*)(vp + 32 * AT_VP), pf, o1, 0, 0, 0);
                    }
                }
            }
            const float il = 1.0f / ls;
            bf16* orow = AO + qrow * DM + head * 64 + 4 * hi;
#pragma unroll
            for (int jg = 0; jg < 4; ++jg) { v2u w0, w1;
                w0.x = pk2(o0[4 * jg] * il, o0[4 * jg + 1] * il); w0.y = pk2(o0[4 * jg + 2] * il, o0[4 * jg + 3] * il);
                w1.x = pk2(o1[4 * jg] * il, o1[4 * jg + 1] * il); w1.y = pk2(o1[4 * jg + 2] * il, o1[4 * jg + 3] * il);
                *(GAS v2u*)(orow + 8 * jg) = w0; *(GAS v2u*)(orow + 32 + 8 * jg) = w1; }
        }
        __syncthreads();
    }
}

typedef float f32x2 __attribute__((ext_vector_type(2)));
__device__ __forceinline__ f32x2 gelu_pk(f32x2 v) {
    const f32x2 av = __builtin_elementwise_abs(v), d = av * 0.2316418882f + 1.0f;
    f32x2 t; t.x = __builtin_amdgcn_rcpf(d.x); t.y = __builtin_amdgcn_rcpf(d.y);
    f32x2 q = t * 0.5307027145f + (-0.7265760135f); q = q * t + 0.7107068705f; q = q * t + (-0.142248368f); q = q * t + 0.127414796f; q = q * t;
    const f32x2 s = (v * v) * (-0.72134752044f);
    f32x2 e; e.x = __builtin_amdgcn_exp2f(s.x); e.y = __builtin_amdgcn_exp2f(s.y);
    const f32x2 m = v * (q * e), r = v - m;
    f32x2 o; o.x = v.x < 0.f ? m.x : r.x; o.y = v.y < 0.f ? m.y : r.y; return o;
}
__device__ __forceinline__ int mx_swz(int row) { return (row ^ (row >> 4)) & 15; }
__device__ __forceinline__ void mixer_fused_phase(const Frame& F, const bf16* Z, bf16* Y, const float* convw, const float* lng, const float* lnb, const bf16* Wb, const float* sb) {
    LAS unsigned char* vt = F.lds;
    const int c8 = 8 * F.lane, q = F.lane & 31, hi = F.lane >> 5;
    for (int unit = F.vcu; unit < NTOK / 128; unit += F.G) {
        const size_t t0 = (size_t)unit * 128;
        {
            float cw0[8], cw1[8], cw2[8], lg[8], lb[8];
#pragma unroll
            for (int j = 0; j < 8; ++j) { cw0[j] = convw[(c8 + j) * 3 + 0]; cw1[j] = convw[(c8 + j) * 3 + 1]; cw2[j] = convw[(c8 + j) * 3 + 2]; lg[j] = lng[c8 + j]; lb[j] = lnb[c8 + j]; }
            const size_t tw = t0 + 16 * F.wave;
            float cx1[8], cx2[8];
            if ((tw % SEQ) != 0) {
                float a[8], b[8];
                unpack8(*(const GAS v4u*)(Z + (tw - 1) * MIXIN + 512 + c8), a); unpack8(*(const GAS v4u*)(Z + (tw - 1) * MIXIN + 1024 + c8), b);
#pragma unroll
                for (int j = 0; j < 8; ++j) cx1[j] = a[j] * b[j];
                unpack8(*(const GAS v4u*)(Z + (tw - 2) * MIXIN + 512 + c8), a); unpack8(*(const GAS v4u*)(Z + (tw - 2) * MIXIN + 1024 + c8), b);
#pragma unroll
                for (int j = 0; j < 8; ++j) cx2[j] = a[j] * b[j];
            } else {
#pragma unroll
                for (int j = 0; j < 8; ++j) { cx1[j] = 0.f; cx2[j] = 0.f; }
            }
#pragma unroll 2
            for (int r = 0; r < 16; ++r) {
                const size_t t = tw + r; const int jl = 16 * F.wave + r;
                const bf16* zr = Z + t * MIXIN;
                float ab[8], ac[8], ax[8], bv[8];
                unpack8(*(const GAS v4u*)(zr + c8), ab); unpack8(*(const GAS v4u*)(zr + 512 + c8), ac); unpack8(*(const GAS v4u*)(zr + 1024 + c8), ax); unpack8(*(const GAS v4u*)(zr + 2048 + c8), bv);
                float ya[8], vv[8]; float s = 0.f;
#pragma unroll
                for (int j = 0; j < 8; ++j) { const float cx0 = ac[j] * ax[j]; ya[j] = ab[j] * (cw0[j] * cx2[j] + cw1[j] * cx1[j] + cw2[j] * cx0); cx2[j] = cx1[j]; cx1[j] = cx0; }
#pragma unroll
                for (int j = 0; j < 8; j += 2) { const f32x2 gv = gelu_pk((f32x2){bv[j], bv[j + 1]}); vv[j] = gv.x; vv[j + 1] = gv.y; s += gv.x + gv.y; }
                *(GAS v4u*)(Y + t * DM + c8) = pack8f(ya);
                const float mu = wave_sum(s) * (1.f / 512.f); float qq = 0.f;
#pragma unroll
                for (int j = 0; j < 8; ++j) { vv[j] -= mu; qq += vv[j] * vv[j]; }
                const float rstd = 1.0f / sqrtf(wave_sum(qq) * (1.f / 512.f) + EPS);
#pragma unroll
                for (int j = 0; j < 8; ++j) { const int row = c8 + j; const float y = vv[j] * rstd * lg[j] + lb[j];
                    *(LAS unsigned short*)(vt + row * 256 + (((jl >> 3) ^ mx_swz(row)) << 4) + (jl & 7) * 2) = f2bf1(y); }
            }
        }
        __syncthreads();
        {
            const int h = F.wave >> 1, dt0 = 2 * (F.wave & 1);
#pragma unroll
            for (int it = 0; it < 4; ++it) {
                bf16x8v wf[8];
                const bf16* wrow = Wb + (size_t)(h * 128 + 32 * it + q) * 128 + 8 * hi;
#pragma unroll
                for (int ks = 0; ks < 2 * (it + 1); ++ks) wf[ks] = *(const GAS bf16x8v*)(wrow + 16 * ks);
                const size_t tok = t0 + 32 * it + q; const float sbv = sb[h * 128 + 32 * it + q];
#pragma unroll
                for (int dl = 0; dl < 2; ++dl) {
                    const int dt = dt0 + dl, row = h * 128 + 32 * dt + q; const LAS unsigned char* ap = vt + row * 256; const int sw = mx_swz(row);
                    f32x16 acc = {0.f, 0.f, 0.f, 0.f, 0.f, 0.f, 0.f, 0.f, 0.f, 0.f, 0.f, 0.f, 0.f, 0.f, 0.f, 0.f};
#pragma unroll
                    for (int ks = 0; ks < 2 * (it + 1); ++ks) acc = __builtin_amdgcn_mfma_f32_32x32x16_bf16(*(const LAS bf16x8v*)(ap + (((2 * ks + hi) ^ sw) << 4)), wf[ks], acc, 0, 0, 0);
                    const int cb = h * 128 + 32 * dt + 4 * hi;
#pragma unroll
                    for (int jg = 0; jg < 4; ++jg) { const v2u bw = *(const GAS v2u*)(Z + tok * MIXIN + 1536 + cb + 8 * jg);
                        const f32x2 u0 = gelu_pk((f32x2){bflo(bw.x), bfhi(bw.x)}), u1 = gelu_pk((f32x2){bflo(bw.y), bfhi(bw.y)});
                        v2u w; w.x = pk2(u0.x * (acc[4 * jg] + sbv), u0.y * (acc[4 * jg + 1] + sbv)); w.y = pk2(u1.x * (acc[4 * jg + 2] + sbv), u1.y * (acc[4 * jg + 3] + sbv));
                        *(GAS v2u*)(Y + tok * DM + 512 + cb + 8 * jg) = w; }
                }
            }
        }
        __syncthreads();
    }
}

struct Args {
    const float* x; const int* pos; const float* fng;
    const float *e_n1, *e_win, *e_conv, *e_lng, *e_lnb, *e_sw, *e_sb, *e_wout, *e_n2, *e_wg, *e_wu, *e_wd;
    const float *o_n1, *o_wqkv, *o_bqkv, *o_sinks, *o_wo, *o_bo, *o_n2, *o_rw, *o_ewg, *o_ewu, *o_ewd;
    float* out; unsigned char* ws; int lo, hi, li, pad;
};
constexpr int PH_PER_PAIR = 17;
constexpr int N_PHASES = 1 + 2 * PH_PER_PAIR + 1;

typedef const __attribute__((address_space(4))) Args* ArgsP;
#define PH_ARGS(ap) ArgsP ap = (ArgsP)__builtin_amdgcn_kernarg_segment_ptr(); asm volatile("" : "+s"(ap))
__device__ __forceinline__ Frame make_frame(LAS unsigned char* lds) {
    Frame F; int tid = threadIdx.x; asm volatile("" : "+v"(tid));
    F.lds = lds; F.tid = tid; F.lane = tid & 63; F.wave = __builtin_amdgcn_readfirstlane(tid >> 6);
    F.G = gridDim.x; { const int bx = blockIdx.x; F.vcu = (F.G % 8 == 0) ? (bx % 8) * (F.G / 8) + bx / 8 : bx; }
    return F;
}
__global__ void __launch_bounds__(NWAVES * 64, 2) fwd(Args A_unused) {
    extern __shared__ __attribute__((aligned(16))) unsigned char lds_raw[];
    LAS unsigned char* const lds = (LAS unsigned char*)lds_raw;
    for (int u = threadIdx.x; u < (LDS_BYTES - LDSCTL_OFF) / 4; u += NWAVES * 64) ((LAS unsigned*)(lds + LDSCTL_OFF))[u] = 0u;
    __syncthreads();
    int lo, hi;
    { PH_ARGS(ap); lo = ap->lo; hi = ap->hi; }
#if MK_ONE_LAUNCH
    XcdBarrier bar;
    { PH_ARGS(ap); bar = xcd_barrier_post((unsigned*)(ap->ws + WS_CTL) + CW_BAR, (volatile LAS unsigned*)(lds + MISC_OFF) + 8); }
#define GRID_BAR() xcd_barrier(bar)
#else
#define GRID_BAR() do { } while (0)
#endif
#ifndef PHMASK
#define PHMASK 0xFFFFFFFFu
#endif
#define PHEN(k) (((PHMASK) >> (k)) & 1u)
#ifndef PROBE_DUP
#define PROBE_DUP 0u
#endif
#define DUP(k) (1 + (int)(((PROBE_DUP) >> (k)) & 1u))
#define IN(k) (lo <= (k) && (k) < hi)
#define SEAM(k) do { if (IN(k) && IN((k) + 1)) GRID_BAR(); } while (0)
#define PH_BEGIN() PH_ARGS(ap); const Frame F = make_frame(lds); unsigned char* const ws = ap->ws; const int G = F.G, cblk = (int)blockIdx.x; (void)G; (void)cblk

    if (IN(0) && PHEN(16)) { PH_BEGIN(); rope_table_phase(F, ap->pos, (float*)(ws + WS_CS)); } SEAM(0);

#pragma unroll 1
    for (int i = 0; i < 2; ++i) {
        const int pb = 1 + i * PH_PER_PAIR;
        if (IN(pb + 0) && PHEN(0)) { PH_BEGIN(); for (int rep_ = 0; rep_ < DUP(0); ++rep_) { conv_even_phase(F, ap->e_win + (size_t)i * DM * MIXIN, ap->e_wout + (size_t)i * DM * DM, ap->e_wg + (size_t)i * DM * FFN, ap->e_wu + (size_t)i * DM * FFN, ap->e_wd + (size_t)i * FFN * DM, ap->e_sw + (size_t)i * 4 * 128 * 128, ws);
                          rms_phase(F, (i == 0) ? ap->x : ap->out, ap->e_n1 + i * DM, (bf16*)(ws + WS_XN)); } } SEAM(pb + 0);
        if (IN(pb + 1) && PHEN(1)) { PH_BEGIN(); for (int rep_ = 0; rep_ < DUP(1); ++rep_) { pg8::Gemm g{(const bf16*)(ws + WS_XN), (const bf16*)(ws + WS_WIN), DM, 0}; pg8::StaticOrder S; S.init(NTOK, MIXIN, G, cblk); pg8::EpiBf16Plain E{(bf16*)(ws + WS_BIG), MIXIN};
                          pg8::gemm_phase<pg8::EpiBf16Plain, pg8::StaticOrder, true, true>(F.lds, g, S, E); } } SEAM(pb + 1);
        if (IN(pb + 2) && PHEN(2)) { PH_BEGIN(); for (int rep_ = 0; rep_ < DUP(2); ++rep_) { mixer_fused_phase(F, (const bf16*)(ws + WS_BIG), (bf16*)(ws + WS_XN), ap->e_conv + i * 512 * 3, ap->e_lng + i * 512, ap->e_lnb + i * 512, (const bf16*)(ws + WS_WSP), ap->e_sb + i * 4 * 128); } } SEAM(pb + 2);
        if (IN(pb + 3) && PHEN(4)) { PH_BEGIN(); for (int rep_ = 0; rep_ < DUP(4); ++rep_) { pg8::Gemm g{(const bf16*)(ws + WS_XN), (const bf16*)(ws + WS_WOUT), DM, 0}; pg8::StaticOrder S; S.init(NTOK, DM, G, cblk); pg8::EpiResF32 E{(i == 0) ? ap->x : ap->out, (rep_ + 1 < DUP(4)) ? (float*)(ws + WS_BIG) : ap->out, DM, nullptr};
                          pg8::gemm_phase<pg8::EpiResF32, pg8::StaticOrder, true, true>(F.lds, g, S, E); } } SEAM(pb + 3);
        if (IN(pb + 4) && PHEN(5)) { PH_BEGIN(); for (int rep_ = 0; rep_ < DUP(5); ++rep_) { rms_phase(F, ap->out, ap->e_n2 + i * DM, (bf16*)(ws + WS_XN)); } } SEAM(pb + 4);
        if (IN(pb + 5) && PHEN(6)) { PH_BEGIN(); for (int rep_ = 0; rep_ < DUP(6); ++rep_) { pg8::Gemm g{(const bf16*)(ws + WS_XN), (const bf16*)(ws + WS_FGU), DM, 0}; pg8::StaticOrder S; S.init(NTOK, 2 * FFN, G, cblk);
                          if (rep_ + 1 < DUP(6)) { pg8::EpiNull E{(float*)(ws + WS_XG)}; pg8::gemm_phase<pg8::EpiNull, pg8::StaticOrder, true, true>(F.lds, g, S, E); }
                          else { pg8::EpiSwiGLU E{(bf16*)(ws + WS_BIG), FFN}; pg8::gemm_phase<pg8::EpiSwiGLU, pg8::StaticOrder, true, true>(F.lds, g, S, E); } } } SEAM(pb + 5);
        if (IN(pb + 6) && PHEN(7)) { PH_BEGIN(); pg8::Gemm g{(const bf16*)(ws + WS_BIG), (const bf16*)(ws + WS_FD), FFN, 0}; pg8::StaticOrder S; S.init(NTOK, DM, G, cblk); pg8::EpiResF32 E{ap->out, ap->out, DM, nullptr};
                          pg8::gemm_phase<pg8::EpiResF32, pg8::StaticOrder, true, true>(F.lds, g, S, E); } SEAM(pb + 6);
        if (IN(pb + 7) && PHEN(8)) { PH_BEGIN(); for (int rep_ = 0; rep_ < DUP(8); ++rep_) { conv_odd_phase(F, ap->o_wqkv + (size_t)i * DM * QKVD, ap->o_wo + (size_t)i * DM * DM, ap->o_ewg + (size_t)i * NEXP * DM * EXPD, ap->o_ewu + (size_t)i * NEXP * DM * EXPD, ap->o_ewd + (size_t)i * NEXP * EXPD * DM, ws);
                          rms_phase(F, ap->out, ap->o_n1 + i * DM, (bf16*)(ws + WS_XN)); } } SEAM(pb + 7);
        if (IN(pb + 8) && PHEN(9)) { PH_BEGIN(); for (int rep_ = 0; rep_ < DUP(9); ++rep_) { pg8::Gemm g{(const bf16*)(ws + WS_XN), (const bf16*)(ws + WS_WQKV), DM, 0}; pg8::StaticOrder S; S.init(NTOK, QKVD, G, cblk); pg8::EpiQKV E{(bf16*)(ws + WS_BIG), ap->o_bqkv + i * QKVD, (const float*)(ws + WS_CS), QSCALE};
                          pg8::gemm_phase<pg8::EpiQKV, pg8::StaticOrder, true, true>(F.lds, g, S, E); } } SEAM(pb + 8);
        if (IN(pb + 9) && PHEN(10)) { PH_BEGIN(); for (int rep_ = 0; rep_ < DUP(10); ++rep_) { attn_mfma_phase(F, (const bf16*)(ws + WS_BIG), ap->o_sinks + i * 16, (bf16*)(ws + WS_XN)); } } SEAM(pb + 9);
        if (IN(pb + 10) && PHEN(11)) { PH_BEGIN(); pg8::Gemm g{(const bf16*)(ws + WS_XN), (const bf16*)(ws + WS_WO), DM, 0}; pg8::StaticOrder S; S.init(NTOK, DM, G, cblk); pg8::EpiResF32 E{ap->out, ap->out, DM, ap->o_bo + i * DM};
                           pg8::gemm_phase<pg8::EpiResF32, pg8::StaticOrder, true, true>(F.lds, g, S, E); } SEAM(pb + 10);
        if (IN(pb + 11) && PHEN(12)) { PH_BEGIN(); rms_router_phase(F, ap->out, ap->o_n2 + i * DM, ap->o_rw + (size_t)i * DM * NEXP, (bf16*)(ws + WS_XN), (unsigned*)(ws + WS_CTL) + CW_CNT + 64 * i, (unsigned*)(ws + WS_TOKINFO), (int*)(ws + WS_ROWTOK)); } SEAM(pb + 11);
        if (IN(pb + 12) && PHEN(13)) { PH_BEGIN(); slots_phase(F, (const unsigned*)(ws + WS_CTL) + CW_CNT + 64 * i, (const unsigned*)(ws + WS_TOKINFO), (int*)(ws + WS_ROWTOK), (float*)(ws + WS_ROWGATE)); } SEAM(pb + 12);
#pragma unroll 1
        for (int s = 0; s < 2; ++s) {
            const int ps = pb + 13 + 2 * s;
            if (IN(ps + 0) && PHEN(14)) { PH_BEGIN(); for (int rep_ = 0; rep_ < DUP(14); ++rep_) {
                LAS unsigned short* tab = (LAS unsigned short*)(F.lds + TAB_OFF); LAS unsigned* ut = (LAS unsigned*)(F.lds + LDSCTL_OFF); int nun = 0;
                { int pend[8]; moe_prefix((const unsigned*)(ws + WS_CTL) + CW_CNT + 64 * i + 8 * s, pend);
                  pg8::MoeOrder S; S.nM = pend[7]; S.nN = 2 * EXPD / 256; S.nwg = S.nM * S.nN; S.G = G; S.c = cblk; S.NT = DM / 64; S.splitk = false; S.p0 = pend[0]; S.p1 = pend[1]; S.p2 = pend[2]; S.p3 = pend[3]; S.p4 = pend[4]; S.p5 = pend[5]; S.p6 = pend[6];
                  pg8::Unit u; const int* rt = (const int*)(ws + WS_ROWTOK) + (size_t)s * SETROWS;
                  for (int r = 0; r < TAB_ROUNDS && S.next(r, u); ++r) { if (F.tid == 0) pg8::TabOrder::put(ut, r, u);
                      if (F.tid < 256) { const int tk = rt[(size_t)u.pm * 256 + F.tid]; tab[r * 256 + F.tid] = (unsigned short)(tk < 0 ? 0 : tk); } ++nun; } }
                __syncthreads();
                pg8::TabOrder T{ut, nun};
                pg8::Gemm g{(const bf16*)(ws + WS_XN), (const bf16*)(ws + WS_MGU), DM, (size_t)2 * EXPD * DM * 2}; pg8::EpiSwiGLU E{(bf16*)(ws + WS_BIG), EXPD};
                pg8::gemm_phase2<pg8::EpiSwiGLU, pg8::TabOrder, true>(F.lds, g, T, E, tab); __syncthreads(); } } SEAM(ps + 0);
            if (IN(ps + 1) && PHEN(15)) { PH_BEGIN();
                LAS unsigned* ut = (LAS unsigned*)(F.lds + LDSCTL_OFF); int nun = 0;
                { int pend[8]; moe_prefix((const unsigned*)(ws + WS_CTL) + CW_CNT + 64 * i + 8 * s, pend);
                  pg8::MoeOrder S; S.nM = pend[7]; S.nN = DM / 256; S.nwg = S.nM * S.nN; S.G = G; S.c = cblk; S.NT = EXPD / 64; S.splitk = false;    S.p0 = pend[0]; S.p1 = pend[1]; S.p2 = pend[2]; S.p3 = pend[3]; S.p4 = pend[4]; S.p5 = pend[5]; S.p6 = pend[6];
                  pg8::Unit u; for (int r = 0; r < 32 && S.next(r, u); ++r) { if (F.tid == 0) pg8::TabOrder::put(ut, r, u); ++nun; } }
                __syncthreads();
                pg8::TabOrder T{ut, nun};
                pg8::Gemm g{(const bf16*)(ws + WS_BIG), (const bf16*)(ws + WS_MD), EXPD, (size_t)DM * EXPD * 2};
                pg8::EpiMoeDown E{(const int*)(ws + WS_ROWTOK) + (size_t)s * SETROWS, (const float*)(ws + WS_ROWGATE) + (size_t)s * SETROWS, ap->out};
                pg8::gemm_phase2<pg8::EpiMoeDown, pg8::TabOrder, false>(F.lds, g, T, E, nullptr); __syncthreads(); } SEAM(ps + 1);
        }
    }
    if (IN(N_PHASES - 1) && PHEN(17)) { PH_BEGIN(); rms_final_phase(F, ap->out, ap->fng); }
#undef IN
#undef SEAM
}

extern "C" void kernel_launch(void* const* d_in, const int* in_sizes, int n_in, void* d_out, int out_size, void* d_ws, size_t ws_size, hipStream_t stream) {
    static int grid = 0;
    if (grid == 0) {
        if (n_in != 26 || in_sizes[0] != NTOK * DM || out_size != NTOK * DM || ws_size < WS_END) { fprintf(stderr, "kernel_launch: unexpected shapes: n_in %d in0 %d out %d ws %zu (need %zu)\n", n_in, n_in > 0 ? in_sizes[0] : -1, out_size, ws_size, (size_t)WS_END); grid = -1; return; }
        int dev = 0, cus = 0, per_cu = 0;
        if (hipGetDevice(&dev) != hipSuccess || hipDeviceGetAttribute(&cus, hipDeviceAttributeMultiprocessorCount, dev) != hipSuccess) { grid = -1; return; }
        if (hipFuncSetAttribute((const void*)fwd, hipFuncAttributeMaxDynamicSharedMemorySize, LDS_BYTES) != hipSuccess) { fprintf(stderr, "kernel_launch: hipFuncSetAttribute failed\n"); grid = -1; return; }
        if (hipOccupancyMaxActiveBlocksPerMultiprocessor(&per_cu, (const void*)fwd, NWAVES * 64, LDS_BYTES) != hipSuccess || per_cu < 1) fprintf(stderr, "kernel_launch: occupancy query reports %d\n", per_cu);
        (void)hipGetLastError();
        grid = cus;
    }
    if (grid < 0) return;
    (void)hipMemsetAsync((char*)d_ws + WS_CTL, 0, CTL_ZERO_BYTES, stream);
    Args a{};
    a.x = (const float*)d_in[0]; a.pos = (const int*)d_in[1]; a.fng = (const float*)d_in[2];
    a.e_n1 = (const float*)d_in[3]; a.e_win = (const float*)d_in[4]; a.e_conv = (const float*)d_in[5]; a.e_lng = (const float*)d_in[6]; a.e_lnb = (const float*)d_in[7];
    a.e_sw = (const float*)d_in[8]; a.e_sb = (const float*)d_in[9]; a.e_wout = (const float*)d_in[10]; a.e_n2 = (const float*)d_in[11];
    a.e_wg = (const float*)d_in[12]; a.e_wu = (const float*)d_in[13]; a.e_wd = (const float*)d_in[14];
    a.o_n1 = (const float*)d_in[15]; a.o_wqkv = (const float*)d_in[16]; a.o_bqkv = (const float*)d_in[17]; a.o_sinks = (const float*)d_in[18]; a.o_wo = (const float*)d_in[19]; a.o_bo = (const float*)d_in[20];
    a.o_n2 = (const float*)d_in[21]; a.o_rw = (const float*)d_in[22]; a.o_ewg = (const float*)d_in[23]; a.o_ewu = (const float*)d_in[24]; a.o_ewd = (const float*)d_in[25];
    a.out = (float*)d_out; a.ws = (unsigned char*)d_ws;
#if MK_ONE_LAUNCH
    a.lo = 0; a.hi = N_PHASES; a.li = 0;
    hipLaunchKernelGGL(fwd, dim3(grid), dim3(NWAVES * 64), LDS_BYTES, stream, a);
#else
    for (int p = 0; p < N_PHASES; ++p) { a.lo = p; a.hi = p + 1; a.li = p; hipLaunchKernelGGL(fwd, dim3(grid), dim3(NWAVES * 64), LDS_BYTES, stream, a); }
#endif
}
```

```cpp
#include <type_traits>
#include <hip/hip_runtime.h>
#include <cstdio>
#include <cstdint>
#ifndef MK_ONE_LAUNCH
#define MK_ONE_LAUNCH 1
#endif
namespace pg8 {
#define PG8_LAS __attribute__((address_space(3)))
typedef unsigned short bf16_t;
typedef short bf16x8 __attribute__((ext_vector_type(8)));
typedef float f32x4 __attribute__((ext_vector_type(4)));
typedef unsigned u32x4 __attribute__((ext_vector_type(4)));
constexpr int BM = 256, BK = 64, HALF = 128, HTB = HALF * BK * 2  , STAGE_BYTES = 8 * HTB, NXCD = 8, WGM = 4;

__host__ __device__ __forceinline__ int lds_byte(int r, int c) { const int st = (r >> 4) * 2 + (c >> 5), rr = r & 15, cc = c & 31, ob = rr * 64 + cc * 2; return st * 1024 + (ob ^ (((ob >> 9) & 1) << 5)); }
__host__ __device__ __forceinline__ void stage_rc(int b, int& R, int& C) { const int st = b / 1024, sb = b % 1024, swz = sb ^ (((sb >> 9) & 1) << 5); R = (st >> 1) * 16 + swz / 64; C = (st & 1) * 32 + (swz % 64) / 2; }
__host__ __device__ __forceinline__ int perm32(int rho) { const int n = rho >> 4, i = rho & 15; return 8 * (i >> 2) + 4 * n + (i & 3); }

struct Unit { int pm, pn, e, kt0, nt, split, ui; };
struct Gemm { const bf16_t* A; const bf16_t* Bt; int K; size_t estride; };

struct StaticOrder {
    int nM, nN, nwg, G, c, wgm, NT;
    __host__ __device__ __forceinline__ void init(int M, int N, int G_, int c_, int wgm_ = WGM, int nt_ = 0) { nM = M / BM; nN = N / BM; nwg = nM * nN; G = G_; c = c_; wgm = wgm_; NT = nt_; }
    __host__ __device__ __forceinline__ bool next(int i, Unit& u) const {
        const long L = (long)i * G + c; if (L >= nwg) return false;
        int wgid = (int)L; { const int q = nwg / NXCD, r = nwg % NXCD, xcd = wgid % NXCD, off = wgid / NXCD; wgid = (xcd < r ? xcd * (q + 1) : r * (q + 1) + (xcd - r) * q) + off; }
        const int nig = wgm * nN, gid = wgid / nig, fm = gid * wgm, gsz = (nM - fm) < wgm ? (nM - fm) : wgm;
        u.pm = fm + ((wgid % nig) % gsz); u.pn = (wgid % nig) / gsz; u.e = 0; u.kt0 = 0; u.nt = NT; u.split = 0; u.ui = i; return true;
    }
};
struct MoeOrder {
    int nM, nN, nwg, G, c, NT, wgm; bool splitk; int p0, p1, p2, p3, p4, p5, p6;
    __device__ __forceinline__ bool next(int i, Unit& u) const {
        long L = (long)i * G + c; u.kt0 = 0; u.nt = NT; u.split = 0; u.ui = i;
        const int rfull = nwg / G, tail = nwg - rfull * G;
        if (splitk && tail > 0 && tail * 4 <= G) {
            if (i > rfull) return false;
            if (i == rfull) { if (c >= tail * 4) return false; L = (long)rfull * G + (c >> 2); u.split = 1 + (c & 3); }
        } else if (L >= nwg) return false;
        int wgid = (int)L; { const int q = nwg / NXCD, r = nwg % NXCD, xcd = wgid % NXCD, off = wgid / NXCD; wgid = (xcd < r ? xcd * (q + 1) : r * (q + 1) + (xcd - r) * q) + off; }
        const int nig = wgm * nN, gid = wgid / nig, fm = gid * wgm, gsz = (nM - fm) < wgm ? (nM - fm) : wgm;
        const unsigned inv = gsz == 1 ? 65536u : gsz == 2 ? 32768u : gsz == 3 ? 21846u : gsz == 4 ? 16384u : gsz == 5 ? 13108u : gsz == 6 ? 10923u : gsz == 7 ? 9363u : 8192u;
        const int x = wgid - gid * nig, xq = (int)(((unsigned)x * inv) >> 16);
        u.pm = fm + (x - xq * gsz); u.pn = xq;
        u.e = (u.pm >= p0) + (u.pm >= p1) + (u.pm >= p2) + (u.pm >= p3) + (u.pm >= p4) + (u.pm >= p5) + (u.pm >= p6); return true;
    }
};

struct TabOrder {
    const PG8_LAS unsigned* t; int n, base;
    __device__ __forceinline__ static void put(PG8_LAS unsigned* t, int i, const Unit& u) { t[2 * i] = (unsigned)u.pm | ((unsigned)u.pn << 16); t[2 * i + 1] = (unsigned)u.e | ((unsigned)u.kt0 << 8) | ((unsigned)u.nt << 16) | ((unsigned)u.split << 24); }
    __device__ __forceinline__ bool next(int i, Unit& u) const {
        if (i >= n) return false;
        const unsigned w0 = __builtin_amdgcn_readfirstlane(t[2 * i]), w1 = __builtin_amdgcn_readfirstlane(t[2 * i + 1]);
        u.pm = (int)(w0 & 0xffffu); u.pn = (int)(w0 >> 16); u.e = (int)(w1 & 0xffu); u.kt0 = (int)((w1 >> 8) & 0xffu); u.nt = (int)((w1 >> 16) & 0xffu); u.split = (int)(w1 >> 24); u.ui = i + base; return true;
    }
};

__device__ __forceinline__ unsigned cvt_pk_bf16(float lo, float hi) { unsigned r; asm volatile("v_cvt_pk_bf16_f32 %0, %1, %2" : "=v"(r) : "v"(lo), "v"(hi)); return r; }
__device__ __forceinline__ u32x4 pack8(const f32x4 v0, const f32x4 v1) { u32x4 w; w.x = cvt_pk_bf16(v0[0], v0[1]); w.y = cvt_pk_bf16(v0[2], v0[3]); w.z = cvt_pk_bf16(v1[0], v1[1]); w.w = cvt_pk_bf16(v1[2], v1[3]); return w; }

__device__ __forceinline__ float row_rstd(const float* ssp, int row) { const f32x4 q = *(const f32x4*)(ssp + (size_t)row * 4); return __builtin_amdgcn_rsqf(((q[0] + q[1]) + (q[2] + q[3])) * (1.0f / 1024.0f) + 1e-5f); }

struct RowPre { float q[2][4]; };
__device__ __forceinline__ RowPre row_prefetch(const float* ssp, int row0, int fq) { RowPre p;
#pragma unroll
    for (int ai = 0; ai < 2; ++ai)
#pragma unroll
        for (int m = 0; m < 4; ++m) p.q[ai][m] = ssp ? ssp[(size_t)(row0 + ai * HALF + m * 16) * 4 + fq] : 1024.0f;
    return p; }
__device__ __forceinline__ float pre_rstd(float q) { q += __shfl_xor(q, 16); q += __shfl_xor(q, 32); return __builtin_amdgcn_rsqf(q * (1.0f / 1024.0f) + 1e-5f); }
struct NoPre {};
template <class E, class = void> struct PreOf { typedef NoPre type;
    static __device__ __forceinline__ NoPre get(const E&, const Unit&, int, int, int, int) { return NoPre{}; }
    template <class A> static __device__ __forceinline__ void run(const E& e, const A& acc, const Unit& u, int wr, int wc, int fr, int fq, const NoPre&) { e(acc, u, wr, wc, fr, fq); } };
template <class E> struct PreOf<E, std::void_t<typename E::Pre>> { typedef typename E::Pre type;
    static __device__ __forceinline__ type get(const E& e, const Unit& u, int wr, int wc, int fr, int fq) { return e.prefetch(u, wr, wc, fr, fq); }
    template <class A> static __device__ __forceinline__ void run(const E& e, const A& acc, const Unit& u, int wr, int wc, int fr, int fq, const type& pre) { e(acc, u, wr, wc, fr, fq, pre); } };
struct EpiBf16Plain {
    static constexpr bool PERM = true; static constexpr int NVM = 16;
    bf16_t* O; int ldc; const float* ssp;
    __device__ __forceinline__ void operator()(const f32x4 (&acc)[2][2][4][2], const Unit& u, int wr, int wc, int fr, int fq) const {
        const int row0 = u.pm * BM + wr * 64 + fr, col0 = u.pn * BM + wc * 32 + 8 * fq;
        float rs[2][4];
#pragma unroll
        for (int ai = 0; ai < 2; ++ai)
#pragma unroll
            for (int m = 0; m < 4; ++m) rs[ai][m] = ssp ? row_rstd(ssp, row0 + ai * HALF + m * 16) : 1.0f;
#pragma unroll
        for (int ai = 0; ai < 2; ++ai)
#pragma unroll
            for (int m = 0; m < 4; ++m) { bf16_t* rowp = O + (size_t)(row0 + ai * HALF + m * 16) * ldc + col0;
#pragma unroll
                for (int bj = 0; bj < 2; ++bj) *(u32x4*)(rowp + bj * HALF) = pack8(acc[ai][bj][m][0] * rs[ai][m], acc[ai][bj][m][1] * rs[ai][m]); }
    }
};
template <int MODE> struct EpiProbe {
    static constexpr bool PERM = true; static constexpr int NVM = 0;
    bf16_t* O; int ldc;
    __device__ __forceinline__ void operator()(const f32x4 (&acc)[2][2][4][2], const Unit& u, int wr, int wc, int fr, int fq) const {
        const int row0 = u.pm * BM + wr * 64 + fr, col0 = (u.pn * BM) % ldc + wc * 32 + 8 * fq;
        if (MODE == 0) { f32x4 s = (f32x4){0.f, 0.f, 0.f, 0.f};
#pragma unroll
            for (int ai = 0; ai < 2; ++ai)
#pragma unroll
                for (int bj = 0; bj < 2; ++bj)
#pragma unroll
                    for (int m = 0; m < 4; ++m)
#pragma unroll
                        for (int n = 0; n < 2; ++n) s += acc[ai][bj][m][n];
            if (s[0] + s[1] + s[2] + s[3] == 12345.678f) O[row0] = 1; return; }
        unsigned chk = 0u;
#pragma unroll
        for (int ai = 0; ai < 2; ++ai)
#pragma unroll
            for (int m = 0; m < 4; ++m) { bf16_t* rowp = O + (size_t)(row0 + ai * HALF + m * 16) * ldc + col0;
#pragma unroll
                for (int bj = 0; bj < 2; ++bj) { const u32x4 w = pack8(acc[ai][bj][m][0], acc[ai][bj][m][1]);
                    if (MODE == 2 || MODE == 4 || (MODE == 5 && ai == 0)) *(u32x4*)(rowp + bj * HALF) = w; else if (MODE == 1 || MODE == 5) chk ^= (w.x + w.y) ^ (w.z + w.w);
                    if (MODE == 6) __builtin_nontemporal_store(w, (u32x4*)(rowp + bj * HALF));
                    if (MODE == 7 || MODE == 8) { const __amdgpu_buffer_rsrc_t rs = __builtin_amdgcn_make_buffer_rsrc((void*)O, 0, 0x7fffffff, 0x00020000);
                        __builtin_amdgcn_raw_buffer_store_b128(w, rs, (int)(((size_t)(row0 + ai * HALF + m * 16) * ldc + col0 + bj * HALF) * 2), 0, MODE == 7 ? 16 : 17); } } }
        if (MODE == 4) asm volatile("s_waitcnt vmcnt(0)" ::: "memory");
        if (MODE == 5 && chk == 0x9e3779b9u) O[row0] = 1;
        if (MODE == 1 && chk == 0x9e3779b9u) O[row0] = 1;
        if (MODE == 9) {
            const int lane = fq * 16 + fr, wid = wr * 4 + wc;
#pragma unroll
            for (int ai = 0; ai < 2; ++ai)
#pragma unroll
                for (int m = 0; m < 4; ++m)
#pragma unroll
                    for (int bj = 0; bj < 2; ++bj) { const u32x4 w = pack8(acc[ai][bj][m][0], acc[ai][bj][m][1]);
                        *(u32x4*)(O + (size_t)(u.pm * BM + wid * 32 + (ai * 8 + m * 2 + bj) * 2 + (lane >> 5)) * ldc + (u.pn * BM) % ldc + (lane & 31) * 8) = w; }
        }
        if (MODE == 3) {
            const int lane = fq * 16 + fr;
#pragma unroll
            for (int ai = 0; ai < 2; ++ai)
#pragma unroll
                for (int m = 0; m < 4; ++m)
#pragma unroll
                    for (int bj = 0; bj < 2; ++bj) { const u32x4 w = pack8(acc[ai][bj][m][0], acc[ai][bj][m][1]);
                        *(u32x4*)(O + (size_t)(u.pm * BM + ai * HALF + wr * 64 + m * 16 + 8 * bj + (lane >> 3)) * ldc + (u.pn * BM) % ldc + wc * 64 + (lane & 7) * 8) = w; }
        }
    }
};
struct EpiMixIn {
    static constexpr bool PERM = true; static constexpr int NVM = 16;
    bf16_t* O; const float* ssp;
    typedef RowPre Pre;
    __device__ __forceinline__ Pre prefetch(const Unit& u, int wr, int wc, int fr, int fq) const { return row_prefetch(ssp, u.pm * BM + wr * 64 + fr, fq); }
    __device__ __forceinline__ void operator()(const f32x4 (&acc)[2][2][4][2], const Unit& u, int wr, int wc, int fr, int fq, const Pre& pre) const {
        const int row0 = u.pm * BM + wr * 64 + fr;
        float rs[2][4];
#pragma unroll
        for (int ai = 0; ai < 2; ++ai)
#pragma unroll
            for (int m = 0; m < 4; ++m) rs[ai][m] = ssp ? pre_rstd(pre.q[ai][m]) : 1.0f;
        const bool paired = (u.pn >= 2) && (u.pn < 6);
        if (paired) {
            const int col0 = 512 + (u.pn - 2) * HALF + wc * 32 + 8 * fq;
#pragma unroll
            for (int ai = 0; ai < 2; ++ai)
#pragma unroll
                for (int m = 0; m < 4; ++m) { const float r2 = rs[ai][m] * rs[ai][m];
                    *(u32x4*)(O + (size_t)(row0 + ai * HALF + m * 16) * 2048 + col0) = pack8(acc[ai][0][m][0] * acc[ai][1][m][0] * r2, acc[ai][0][m][1] * acc[ai][1][m][1] * r2); }
        } else {
            const int col0 = (u.pn < 2 ? u.pn * BM : 1024 + (u.pn - 6) * BM) + wc * 32 + 8 * fq;
#pragma unroll
            for (int ai = 0; ai < 2; ++ai)
#pragma unroll
                for (int m = 0; m < 4; ++m) { bf16_t* rowp = O + (size_t)(row0 + ai * HALF + m * 16) * 2048 + col0;
#pragma unroll
                    for (int bj = 0; bj < 2; ++bj) *(u32x4*)(rowp + bj * HALF) = pack8(acc[ai][bj][m][0] * rs[ai][m], acc[ai][bj][m][1] * rs[ai][m]); }
        }
    }
};
typedef float f32x2 __attribute__((ext_vector_type(2)));
__device__ __forceinline__ f32x2 silu_mul2(f32x2 g, f32x2 u) {
    f32x2 e; e.x = __builtin_amdgcn_exp2f(-g.x); e.y = __builtin_amdgcn_exp2f(-g.y);
    const f32x2 d = e + 1.0f; f32x2 r; r.x = __builtin_amdgcn_rcpf(d.x); r.y = __builtin_amdgcn_rcpf(d.y);
    return (g * u) * r;
}
typedef unsigned u32x2 __attribute__((ext_vector_type(2)));
struct EpiSwiGLU {
    static constexpr bool PERM = true; static constexpr int NVM = 8;
    bf16_t* O; int ldc; const float* ssp; float escale; float o8scale;
    typedef RowPre Pre;
    __device__ __forceinline__ Pre prefetch(const Unit& u, int wr, int wc, int fr, int fq) const { return row_prefetch(ssp, u.pm * BM + wr * 64 + fr, fq); }
    __device__ __forceinline__ void operator()(const f32x4 (&acc)[2][2][4][2], const Unit& u, int wr, int wc, int fr, int fq, const Pre& pre) const {
        if (escale != 1.0f) asm volatile("s_nop 15\n\ts_nop 7" ::: "memory");
        const int row0 = u.pm * BM + wr * 64 + fr, col0 = u.pn * HALF + wc * 32 + 8 * fq;
        float rs[2][4];
#pragma unroll
        for (int ai = 0; ai < 2; ++ai)
#pragma unroll
            for (int m = 0; m < 4; ++m) { rs[ai][m] = escale;
                if (ssp) rs[ai][m] = escale * pre_rstd(pre.q[ai][m]); }
#pragma unroll
        for (int ai = 0; ai < 2; ++ai)
#pragma unroll
            for (int m = 0; m < 4; ++m) { bf16_t* rowp = O + (size_t)(row0 + ai * HALF + m * 16) * ldc + col0; const float r = rs[ai][m];
                const float ru = (o8scale != 0.0f) ? r * o8scale : r;
                const f32x4 g0 = acc[ai][0][m][0] * r, g1 = acc[ai][0][m][1] * r, u0 = acc[ai][1][m][0] * ru, u1 = acc[ai][1][m][1] * ru;
                const f32x2 a = silu_mul2((f32x2){g0[0], g0[1]}, (f32x2){u0[0], u0[1]}), b = silu_mul2((f32x2){g0[2], g0[3]}, (f32x2){u0[2], u0[3]});
                const f32x2 c = silu_mul2((f32x2){g1[0], g1[1]}, (f32x2){u1[0], u1[1]}), d = silu_mul2((f32x2){g1[2], g1[3]}, (f32x2){u1[2], u1[3]});
                if (o8scale != 0.0f) { unsigned w0 = 0u, w1 = 0u;
#define PG8_C8(v) (v)
                    w0 = __builtin_amdgcn_cvt_pk_fp8_f32(PG8_C8(a.x), PG8_C8(a.y), w0, false); w0 = __builtin_amdgcn_cvt_pk_fp8_f32(PG8_C8(b.x), PG8_C8(b.y), w0, true);
                    w1 = __builtin_amdgcn_cvt_pk_fp8_f32(PG8_C8(c.x), PG8_C8(c.y), w1, false); w1 = __builtin_amdgcn_cvt_pk_fp8_f32(PG8_C8(d.x), PG8_C8(d.y), w1, true);
#undef PG8_C8
                    u32x2 w8; w8.x = w0; w8.y = w1; *(u32x2*)((unsigned char*)O + (size_t)(row0 + ai * HALF + m * 16) * ldc + col0) = w8; continue; }
                u32x4 w; w.x = cvt_pk_bf16(a.x, a.y); w.y = cvt_pk_bf16(b.x, b.y); w.z = cvt_pk_bf16(c.x, c.y); w.w = cvt_pk_bf16(d.x, d.y);
                *(u32x4*)rowp = w; }
    }
};
struct EpiResF32 {
    static constexpr bool PERM = false; static constexpr int NVM = 64;
    const float* base; float* out; int ldc; const float* bias;
    __device__ __forceinline__ void operator()(const f32x4 (&acc)[2][2][4][2], const Unit& u, int wr, int wc, int fr, int fq) const {
        const int row0 = u.pm * BM + wr * 64 + fr, col0 = u.pn * BM + wc * 32 + 4 * fq;
        f32x4 bv[2][2];
#pragma unroll
        for (int bj = 0; bj < 2; ++bj)
#pragma unroll
            for (int n = 0; n < 2; ++n) bv[bj][n] = bias ? *(const f32x4*)(bias + col0 + bj * HALF + n * 16) : (f32x4){0.f, 0.f, 0.f, 0.f};
#pragma unroll
        for (int ai = 0; ai < 2; ++ai) {
            f32x4 b[4][2][2];
#pragma unroll
            for (int m = 0; m < 4; ++m) { const size_t off = (size_t)(row0 + ai * HALF + m * 16) * ldc + col0;
#pragma unroll
                for (int bj = 0; bj < 2; ++bj)
#pragma unroll
                    for (int n = 0; n < 2; ++n) b[m][bj][n] = *(const f32x4*)(base + off + bj * HALF + n * 16); }
            asm volatile("" ::: "memory");
#pragma unroll
            for (int m = 0; m < 4; ++m) { const size_t off = (size_t)(row0 + ai * HALF + m * 16) * ldc + col0;
#pragma unroll
                for (int bj = 0; bj < 2; ++bj)
#pragma unroll
                    for (int n = 0; n < 2; ++n) *(f32x4*)(out + off + bj * HALF + n * 16) = b[m][bj][n] + acc[ai][bj][m][n] + bv[bj][n]; }
            asm volatile("" ::: "memory");
        }
    }
};

struct EpiResNorm {
    static constexpr bool PERM = false; static constexpr int NVM = 96;
    const float* base; float* out; int ldc; const float* bias; bf16_t* xn; float* ssp; PG8_LAS float* red;
    __device__ __forceinline__ void operator()(const f32x4 (&acc)[2][2][4][2], const Unit& u, int wr, int wc, int fr, int fq) const {
        const int row0 = u.pm * BM + wr * 64 + fr, col0 = u.pn * BM + wc * 32 + 4 * fq;
        f32x4 bv[2][2];
#pragma unroll
        for (int bj = 0; bj < 2; ++bj)
#pragma unroll
            for (int n = 0; n < 2; ++n) bv[bj][n] = bias ? *(const f32x4*)(bias + col0 + bj * HALF + n * 16) : (f32x4){0.f, 0.f, 0.f, 0.f};
        float sq[2][4];
#pragma unroll
        for (int ai = 0; ai < 2; ++ai) {
            f32x4 b[4][2][2];
#pragma unroll
            for (int m = 0; m < 4; ++m) { const size_t off = (size_t)(row0 + ai * HALF + m * 16) * ldc + col0;
#pragma unroll
                for (int bj = 0; bj < 2; ++bj)
#pragma unroll
                    for (int n = 0; n < 2; ++n) b[m][bj][n] = *(const f32x4*)(base + off + bj * HALF + n * 16); }
            asm volatile("" ::: "memory");
#pragma unroll
            for (int m = 0; m < 4; ++m) { const size_t off = (size_t)(row0 + ai * HALF + m * 16) * ldc + col0; float s = 0.f;
#pragma unroll
                for (int bj = 0; bj < 2; ++bj)
#pragma unroll
                    for (int n = 0; n < 2; ++n) { const f32x4 v = b[m][bj][n] + acc[ai][bj][m][n] + bv[bj][n]; *(f32x4*)(out + off + bj * HALF + n * 16) = v;
                        s += (v[0] * v[0] + v[1] * v[1]) + (v[2] * v[2] + v[3] * v[3]);
                        u32x2 w; w.x = cvt_pk_bf16(v[0], v[1]); w.y = cvt_pk_bf16(v[2], v[3]); *(u32x2*)(xn + off + bj * HALF + n * 16) = w; }
                sq[ai][m] = s; }
            asm volatile("" ::: "memory");
        }
#pragma unroll
        for (int ai = 0; ai < 2; ++ai)
#pragma unroll
            for (int m = 0; m < 4; ++m) { float s = sq[ai][m]; s += __shfl_xor(s, 16); s += __shfl_xor(s, 32); if (fq == 0) red[(ai * HALF + wr * 64 + m * 16 + fr) * 4 + wc] = s; }
        asm volatile("s_waitcnt lgkmcnt(0)" ::: "memory"); __builtin_amdgcn_s_barrier(); asm volatile("" ::: "memory");
        const int tid = (wr * 4 + wc) * 64 + fq * 16 + fr;
        if (tid < 256) { const f32x4 r = *(const PG8_LAS f32x4*)(red + tid * 4); ssp[(size_t)(u.pm * BM + tid) * 4 + u.pn] = (r[0] + r[1]) + (r[2] + r[3]); }
    }
};
template <int ADIV = 1> struct EpiQKVT {
    static constexpr bool PERM = true; static constexpr int NVM = 26;
    bf16_t* O; const float* bias; const float* cs; float qscale; const float* ssp; PG8_LAS float* stg;
    typedef RowPre Pre;
    __device__ __forceinline__ Pre prefetch(const Unit& u, int wr, int wc, int fr, int fq) const { return row_prefetch(ssp, u.pm * BM + wr * 64 + fr, fq); }
    __device__ __forceinline__ void operator()(const f32x4 (&acc)[2][2][4][2], const Unit& u, int wr, int wc, int fr, int fq, const Pre& pre) const {
        if constexpr (ADIV != 1) asm volatile("s_nop 15\n\ts_nop 7" ::: "memory");
        const int row0 = u.pm * BM + wr * 64 + fr, colt = u.pn * BM, col0 = colt + wc * 32 + 8 * fq;
        const bool ropew = ((wc & 1) == 0);
        const int tid = (wr * 4 + wc) * 64 + fq * 16 + fr;
        const f32x4 t0 = *(const f32x4*)(cs + (size_t)(u.pm * BM + (tid >> 2)) * 16 + (tid & 3) * 4), t1 = *(const f32x4*)(cs + (size_t)(u.pm * BM + HALF + (tid >> 2)) * 16 + (tid & 3) * 4);
        f32x4 bv[2][2];
#pragma unroll
        for (int bj = 0; bj < 2; ++bj)
#pragma unroll
            for (int n = 0; n < 2; ++n) bv[bj][n] = *(const f32x4*)(bias + col0 + bj * HALF + 4 * n);
        float rsr[2][4];
#pragma unroll
        for (int ai = 0; ai < 2; ++ai)
#pragma unroll
            for (int m = 0; m < 4; ++m) rsr[ai][m] = pre_rstd(pre.q[ai][m]) * (1.0f / (float)ADIV);
        const float sgn = (fq == 0) ? -1.f : 1.f;
#pragma unroll
        for (int ai = 0; ai < 2; ++ai) {
            if (ai) { asm volatile("s_waitcnt lgkmcnt(0)" ::: "memory"); __builtin_amdgcn_s_barrier(); }
            *(PG8_LAS f32x4*)(stg + (tid >> 2) * 20 + (tid & 3) * 4) = ai ? t1 : t0;
            asm volatile("s_waitcnt lgkmcnt(0)" ::: "memory"); __builtin_amdgcn_s_barrier(); asm volatile("" ::: "memory");
#pragma unroll
            for (int m = 0; m < 4; ++m) { const int row = row0 + ai * HALF + m * 16; bf16_t* rowp = O + (size_t)row * 1280 + col0;
                f32x4 c0 = (f32x4){1.f, 1.f, 1.f, 1.f}, c1 = c0, s0 = (f32x4){0.f, 0.f, 0.f, 0.f}, s1 = s0;
                if (ropew && fq < 2) { const PG8_LAS f32x4* cp = (const PG8_LAS f32x4*)(stg + (wr * 64 + m * 16 + fr) * 20); c0 = cp[0]; c1 = cp[1]; s0 = cp[2] * sgn; s1 = cp[3] * sgn; }
                const float rs = rsr[ai][m];
#pragma unroll
                for (int bj = 0; bj < 2; ++bj) { f32x4 v0 = acc[ai][bj][m][0] * rs + bv[bj][0], v1 = acc[ai][bj][m][1] * rs + bv[bj][1];
                    const int gc = colt + bj * HALF;
                    if (ropew && gc < 1152) { f32x4 p0, p1;
#pragma unroll
                        for (int j = 0; j < 4; ++j) { p0[j] = __shfl_xor(v0[j], 16); p1[j] = __shfl_xor(v1[j], 16); }
                        v0 = v0 * c0 + p0 * s0; v1 = v1 * c1 + p1 * s1; }
                    if (gc < 1024) { v0 = v0 * qscale; v1 = v1 * qscale; }
                    *(u32x4*)(rowp + bj * HALF) = pack8(v0, v1); }
                if (m & 1) asm volatile("" ::: "memory"); }
        }
        asm volatile("s_waitcnt lgkmcnt(0)" ::: "memory"); __builtin_amdgcn_s_barrier();
    }
};
typedef EpiQKVT<1> EpiQKV;
__device__ __forceinline__ void unpack8v(const u32x4 w, f32x4& a, f32x4& b) {
    a[0] = __uint_as_float(w.x << 16); a[1] = __uint_as_float(w.x & 0xffff0000u); a[2] = __uint_as_float(w.y << 16); a[3] = __uint_as_float(w.y & 0xffff0000u);
    b[0] = __uint_as_float(w.z << 16); b[1] = __uint_as_float(w.z & 0xffff0000u); b[2] = __uint_as_float(w.w << 16); b[3] = __uint_as_float(w.w & 0xffff0000u);
}
template <bool ONE_BATCH, int ADIV = 1, long H8OFF = 0> struct EpiResB {
    static constexpr bool PERM = true; static constexpr int NVM = 32;
    bf16_t* hb; const float* bias; float* ssp; PG8_LAS float* red; int norm;
    __device__ __forceinline__ void operator()(const f32x4 (&acc)[2][2][4][2], const Unit& u, int wr, int wc, int fr, int fq) const {
        constexpr float ascale = 1.0f / (float)ADIV;
        if constexpr (ADIV != 1) asm volatile("s_nop 15\n\ts_nop 7" ::: "memory");
        const int row0 = u.pm * BM + wr * 64 + fr, col0 = u.pn * BM + wc * 32 + 8 * fq;
        f32x4 bv[2][2];
#pragma unroll
        for (int bj = 0; bj < 2; ++bj)
#pragma unroll
            for (int n = 0; n < 2; ++n) bv[bj][n] = bias ? *(const f32x4*)(bias + col0 + bj * HALF + 4 * n) : (f32x4){0.f, 0.f, 0.f, 0.f};
        float sq[2][4];
        u32x4 b[2][4][2];
        if constexpr (ONE_BATCH) {
#pragma unroll
            for (int ai = 0; ai < 2; ++ai)
#pragma unroll
                for (int m = 0; m < 4; ++m)
#pragma unroll
                    for (int bj = 0; bj < 2; ++bj) b[ai][m][bj] = *(const u32x4*)(hb + (size_t)(row0 + ai * HALF + m * 16) * 1024 + col0 + bj * HALF);
            asm volatile("" ::: "memory");
        }
#pragma unroll
        for (int ai = 0; ai < 2; ++ai) {
            if constexpr (!ONE_BATCH) {
#pragma unroll
                for (int m = 0; m < 4; ++m)
#pragma unroll
                    for (int bj = 0; bj < 2; ++bj) b[ai][m][bj] = *(const u32x4*)(hb + (size_t)(row0 + ai * HALF + m * 16) * 1024 + col0 + bj * HALF);
                asm volatile("" ::: "memory");
            }
#pragma unroll
            for (int m = 0; m < 4; ++m) { float s = 0.f;
#pragma unroll
                for (int bj = 0; bj < 2; ++bj) { f32x4 h0, h1; unpack8v(b[ai][m][bj], h0, h1);
                    f32x4 v0, v1; if constexpr (ADIV != 1) { v0 = h0 + acc[ai][bj][m][0] * ascale + bv[bj][0]; v1 = h1 + acc[ai][bj][m][1] * ascale + bv[bj][1]; } else { v0 = h0 + acc[ai][bj][m][0] + bv[bj][0]; v1 = h1 + acc[ai][bj][m][1] + bv[bj][1]; }
                    s += ((v0[0] * v0[0] + v0[1] * v0[1]) + (v0[2] * v0[2] + v0[3] * v0[3])) + ((v1[0] * v1[0] + v1[1] * v1[1]) + (v1[2] * v1[2] + v1[3] * v1[3]));
                    *(u32x4*)(hb + (size_t)(row0 + ai * HALF + m * 16) * 1024 + col0 + bj * HALF) = pack8(v0, v1);
                    if constexpr (H8OFF != 0) { unsigned w0 = 0u, w1 = 0u;
#define PG8_C8(v) (v)
                        w0 = __builtin_amdgcn_cvt_pk_fp8_f32(PG8_C8(v0[0]), PG8_C8(v0[1]), w0, false); w0 = __builtin_amdgcn_cvt_pk_fp8_f32(PG8_C8(v0[2]), PG8_C8(v0[3]), w0, true);
                        w1 = __builtin_amdgcn_cvt_pk_fp8_f32(PG8_C8(v1[0]), PG8_C8(v1[1]), w1, false); w1 = __builtin_amdgcn_cvt_pk_fp8_f32(PG8_C8(v1[2]), PG8_C8(v1[3]), w1, true);
#undef PG8_C8
                        u32x2 w8; w8.x = w0; w8.y = w1; *(u32x2*)((unsigned char*)hb + H8OFF + (size_t)(row0 + ai * HALF + m * 16) * 1024 + col0 + bj * HALF) = w8; } }
                sq[ai][m] = s; }
            asm volatile("" ::: "memory");
        }
        if (norm) {
#pragma unroll
            for (int ai = 0; ai < 2; ++ai)
#pragma unroll
                for (int m = 0; m < 4; ++m) { float s = sq[ai][m]; s += __shfl_xor(s, 16); s += __shfl_xor(s, 32); if (fq == 0) red[(ai * HALF + wr * 64 + m * 16 + fr) * 4 + wc] = s; }
            asm volatile("s_waitcnt lgkmcnt(0)" ::: "memory"); __builtin_amdgcn_s_barrier(); asm volatile("" ::: "memory");
            const int tid = (wr * 4 + wc) * 64 + fq * 16 + fr;
            if (tid < 256) { const f32x4 r = *(const PG8_LAS f32x4*)(red + tid * 4); ssp[(size_t)(u.pm * BM + tid) * 4 + u.pn] = (r[0] + r[1]) + (r[2] + r[3]); }
        }
    }
};
struct EpiMoeDown {
    static constexpr bool PERM = true; static constexpr int NVM = 8;
    const PG8_LAS int* ltab; bf16_t* hb; float* ssp; PG8_LAS float* red; int norm; float gscale;
    __device__ __forceinline__ void operator()(const f32x4 (&acc)[2][2][4][2], const Unit& u, int wr, int wc, int fr, int fq) const {
        if (gscale != 1.0f) asm volatile("s_nop 15\n\ts_nop 7" ::: "memory");
        const int col0 = u.pn * BM + wc * 32 + 8 * fq;
        const int qa = (u.split - 1) >> 1, qb = (u.split - 1) & 1;
        float sq[2][4];
        int tok[2][4]; float gate[2][4]; u32x4 b[2][4][2];
#pragma unroll
        for (int ai = 0; ai < 2; ++ai)
#pragma unroll
            for (int m = 0; m < 4; ++m) { const int lrow = ai * HALF + wr * 64 + m * 16 + fr; tok[ai][m] = ltab[u.ui * 512 + lrow]; gate[ai][m] = __int_as_float(ltab[u.ui * 512 + 256 + lrow]) * gscale; sq[ai][m] = 0.f; }
#pragma unroll
        for (int ai = 0; ai < 2; ++ai) { if (u.split && ai != qa) continue;
#pragma unroll
            for (int m = 0; m < 4; ++m)
#pragma unroll
                for (int bj = 0; bj < 2; ++bj) b[ai][m][bj] = *(const u32x4*)(hb + (size_t)(tok[ai][m] < 0 ? 0 : tok[ai][m]) * 1024 + col0 + bj * HALF); }
        asm volatile("" ::: "memory");
#pragma unroll
        for (int ai = 0; ai < 2; ++ai) { if (u.split && ai != qa) continue;
#pragma unroll
            for (int m = 0; m < 4; ++m) { if (tok[ai][m] >= 0) {
#pragma unroll
                for (int bj = 0; bj < 2; ++bj) { if (u.split && bj != qb) continue;
                    f32x4 h0, h1; unpack8v(b[ai][m][bj], h0, h1);
                    const f32x4 v0 = h0 + acc[ai][bj][m][0] * gate[ai][m], v1 = h1 + acc[ai][bj][m][1] * gate[ai][m];
                    sq[ai][m] += ((v0[0] * v0[0] + v0[1] * v0[1]) + (v0[2] * v0[2] + v0[3] * v0[3])) + ((v1[0] * v1[0] + v1[1] * v1[1]) + (v1[2] * v1[2] + v1[3] * v1[3]));
                    *(u32x4*)(hb + (size_t)tok[ai][m] * 1024 + col0 + bj * HALF) = pack8(v0, v1); } } }
            asm volatile("" ::: "memory");
        }
        if (norm) {
#pragma unroll
            for (int ai = 0; ai < 2; ++ai)
#pragma unroll
                for (int m = 0; m < 4; ++m) { float s = sq[ai][m]; s += __shfl_xor(s, 16); s += __shfl_xor(s, 32); if (fq == 0) red[(ai * HALF + wr * 64 + m * 16 + fr) * 4 + wc] = s; }
            asm volatile("s_waitcnt lgkmcnt(0)" ::: "memory"); __builtin_amdgcn_s_barrier(); asm volatile("" ::: "memory");
            const int tid = (wr * 4 + wc) * 64 + fq * 16 + fr;
            if (tid < 256) { const int tk = ltab[u.ui * 512 + tid]; const f32x4 r = *(const PG8_LAS f32x4*)(red + tid * 4); if (tk >= 0) ssp[(size_t)tk * 4 + u.pn] = (r[0] + r[1]) + (r[2] + r[3]); }
        }
    }
};

template <class Epi, class Sched, bool ALIGN_EPI = false, bool SP2 = false>
__device__ __forceinline__ void gemm_phase(PG8_LAS unsigned char* lds, const Gemm g, const Sched& S, const Epi& E, int stag_ticks = 0) {
    if (stag_ticks > 0) {
        const unsigned long long t_end = __builtin_amdgcn_s_memrealtime() + (((unsigned long long)blockIdx.x * (unsigned)stag_ticks) >> 8);
        while (__builtin_amdgcn_s_memrealtime() < t_end) __builtin_amdgcn_s_sleep(4);
    }
    int tid_ = threadIdx.x; asm volatile("" : "+v"(tid_));
    const int tid = tid_, wid = __builtin_amdgcn_readfirstlane(tid >> 6), lane = tid & 63, wr = wid >> 2, wc = wid & 3, fr = lane & 15, fq = lane >> 4;
    const int K = g.K, nt = K / BK;
    constexpr int EPI_S = Epi::NVM < 48 ? Epi::NVM : 48;
    unsigned voffA[2], voffB[2];
#pragma unroll
    for (int i = 0; i < 2; ++i) { int R, C; stage_rc(tid * 16 + i * 8192, R, C); const int Rb = Epi::PERM ? ((R & ~31) + perm32(R & 31)) : R;
        voffA[i] = (unsigned)(R * K + C) * 2u; voffB[i] = (unsigned)(Rb * K + C) * 2u; }
    const size_t kstep = (size_t)(BK * 2);
    const size_t hstep = (size_t)HALF * K * 2;
    const size_t tstep = 2 * hstep;
    const unsigned ldsw = (unsigned)wid * 1024u;
    const int aoff = lds_byte(wr * 64 + fr, fq * 8), boff = lds_byte(wc * 32 + fr, fq * 8);
#define PG8_SA(b, h) (((b) * 2 + (h)) * HTB)
#define PG8_SB(b, h) ((4 + (b) * 2 + (h)) * HTB)
#define PG8_STAGE(bufoff, gbase, voff) do { _Pragma("unroll") for (int _i = 0; _i < 2; ++_i) \
        __builtin_amdgcn_global_load_lds((const unsigned*)((const char*)(gbase) + (voff)[_i]), (PG8_LAS unsigned*)(lds + (bufoff) + ldsw + _i * 8192), 16, 0, 0); } while (0)
#define PG8_LDA(dst, b, h) do { _Pragma("unroll") for (int m = 0; m < 4; ++m) _Pragma("unroll") for (int k = 0; k < 2; ++k) dst[m][k] = *(const PG8_LAS bf16x8*)(lds + PG8_SA(b, h) + aoff + m * 2048 + k * 1024); } while (0)
#define PG8_LDB(dst, b, h) do { _Pragma("unroll") for (int n = 0; n < 2; ++n) _Pragma("unroll") for (int k = 0; k < 2; ++k) dst[n][k] = *(const PG8_LAS bf16x8*)(lds + PG8_SB(b, h) + boff + n * 2048 + k * 1024); } while (0)
#define PG8_MMA(ai, bj, At, Bt) do { __builtin_amdgcn_s_setprio(1); _Pragma("unroll") for (int m = 0; m < 4; ++m) _Pragma("unroll") for (int n = 0; n < 2; ++n) _Pragma("unroll") for (int k = 0; k < 2; ++k) \
        acc[ai][bj][m][n] = __builtin_amdgcn_mfma_f32_16x16x32_bf16(Bt[n][k], At[m][k], acc[ai][bj][m][n], 0, 0, 0); __builtin_amdgcn_s_setprio(0); } while (0)
#define PG8_WAIT_V(n) asm volatile("s_waitcnt vmcnt(" #n ")" ::: "memory")
#define PG8_WAIT_V8R(rx) do { if (rx) asm volatile("s_waitcnt vmcnt(%0)" :: "n"(8 + EPI_S) : "memory"); else PG8_WAIT_V(8); } while (0)
#define PG8_WAIT_L(n) asm volatile("s_waitcnt lgkmcnt(" #n ")" ::: "memory")
#define PG8_BAR __builtin_amdgcn_s_barrier()
#define PG8_SCHED __builtin_amdgcn_sched_barrier(0)
    Unit cur, nxt; int ui = 0;
    if (!S.next(0, cur)) return;
    typename PreOf<Epi>::type pre = PreOf<Epi>::get(E, cur, wr, wc, fr, fq);
    f32x4 acc[2][2][4][2];
#pragma unroll
    for (int a = 0; a < 2; ++a)
#pragma unroll
        for (int b = 0; b < 2; ++b)
#pragma unroll
            for (int m = 0; m < 4; ++m)
#pragma unroll
                for (int n = 0; n < 2; ++n) acc[a][b][m][n] = (f32x4){0.f, 0.f, 0.f, 0.f};
    bf16x8 At[4][2], B0[2][2], B1[2][2];
    const char* cA = (const char*)g.A + (size_t)cur.pm * tstep; const char* cB = (const char*)g.Bt + (size_t)cur.e * g.estride + (size_t)cur.pn * tstep;
    if constexpr (SP2) {
        PG8_STAGE(PG8_SB(0, 0), cB, voffB); PG8_STAGE(PG8_SB(0, 1), cB + hstep, voffB); PG8_STAGE(PG8_SA(0, 0), cA, voffA); PG8_STAGE(PG8_SA(0, 1), cA + hstep, voffA);
        if (wr == 1) PG8_BAR;
        PG8_WAIT_V(2); PG8_BAR;
        PG8_STAGE(PG8_SB(1, 0), cB + kstep, voffB); PG8_STAGE(PG8_SA(1, 0), cA + kstep, voffA); PG8_STAGE(PG8_SB(1, 1), cB + hstep + kstep, voffB);
        PG8_WAIT_V(6); PG8_BAR;
    } else {
        PG8_STAGE(PG8_SB(0, 0), cB, voffB); PG8_STAGE(PG8_SA(0, 0), cA, voffA); PG8_STAGE(PG8_SB(0, 1), cB + hstep, voffB); PG8_STAGE(PG8_SA(0, 1), cA + hstep, voffA);
        if (wr == 1) PG8_BAR;
        PG8_WAIT_V(4); PG8_BAR;
        PG8_STAGE(PG8_SB(1, 0), cB + kstep, voffB); PG8_STAGE(PG8_SA(1, 0), cA + kstep, voffA); PG8_STAGE(PG8_SB(1, 1), cB + hstep + kstep, voffB);
        PG8_WAIT_V(6); PG8_BAR;
    }
    for (;;) {
        const bool has_next = S.next(ui + 1, nxt);
        const char* nA = has_next ? (const char*)g.A + (size_t)nxt.pm * tstep : cA; const char* nB = has_next ? (const char*)g.Bt + (size_t)nxt.e * g.estride + (size_t)nxt.pn * tstep : cB;
        for (int t = 0; t < nt; t += 2) {
            const bool last = (t == nt - 2);
            const char* a1 = cA + (size_t)(t + 1) * kstep;
            const char* a2 = last ? nA : cA + (size_t)(t + 2) * kstep; const char* b2 = last ? nB : cB + (size_t)(t + 2) * kstep;
            const char* a3 = a2 + kstep; const char* b3 = b2 + kstep;
            if constexpr (SP2) {
            PG8_LDB(B0, 0, 0); PG8_LDB(B1, 0, 1); PG8_SCHED; PG8_LDA(At, 0, 0); PG8_STAGE(PG8_SA(1, 1), a1 + hstep, voffA);
            PG8_WAIT_V(8); PG8_WAIT_L(0); PG8_BAR; PG8_MMA(0, 0, At, B0); PG8_MMA(0, 1, At, B1); PG8_BAR; PG8_SCHED;
            PG8_LDA(At, 0, 1); PG8_STAGE(PG8_SB(0, 0), b2, voffB); PG8_STAGE(PG8_SB(0, 1), b2 + hstep, voffB); PG8_STAGE(PG8_SA(0, 0), a2, voffA);
            PG8_WAIT_V(8); PG8_WAIT_L(0); PG8_BAR; PG8_MMA(1, 0, At, B0); PG8_MMA(1, 1, At, B1); PG8_BAR; PG8_SCHED;
            PG8_LDB(B0, 1, 0); PG8_LDB(B1, 1, 1); PG8_SCHED; PG8_LDA(At, 1, 0); PG8_STAGE(PG8_SA(0, 1), a2 + hstep, voffA);
            PG8_WAIT_V(8); PG8_WAIT_L(0); PG8_BAR; PG8_MMA(0, 0, At, B0); PG8_MMA(0, 1, At, B1); PG8_BAR; PG8_SCHED;
            PG8_LDA(At, 1, 1); PG8_STAGE(PG8_SB(1, 0), b3, voffB); PG8_STAGE(PG8_SB(1, 1), b3 + hstep, voffB); PG8_STAGE(PG8_SA(1, 0), a3, voffA);
            PG8_WAIT_V(8); PG8_WAIT_L(0); PG8_BAR; PG8_MMA(1, 0, At, B0); PG8_MMA(1, 1, At, B1); PG8_BAR; PG8_SCHED;
            } else {
            PG8_LDB(B0, 0, 0); PG8_SCHED; PG8_LDA(At, 0, 0); PG8_STAGE(PG8_SA(1, 1), a1 + hstep, voffA);
            PG8_WAIT_L(8); PG8_BAR; PG8_WAIT_L(0); PG8_MMA(0, 0, At, B0); PG8_BAR; PG8_SCHED;
            PG8_LDB(B1, 0, 1); PG8_STAGE(PG8_SB(0, 0), b2, voffB);
            PG8_BAR; PG8_WAIT_L(0); PG8_MMA(0, 1, At, B1); PG8_BAR;
            PG8_LDA(At, 0, 1); PG8_STAGE(PG8_SA(0, 0), a2, voffA);
            PG8_BAR; PG8_WAIT_L(0); PG8_MMA(1, 0, At, B0); PG8_BAR; PG8_SCHED;
            PG8_STAGE(PG8_SB(0, 1), b2 + hstep, voffB);
            PG8_WAIT_V(6); PG8_BAR; PG8_MMA(1, 1, At, B1); PG8_BAR;
            PG8_LDB(B0, 1, 0); PG8_SCHED; PG8_LDA(At, 1, 0); PG8_STAGE(PG8_SA(0, 1), a2 + hstep, voffA);
            PG8_WAIT_L(8); PG8_BAR; PG8_WAIT_L(0); PG8_MMA(0, 0, At, B0); PG8_BAR; PG8_SCHED;
            PG8_LDB(B1, 1, 1); PG8_STAGE(PG8_SB(1, 0), b3, voffB);
            PG8_BAR; PG8_WAIT_L(0); PG8_MMA(0, 1, At, B1); PG8_BAR;
            PG8_LDA(At, 1, 1); PG8_STAGE(PG8_SA(1, 0), a3, voffA);
            PG8_BAR; PG8_WAIT_L(0); PG8_MMA(1, 0, At, B0); PG8_BAR; PG8_SCHED;
            PG8_STAGE(PG8_SB(1, 1), b3 + hstep, voffB);
            PG8_WAIT_V(6); PG8_BAR; PG8_MMA(1, 1, At, B1); PG8_BAR;
            }
        }
        if constexpr (ALIGN_EPI) { if (wr == 0) PG8_BAR; }
        PreOf<Epi>::run(E, acc, cur, wr, wc, fr, fq, pre);
        asm volatile("" ::: "memory");
        if (!has_next) break;
        pre = PreOf<Epi>::get(E, nxt, wr, wc, fr, fq);
#pragma unroll
        for (int a = 0; a < 2; ++a)
#pragma unroll
            for (int b = 0; b < 2; ++b)
#pragma unroll
                for (int m = 0; m < 4; ++m)
#pragma unroll
                    for (int n = 0; n < 2; ++n) acc[a][b][m][n] = (f32x4){0.f, 0.f, 0.f, 0.f};
        cur = nxt; cA = nA; cB = nB; ++ui;
        if constexpr (ALIGN_EPI) { if (wr == 1) PG8_BAR; }
    }
    PG8_WAIT_V(0);
    if constexpr (!ALIGN_EPI) { if (wr == 0) PG8_BAR; }
    PG8_BAR;
#undef PG8_SA
#undef PG8_SB
#undef PG8_STAGE
#undef PG8_LDA
#undef PG8_LDB
#undef PG8_MMA
#undef PG8_WAIT_V
#undef PG8_WAIT_V8R
#undef PG8_WAIT_L
#undef PG8_BAR
#undef PG8_SCHED
}

template <class Epi, class Sched, bool GATHER, bool QUARTER = false, bool FP8 = false>
__device__ __forceinline__ void gemm_phase2(PG8_LAS unsigned char* lds, const Gemm g, const Sched& S, const Epi& E, const PG8_LAS unsigned short* tab, int stag_ticks = 0) {
    if (stag_ticks > 0) {
        const unsigned long long t_end = __builtin_amdgcn_s_memrealtime() + (((unsigned long long)blockIdx.x * (unsigned)stag_ticks) >> 8);
        while (__builtin_amdgcn_s_memrealtime() < t_end) __builtin_amdgcn_s_sleep(4);
    }
    int tid_ = threadIdx.x; asm volatile("" : "+v"(tid_));
    const int tid = tid_, wid = __builtin_amdgcn_readfirstlane(tid >> 6), lane = tid & 63, wr = wid >> 2, wc = wid & 3, fr = lane & 15, fq = lane >> 4;
    const int K = g.K;
    constexpr bool ZIL = std::is_same<Sched, TabOrder>::value;
    constexpr int EPI_S = Epi::NVM < 48 ? Epi::NVM : 48;
    unsigned cofA[2], voffB[2]; int R0 = 0;
#pragma unroll
    for (int i = 0; i < 2; ++i) { int R, C; stage_rc(tid * 16 + i * 8192, R, C); const int Rb = Epi::PERM ? ((R & ~31) + perm32(R & 31)) : R;
        cofA[i] = GATHER ? (unsigned)(C * 2) : (unsigned)(R * K + C) * 2u; voffB[i] = (unsigned)(Rb * K + C) * 2u; if (i == 0) R0 = R; }
    const unsigned pitchA = (unsigned)K * 2u;
    const size_t kstep = (size_t)(BK * 2), hstep = (size_t)HALF * K * 2, tstep = 2 * hstep, hstepA = GATHER ? 0 : hstep;
    const unsigned ldsw = (unsigned)wid * 1024u;
    const int aoff = lds_byte(wr * 64 + fr, fq * 8), boff = lds_byte(wc * 32 + fr, fq * 8);
#define PG8_SA(b, h) (((b) * 2 + (h)) * HTB)
#define PG8_SB(b, h) ((4 + (b) * 2 + (h)) * HTB)
#define PG8_STAGEB(bufoff, gbase) do { _Pragma("unroll") for (int _i = 0; _i < 2; ++_i) \
        __builtin_amdgcn_global_load_lds((const unsigned*)((const char*)(gbase) + voffB[_i]), (PG8_LAS unsigned*)(lds + (bufoff) + ldsw + _i * 8192), 16, 0, 0); } while (0)
#define PG8_STAGEA(bufoff, gbase, tkw) do { _Pragma("unroll") for (int _i = 0; _i < 2; ++_i) { const unsigned _vo = GATHER ? ((((tkw) >> (16 * _i)) & 0xffffu) * pitchA + cofA[_i]) : cofA[_i]; \
        __builtin_amdgcn_global_load_lds((const unsigned*)((const char*)(gbase) + _vo), (PG8_LAS unsigned*)(lds + (bufoff) + ldsw + _i * 8192), 16, 0, 0); } } while (0)
#define PG8_LOADTK(d0, d1, uidx) do { if constexpr (GATHER) { const PG8_LAS unsigned short* _tp = tab + (uidx) * 256 + R0; d0 = (unsigned)_tp[0] | ((unsigned)_tp[64] << 16); d1 = (unsigned)_tp[128] | ((unsigned)_tp[192] << 16); } } while (0)
#define PG8_LDA(dst, b, h) do { _Pragma("unroll") for (int m = 0; m < 4; ++m) { const PG8_LAS unsigned char* _p = lds + PG8_SA(b, h) + aoff + m * 2048; \
        if constexpr (FP8) dst##8[m] = __builtin_shufflevector(*(const PG8_LAS v4i_*)_p, *(const PG8_LAS v4i_*)(_p + 1024), 0, 1, 2, 3, 4, 5, 6, 7); \
        else { dst[m][0] = *(const PG8_LAS bf16x8*)_p; dst[m][1] = *(const PG8_LAS bf16x8*)(_p + 1024); } } } while (0)
#define PG8_LDB(dst, b, h) do { _Pragma("unroll") for (int n = 0; n < 2; ++n) { const PG8_LAS unsigned char* _p = lds + PG8_SB(b, h) + boff + n * 2048; \
        if constexpr (FP8) dst##8[n] = __builtin_shufflevector(*(const PG8_LAS v4i_*)_p, *(const PG8_LAS v4i_*)(_p + 1024), 0, 1, 2, 3, 4, 5, 6, 7); \
        else { dst[n][0] = *(const PG8_LAS bf16x8*)_p; dst[n][1] = *(const PG8_LAS bf16x8*)(_p + 1024); } } } while (0)
#define PG8_MMA(ai, bj, At, Bt) do { __builtin_amdgcn_s_setprio(1); _Pragma("unroll") for (int m = 0; m < 4; ++m) _Pragma("unroll") for (int n = 0; n < 2; ++n) { \
        if constexpr (FP8) asm volatile("v_mfma_f32_16x16x128_f8f6f4 %0, %1, %2, %0" : "+v"(acc[ai][bj][m][n]) : "v"(Bt##8[n]), "v"(At##8[m]));     \
        else { _Pragma("unroll") for (int k = 0; k < 2; ++k) acc[ai][bj][m][n] = __builtin_amdgcn_mfma_f32_16x16x32_bf16(Bt[n][k], At[m][k], acc[ai][bj][m][n], 0, 0, 0); } } \
        __builtin_amdgcn_s_setprio(0); } while (0)
#define PG8_ZERO(ai) do { _Pragma("unroll") for (int b_ = 0; b_ < 2; ++b_) _Pragma("unroll") for (int m_ = 0; m_ < 4; ++m_) _Pragma("unroll") for (int n_ = 0; n_ < 2; ++n_) acc[ai][b_][m_][n_] = (f32x4){0.f, 0.f, 0.f, 0.f}; } while (0)
#define PG8_WAIT_V(n) asm volatile("s_waitcnt vmcnt(" #n ")" ::: "memory")
#define PG8_WAIT_V8R(rx) do { if (rx) asm volatile("s_waitcnt vmcnt(%0)" :: "n"(8 + EPI_S) : "memory"); else PG8_WAIT_V(8); } while (0)
#define PG8_WAIT_L(n) asm volatile("s_waitcnt lgkmcnt(" #n ")" ::: "memory")
#define PG8_BAR __builtin_amdgcn_s_barrier()
#define PG8_SCHED __builtin_amdgcn_sched_barrier(0)
    Unit cur, nxt; int ui = 0;
    if (!S.next(0, cur)) return;
    typename PreOf<Epi>::type pre = PreOf<Epi>::get(E, cur, wr, wc, fr, fq);
    f32x4 acc[2][2][4][2];
#pragma unroll
    for (int a = 0; a < 2; ++a)
#pragma unroll
        for (int b = 0; b < 2; ++b)
#pragma unroll
            for (int m = 0; m < 4; ++m)
#pragma unroll
                for (int n = 0; n < 2; ++n) acc[a][b][m][n] = (f32x4){0.f, 0.f, 0.f, 0.f};
    typedef int v4i_ __attribute__((ext_vector_type(4))); typedef int v8i_ __attribute__((ext_vector_type(8)));
    bf16x8 At[4][2], B0[2][2], B1[2][2];
    v8i_ At8[4], B08[2], B18[2];
    unsigned tkc0 = 0u, tkc1 = 0u, tkn0 = 0u, tkn1 = 0u;
    PG8_LOADTK(tkc0, tkc1, 0);
    const char* cA = (const char*)g.A + (GATHER ? (size_t)0 : (size_t)cur.pm * tstep) + (size_t)cur.kt0 * kstep;
    const char* cB = (const char*)g.Bt + (size_t)cur.e * g.estride + (size_t)cur.pn * tstep + (size_t)cur.kt0 * kstep;
    PG8_STAGEB(PG8_SB(0, 0), cB); PG8_STAGEB(PG8_SB(0, 1), cB + hstep); PG8_STAGEA(PG8_SA(0, 0), cA, tkc0); PG8_STAGEA(PG8_SA(0, 1), cA + hstepA, tkc1);
    if (wr == 1) PG8_BAR;
    PG8_WAIT_V(2); PG8_BAR;
    PG8_STAGEB(PG8_SB(1, 0), cB + kstep); PG8_STAGEA(PG8_SA(1, 0), cA + kstep, tkc0); PG8_STAGEB(PG8_SB(1, 1), cB + hstep + kstep);
    PG8_WAIT_V(6); PG8_BAR;
    for (;;) {
        const bool has_next = S.next(ui + 1, nxt);
        const char* nA = has_next ? (const char*)g.A + (GATHER ? (size_t)0 : (size_t)nxt.pm * tstep) + (size_t)nxt.kt0 * kstep : cA;
        const char* nB = has_next ? (const char*)g.Bt + (size_t)nxt.e * g.estride + (size_t)nxt.pn * tstep + (size_t)nxt.kt0 * kstep : cB;
        tkn0 = tkc0; tkn1 = tkc1;
        if (has_next) PG8_LOADTK(tkn0, tkn1, ui + 1);
        const int nt = cur.nt;
        for (int t = 0; t < nt; t += 2) {
            const bool last = (t == nt - 2);
            int sp = 0; if constexpr (QUARTER) { sp = cur.split; asm volatile("" : "+s"(sp)); }
            const bool q00 = !QUARTER || (sp == 0) | (sp == 1), q01 = !QUARTER || (sp == 0) | (sp == 2), q10 = !QUARTER || (sp == 0) | (sp == 3), q11 = !QUARTER || (sp == 0) | (sp == 4);
            const char* a1 = cA + (size_t)(t + 1) * kstep;
            const char* a2 = last ? nA : cA + (size_t)(t + 2) * kstep; const char* b2 = last ? nB : cB + (size_t)(t + 2) * kstep;
            const char* a3 = a2 + kstep; const char* b3 = b2 + kstep;
            const unsigned t20 = last ? tkn0 : tkc0, t21 = last ? tkn1 : tkc1;
            PG8_LDB(B0, 0, 0); PG8_LDB(B1, 0, 1); PG8_SCHED; PG8_LDA(At, 0, 0); PG8_STAGEA(PG8_SA(1, 1), a1 + hstepA, tkc1);
            int tz = 1; if constexpr (ZIL) { tz = __builtin_amdgcn_readfirstlane(t | (ui > 0 ? 0 : 1)); asm volatile("" : "+s"(tz)); }
            if (tz == 0) { PG8_ZERO(0); PG8_SCHED; }
            PG8_WAIT_V(8); PG8_WAIT_L(0); PG8_BAR; if (q00) PG8_MMA(0, 0, At, B0); if (q01) PG8_MMA(0, 1, At, B1); PG8_BAR; PG8_SCHED;
            PG8_LDA(At, 0, 1); PG8_STAGEB(PG8_SB(0, 0), b2); PG8_STAGEB(PG8_SB(0, 1), b2 + hstep); PG8_STAGEA(PG8_SA(0, 0), a2, t20);
            if (tz == 0) { PG8_ZERO(1); PG8_SCHED; }
            PG8_WAIT_V(8); PG8_WAIT_L(0); PG8_BAR; if (q10) PG8_MMA(1, 0, At, B0); if (q11) PG8_MMA(1, 1, At, B1); PG8_BAR; PG8_SCHED;
            PG8_LDB(B0, 1, 0); PG8_LDB(B1, 1, 1); PG8_SCHED; PG8_LDA(At, 1, 0); PG8_STAGEA(PG8_SA(0, 1), a2 + hstepA, t21);
            PG8_WAIT_V(8); PG8_WAIT_L(0); PG8_BAR; if (q00) PG8_MMA(0, 0, At, B0); if (q01) PG8_MMA(0, 1, At, B1); PG8_BAR; PG8_SCHED;
            PG8_LDA(At, 1, 1); PG8_STAGEB(PG8_SB(1, 0), b3); PG8_STAGEB(PG8_SB(1, 1), b3 + hstep); PG8_STAGEA(PG8_SA(1, 0), a3, t20);
            PG8_WAIT_V(8); PG8_WAIT_L(0); PG8_BAR; if (q10) PG8_MMA(1, 0, At, B0); if (q11) PG8_MMA(1, 1, At, B1); PG8_BAR; PG8_SCHED;
        }
        if (wr == 0) PG8_BAR;
        PreOf<Epi>::run(E, acc, cur, wr, wc, fr, fq, pre);
        asm volatile("" ::: "memory");
        if (!has_next) break;
        pre = PreOf<Epi>::get(E, nxt, wr, wc, fr, fq);
        if constexpr (!ZIL) {
#pragma unroll
        for (int a = 0; a < 2; ++a)
#pragma unroll
            for (int b = 0; b < 2; ++b)
#pragma unroll
                for (int m = 0; m < 4; ++m)
#pragma unroll
                    for (int n = 0; n < 2; ++n) acc[a][b][m][n] = (f32x4){0.f, 0.f, 0.f, 0.f};
        }
        cur = nxt; cA = nA; cB = nB; tkc0 = tkn0; tkc1 = tkn1; ++ui;
        if (wr == 1) PG8_BAR;
    }
    PG8_WAIT_V(0);
    PG8_BAR;
#undef PG8_SA
#undef PG8_SB
#undef PG8_STAGEA
#undef PG8_STAGEB
#undef PG8_LOADTK
#undef PG8_LDA
#undef PG8_LDB
#undef PG8_MMA
#undef PG8_ZERO
#undef PG8_WAIT_V
#undef PG8_WAIT_V8R
#undef PG8_WAIT_L
#undef PG8_BAR
#undef PG8_SCHED
}
}

constexpr int NWAVES = 8;
constexpr int NTOK = 65536, DM = 1024, SEQ = 8192;
constexpr int MIXIN = 2560, FFN = 2816, QKVD = 1280, EXPD = 3584, NEXP = 8;
constexpr int SETROWS = NTOK + NEXP * 256;
constexpr float EPS = 1e-5f;
constexpr float LOG2E = 1.4426950408889634f;
constexpr float QSCALE = 0.125f * LOG2E;

constexpr size_t MiB = 1u << 20;
constexpr size_t WS_CTL = 0, CTL_ZERO_BYTES = 1 * MiB;
constexpr size_t WS_CS = 1 * MiB;
constexpr size_t WS_TOKINFO = 5 * MiB;
constexpr size_t WS_ROWTOK = 7 * MiB;
constexpr size_t WS_ROWGATE = 8 * MiB;
constexpr size_t WS_SSP = 12 * MiB;
constexpr size_t WS_AOOFF = 160 * MiB;
constexpr size_t WS_YOFF = 320 * MiB;
constexpr size_t WS_WSP = 9 * MiB;
constexpr size_t WS_WIN = 16 * MiB, WS_WOUT = 21 * MiB, WS_FGU = 23 * MiB, WS_FD = 34 * MiB;
constexpr size_t WS_WQKV = 40 * MiB, WS_WO = 43 * MiB, WS_MGU = 45 * MiB, WS_MD = 157 * MiB;
constexpr size_t WS_XN = 216 * MiB;
constexpr size_t WS_XG = 344 * MiB;
constexpr size_t WS_BIG = 476 * MiB;
constexpr size_t WS_END = WS_BIG + (size_t)SETROWS * EXPD * 2;
static_assert(WS_MD + (size_t)NEXP * DM * EXPD * 2 <= WS_XN && WS_XN + (size_t)NTOK * DM * 2 <= WS_XG && WS_XG + (size_t)SETROWS * DM * 2 <= WS_BIG, "d_ws map");
static_assert(WS_FD + (size_t)DM * FFN * 2 <= WS_WQKV && WS_MGU + (size_t)NEXP * 2 * EXPD * DM * 2 <= WS_MD, "d_ws map (weights)");
constexpr int CW_BAR = 4096;
constexpr int CW_CNT = 16384;

constexpr int RING_BYTES = 131072;
constexpr int TAB_OFF = RING_BYTES, TAB_ROUNDS = 29, TAB_BYTES = TAB_ROUNDS * 512;
constexpr int LDSCTL_OFF = TAB_OFF + TAB_BYTES, MISC_OFF = LDSCTL_OFF + 320;
constexpr int LDS_BYTES = 147456;
static_assert(MISC_OFF + 64 <= LDS_BYTES && 8 * 64 * 65 * 4 <= LDSCTL_OFF, "LDS map");

#define GAS __attribute__((address_space(1)))
#define LAS __attribute__((address_space(3)))
typedef unsigned short bf16;
typedef unsigned v4u __attribute__((ext_vector_type(4)));
typedef unsigned v2u __attribute__((ext_vector_type(2)));
typedef float f32x4 __attribute__((ext_vector_type(4)));
typedef GAS unsigned gu32;
#define RLX_AGENT __ATOMIC_RELAXED, __HIP_MEMORY_SCOPE_AGENT
#define LDS_WAIT() asm volatile("s_waitcnt lgkmcnt(0)" ::: "memory")
#define VM_WAIT() asm volatile("s_waitcnt vmcnt(0)" ::: "memory")
__device__ __forceinline__ unsigned pk2(float lo, float hi) { return pg8::cvt_pk_bf16(lo, hi); }
__device__ __forceinline__ float bflo(unsigned w) { return __uint_as_float(w << 16); }
__device__ __forceinline__ float bfhi(unsigned w) { return __uint_as_float(w & 0xffff0000u); }
__device__ __forceinline__ float bf1(bf16 h) { return __uint_as_float(((unsigned)h) << 16); }
__device__ __forceinline__ bf16 f2bf1(float f) { return (bf16)(pk2(f, 0.f) & 0xffffu); }
__device__ __forceinline__ void unpack8(const v4u w, float (&f)[8]) { f[0] = bflo(w.x); f[1] = bfhi(w.x); f[2] = bflo(w.y); f[3] = bfhi(w.y); f[4] = bflo(w.z); f[5] = bfhi(w.z); f[6] = bflo(w.w); f[7] = bfhi(w.w); }
__device__ __forceinline__ v4u pack8f(const float (&f)[8]) { v4u w; w.x = pk2(f[0], f[1]); w.y = pk2(f[2], f[3]); w.z = pk2(f[4], f[5]); w.w = pk2(f[6], f[7]); return w; }
__device__ __forceinline__ float gelu_erf(float v) { return 0.5f * v * (1.0f + erff(v * 0.70710678118654752f)); }

#define XB_TMO      128
#define XB_XCNT(j)  (256  + 64 * (j))
#define XB_XSUB(j)  (1280 + 64 * (j))
#define XB_XGEN(j)  (2304 + 64 * (j))
#define XB_TOP      3328
#define XB_TOPGEN   3392
#define XCD_BAR_WORDS 3456
#define XB_SPIN_CAP (1u << 18)

__device__ __forceinline__ unsigned xb_ld(unsigned* p)              { return __hip_atomic_load(p, __ATOMIC_RELAXED, __HIP_MEMORY_SCOPE_AGENT); }
__device__ __forceinline__ unsigned xb_add(unsigned* p, unsigned v) { return __hip_atomic_fetch_add(p, v, __ATOMIC_RELAXED, __HIP_MEMORY_SCOPE_AGENT); }
__device__ __forceinline__ unsigned xb_xcc_id() { return (unsigned)__builtin_amdgcn_s_getreg((3 << 11) | 20) & 0xFu; }
#define XB_SPIN(cond, bar) do { unsigned _sp = 0; while (cond) { __builtin_amdgcn_s_sleep(1); \
    if ((++_sp & 255u) == 0u) { if (xb_ld(&(bar)[XB_TMO])) break; if (_sp > XB_SPIN_CAP) { atomicAdd(&(bar)[XB_TMO], 1u); break; } } } } while (0)

struct XcdBarrier {
    unsigned* bar; unsigned x;
    volatile LAS unsigned* st;
};

__device__ __forceinline__ XcdBarrier xcd_barrier_post(unsigned* bar, volatile LAS unsigned* st) {
    XcdBarrier b; b.bar = bar; b.x = xb_xcc_id(); b.st = st;
    if (threadIdx.x == 0) (void)xb_add(&bar[XB_XCNT(b.x)], 1u);
    return b;
}
__device__ __forceinline__ void xcd_barrier_complete(unsigned* bar, unsigned x, unsigned& nloc, unsigned& nx) {
    const unsigned G = gridDim.x * gridDim.y * gridDim.z;
    unsigned sum, cnt, mine, sp = 0u;
    for (;;) {
        sum = 0u; cnt = 0u; mine = 0u;
#pragma unroll
        for (unsigned j = 0; j < 16; ++j) { const unsigned c = xb_ld(&bar[XB_XCNT(j)]); sum += c; cnt += (c > 0u) ? 1u : 0u; mine = (j == x) ? c : mine; }
        if (sum == G) break;
        __builtin_amdgcn_s_sleep(1);
        if ((++sp & 255u) == 0u) { if (xb_ld(&bar[XB_TMO])) break; if (sp > XB_SPIN_CAP) { atomicAdd(&bar[XB_TMO], 1u); break; } }
    }
    nloc = mine > 0u ? mine : 1u; nx = cnt > 0u ? cnt : 1u;
}

__device__ __forceinline__ void xcd_barrier(const XcdBarrier& b) {
    asm volatile("s_waitcnt vmcnt(0)" ::: "memory");
    __syncthreads();
    if (threadIdx.x == 0) {
        unsigned* bar = b.bar;
        __builtin_amdgcn_s_waitcnt(0);
        unsigned nloc = b.st[0], nx = b.st[1];
        if (nloc == 0u) { xcd_barrier_complete(bar, b.x, nloc, nx); b.st[0] = nloc; b.st[1] = nx; }
        const unsigned old = xb_add(&bar[XB_XSUB(b.x)], 1u);
        const unsigned gen = old / nloc;
        if (old + 1u == (gen + 1u) * nloc) {
            __builtin_amdgcn_fence(__ATOMIC_RELEASE, "agent");
            asm volatile("s_waitcnt vmcnt(0)" ::: "memory");
            const unsigned og = xb_add(&bar[XB_TOP], 1u);
            const unsigned tg = og / nx;
            if (og + 1u == (tg + 1u) * nx) xb_add(&bar[XB_TOPGEN], 1u);
            else XB_SPIN(xb_ld(&bar[XB_TOPGEN]) == tg, bar);
            __builtin_amdgcn_fence(__ATOMIC_ACQUIRE, "agent");
            xb_add(&bar[XB_XGEN(b.x)], 1u);
            asm volatile("s_waitcnt vmcnt(0)" ::: "memory");
        } else {
            XB_SPIN(xb_ld(&bar[XB_XGEN(b.x)]) == gen, bar);
            __builtin_amdgcn_fence(__ATOMIC_ACQUIRE, "agent");
            asm volatile("s_waitcnt vmcnt(0)" ::: "memory");
        }
    }
    __syncthreads();
}

struct Frame {
    LAS unsigned char* lds;
    int tid, lane, wave;
    int vcu, G;
};
__device__ __forceinline__ float wave_sum(float v) {
#pragma unroll
    for (int o = 1; o < 64; o <<= 1) v += __shfl_xor(v, o);
    return v;
}

constexpr int TR_SCR = 64 * 65 * 4;
struct TrItem { const float* W; int N, k0, n0; bf16* WT; int K, orow0; float scale; const float* gk; int f8; };
__device__ __forceinline__ void tr_load(const TrItem& t, float (&r)[64], int lane) {
#pragma unroll
    for (int i = 0; i < 64; ++i) r[i] = t.W[(size_t)(t.k0 + i) * t.N + t.n0 + lane];
}
__device__ __forceinline__ void tr_store(const TrItem& t, const float (&r)[64], LAS float* scr, int lane) {
#pragma unroll
    for (int i = 0; i < 64; ++i) scr[i * 65 + lane] = r[i] * (t.gk ? t.scale * t.gk[t.k0 + i] : t.scale);
    LDS_WAIT(); asm volatile("" ::: "memory");
    const int c = lane & 7;
#pragma unroll
    for (int j = 0; j < 8; ++j) { const int n = (lane >> 3) + 8 * j; const LAS float* s = scr + (8 * c) * 65 + n;
        v4u o; o.x = pk2(s[0 * 65], s[1 * 65]); o.y = pk2(s[2 * 65], s[3 * 65]); o.z = pk2(s[4 * 65], s[5 * 65]); o.w = pk2(s[6 * 65], s[7 * 65]);
        if (t.f8) { unsigned w0 = 0u, w1 = 0u;
            w0 = __builtin_amdgcn_cvt_pk_fp8_f32(s[0 * 65], s[1 * 65], w0, false); w0 = __builtin_amdgcn_cvt_pk_fp8_f32(s[2 * 65], s[3 * 65], w0, true);
            w1 = __builtin_amdgcn_cvt_pk_fp8_f32(s[4 * 65], s[5 * 65], w1, false); w1 = __builtin_amdgcn_cvt_pk_fp8_f32(s[6 * 65], s[7 * 65], w1, true);
            v2u o8; o8.x = w0; o8.y = w1; *(GAS v2u*)((unsigned char*)t.WT + (size_t)(t.orow0 + n) * t.K + t.k0 + 8 * c) = o8; continue; }
        *(GAS v4u*)(t.WT + (size_t)(t.orow0 + n) * t.K + t.k0 + 8 * c) = o; }
    LDS_WAIT(); asm volatile("" ::: "memory");
}
__device__ __forceinline__ TrItem tr_plain(const float* W, int K, int N, bf16* WT, int item, const float* gk = nullptr) {
    const int nblk = N / 64, kb = item / nblk, nb = item % nblk; return TrItem{W, N, 64 * kb, 64 * nb, WT, K, 64 * nb, 1.0f, gk, 0};
}
constexpr float F8_WSCALE = 64.0f;
__device__ __forceinline__ TrItem tr_gu(const float* W, int K, int N, bf16* WT, int up, int item, const float* gk = nullptr, int f8 = 0) {
    const int nblk = N / 64, kb = item / nblk, nb = item % nblk, n0 = 64 * nb; return TrItem{W, N, 64 * kb, n0, WT, K, 256 * (n0 / 128) + 128 * up + (n0 % 128), (up ? 0.6931471805599453f : 1.4426950408889634f) * (f8 ? F8_WSCALE : 1.0f), gk, f8};
}

__device__ __forceinline__ TrItem even_item(int r, const float* w_in, const float* w_out, const float* wg, const float* wu, const float* wd, const float* g1, const float* g2, unsigned char* ws, int f8) {
    constexpr int I_IN = (DM / 64) * (MIXIN / 64), I_OUT = (DM / 64) * (DM / 64), I_G = (DM / 64) * (FFN / 64);
    if (r < I_IN) { const int nblk = MIXIN / 64, kb = r / nblk, n0 = 64 * (r % nblk);
        const int j = (n0 - 512) & 511, orow = (n0 < 512 || n0 >= 1536) ? n0 : 512 + 256 * (j >> 7) + (n0 >= 1024 ? 128 : 0) + (j & 127);
        return TrItem{w_in, MIXIN, 64 * kb, n0, (bf16*)(ws + WS_WIN), DM, orow, 1.0f, g1, 0}; } r -= I_IN;
    if (r < I_OUT) return tr_plain(w_out, DM, DM, (bf16*)(ws + WS_WOUT), r); r -= I_OUT;
    if (r < I_G) return tr_gu(wg, DM, FFN, (bf16*)(ws + WS_FGU), 0, r, g2, f8); r -= I_G;
    if (r < I_G) return tr_gu(wu, DM, FFN, (bf16*)(ws + WS_FGU), 1, r, g2, f8); r -= I_G;
    { TrItem t = tr_plain(wd, FFN, DM, (bf16*)(ws + WS_FD), r); if (f8) { t.f8 = 1; t.scale = F8_WSCALE; } return t; }
}
__device__ __forceinline__ void conv_even_phase(const Frame& F, const float* w_in, const float* w_out, const float* wg, const float* wu, const float* wd, const float* sw, const float* g1, const float* g2, unsigned char* ws, int f8) {
    LAS float* scr = (LAS float*)(F.lds + F.wave * TR_SCR);
    const int gw = F.vcu * NWAVES + F.wave, NGW = F.G * NWAVES;
    constexpr int NITEMS = (DM / 64) * (MIXIN / 64) + (DM / 64) * (DM / 64) + 2 * (DM / 64) * (FFN / 64) + (FFN / 64) * (DM / 64);
    float r[64];
    if (gw < NITEMS) { const TrItem t = even_item(gw, w_in, w_out, wg, wu, wd, g1, g2, ws, f8); tr_load(t, r, F.lane); }
    for (int it = gw; it < NITEMS; it += NGW) {
        const TrItem t = even_item(it, w_in, w_out, wg, wu, wd, g1, g2, ws, f8);
        float cur[64];
#pragma unroll
        for (int i = 0; i < 64; ++i) cur[i] = r[i];
        if (it + NGW < NITEMS) { const TrItem tn = even_item(it + NGW, w_in, w_out, wg, wu, wd, g1, g2, ws, f8); tr_load(tn, r, F.lane); }
        tr_store(t, cur, scr, F.lane);
    }
    bf16* wsp = (bf16*)(ws + WS_WSP);
    for (int idx = (F.vcu * NWAVES * 64) + F.tid; idx < 4 * 128 * 128; idx += F.G * NWAVES * 64) { const int ii = (idx >> 7) & 127, jj = idx & 127; wsp[idx] = f2bf1((jj <= ii) ? sw[idx] : 0.f); }
}
__device__ __forceinline__ TrItem odd_item(int r, const float* wqkv, const float* wo, const float* ewg, const float* ewu, const float* ewd, const float* g1, unsigned char* ws, int f8) {
    constexpr int I_Q = (DM / 64) * (QKVD / 64), I_O = (DM / 64) * (DM / 64), I_G = (DM / 64) * (EXPD / 64), I_D = (EXPD / 64) * (DM / 64);
    if (r < I_Q) { TrItem t = tr_plain(wqkv, DM, QKVD, (bf16*)(ws + WS_WQKV), r, g1); if (f8 & 2) { t.f8 = 1; t.scale = F8_WSCALE; } return t; } r -= I_Q;
    if (r < I_O) return tr_plain(wo, DM, DM, (bf16*)(ws + WS_WO), r); r -= I_O;
    const int e = r / (2 * I_G + I_D); r -= e * (2 * I_G + I_D);
    const int f8e = f8 & 1;
    bf16* gu = (bf16*)(ws + WS_MGU + (size_t)e * 2 * EXPD * DM * (f8e ? 1 : 2)); bf16* dd = (bf16*)(ws + WS_MD) + (size_t)e * DM * EXPD;
    if (r < I_G) return tr_gu(ewg + (size_t)e * DM * EXPD, DM, EXPD, gu, 0, r, nullptr, f8e); r -= I_G;
    if (r < I_G) return tr_gu(ewu + (size_t)e * DM * EXPD, DM, EXPD, gu, 1, r, nullptr, f8e); r -= I_G;
    { TrItem t = tr_plain(ewd + (size_t)e * EXPD * DM, EXPD, DM, f8e ? (bf16*)(ws + WS_MD + (size_t)e * DM * EXPD) : dd, r); if (f8e) { t.f8 = 1; t.scale = F8_WSCALE; } return t; }
}
__device__ __forceinline__ void conv_odd_phase(const Frame& F, const float* wqkv, const float* wo, const float* ewg, const float* ewu, const float* ewd, const float* g1, unsigned char* ws, int f8) {
    LAS float* scr = (LAS float*)(F.lds + F.wave * TR_SCR);
    const int gw = F.vcu * NWAVES + F.wave, NGW = F.G * NWAVES;
    constexpr int NITEMS = (DM / 64) * (QKVD / 64) + (DM / 64) * (DM / 64) + NEXP * (2 * (DM / 64) * (EXPD / 64) + (EXPD / 64) * (DM / 64));
    float r[64];
    if (gw < NITEMS) { const TrItem t = odd_item(gw, wqkv, wo, ewg, ewu, ewd, g1, ws, f8); tr_load(t, r, F.lane); }
    for (int it = gw; it < NITEMS; it += NGW) {
        const TrItem t = odd_item(it, wqkv, wo, ewg, ewu, ewd, g1, ws, f8);
        float cur[64];
#pragma unroll
        for (int i = 0; i < 64; ++i) cur[i] = r[i];
        if (it + NGW < NITEMS) { const TrItem tn = odd_item(it + NGW, wqkv, wo, ewg, ewu, ewd, g1, ws, f8); tr_load(tn, r, F.lane); }
        tr_store(t, cur, scr, F.lane);
    }
}
__device__ __forceinline__ void rope_table_phase(const Frame& F, const int* pos, float* cs) {
    for (int idx = (F.vcu * NWAVES * 64) + F.tid; idx < NTOK * 8; idx += F.G * NWAVES * 64) {
        const int t = idx >> 3, i = idx & 7;
        const float inv = (float)exp(-log(500000.0) * (double)(2 * i) / 16.0);
        const float ang = (float)pos[t] * inv;
        cs[(size_t)t * 16 + i] = (float)cos((double)ang); cs[(size_t)t * 16 + 8 + i] = (float)sin((double)ang);
    }
}
__device__ __forceinline__ void rms_phase(const Frame& F, const float* hin, const float* g, bf16* XN) {
    const int gw = F.vcu * NWAVES + F.wave, NGW = F.G * NWAVES;
    f32x4 gv[4];
#pragma unroll
    for (int j = 0; j < 4; ++j) gv[j] = ((const f32x4*)g)[F.lane + 64 * j];
    for (int m = gw; m < NTOK; m += NGW) {
        const GAS f32x4* xr = (const GAS f32x4*)(hin + (size_t)m * DM) + F.lane;
        f32x4 v[4]; float s = 0.f;
#pragma unroll
        for (int j = 0; j < 4; ++j) { v[j] = xr[64 * j]; s += (v[j].x * v[j].x + v[j].y * v[j].y) + (v[j].z * v[j].z + v[j].w * v[j].w); }
        const float rstd = 1.0f / sqrtf(wave_sum(s) * (1.f / DM) + EPS);
        GAS v2u* o8 = (GAS v2u*)(XN + (size_t)m * DM) + F.lane;
#pragma unroll
        for (int j = 0; j < 4; ++j) { const f32x4 y = v[j] * rstd * gv[j]; v2u w; w.x = pk2(y.x, y.y); w.y = pk2(y.z, y.w); o8[64 * j] = w; }
    }
}
__device__ __forceinline__ void xcast_phase(const Frame& F, const float* x, bf16* XN, float* ssp) {
    const int gw = F.vcu * NWAVES + F.wave, NGW = F.G * NWAVES;
    f32x4 nx[4];
    if (gw < NTOK) { const GAS f32x4* xr = (const GAS f32x4*)(x + (size_t)gw * DM) + F.lane;
#pragma unroll
        for (int j = 0; j < 4; ++j) nx[j] = xr[64 * j]; }
    for (int m = gw; m < NTOK; m += NGW) {
        f32x4 v[4]; float s = 0.f;
#pragma unroll
        for (int j = 0; j < 4; ++j) { v[j] = nx[j]; s += (v[j].x * v[j].x + v[j].y * v[j].y) + (v[j].z * v[j].z + v[j].w * v[j].w); }
        if (m + NGW < NTOK) { const GAS f32x4* xr = (const GAS f32x4*)(x + (size_t)(m + NGW) * DM) + F.lane;
#pragma unroll
            for (int j = 0; j < 4; ++j) nx[j] = xr[64 * j]; }
        s = wave_sum(s);
        GAS v2u* o8 = (GAS v2u*)(XN + (size_t)m * DM) + F.lane;
#pragma unroll
        for (int j = 0; j < 4; ++j) { v2u w; w.x = pk2(v[j].x, v[j].y); w.y = pk2(v[j].z, v[j].w); o8[64 * j] = w; }
        if (F.lane == 0) *(GAS f32x4*)(ssp + (size_t)m * 4) = (f32x4){s, 0.f, 0.f, 0.f};
    }
}
__device__ __forceinline__ void rms_final_phase(const Frame& F, const bf16* hb, const float* g, float* out) {
    const int gw = F.vcu * NWAVES + F.wave, NGW = F.G * NWAVES;
    f32x4 gv[4];
#pragma unroll
    for (int j = 0; j < 2; ++j) { gv[2 * j] = *(const f32x4*)(g + 512 * j + 8 * F.lane); gv[2 * j + 1] = *(const f32x4*)(g + 512 * j + 8 * F.lane + 4); }
    v4u nx0 = {0u, 0u, 0u, 0u}, nx1 = nx0;
    if (gw < NTOK) { const bf16* hr = hb + (size_t)gw * DM + 8 * F.lane; nx0 = *(const GAS v4u*)hr; nx1 = *(const GAS v4u*)(hr + 512); }
    for (int m = gw; m < NTOK; m += NGW) {
        float v[16]; { float t[8]; unpack8(nx0, t);
#pragma unroll
            for (int j = 0; j < 8; ++j) v[j] = t[j];
            unpack8(nx1, t);
#pragma unroll
            for (int j = 0; j < 8; ++j) v[8 + j] = t[j]; }
        if (m + NGW < NTOK) { const bf16* hr = hb + (size_t)(m + NGW) * DM + 8 * F.lane; nx0 = *(const GAS v4u*)hr; nx1 = *(const GAS v4u*)(hr + 512); }
        float s = 0.f;
#pragma unroll
        for (int j = 0; j < 16; ++j) s += v[j] * v[j];
        const float rstd = 1.0f / sqrtf(wave_sum(s) * (1.f / DM) + EPS);
        float* orow = out + (size_t)m * DM + 8 * F.lane;
#pragma unroll
        for (int j = 0; j < 2; ++j) { *(GAS f32x4*)(orow + 512 * j) = (f32x4){v[8 * j], v[8 * j + 1], v[8 * j + 2], v[8 * j + 3]} * rstd * gv[2 * j]; *(GAS f32x4*)(orow + 512 * j + 4) = (f32x4){v[8 * j + 4], v[8 * j + 5], v[8 * j + 6], v[8 * j + 7]} * rstd * gv[2 * j + 1]; }
    }
}
__device__ __forceinline__ void rms_router_phase(const Frame& F, const bf16* hb, const float* g, const float* rw, bf16* XNR, unsigned* gcnt, unsigned* tokinfo, int* rowtok, int f8) {
    for (int idx = (F.vcu * NWAVES * 64) + F.tid; idx < 2 * SETROWS; idx += F.G * NWAVES * 64) rowtok[idx] = -1;
    LAS unsigned* lcnt = (LAS unsigned*)F.lds;
    LAS unsigned* lbase = lcnt + 16;
    LAS unsigned* rec = lcnt + 64;
    float gvf[16];
#pragma unroll
    for (int j = 0; j < 16; ++j) gvf[j] = g[512 * (j >> 3) + 8 * F.lane + (j & 7)];
    f32x4 rwv[16][2];
#pragma unroll
    for (int j = 0; j < 16; ++j) { const f32x4* p = (const f32x4*)(rw + (size_t)(512 * (j >> 3) + 8 * F.lane + (j & 7)) * 8); rwv[j][0] = p[0]; rwv[j][1] = p[1]; }
    for (int panel = F.vcu; panel < NTOK / 256; panel += F.G) {
        if (F.tid < 16) lcnt[F.tid] = 0u;
        __syncthreads();
        v4u nx[2][2];
#pragma unroll
        for (int h2 = 0; h2 < 2; ++h2) { const bf16* hr = hb + (size_t)(panel * 256 + F.wave * 32 + 16 * h2) * DM + 8 * F.lane; nx[h2][0] = *(const GAS v4u*)hr; nx[h2][1] = *(const GAS v4u*)(hr + 512); }
        for (int r = 0; r < 16; ++r) {
            float v[2][16], s[2];
#pragma unroll
            for (int h2 = 0; h2 < 2; ++h2) { float t[8]; unpack8(nx[h2][0], t);
#pragma unroll
                for (int j = 0; j < 8; ++j) v[h2][j] = t[j];
                unpack8(nx[h2][1], t);
#pragma unroll
                for (int j = 0; j < 8; ++j) v[h2][8 + j] = t[j];
                float ss = 0.f;
#pragma unroll
                for (int j = 0; j < 16; ++j) ss += v[h2][j] * v[h2][j];
                s[h2] = ss; }
            if (r + 1 < 16) {
#pragma unroll
                for (int h2 = 0; h2 < 2; ++h2) { const bf16* hr = hb + (size_t)(panel * 256 + F.wave * 32 + 16 * h2 + r + 1) * DM + 8 * F.lane; nx[h2][0] = *(const GAS v4u*)hr; nx[h2][1] = *(const GAS v4u*)(hr + 512); } }
#pragma unroll
            for (int o = 1; o < 64; o <<= 1) { s[0] += __shfl_xor(s[0], o); s[1] += __shfl_xor(s[1], o); }
            float lg[2][8];
#pragma unroll
            for (int h2 = 0; h2 < 2; ++h2) { const int m = panel * 256 + F.wave * 32 + 16 * h2 + r;
                const float rstd = 1.0f / sqrtf(s[h2] * (1.f / DM) + EPS);
                f32x4 l0 = (f32x4){0.f, 0.f, 0.f, 0.f}, l1 = l0; float y[16];
#pragma unroll
                for (int j = 0; j < 16; ++j) { y[j] = v[h2][j] * rstd * gvf[j]; l0 += rwv[j][0] * y[j]; l1 += rwv[j][1] * y[j]; }
                if (f8) { unsigned char* xr8 = (unsigned char*)XNR + (size_t)m * DM + 8 * F.lane;
#pragma unroll
                  for (int hh = 0; hh < 2; ++hh) { unsigned w0 = 0u, w1 = 0u;
                      w0 = __builtin_amdgcn_cvt_pk_fp8_f32(y[8 * hh + 0], y[8 * hh + 1], w0, false); w0 = __builtin_amdgcn_cvt_pk_fp8_f32(y[8 * hh + 2], y[8 * hh + 3], w0, true);
                      w1 = __builtin_amdgcn_cvt_pk_fp8_f32(y[8 * hh + 4], y[8 * hh + 5], w1, false); w1 = __builtin_amdgcn_cvt_pk_fp8_f32(y[8 * hh + 6], y[8 * hh + 7], w1, true);
                      v2u o8; o8.x = w0; o8.y = w1; *(GAS v2u*)(xr8 + 512 * hh) = o8; } }
                else { float t[8];
#pragma unroll
                  for (int j = 0; j < 8; ++j) t[j] = y[j];
                  *(GAS v4u*)(XNR + (size_t)m * DM + 8 * F.lane) = pack8f(t);
#pragma unroll
                  for (int j = 0; j < 8; ++j) t[j] = y[8 + j];
                  *(GAS v4u*)(XNR + (size_t)m * DM + 512 + 8 * F.lane) = pack8f(t); }
#pragma unroll
                for (int e = 0; e < 4; ++e) { lg[h2][e] = l0[e]; lg[h2][4 + e] = l1[e]; } }
#pragma unroll
            for (int o = 1; o < 64; o <<= 1) {
#pragma unroll
                for (int e = 0; e < 8; ++e) { lg[0][e] += __shfl_xor(lg[0][e], o); lg[1][e] += __shfl_xor(lg[1][e], o); } }
#pragma unroll
            for (int h2 = 0; h2 < 2; ++h2) { const int lrow = F.wave * 32 + 16 * h2 + r;
                int e1 = 0; float v1 = lg[h2][0];
#pragma unroll
                for (int e = 1; e < 8; ++e) if (lg[h2][e] > v1) { v1 = lg[h2][e]; e1 = e; }
                int e2 = -1; float v2 = -INFINITY;
#pragma unroll
                for (int e = 0; e < 8; ++e) if (e != e1 && (e2 < 0 || lg[h2][e] > v2)) { v2 = lg[h2][e]; e2 = e; }
                const float g2 = 1.0f / (1.0f + expf(v1 - v2)), g1 = 1.0f - g2;
                if (F.lane == 0) {
                    const unsigned p1 = __hip_atomic_fetch_add(lcnt + e1, 1u, __ATOMIC_RELAXED, __HIP_MEMORY_SCOPE_WORKGROUP), p2 = __hip_atomic_fetch_add(lcnt + 8 + e2, 1u, __ATOMIC_RELAXED, __HIP_MEMORY_SCOPE_WORKGROUP);
                    LAS unsigned* rr = rec + lrow * 8; rr[0] = (unsigned)e1; rr[1] = p1; rr[2] = __float_as_uint(g1); rr[3] = (unsigned)e2; rr[4] = p2; rr[5] = __float_as_uint(g2);
                } }
        }
        __syncthreads();
        if (F.tid < 16) lbase[F.tid] = __hip_atomic_fetch_add(gcnt + F.tid, lcnt[F.tid], RLX_AGENT);
        __syncthreads();
        if (F.tid < 256) { const LAS unsigned* rr = rec + F.tid * 8; v4u a, b; a.x = rr[0]; a.y = rr[1] + lbase[rr[0]]; a.z = rr[2]; a.w = rr[3]; b.x = rr[4] + lbase[8 + rr[3]]; b.y = rr[5]; b.z = 0u; b.w = 0u;
            GAS v4u* ti = (GAS v4u*)(tokinfo + (size_t)(panel * 256 + F.tid) * 8); ti[0] = a; ti[1] = b; }
        __syncthreads();
    }
}
__device__ __forceinline__ void moe_prefix(const unsigned* gcnt_set, int (&pend)[8]) {
    int acc = 0;
#pragma unroll
    for (int e = 0; e < 8; ++e) { const unsigned c = __hip_atomic_load(gcnt_set + e, RLX_AGENT); acc += (int)((c + 255u) >> 8); pend[e] = acc; }
}
__device__ __forceinline__ void slots_phase(const Frame& F, const unsigned* gcnt, const unsigned* tokinfo, int* rowtok, float* rowgate) {
    int pe0[8], pe1[8]; moe_prefix(gcnt, pe0); moe_prefix(gcnt + 8, pe1);
    for (int t = F.vcu * NWAVES * 64 + F.tid; t < NTOK; t += F.G * NWAVES * 64) {
        const v4u a = *(const GAS v4u*)(tokinfo + (size_t)t * 8), b = *(const GAS v4u*)(tokinfo + (size_t)t * 8 + 4);
        const int e1 = (int)a.x, e2 = (int)a.w; int s1 = 0, s2 = 0;
#pragma unroll
        for (int k = 0; k < 7; ++k) { s1 = (e1 == k + 1) ? pe0[k] : s1; s2 = (e2 == k + 1) ? pe1[k] : s2; }
        const size_t slot1 = (size_t)s1 * 256 + a.y, slot2 = (size_t)SETROWS + (size_t)s2 * 256 + b.x;
        rowtok[slot1] = t; rowgate[slot1] = __uint_as_float(a.z); rowtok[slot2] = t; rowgate[slot2] = __uint_as_float(b.y);
    }
}

typedef short bf16x8v __attribute__((ext_vector_type(8)));
typedef float f32x16 __attribute__((ext_vector_type(16)));
constexpr int AT_KP = 144, AT_VP = 528, AT_VOFF = 256 * AT_KP;
__device__ __forceinline__ void attn_mfma_phase(const Frame& F, const bf16* QKV, const float* sinks, bf16* AO) {
    LAS unsigned char* Ks = F.lds; LAS unsigned char* Vt = F.lds + AT_VOFF;
    const int q = F.lane & 31, hi = F.lane >> 5;
    v4u kreg[4], vreg[4];
#define AT_FETCH(unit_) do { const int b_ = (unit_) >> 7, n_ = ((unit_) >> 1) & 63, hk_ = (unit_) & 1; _Pragma("unroll") for (int i = 0; i < 4; ++i) { const int p = F.tid + 512 * i, key = p >> 3, ch = p & 7; \
        const int kt = (n_ == 0 && key < 128) ? key : (n_ - 1) * 128 + key;        \
        const bf16* src = QKV + ((size_t)b_ * SEQ + kt) * QKVD + 1024 + hk_ * 64 + ch * 8; kreg[i] = *(const GAS v4u*)src; vreg[i] = *(const GAS v4u*)(src + 128); } } while (0)
    int unit = F.vcu;
    if (unit < 8 * 64 * 2) AT_FETCH(unit);
    for (; unit < 8 * 64 * 2; unit += F.G) {
        const int b = unit >> 7, n = (unit >> 1) & 63, hk = unit & 1;
        const size_t tb = (size_t)b * SEQ;
#pragma unroll
        for (int i = 0; i < 4; ++i) { const int p = F.tid + 512 * i, key = p >> 3, ch = p & 7;
            *(LAS v4u*)(Ks + key * AT_KP + ch * 16) = kreg[i];
            const v4u v = vreg[i];
            const int kg = key & 15, kpos = (key & ~15) + (kg & 3) + ((kg >> 3) & 1) * 4 + ((kg >> 2) & 1) * 8;
            LAS unsigned short* vp = (LAS unsigned short*)(Vt + (ch * 8) * AT_VP + kpos * 2);
            vp[0 * (AT_VP / 2)] = (unsigned short)(v.x & 0xffffu); vp[1 * (AT_VP / 2)] = (unsigned short)(v.x >> 16); vp[2 * (AT_VP / 2)] = (unsigned short)(v.y & 0xffffu); vp[3 * (AT_VP / 2)] = (unsigned short)(v.y >> 16);
            vp[4 * (AT_VP / 2)] = (unsigned short)(v.z & 0xffffu); vp[5 * (AT_VP / 2)] = (unsigned short)(v.z >> 16); vp[6 * (AT_VP / 2)] = (unsigned short)(v.w & 0xffffu); vp[7 * (AT_VP / 2)] = (unsigned short)(v.w >> 16); }
        const int head = hk * 8 + F.wave; const float sk = sinks[head] * LOG2E;
        bf16x8v qf[4][4];
#pragma unroll
        for (int qt = 0; qt < 4; ++qt)
#pragma unroll
            for (int d0 = 0; d0 < 4; ++d0) qf[qt][d0] = *(const GAS bf16x8v*)(QKV + (tb + (size_t)n * 128 + qt * 32 + q) * QKVD + head * 64 + 16 * d0 + 8 * hi);
        if (unit + F.G < 8 * 64 * 2) AT_FETCH(unit + F.G);
        __syncthreads();
#pragma unroll
        for (int qt = 0; qt < 4; ++qt) {
            const size_t qrow = tb + (size_t)n * 128 + qt * 32 + q;
            f32x16 p[5];
#pragma unroll
            for (int j = 0; j < 5; ++j) {
                const int kt = qt + j;
                if (n == 0 && kt < 4) {
#pragma unroll
                    for (int r = 0; r < 16; ++r) p[j][r] = -INFINITY;
                } else {
                    f32x16 a = {0.f, 0.f, 0.f, 0.f, 0.f, 0.f, 0.f, 0.f, 0.f, 0.f, 0.f, 0.f, 0.f, 0.f, 0.f, 0.f};
                    const LAS unsigned char* kp = Ks + (32 * kt + q) * AT_KP + 16 * hi;
#pragma unroll
                    for (int d0 = 0; d0 < 4; ++d0) a = __builtin_amdgcn_mfma_f32_32x32x16_bf16(*(const LAS bf16x8v*)(kp + 32 * d0), qf[qt][d0], a, 0, 0, 0);
                    p[j] = a;
                }
            }
#pragma unroll
            for (int r = 0; r < 16; ++r) { const int key = (r & 3) + 8 * (r >> 2) + 4 * hi; if (key <= q) p[0][r] = -INFINITY; if (key > q) p[4][r] = -INFINITY; }
            float mx = sk;
#pragma unroll
            for (int j = 0; j < 5; ++j)
#pragma unroll
                for (int r = 0; r < 16; ++r) mx = fmaxf(mx, p[j][r]);
            mx = fmaxf(mx, __shfl_xor(mx, 32));
            float ls = 0.f;
#pragma unroll
            for (int j = 0; j < 5; ++j)
#pragma unroll
                for (int r = 0; r < 16; ++r) { p[j][r] = __builtin_amdgcn_exp2f(p[j][r] - mx); ls += p[j][r]; }
            ls += __shfl_xor(ls, 32); ls += __builtin_amdgcn_exp2f(sk - mx);
            f32x16 o0 = {0.f, 0.f, 0.f, 0.f, 0.f, 0.f, 0.f, 0.f, 0.f, 0.f, 0.f, 0.f, 0.f, 0.f, 0.f, 0.f}, o1 = o0;
#pragma unroll
            for (int j = 0; j < 5; ++j) {
                const int kt = qt + j;
                if (!(n == 0 && kt < 4)) {
#pragma unroll
                    for (int ks = 0; ks < 2; ++ks) {
                        v4u pw; pw.x = pk2(p[j][8 * ks + 0], p[j][8 * ks + 1]); pw.y = pk2(p[j][8 * ks + 2], p[j][8 * ks + 3]); pw.z = pk2(p[j][8 * ks + 4], p[j][8 * ks + 5]); pw.w = pk2(p[j][8 * ks + 6], p[j][8 * ks + 7]);
                        const bf16x8v pf = __builtin_bit_cast(bf16x8v, pw);
                        const LAS unsigned char* vp = Vt + q * AT_VP + (32 * kt + 16 * ks + 8 * hi) * 2;
                        o0 = __builtin_amdgcn_mfma_f32_32x32x16_bf16(*(const LAS bf16x8v*)vp, pf, o0, 0, 0, 0);
                        o1 = __builtin_amdgcn_mfma_f32_32x32x16_bf16(*(const LAS bf16x8v*)(vp + 32 * AT_VP), pf, o1, 0, 0, 0);
                    }
                }
            }
            const float il = 1.0f / ls;
            bf16* orow = AO + qrow * DM + head * 64 + 8 * hi;
#pragma unroll
            for (int jg = 0; jg < 4; jg += 2) { v2u a0, b0, a1, b1;
                a0.x = pk2(o0[4 * jg] * il, o0[4 * jg + 1] * il); a0.y = pk2(o0[4 * jg + 2] * il, o0[4 * jg + 3] * il);
                b0.x = pk2(o0[4 * jg + 4] * il, o0[4 * jg + 5] * il); b0.y = pk2(o0[4 * jg + 6] * il, o0[4 * jg + 7] * il);
                a1.x = pk2(o1[4 * jg] * il, o1[4 * jg + 1] * il); a1.y = pk2(o1[4 * jg + 2] * il, o1[4 * jg + 3] * il);
                b1.x = pk2(o1[4 * jg + 4] * il, o1[4 * jg + 5] * il); b1.y = pk2(o1[4 * jg + 6] * il, o1[4 * jg + 7] * il);
                { auto r = __builtin_amdgcn_permlane32_swap(a0.x, b0.x, false, false); a0.x = r[0]; b0.x = r[1]; }
                { auto r = __builtin_amdgcn_permlane32_swap(a0.y, b0.y, false, false); a0.y = r[0]; b0.y = r[1]; }
                { auto r = __builtin_amdgcn_permlane32_swap(a1.x, b1.x, false, false); a1.x = r[0]; b1.x = r[1]; }
                { auto r = __builtin_amdgcn_permlane32_swap(a1.y, b1.y, false, false); a1.y = r[0]; b1.y = r[1]; }
                *(GAS v4u*)(orow + 8 * jg) = (v4u){a0.x, a0.y, b0.x, b0.y}; *(GAS v4u*)(orow + 32 + 8 * jg) = (v4u){a1.x, a1.y, b1.x, b1.y}; }
        }
        __syncthreads();
    }
#undef AT_FETCH
}

typedef float f32x2 __attribute__((ext_vector_type(2)));
__device__ __forceinline__ f32x2 gelu_pk(f32x2 v) {
    const f32x2 av = __builtin_elementwise_abs(v), d = av * 0.2316418882f + 1.0f;
    f32x2 t; t.x = __builtin_amdgcn_rcpf(d.x); t.y = __builtin_amdgcn_rcpf(d.y);
    f32x2 q = t * 0.5307027145f + (-0.7265760135f); q = q * t + 0.7107068705f; q = q * t + (-0.142248368f); q = q * t + 0.127414796f; q = q * t;
    const f32x2 s = (v * v) * (-0.72134752044f);
    f32x2 e; e.x = __builtin_amdgcn_exp2f(s.x); e.y = __builtin_amdgcn_exp2f(s.y);
    const f32x2 m = v * (q * e), r = v - m;
    f32x2 o; o.x = v.x < 0.f ? m.x : r.x; o.y = v.y < 0.f ? m.y : r.y; return o;
}
constexpr int ZP = 2048;
__device__ __forceinline__ int mx_swz(int row) { return (row ^ (row >> 4)) & 15; }
__device__ __forceinline__ void mixer_fused_phase(const Frame& F, const bf16* Z, bf16* Y, const float* convw, const float* lng, const float* lnb, const bf16* Wb, const float* sb, int pmode = 0) {
    LAS unsigned char* vt = F.lds;
    const int c8 = 8 * F.lane, q = F.lane & 31, hi = F.lane >> 5;
    for (int unit = F.vcu; unit < NTOK / 128; unit += F.G) {
        const size_t t0 = (size_t)unit * 128;
        if (pmode != 2) {
            float cw0[8], cw1[8], cw2[8], lg[8], lb[8];
#pragma unroll
            for (int j = 0; j < 8; ++j) { cw0[j] = convw[(c8 + j) * 3 + 0]; cw1[j] = convw[(c8 + j) * 3 + 1]; cw2[j] = convw[(c8 + j) * 3 + 2]; lg[j] = lng[c8 + j]; lb[j] = lnb[c8 + j]; }
            const size_t tw = t0 + 16 * F.wave;
            float cx1[8], cx2[8];
            if ((tw % SEQ) != 0) {
                unpack8(*(const GAS v4u*)(Z + (tw - 1) * ZP + 512 + c8), cx1);
                unpack8(*(const GAS v4u*)(Z + (tw - 2) * ZP + 512 + c8), cx2);
            } else {
#pragma unroll
                for (int j = 0; j < 8; ++j) { cx1[j] = 0.f; cx2[j] = 0.f; }
            }
            constexpr int NTB = 2;
            v4u nab[NTB], ncx[NTB], nbv[NTB];
#pragma unroll
            for (int k = 0; k < NTB; ++k) { const bf16* zr = Z + (tw + k) * ZP; nab[k] = *(const GAS v4u*)(zr + c8); ncx[k] = *(const GAS v4u*)(zr + 512 + c8); nbv[k] = *(const GAS v4u*)(zr + 1536 + c8); }
#pragma unroll 1
            for (int r0 = 0; r0 < 16; r0 += NTB) {
                v4u wab[NTB], wcx[NTB], wbv[NTB];
#pragma unroll
                for (int k = 0; k < NTB; ++k) { wab[k] = nab[k]; wcx[k] = ncx[k]; wbv[k] = nbv[k]; }
                if (r0 + NTB < 16) {
#pragma unroll
                    for (int k = 0; k < NTB; ++k) { const bf16* zr = Z + (tw + r0 + NTB + k) * ZP; nab[k] = *(const GAS v4u*)(zr + c8); ncx[k] = *(const GAS v4u*)(zr + 512 + c8); nbv[k] = *(const GAS v4u*)(zr + 1536 + c8); } }
                float vv[NTB][8], s[NTB];
#pragma unroll
                for (int k = 0; k < NTB; ++k) {
                    float ab[8], cxv[8], bv[8], ya[8];
                    unpack8(wab[k], ab); unpack8(wcx[k], cxv); unpack8(wbv[k], bv);
#pragma unroll
                    for (int j = 0; j < 8; ++j) { const float cx0 = cxv[j]; ya[j] = ab[j] * (cw0[j] * cx2[j] + cw1[j] * cx1[j] + cw2[j] * cx0); cx2[j] = cx1[j]; cx1[j] = cx0; }
                    *(GAS v4u*)(Y + (tw + r0 + k) * DM + c8) = pack8f(ya);
                    float sk = 0.f;
#pragma unroll
                    for (int j = 0; j < 8; j += 2) { const f32x2 gv = gelu_pk((f32x2){bv[j], bv[j + 1]}); vv[k][j] = gv.x; vv[k][j + 1] = gv.y; sk += gv.x + gv.y; }
                    s[k] = sk;
                }
#pragma unroll
                for (int o = 1; o < 64; o <<= 1) {
#pragma unroll
                    for (int k = 0; k < NTB; ++k) s[k] += __shfl_xor(s[k], o); }
                float q[NTB];
#pragma unroll
                for (int k = 0; k < NTB; ++k) { const float mu = s[k] * (1.f / 512.f); float qq = 0.f;
#pragma unroll
                    for (int j = 0; j < 8; ++j) { vv[k][j] -= mu; qq += vv[k][j] * vv[k][j]; }
                    q[k] = qq; }
#pragma unroll
                for (int o = 1; o < 64; o <<= 1) {
#pragma unroll
                    for (int k = 0; k < NTB; ++k) q[k] += __shfl_xor(q[k], o); }
#pragma unroll
                for (int k = 0; k < NTB; ++k) { const float rstd = 1.0f / sqrtf(q[k] * (1.f / 512.f) + EPS); const int jl = 16 * F.wave + r0 + k;
#pragma unroll
                    for (int j = 0; j < 8; ++j) { const int row = c8 + j; const float y = vv[k][j] * rstd * lg[j] + lb[j];
                        *(LAS unsigned short*)(vt + row * 256 + (((jl >> 3) ^ mx_swz(row)) << 4) + (jl & 7) * 2) = f2bf1(y); } }
            }
        }
        __syncthreads();
        if (pmode != 1) {
            const int h = F.wave >> 1, dt0 = 2 * (F.wave & 1);
            v2u bwa[4][2][4];
#pragma unroll
            for (int it = 0; it < 4; ++it) {
#pragma unroll
                for (int dl = 0; dl < 2; ++dl)
#pragma unroll
                    for (int jg = 0; jg < 4; ++jg) bwa[it][dl][jg] = *(const GAS v2u*)(Z + (t0 + 32 * it + q) * ZP + 1024 + h * 128 + 32 * (dt0 + dl) + 4 * hi + 8 * jg);
            }
#pragma unroll
            for (int it = 0; it < 4; ++it) {
                const size_t tok = t0 + 32 * it + q; const float sbv = sb[h * 128 + 32 * it + q];
                bf16x8v wf[8];
                const bf16* wrow = Wb + (size_t)(h * 128 + 32 * it + q) * 128 + 8 * hi;
#pragma unroll
                for (int ks = 0; ks < 2 * (it + 1); ++ks) wf[ks] = *(const GAS bf16x8v*)(wrow + 16 * ks);
#pragma unroll
                for (int dl = 0; dl < 2; ++dl) {
                    const int dt = dt0 + dl, row = h * 128 + 32 * dt + q; const LAS unsigned char* ap = vt + row * 256; const int sw = mx_swz(row);
                    f32x16 acc = {0.f, 0.f, 0.f, 0.f, 0.f, 0.f, 0.f, 0.f, 0.f, 0.f, 0.f, 0.f, 0.f, 0.f, 0.f, 0.f};
#pragma unroll
                    for (int ks = 0; ks < 2 * (it + 1); ++ks) acc = __builtin_amdgcn_mfma_f32_32x32x16_bf16(*(const LAS bf16x8v*)(ap + (((2 * ks + hi) ^ sw) << 4)), wf[ks], acc, 0, 0, 0);
                    const int cb = h * 128 + 32 * dt + 8 * hi;
                    v2u wv[4];
#pragma unroll
                    for (int jg = 0; jg < 4; ++jg) { const v2u bw = bwa[it][dl][jg];
                        const f32x2 u0 = gelu_pk((f32x2){bflo(bw.x), bfhi(bw.x)}), u1 = gelu_pk((f32x2){bflo(bw.y), bfhi(bw.y)});
                        wv[jg].x = pk2(u0.x * (acc[4 * jg] + sbv), u0.y * (acc[4 * jg + 1] + sbv)); wv[jg].y = pk2(u1.x * (acc[4 * jg + 2] + sbv), u1.y * (acc[4 * jg + 3] + sbv)); }
#pragma unroll
                    for (int jg = 0; jg < 4; jg += 2) { v2u a = wv[jg], b = wv[jg + 1];
                        { auto r = __builtin_amdgcn_permlane32_swap(a.x, b.x, false, false); a.x = r[0]; b.x = r[1]; }
                        { auto r = __builtin_amdgcn_permlane32_swap(a.y, b.y, false, false); a.y = r[0]; b.y = r[1]; }
                        *(GAS v4u*)(Y + tok * DM + 512 + cb + 8 * jg) = (v4u){a.x, a.y, b.x, b.y}; }
                }
            }
        }
        __syncthreads();
    }
}

struct Args {
    const float* x; const int* pos; const float* fng;
    const float *e_n1, *e_win, *e_conv, *e_lng, *e_lnb, *e_sw, *e_sb, *e_wout, *e_n2, *e_wg, *e_wu, *e_wd;
    const float *o_n1, *o_wqkv, *o_bqkv, *o_sinks, *o_wo, *o_bo, *o_n2, *o_rw, *o_ewg, *o_ewu, *o_ewd;
    float* out; unsigned char* ws; int lo, hi, li, pad;
};
constexpr int PH_PER_PAIR = 16;
#ifndef F8_MOE_MASK
#define F8_MOE_MASK 3
#endif
#define F8M(i) (F8_MOE_MASK == 3 ? 1 : ((F8_MOE_MASK >> (i)) & 1))
#ifndef F8_FFN_MASK
#define F8_FFN_MASK 2
#endif
#define F8F(i) ((F8_FFN_MASK >> (i)) & 1)
#ifndef F8_QKV_MASK
#define F8_QKV_MASK 2
#endif
#define F8Q(i) (((F8_QKV_MASK & F8_FFN_MASK) >> (i)) & 1)
#ifndef F8_H1SCALE
#define F8_H1SCALE 8.0f
#define F8_H1SCALE_I 8
constexpr size_t H1SET8 = (size_t)SETROWS * EXPD;
static_assert(WS_BIG + 2 * H1SET8 <= WS_END, "two e4m3 H1 buffers");
#endif
#ifndef WGM_MOEGU
#define WGM_MOEGU 4
#endif
#ifndef WGM_N1024
#define WGM_N1024 4
#endif
#ifndef WGM_E1
#define WGM_E1 4
#endif
#ifndef WGM_FFNGU
#define WGM_FFNGU 4
#endif
#ifndef WGM_QKV
#define WGM_QKV 4
#endif
#ifndef PROBE_MODE
#define PROBE_MODE 0
#endif
#ifndef PROBE_STAG
#define PROBE_STAG 0
#endif
#ifndef STAG_MOEGU
#define STAG_MOEGU 0
#endif
#ifndef STAG_FFNGU
#define STAG_FFNGU 0
#endif
constexpr int N_PHASES = 1 + 2 * PH_PER_PAIR + 1;

typedef const __attribute__((address_space(4))) Args* ArgsP;
#define PH_ARGS(ap) ArgsP ap = (ArgsP)__builtin_amdgcn_kernarg_segment_ptr(); asm volatile("" : "+s"(ap))
__device__ __forceinline__ Frame make_frame(LAS unsigned char* lds) {
    Frame F; int tid = threadIdx.x; asm volatile("" : "+v"(tid));
    F.lds = lds; F.tid = tid; F.lane = tid & 63; F.wave = __builtin_amdgcn_readfirstlane(tid >> 6);
    F.G = gridDim.x; { const int bx = blockIdx.x; F.vcu = (F.G % 8 == 0) ? (bx % 8) * (F.G / 8) + bx / 8 : bx; }
    return F;
}
__global__ void __launch_bounds__(NWAVES * 64, 2) fwd(Args A_unused) {
    extern __shared__ __attribute__((aligned(16))) unsigned char lds_raw[];
    LAS unsigned char* const lds = (LAS unsigned char*)lds_raw;
    asm volatile("s_setreg_imm32_b32 hwreg(HW_REG_MODE, 23, 1), 1");
    for (int u = threadIdx.x; u < (LDS_BYTES - LDSCTL_OFF) / 4; u += NWAVES * 64) ((LAS unsigned*)(lds + LDSCTL_OFF))[u] = 0u;
    __syncthreads();
    int lo, hi;
    { PH_ARGS(ap); lo = ap->lo; hi = ap->hi; }
#if MK_ONE_LAUNCH
    XcdBarrier bar;
    { PH_ARGS(ap); bar = xcd_barrier_post((unsigned*)(ap->ws + WS_CTL) + CW_BAR, (volatile LAS unsigned*)(lds + MISC_OFF) + 8); }
#define GRID_BAR() xcd_barrier(bar)
#else
#define GRID_BAR() do { } while (0)
#endif
#ifndef PHMASK
#define PHMASK 0xFFFFFFFFu
#endif
#define PHEN(k) (((PHMASK) >> (k)) & 1u)
#ifndef PROBE_DUP
#define PROBE_DUP 0u
#endif
#define DUP(k) (1 + (int)(((PROBE_DUP) >> (k)) & 1u))
#define IN(k) (lo <= (k) && (k) < hi)
#define SEAM(k) do { if (IN(k) && IN((k) + 1)) GRID_BAR(); } while (0)
#define PH_BEGIN() PH_ARGS(ap); const Frame F = make_frame(lds); unsigned char* const ws = ap->ws; const int G = F.G, cblk = (int)blockIdx.x; (void)G; (void)cblk

    if (IN(0) && PHEN(16)) { PH_BEGIN(); rope_table_phase(F, ap->pos, (float*)(ws + WS_CS)); }

#pragma unroll 1
    for (int i = 0; i < 2; ++i) {
        const int pb = 1 + i * PH_PER_PAIR;
        if (IN(pb + 0) && PHEN(0)) { PH_BEGIN(); for (int rep_ = 0; rep_ < DUP(0); ++rep_) { conv_even_phase(F, ap->e_win + (size_t)i * DM * MIXIN, ap->e_wout + (size_t)i * DM * DM, ap->e_wg + (size_t)i * DM * FFN, ap->e_wu + (size_t)i * DM * FFN, ap->e_wd + (size_t)i * FFN * DM, ap->e_sw + (size_t)i * 4 * 128 * 128, ap->e_n1 + i * DM, ap->e_n2 + i * DM, ws, F8F(i) ? 1 : 0);
                          if (i == 0) xcast_phase(F, ap->x, (bf16*)(ws + WS_XN), (float*)(ws + WS_SSP)); } } SEAM(pb + 0);
        if (IN(pb + 1) && PHEN(1)) { PH_BEGIN(); for (int rep_ = 0; rep_ < DUP(1); ++rep_) { pg8::Gemm g{(const bf16*)(ws + WS_XN), (const bf16*)(ws + WS_WIN), DM, 0}; pg8::StaticOrder S; S.init(NTOK, MIXIN, G, cblk, WGM_E1); if (rep_ + 1 < DUP(1)) {
#if PROBE_MODE >= 10
                              pg8::EpiMixIn E0{(bf16*)(ws + WS_BIG), PROBE_MODE == 10 ? (const float*)(ws + WS_SSP) : (const float*)nullptr}; pg8::gemm_phase<pg8::EpiMixIn, pg8::StaticOrder, true, true>(F.lds, g, S, E0);
#else
                              pg8::EpiProbe<PROBE_MODE> E0{(bf16*)(ws + WS_BIG), 2048}; pg8::gemm_phase<pg8::EpiProbe<PROBE_MODE>, pg8::StaticOrder, true, true>(F.lds, g, S, E0, PROBE_STAG);
#endif
                          }
                          else { pg8::EpiMixIn E{(bf16*)(ws + WS_BIG), (const float*)(ws + WS_SSP)};
                          pg8::gemm_phase<pg8::EpiMixIn, pg8::StaticOrder, true, true>(F.lds, g, S, E); } } } SEAM(pb + 1);
        if (IN(pb + 2) && PHEN(2)) { PH_BEGIN(); for (int rep_ = 0; rep_ < DUP(2); ++rep_) { mixer_fused_phase(F, (const bf16*)(ws + WS_BIG), (bf16*)(ws + WS_BIG + WS_YOFF), ap->e_conv + i * 512 * 3, ap->e_lng + i * 512, ap->e_lnb + i * 512, (const bf16*)(ws + WS_WSP), ap->e_sb + i * 4 * 128, (rep_ + 1 < DUP(2)) ? PROBE_MODE : 0); } } SEAM(pb + 2);
        if (IN(pb + 3) && PHEN(4)) { PH_BEGIN(); pg8::Gemm g{(const bf16*)(ws + WS_BIG + WS_YOFF), (const bf16*)(ws + WS_WOUT), DM, 0}; pg8::StaticOrder S; S.init(NTOK, DM, G, cblk, WGM_N1024);
                          if (F8F(i)) { typedef pg8::EpiResB<false, 1, (long)WS_XG - (long)WS_XN> EpiT; EpiT E{(bf16*)(ws + WS_XN), nullptr, (float*)(ws + WS_SSP), (LAS float*)(F.lds + TAB_OFF), 1};
                              pg8::gemm_phase<EpiT, pg8::StaticOrder, true, true>(F.lds, g, S, E); }
                          else { pg8::EpiResB<true> E{(bf16*)(ws + WS_XN), nullptr, (float*)(ws + WS_SSP), (LAS float*)(F.lds + TAB_OFF), 1};
                          pg8::gemm_phase<pg8::EpiResB<true>, pg8::StaticOrder, true, true>(F.lds, g, S, E); } } SEAM(pb + 3);
        if (IN(pb + 4) && PHEN(6)) { PH_BEGIN(); for (int rep_ = 0; rep_ < DUP(6); ++rep_) { if (F8F(i)) { pg8::Gemm g{(const bf16*)(ws + WS_XG), (const bf16*)(ws + WS_FGU), DM / 2, 0}; pg8::StaticOrder S; S.init(NTOK, 2 * FFN, G, cblk, WGM_FFNGU, DM / 128);
                              pg8::EpiSwiGLU E{(bf16*)(ws + WS_BIG), FFN, (const float*)(ws + WS_SSP), 1.0f / 64.0f, F8_H1SCALE}; pg8::gemm_phase2<pg8::EpiSwiGLU, pg8::StaticOrder, false, false, true>(F.lds, g, S, E, nullptr, STAG_FFNGU); }
                          else { pg8::Gemm g{(const bf16*)(ws + WS_XN), (const bf16*)(ws + WS_FGU), DM, 0}; pg8::StaticOrder S; S.init(NTOK, 2 * FFN, G, cblk, WGM_FFNGU);
                          pg8::EpiSwiGLU E{(bf16*)(ws + WS_BIG), FFN, (const float*)(ws + WS_SSP), 1.0f, 0.0f}; pg8::gemm_phase<pg8::EpiSwiGLU, pg8::StaticOrder, true, true>(F.lds, g, S, E, STAG_FFNGU); } } } SEAM(pb + 4);
        if (IN(pb + 5) && PHEN(7)) { PH_BEGIN();
                          if (F8F(i)) { pg8::Gemm g{(const bf16*)(ws + WS_BIG), (const bf16*)(ws + WS_FD), FFN / 2, 0}; pg8::StaticOrder S; S.init(NTOK, DM, G, cblk, WGM_N1024, FFN / 128);
                              if (F8Q(i)) { typedef pg8::EpiResB<false, 64 * F8_H1SCALE_I, (long)WS_XG - (long)WS_XN> EpiT; EpiT E{(bf16*)(ws + WS_XN), nullptr, (float*)(ws + WS_SSP), (LAS float*)(F.lds + TAB_OFF), 1};
                                  pg8::gemm_phase2<EpiT, pg8::StaticOrder, false, false, true>(F.lds, g, S, E, nullptr); }
                              else { typedef pg8::EpiResB<true, 64 * F8_H1SCALE_I> EpiT; EpiT E{(bf16*)(ws + WS_XN), nullptr, (float*)(ws + WS_SSP), (LAS float*)(F.lds + TAB_OFF), 1};
                              pg8::gemm_phase2<EpiT, pg8::StaticOrder, false, false, true>(F.lds, g, S, E, nullptr); } }
                          else { pg8::Gemm g{(const bf16*)(ws + WS_BIG), (const bf16*)(ws + WS_FD), FFN, 0}; pg8::StaticOrder S; S.init(NTOK, DM, G, cblk, WGM_N1024);
                          pg8::EpiResB<true> E{(bf16*)(ws + WS_XN), nullptr, (float*)(ws + WS_SSP), (LAS float*)(F.lds + TAB_OFF), 1};
                          pg8::gemm_phase<pg8::EpiResB<true>, pg8::StaticOrder, true, true>(F.lds, g, S, E); } }
        if (IN(pb + 6) && PHEN(8)) { PH_BEGIN(); for (int rep_ = 0; rep_ < DUP(8); ++rep_) { conv_odd_phase(F, ap->o_wqkv + (size_t)i * DM * QKVD, ap->o_wo + (size_t)i * DM * DM, ap->o_ewg + (size_t)i * NEXP * DM * EXPD, ap->o_ewu + (size_t)i * NEXP * DM * EXPD, ap->o_ewd + (size_t)i * NEXP * EXPD * DM, ap->o_n1 + i * DM, ws, (F8M(i) ? 1 : 0) | (F8Q(i) ? 2 : 0)); } } SEAM(pb + 6);
        if (IN(pb + 7) && PHEN(9)) { PH_BEGIN(); for (int rep_ = 0; rep_ < DUP(9); ++rep_) { if (F8Q(i)) { pg8::Gemm g{(const bf16*)(ws + WS_XG), (const bf16*)(ws + WS_WQKV), DM / 2, 0}; pg8::StaticOrder S; S.init(NTOK, QKVD, G, cblk, WGM_QKV, DM / 128);
                              pg8::EpiQKVT<64> E{(bf16*)(ws + WS_BIG), ap->o_bqkv + i * QKVD, (const float*)(ws + WS_CS), QSCALE, (const float*)(ws + WS_SSP), (LAS float*)(F.lds + TAB_OFF)};
                              pg8::gemm_phase2<pg8::EpiQKVT<64>, pg8::StaticOrder, false, false, true>(F.lds, g, S, E, nullptr); }
                          else { pg8::Gemm g{(const bf16*)(ws + WS_XN), (const bf16*)(ws + WS_WQKV), DM, 0}; pg8::StaticOrder S; S.init(NTOK, QKVD, G, cblk, WGM_QKV); pg8::EpiQKV E{(bf16*)(ws + WS_BIG), ap->o_bqkv + i * QKVD, (const float*)(ws + WS_CS), QSCALE, (const float*)(ws + WS_SSP), (LAS float*)(F.lds + TAB_OFF)};
                          pg8::gemm_phase<pg8::EpiQKV, pg8::StaticOrder, true, true>(F.lds, g, S, E); } } } SEAM(pb + 7);
        if (IN(pb + 8) && PHEN(10)) { PH_BEGIN(); for (int rep_ = 0; rep_ < DUP(10); ++rep_) { attn_mfma_phase(F, (const bf16*)(ws + WS_BIG), ap->o_sinks + i * 16, (bf16*)(ws + WS_BIG + WS_AOOFF)); } } SEAM(pb + 8);
        if (IN(pb + 9) && PHEN(11)) { PH_BEGIN(); pg8::Gemm g{(const bf16*)(ws + WS_BIG + WS_AOOFF), (const bf16*)(ws + WS_WO), DM, 0}; pg8::StaticOrder S; S.init(NTOK, DM, G, cblk, WGM_N1024); pg8::EpiResB<false> E{(bf16*)(ws + WS_XN), ap->o_bo + i * DM, nullptr, nullptr, 0};
                           pg8::gemm_phase<pg8::EpiResB<false>, pg8::StaticOrder, true, true>(F.lds, g, S, E); } SEAM(pb + 9);
        if (IN(pb + 10) && PHEN(12)) { PH_BEGIN(); rms_router_phase(F, (const bf16*)(ws + WS_XN), ap->o_n2 + i * DM, ap->o_rw + (size_t)i * DM * NEXP, (bf16*)(ws + WS_XG), (unsigned*)(ws + WS_CTL) + CW_CNT + 64 * i, (unsigned*)(ws + WS_TOKINFO), (int*)(ws + WS_ROWTOK), F8M(i) ? 1 : 0); } SEAM(pb + 10);
        if (IN(pb + 11) && PHEN(13)) { PH_BEGIN(); slots_phase(F, (const unsigned*)(ws + WS_CTL) + CW_CNT + 64 * i, (const unsigned*)(ws + WS_TOKINFO), (int*)(ws + WS_ROWTOK), (float*)(ws + WS_ROWGATE)); } SEAM(pb + 11);
#pragma unroll 1
        for (int s = 0; s < 2; ++s) {
            const int ps = pb + 12 + 2 * s;
            if (IN(ps + 0) && PHEN(14)) { PH_BEGIN(); for (int rep_ = 0; rep_ < DUP(14); ++rep_) {
                LAS unsigned short* tab = (LAS unsigned short*)(F.lds + TAB_OFF); LAS unsigned* ut = (LAS unsigned*)(F.lds + LDSCTL_OFF); int nun;
                { int pend[8]; moe_prefix((const unsigned*)(ws + WS_CTL) + CW_CNT + 64 * i + 8 * s, pend);
                  pg8::MoeOrder S; S.nM = pend[7]; S.nN = 2 * EXPD / 256; S.nwg = S.nM * S.nN; S.G = G; S.c = cblk; S.NT = F8M(i) ? DM / 128 : DM / 64; S.wgm = WGM_MOEGU; S.splitk = false; S.p0 = pend[0]; S.p1 = pend[1]; S.p2 = pend[2]; S.p3 = pend[3]; S.p4 = pend[4]; S.p5 = pend[5]; S.p6 = pend[6];
                  nun = 0; pg8::Unit u = {0, 0, 0, 0, 0, 0}; const int* rt = (const int*)(ws + WS_ROWTOK) + (size_t)s * SETROWS;
                  for (int r = 0; r < TAB_ROUNDS && S.next(r, u); ++r) { if (F.tid == 0) pg8::TabOrder::put(ut, r, u);
                      if (F.tid < 256) { const int tk = rt[(size_t)u.pm * 256 + F.tid]; tab[r * 256 + F.tid] = (unsigned short)(tk < 0 ? 0 : tk); } ++nun; } }
                __syncthreads();
                pg8::TabOrder T{ut, nun, 0};
                if (F8M(i)) {
                    pg8::Gemm g{(const bf16*)(ws + WS_XG), (const bf16*)(ws + WS_MGU), DM / 2, (size_t)2 * EXPD * DM}; pg8::EpiSwiGLU E{(bf16*)(ws + WS_BIG + (size_t)s * H1SET8), EXPD, nullptr, 1.0f / 64.0f, F8_H1SCALE};
                    pg8::gemm_phase2<pg8::EpiSwiGLU, pg8::TabOrder, true, false, true>(F.lds, g, T, E, tab, STAG_MOEGU); }
                else { pg8::Gemm g{(const bf16*)(ws + WS_XG), (const bf16*)(ws + WS_MGU), DM, (size_t)2 * EXPD * DM * 2}; pg8::EpiSwiGLU E{(bf16*)(ws + WS_BIG), EXPD, nullptr, 1.0f, 0.0f};
                    pg8::gemm_phase2<pg8::EpiSwiGLU, pg8::TabOrder, true>(F.lds, g, T, E, tab, STAG_MOEGU); }
                __syncthreads(); } } SEAM(ps + 0);
            if (IN(ps + 1) && PHEN(15)) { PH_BEGIN();
                LAS unsigned* ut = (LAS unsigned*)(F.lds + LDSCTL_OFF); int nun, nq;
                { int pend[8]; moe_prefix((const unsigned*)(ws + WS_CTL) + CW_CNT + 64 * i + 8 * s, pend);
                  pg8::MoeOrder S; S.nM = pend[7]; S.nN = DM / 256; S.nwg = S.nM * S.nN; S.G = G; S.c = cblk; S.NT = F8M(i) ? EXPD / 128 : EXPD / 64; S.wgm = WGM_N1024; S.splitk = !(s == 1 && i == 0);     S.p0 = pend[0]; S.p1 = pend[1]; S.p2 = pend[2]; S.p3 = pend[3]; S.p4 = pend[4]; S.p5 = pend[5]; S.p6 = pend[6];
                  nun = 0; nq = 0; pg8::Unit u = {0, 0, 0, 0, 0, 0}; for (int r = 0; r < 32 && S.next(r, u); ++r) { if (u.split) { if (F.tid == 0) pg8::TabOrder::put(ut + 64, nq, u); ++nq; } else { if (F.tid == 0) pg8::TabOrder::put(ut, nun, u); ++nun; } } }
                __syncthreads();
                const int normf = (s == 1 && i == 0) ? 1 : 0;
                LAS int* ltab = (LAS int*)(F.lds + TAB_OFF + (normf ? 4096 : 0));
                { const int* rt = (const int*)(ws + WS_ROWTOK) + (size_t)s * SETROWS; const int* rg = (const int*)(ws + WS_ROWGATE) + (size_t)s * SETROWS;
                  if (F.tid < 256) { for (int r = 0; r < nun + nq; ++r) { const int pm = (int)((r < nun ? ut[2 * r] : ut[64 + 2 * (r - nun)]) & 0xffffu);
                      ltab[r * 512 + F.tid] = rt[(size_t)pm * 256 + F.tid]; ltab[r * 512 + 256 + F.tid] = rg[(size_t)pm * 256 + F.tid]; } } }
                __syncthreads();
                pg8::TabOrder T{ut, nun, 0}, TQ{ut + 64, nq, nun};
                if (F8M(i)) {
                    pg8::Gemm g{(const bf16*)(ws + WS_BIG + (size_t)s * H1SET8), (const bf16*)(ws + WS_MD), EXPD / 2, (size_t)DM * EXPD};
                    pg8::EpiMoeDown E{ltab, (bf16*)(ws + WS_XN), (float*)(ws + WS_SSP), (LAS float*)(F.lds + TAB_OFF), normf, 1.0f / (64.0f * F8_H1SCALE)};
                    pg8::gemm_phase2<pg8::EpiMoeDown, pg8::TabOrder, false, false, true>(F.lds, g, T, E, nullptr); __syncthreads();
                    if (nq > 0) { pg8::gemm_phase2<pg8::EpiMoeDown, pg8::TabOrder, false, true, true>(F.lds, g, TQ, E, nullptr); __syncthreads(); } }
                else {
                pg8::Gemm g{(const bf16*)(ws + WS_BIG), (const bf16*)(ws + WS_MD), EXPD, (size_t)DM * EXPD * 2};
                pg8::EpiMoeDown E{ltab, (bf16*)(ws + WS_XN), (float*)(ws + WS_SSP), (LAS float*)(F.lds + TAB_OFF), normf, 1.0f};
                pg8::gemm_phase2<pg8::EpiMoeDown, pg8::TabOrder, false>(F.lds, g, T, E, nullptr); __syncthreads();
                if (nq > 0) { pg8::gemm_phase2<pg8::EpiMoeDown, pg8::TabOrder, false, true>(F.lds, g, TQ, E, nullptr); __syncthreads(); } } } if (!(s == 1 && i == 0) && !(s == 0 && F8M(i))) SEAM(ps + 1);
        }
    }
    if (IN(N_PHASES - 1) && PHEN(17)) { PH_BEGIN(); rms_final_phase(F, (const bf16*)(ws + WS_XN), ap->fng, ap->out); }
#undef IN
#undef SEAM
}

extern "C" void kernel_launch(void* const* d_in, const int* in_sizes, int n_in, void* d_out, int out_size, void* d_ws, size_t ws_size, hipStream_t stream) {
    static int grid = 0;
    if (grid == 0) {
        if (n_in != 26 || in_sizes[0] != NTOK * DM || out_size != NTOK * DM || ws_size < WS_END) { fprintf(stderr, "kernel_launch: unexpected shapes: n_in %d in0 %d out %d ws %zu (need %zu)\n", n_in, n_in > 0 ? in_sizes[0] : -1, out_size, ws_size, (size_t)WS_END); grid = -1; return; }
        int dev = 0, cus = 0, per_cu = 0;
        if (hipGetDevice(&dev) != hipSuccess || hipDeviceGetAttribute(&cus, hipDeviceAttributeMultiprocessorCount, dev) != hipSuccess) { grid = -1; return; }
        if (hipFuncSetAttribute((const void*)fwd, hipFuncAttributeMaxDynamicSharedMemorySize, LDS_BYTES) != hipSuccess) { fprintf(stderr, "kernel_launch: hipFuncSetAttribute failed\n"); grid = -1; return; }
        if (hipOccupancyMaxActiveBlocksPerMultiprocessor(&per_cu, (const void*)fwd, NWAVES * 64, LDS_BYTES) != hipSuccess || per_cu < 1) fprintf(stderr, "kernel_launch: occupancy query reports %d\n", per_cu);
        (void)hipGetLastError();
        grid = cus;
    }
    if (grid < 0) return;
    (void)hipMemsetAsync((char*)d_ws + WS_CTL, 0, CTL_ZERO_BYTES, stream);
    Args a{};
    a.x = (const float*)d_in[0]; a.pos = (const int*)d_in[1]; a.fng = (const float*)d_in[2];
    a.e_n1 = (const float*)d_in[3]; a.e_win = (const float*)d_in[4]; a.e_conv = (const float*)d_in[5]; a.e_lng = (const float*)d_in[6]; a.e_lnb = (const float*)d_in[7];
    a.e_sw = (const float*)d_in[8]; a.e_sb = (const float*)d_in[9]; a.e_wout = (const float*)d_in[10]; a.e_n2 = (const float*)d_in[11];
    a.e_wg = (const float*)d_in[12]; a.e_wu = (const float*)d_in[13]; a.e_wd = (const float*)d_in[14];
    a.o_n1 = (const float*)d_in[15]; a.o_wqkv = (const float*)d_in[16]; a.o_bqkv = (const float*)d_in[17]; a.o_sinks = (const float*)d_in[18]; a.o_wo = (const float*)d_in[19]; a.o_bo = (const float*)d_in[20];
    a.o_n2 = (const float*)d_in[21]; a.o_rw = (const float*)d_in[22]; a.o_ewg = (const float*)d_in[23]; a.o_ewu = (const float*)d_in[24]; a.o_ewd = (const float*)d_in[25];
    a.out = (float*)d_out; a.ws = (unsigned char*)d_ws;
#if MK_ONE_LAUNCH
    a.lo = 0; a.hi = N_PHASES; a.li = 0;
    hipLaunchKernelGGL(fwd, dim3(grid), dim3(NWAVES * 64), LDS_BYTES, stream, a);
#else
    for (int p = 0; p < N_PHASES; ++p) { a.lo = p; a.hi = p + 1; a.li = p; hipLaunchKernelGGL(fwd, dim3(grid), dim3(NWAVES * 64), LDS_BYTES, stream, a); }
#endif
}
```

```cpp
#include <type_traits>
#include <hip/hip_runtime.h>
#include <cstdio>
#include <cstdint>
#ifndef MK_ONE_LAUNCH
#define MK_ONE_LAUNCH 1
#endif
namespace pg8 {
#define PG8_LAS __attribute__((address_space(3)))
typedef unsigned short bf16_t;
typedef short bf16x8 __attribute__((ext_vector_type(8)));
typedef float f32x4 __attribute__((ext_vector_type(4)));
typedef unsigned u32x4 __attribute__((ext_vector_type(4)));
constexpr int BM = 256, BK = 64, HALF = 128, HTB = HALF * BK * 2  , STAGE_BYTES = 8 * HTB, NXCD = 8, WGM = 4;

__host__ __device__ __forceinline__ int lds_byte(int r, int c) { const int st = (r >> 4) * 2 + (c >> 5), rr = r & 15, cc = c & 31, ob = rr * 64 + cc * 2; return st * 1024 + (ob ^ (((ob >> 9) & 1) << 5)); }
__host__ __device__ __forceinline__ void stage_rc(int b, int& R, int& C) { const int st = b / 1024, sb = b % 1024, swz = sb ^ (((sb >> 9) & 1) << 5); R = (st >> 1) * 16 + swz / 64; C = (st & 1) * 32 + (swz % 64) / 2; }
__host__ __device__ __forceinline__ int perm32(int rho) { const int n = rho >> 4, i = rho & 15; return 8 * (i >> 2) + 4 * n + (i & 3); }

struct Unit { int pm, pn, e, kt0, nt, split, ui; };
struct Gemm { const bf16_t* A; const bf16_t* Bt; int K; size_t estride; };

struct StaticOrder {
    int nM, nN, nwg, G, c, wgm, NT;
    __host__ __device__ __forceinline__ void init(int M, int N, int G_, int c_, int wgm_ = WGM, int nt_ = 0) { nM = M / BM; nN = N / BM; nwg = nM * nN; G = G_; c = c_; wgm = wgm_; NT = nt_; }
    __host__ __device__ __forceinline__ bool next(int i, Unit& u) const {
        const long L = (long)i * G + c; if (L >= nwg) return false;
        int wgid = (int)L; { const int q = nwg / NXCD, r = nwg % NXCD, xcd = wgid % NXCD, off = wgid / NXCD; wgid = (xcd < r ? xcd * (q + 1) : r * (q + 1) + (xcd - r) * q) + off; }
        const int nig = wgm * nN, gid = wgid / nig, fm = gid * wgm, gsz = (nM - fm) < wgm ? (nM - fm) : wgm;
        u.pm = fm + ((wgid % nig) % gsz); u.pn = (wgid % nig) / gsz; u.e = 0; u.kt0 = 0; u.nt = NT; u.split = 0; u.ui = i; return true;
    }
};
struct MoeOrder {
    int nM, nN, nwg, G, c, NT, wgm; bool splitk; int p0, p1, p2, p3, p4, p5, p6;
    __device__ __forceinline__ bool next(int i, Unit& u) const {
        long L = (long)i * G + c; u.kt0 = 0; u.nt = NT; u.split = 0; u.ui = i;
        const int rfull = nwg / G, tail = nwg - rfull * G;
        if (splitk && tail > 0 && tail * 4 <= G) {
            if (i > rfull) return false;
            if (i == rfull) { if (c >= tail * 4) return false; L = (long)rfull * G + (c >> 2); u.split = 1 + (c & 3); }
        } else if (L >= nwg) return false;
        int wgid = (int)L; { const int q = nwg / NXCD, r = nwg % NXCD, xcd = wgid % NXCD, off = wgid / NXCD; wgid = (xcd < r ? xcd * (q + 1) : r * (q + 1) + (xcd - r) * q) + off; }
        const int nig = wgm * nN, gid = wgid / nig, fm = gid * wgm, gsz = (nM - fm) < wgm ? (nM - fm) : wgm;
        const unsigned inv = gsz == 1 ? 65536u : gsz == 2 ? 32768u : gsz == 3 ? 21846u : gsz == 4 ? 16384u : gsz == 5 ? 13108u : gsz == 6 ? 10923u : gsz == 7 ? 9363u : 8192u;
        const int x = wgid - gid * nig, xq = (int)(((unsigned)x * inv) >> 16);
        u.pm = fm + (x - xq * gsz); u.pn = xq;
        u.e = (u.pm >= p0) + (u.pm >= p1) + (u.pm >= p2) + (u.pm >= p3) + (u.pm >= p4) + (u.pm >= p5) + (u.pm >= p6); return true;
    }
};

struct TabOrder {
    const PG8_LAS unsigned* t; int n, base;
    __device__ __forceinline__ static void put(PG8_LAS unsigned* t, int i, const Unit& u) { t[2 * i] = (unsigned)u.pm | ((unsigned)u.pn << 16); t[2 * i + 1] = (unsigned)u.e | ((unsigned)u.kt0 << 8) | ((unsigned)u.nt << 16) | ((unsigned)u.split << 24); }
    __device__ __forceinline__ bool next(int i, Unit& u) const {
        if (i >= n) return false;
        const unsigned w0 = __builtin_amdgcn_readfirstlane(t[2 * i]), w1 = __builtin_amdgcn_readfirstlane(t[2 * i + 1]);
        u.pm = (int)(w0 & 0xffffu); u.pn = (int)(w0 >> 16); u.e = (int)(w1 & 0xffu); u.kt0 = (int)((w1 >> 8) & 0xffu); u.nt = (int)((w1 >> 16) & 0xffu); u.split = (int)(w1 >> 24); u.ui = i + base; return true;
    }
};

__device__ __forceinline__ unsigned cvt_pk_bf16(float lo, float hi) { unsigned r; asm volatile("v_cvt_pk_bf16_f32 %0, %1, %2" : "=v"(r) : "v"(lo), "v"(hi)); return r; }
__device__ __forceinline__ u32x4 pack8(const f32x4 v0, const f32x4 v1) { u32x4 w; w.x = cvt_pk_bf16(v0[0], v0[1]); w.y = cvt_pk_bf16(v0[2], v0[3]); w.z = cvt_pk_bf16(v1[0], v1[1]); w.w = cvt_pk_bf16(v1[2], v1[3]); return w; }

__device__ __forceinline__ float row_rstd(const float* ssp, int row) { const f32x4 q = *(const f32x4*)(ssp + (size_t)row * 4); return __builtin_amdgcn_rsqf(((q[0] + q[1]) + (q[2] + q[3])) * (1.0f / 1024.0f) + 1e-5f); }

struct RowPre { float q[2][4]; };
__device__ __forceinline__ RowPre row_prefetch(const float* ssp, int row0, int fq) { RowPre p;
#pragma unroll
    for (int ai = 0; ai < 2; ++ai)
#pragma unroll
        for (int m = 0; m < 4; ++m) p.q[ai][m] = ssp ? ssp[(size_t)(row0 + ai * HALF + m * 16) * 4 + fq] : 1024.0f;
    return p; }
__device__ __forceinline__ float pre_rstd(float q) { q += __shfl_xor(q, 16); q += __shfl_xor(q, 32); return __builtin_amdgcn_rsqf(q * (1.0f / 1024.0f) + 1e-5f); }
struct NoPre {};
template <class E, class = void> struct PreOf { typedef NoPre type;
    static __device__ __forceinline__ NoPre get(const E&, const Unit&, int, int, int, int) { return NoPre{}; }
    template <class A> static __device__ __forceinline__ void run(const E& e, const A& acc, const Unit& u, int wr, int wc, int fr, int fq, const NoPre&) { e(acc, u, wr, wc, fr, fq); } };
template <class E> struct PreOf<E, std::void_t<typename E::Pre>> { typedef typename E::Pre type;
    static __device__ __forceinline__ type get(const E& e, const Unit& u, int wr, int wc, int fr, int fq) { return e.prefetch(u, wr, wc, fr, fq); }
    template <class A> static __device__ __forceinline__ void run(const E& e, const A& acc, const Unit& u, int wr, int wc, int fr, int fq, const type& pre) { e(acc, u, wr, wc, fr, fq, pre); } };
struct EpiBf16Plain {
    static constexpr bool PERM = true; static constexpr int NVM = 16;
    bf16_t* O; int ldc; const float* ssp;
    __device__ __forceinline__ void operator()(const f32x4 (&acc)[2][2][4][2], const Unit& u, int wr, int wc, int fr, int fq) const {
        const int row0 = u.pm * BM + wr * 64 + fr, col0 = u.pn * BM + wc * 32 + 8 * fq;
        float rs[2][4];
#pragma unroll
        for (int ai = 0; ai < 2; ++ai)
#pragma unroll
            for (int m = 0; m < 4; ++m) rs[ai][m] = ssp ? row_rstd(ssp, row0 + ai * HALF + m * 16) : 1.0f;
#pragma unroll
        for (int ai = 0; ai < 2; ++ai)
#pragma unroll
            for (int m = 0; m < 4; ++m) { bf16_t* rowp = O + (size_t)(row0 + ai * HALF + m * 16) * ldc + col0;
#pragma unroll
                for (int bj = 0; bj < 2; ++bj) *(u32x4*)(rowp + bj * HALF) = pack8(acc[ai][bj][m][0] * rs[ai][m], acc[ai][bj][m][1] * rs[ai][m]); }
    }
};
template <int MODE> struct EpiProbe {
    static constexpr bool PERM = true; static constexpr int NVM = 0;
    bf16_t* O; int ldc;
    __device__ __forceinline__ void operator()(const f32x4 (&acc)[2][2][4][2], const Unit& u, int wr, int wc, int fr, int fq) const {
        const int row0 = u.pm * BM + wr * 64 + fr, col0 = (u.pn * BM) % ldc + wc * 32 + 8 * fq;
        if (MODE == 0) { f32x4 s = (f32x4){0.f, 0.f, 0.f, 0.f};
#pragma unroll
            for (int ai = 0; ai < 2; ++ai)
#pragma unroll
                for (int bj = 0; bj < 2; ++bj)
#pragma unroll
                    for (int m = 0; m < 4; ++m)
#pragma unroll
                        for (int n = 0; n < 2; ++n) s += acc[ai][bj][m][n];
            if (s[0] + s[1] + s[2] + s[3] == 12345.678f) O[row0] = 1; return; }
        unsigned chk = 0u;
#pragma unroll
        for (int ai = 0; ai < 2; ++ai)
#pragma unroll
            for (int m = 0; m < 4; ++m) { bf16_t* rowp = O + (size_t)(row0 + ai * HALF + m * 16) * ldc + col0;
#pragma unroll
                for (int bj = 0; bj < 2; ++bj) { const u32x4 w = pack8(acc[ai][bj][m][0], acc[ai][bj][m][1]);
                    if (MODE == 2 || MODE == 4 || (MODE == 5 && ai == 0)) *(u32x4*)(rowp + bj * HALF) = w; else if (MODE == 1 || MODE == 5) chk ^= (w.x + w.y) ^ (w.z + w.w);
                    if (MODE == 6) __builtin_nontemporal_store(w, (u32x4*)(rowp + bj * HALF));
                    if (MODE == 7 || MODE == 8) { const __amdgpu_buffer_rsrc_t rs = __builtin_amdgcn_make_buffer_rsrc((void*)O, 0, 0x7fffffff, 0x00020000);
                        __builtin_amdgcn_raw_buffer_store_b128(w, rs, (int)(((size_t)(row0 + ai * HALF + m * 16) * ldc + col0 + bj * HALF) * 2), 0, MODE == 7 ? 16 : 17); } } }
        if (MODE == 4) asm volatile("s_waitcnt vmcnt(0)" ::: "memory");
        if (MODE == 5 && chk == 0x9e3779b9u) O[row0] = 1;
        if (MODE == 1 && chk == 0x9e3779b9u) O[row0] = 1;
        if (MODE == 9) {
            const int lane = fq * 16 + fr, wid = wr * 4 + wc;
#pragma unroll
            for (int ai = 0; ai < 2; ++ai)
#pragma unroll
                for (int m = 0; m < 4; ++m)
#pragma unroll
                    for (int bj = 0; bj < 2; ++bj) { const u32x4 w = pack8(acc[ai][bj][m][0], acc[ai][bj][m][1]);
                        *(u32x4*)(O + (size_t)(u.pm * BM + wid * 32 + (ai * 8 + m * 2 + bj) * 2 + (lane >> 5)) * ldc + (u.pn * BM) % ldc + (lane & 31) * 8) = w; }
        }
        if (MODE == 3) {
            const int lane = fq * 16 + fr;
#pragma unroll
            for (int ai = 0; ai < 2; ++ai)
#pragma unroll
                for (int m = 0; m < 4; ++m)
#pragma unroll
                    for (int bj = 0; bj < 2; ++bj) { const u32x4 w = pack8(acc[ai][bj][m][0], acc[ai][bj][m][1]);
                        *(u32x4*)(O + (size_t)(u.pm * BM + ai * HALF + wr * 64 + m * 16 + 8 * bj + (lane >> 3)) * ldc + (u.pn * BM) % ldc + wc * 64 + (lane & 7) * 8) = w; }
        }
    }
};
struct EpiMixIn {
    static constexpr bool PERM = true; static constexpr int NVM = 16;
    bf16_t* O; const float* ssp;
    typedef RowPre Pre;
    __device__ __forceinline__ Pre prefetch(const Unit& u, int wr, int wc, int fr, int fq) const { return row_prefetch(ssp, u.pm * BM + wr * 64 + fr, fq); }
    __device__ __forceinline__ void operator()(const f32x4 (&acc)[2][2][4][2], const Unit& u, int wr, int wc, int fr, int fq, const Pre& pre) const {
        const int row0 = u.pm * BM + wr * 64 + fr;
        float rs[2][4];
#pragma unroll
        for (int ai = 0; ai < 2; ++ai)
#pragma unroll
            for (int m = 0; m < 4; ++m) rs[ai][m] = ssp ? pre_rstd(pre.q[ai][m]) : 1.0f;
        const bool paired = (u.pn >= 2) && (u.pn < 6);
        if (paired) {
            const int col0 = 512 + (u.pn - 2) * HALF + wc * 32 + 8 * fq;
#pragma unroll
            for (int ai = 0; ai < 2; ++ai)
#pragma unroll
                for (int m = 0; m < 4; ++m) { const float r2 = rs[ai][m] * rs[ai][m];
                    *(u32x4*)(O + (size_t)(row0 + ai * HALF + m * 16) * 2048 + col0) = pack8(acc[ai][0][m][0] * acc[ai][1][m][0] * r2, acc[ai][0][m][1] * acc[ai][1][m][1] * r2); }
        } else {
            const int col0 = (u.pn < 2 ? u.pn * BM : 1024 + (u.pn - 6) * BM) + wc * 32 + 8 * fq;
#pragma unroll
            for (int ai = 0; ai < 2; ++ai)
#pragma unroll
                for (int m = 0; m < 4; ++m) { bf16_t* rowp = O + (size_t)(row0 + ai * HALF + m * 16) * 2048 + col0;
#pragma unroll
                    for (int bj = 0; bj < 2; ++bj) *(u32x4*)(rowp + bj * HALF) = pack8(acc[ai][bj][m][0] * rs[ai][m], acc[ai][bj][m][1] * rs[ai][m]); }
        }
    }
};
typedef float f32x2 __attribute__((ext_vector_type(2)));
__device__ __forceinline__ f32x2 silu_mul2(f32x2 g, f32x2 u) {
    f32x2 e; e.x = __builtin_amdgcn_exp2f(-g.x); e.y = __builtin_amdgcn_exp2f(-g.y);
    const f32x2 d = e + 1.0f; f32x2 r; r.x = __builtin_amdgcn_rcpf(d.x); r.y = __builtin_amdgcn_rcpf(d.y);
    return (g * u) * r;
}
typedef unsigned u32x2 __attribute__((ext_vector_type(2)));
struct EpiSwiGLU {
    static constexpr bool PERM = true; static constexpr int NVM = 8;
    bf16_t* O; int ldc; const float* ssp; float escale; float o8scale;
    typedef RowPre Pre;
    __device__ __forceinline__ Pre prefetch(const Unit& u, int wr, int wc, int fr, int fq) const { return row_prefetch(ssp, u.pm * BM + wr * 64 + fr, fq); }
    __device__ __forceinline__ void operator()(const f32x4 (&acc)[2][2][4][2], const Unit& u, int wr, int wc, int fr, int fq, const Pre& pre) const {
        if (escale != 1.0f) asm volatile("s_nop 15\n\ts_nop 7" ::: "memory");
        const int row0 = u.pm * BM + wr * 64 + fr, col0 = u.pn * HALF + wc * 32 + 8 * fq;
        float rs[2][4];
#pragma unroll
        for (int ai = 0; ai < 2; ++ai)
#pragma unroll
            for (int m = 0; m < 4; ++m) { rs[ai][m] = escale;
                if (ssp) rs[ai][m] = escale * pre_rstd(pre.q[ai][m]); }
#pragma unroll
        for (int ai = 0; ai < 2; ++ai)
#pragma unroll
            for (int m = 0; m < 4; ++m) { bf16_t* rowp = O + (size_t)(row0 + ai * HALF + m * 16) * ldc + col0; const float r = rs[ai][m];
                const float ru = (o8scale != 0.0f) ? r * o8scale : r;
                const f32x4 g0 = acc[ai][0][m][0] * r, g1 = acc[ai][0][m][1] * r, u0 = acc[ai][1][m][0] * ru, u1 = acc[ai][1][m][1] * ru;
                const f32x2 a = silu_mul2((f32x2){g0[0], g0[1]}, (f32x2){u0[0], u0[1]}), b = silu_mul2((f32x2){g0[2], g0[3]}, (f32x2){u0[2], u0[3]});
                const f32x2 c = silu_mul2((f32x2){g1[0], g1[1]}, (f32x2){u1[0], u1[1]}), d = silu_mul2((f32x2){g1[2], g1[3]}, (f32x2){u1[2], u1[3]});
                if (o8scale != 0.0f) { unsigned w0 = 0u, w1 = 0u;
#define PG8_C8(v) (v)
                    w0 = __builtin_amdgcn_cvt_pk_fp8_f32(PG8_C8(a.x), PG8_C8(a.y), w0, false); w0 = __builtin_amdgcn_cvt_pk_fp8_f32(PG8_C8(b.x), PG8_C8(b.y), w0, true);
                    w1 = __builtin_amdgcn_cvt_pk_fp8_f32(PG8_C8(c.x), PG8_C8(c.y), w1, false); w1 = __builtin_amdgcn_cvt_pk_fp8_f32(PG8_C8(d.x), PG8_C8(d.y), w1, true);
#undef PG8_C8
                    u32x2 w8; w8.x = w0; w8.y = w1; *(u32x2*)((unsigned char*)O + (size_t)(row0 + ai * HALF + m * 16) * ldc + col0) = w8; continue; }
                u32x4 w; w.x = cvt_pk_bf16(a.x, a.y); w.y = cvt_pk_bf16(b.x, b.y); w.z = cvt_pk_bf16(c.x, c.y); w.w = cvt_pk_bf16(d.x, d.y);
                *(u32x4*)rowp = w; }
    }
};
struct EpiResF32 {
    static constexpr bool PERM = false; static constexpr int NVM = 64;
    const float* base; float* out; int ldc; const float* bias;
    __device__ __forceinline__ void operator()(const f32x4 (&acc)[2][2][4][2], const Unit& u, int wr, int wc, int fr, int fq) const {
        const int row0 = u.pm * BM + wr * 64 + fr, col0 = u.pn * BM + wc * 32 + 4 * fq;
        f32x4 bv[2][2];
#pragma unroll
        for (int bj = 0; bj < 2; ++bj)
#pragma unroll
            for (int n = 0; n < 2; ++n) bv[bj][n] = bias ? *(const f32x4*)(bias + col0 + bj * HALF + n * 16) : (f32x4){0.f, 0.f, 0.f, 0.f};
#pragma unroll
        for (int ai = 0; ai < 2; ++ai) {
            f32x4 b[4][2][2];
#pragma unroll
            for (int m = 0; m < 4; ++m) { const size_t off = (size_t)(row0 + ai * HALF + m * 16) * ldc + col0;
#pragma unroll
                for (int bj = 0; bj < 2; ++bj)
#pragma unroll
                    for (int n = 0; n < 2; ++n) b[m][bj][n] = *(const f32x4*)(base + off + bj * HALF + n * 16); }
            asm volatile("" ::: "memory");
#pragma unroll
            for (int m = 0; m < 4; ++m) { const size_t off = (size_t)(row0 + ai * HALF + m * 16) * ldc + col0;
#pragma unroll
                for (int bj = 0; bj < 2; ++bj)
#pragma unroll
                    for (int n = 0; n < 2; ++n) *(f32x4*)(out + off + bj * HALF + n * 16) = b[m][bj][n] + acc[ai][bj][m][n] + bv[bj][n]; }
            asm volatile("" ::: "memory");
        }
    }
};

struct EpiResNorm {
    static constexpr bool PERM = false; static constexpr int NVM = 96;
    const float* base; float* out; int ldc; const float* bias; bf16_t* xn; float* ssp; PG8_LAS float* red;
    __device__ __forceinline__ void operator()(const f32x4 (&acc)[2][2][4][2], const Unit& u, int wr, int wc, int fr, int fq) const {
        const int row0 = u.pm * BM + wr * 64 + fr, col0 = u.pn * BM + wc * 32 + 4 * fq;
        f32x4 bv[2][2];
#pragma unroll
        for (int bj = 0; bj < 2; ++bj)
#pragma unroll
            for (int n = 0; n < 2; ++n) bv[bj][n] = bias ? *(const f32x4*)(bias + col0 + bj * HALF + n * 16) : (f32x4){0.f, 0.f, 0.f, 0.f};
        float sq[2][4];
#pragma unroll
        for (int ai = 0; ai < 2; ++ai) {
            f32x4 b[4][2][2];
#pragma unroll
            for (int m = 0; m < 4; ++m) { const size_t off = (size_t)(row0 + ai * HALF + m * 16) * ldc + col0;
#pragma unroll
                for (int bj = 0; bj < 2; ++bj)
#pragma unroll
                    for (int n = 0; n < 2; ++n) b[m][bj][n] = *(const f32x4*)(base + off + bj * HALF + n * 16); }
            asm volatile("" ::: "memory");
#pragma unroll
            for (int m = 0; m < 4; ++m) { const size_t off = (size_t)(row0 + ai * HALF + m * 16) * ldc + col0; float s = 0.f;
#pragma unroll
                for (int bj = 0; bj < 2; ++bj)
#pragma unroll
                    for (int n = 0; n < 2; ++n) { const f32x4 v = b[m][bj][n] + acc[ai][bj][m][n] + bv[bj][n]; *(f32x4*)(out + off + bj * HALF + n * 16) = v;
                        s += (v[0] * v[0] + v[1] * v[1]) + (v[2] * v[2] + v[3] * v[3]);
                        u32x2 w; w.x = cvt_pk_bf16(v[0], v[1]); w.y = cvt_pk_bf16(v[2], v[3]); *(u32x2*)(xn + off + bj * HALF + n * 16) = w; }
                sq[ai][m] = s; }
            asm volatile("" ::: "memory");
        }
#pragma unroll
        for (int ai = 0; ai < 2; ++ai)
#pragma unroll
            for (int m = 0; m < 4; ++m) { float s = sq[ai][m]; s += __shfl_xor(s, 16); s += __shfl_xor(s, 32); if (fq == 0) red[(ai * HALF + wr * 64 + m * 16 + fr) * 4 + wc] = s; }
        asm volatile("s_waitcnt lgkmcnt(0)" ::: "memory"); __builtin_amdgcn_s_barrier(); asm volatile("" ::: "memory");
        const int tid = (wr * 4 + wc) * 64 + fq * 16 + fr;
        if (tid < 256) { const f32x4 r = *(const PG8_LAS f32x4*)(red + tid * 4); ssp[(size_t)(u.pm * BM + tid) * 4 + u.pn] = (r[0] + r[1]) + (r[2] + r[3]); }
    }
};
template <int ADIV = 1> struct EpiQKVT {
    static constexpr bool PERM = true; static constexpr int NVM = 26;
    bf16_t* O; const float* bias; const float* cs; float qscale; const float* ssp; PG8_LAS float* stg;
    typedef RowPre Pre;
    __device__ __forceinline__ Pre prefetch(const Unit& u, int wr, int wc, int fr, int fq) const { return row_prefetch(ssp, u.pm * BM + wr * 64 + fr, fq); }
    __device__ __forceinline__ void operator()(const f32x4 (&acc)[2][2][4][2], const Unit& u, int wr, int wc, int fr, int fq, const Pre& pre) const {
        if constexpr (ADIV != 1) asm volatile("s_nop 15\n\ts_nop 7" ::: "memory");
        const int row0 = u.pm * BM + wr * 64 + fr, colt = u.pn * BM, col0 = colt + wc * 32 + 8 * fq;
        const bool ropew = ((wc & 1) == 0);
        const int tid = (wr * 4 + wc) * 64 + fq * 16 + fr;
        const f32x4 t0 = *(const f32x4*)(cs + (size_t)(u.pm * BM + (tid >> 2)) * 16 + (tid & 3) * 4), t1 = *(const f32x4*)(cs + (size_t)(u.pm * BM + HALF + (tid >> 2)) * 16 + (tid & 3) * 4);
        f32x4 bv[2][2];
#pragma unroll
        for (int bj = 0; bj < 2; ++bj)
#pragma unroll
            for (int n = 0; n < 2; ++n) bv[bj][n] = *(const f32x4*)(bias + col0 + bj * HALF + 4 * n);
        float rsr[2][4];
#pragma unroll
        for (int ai = 0; ai < 2; ++ai)
#pragma unroll
            for (int m = 0; m < 4; ++m) rsr[ai][m] = pre_rstd(pre.q[ai][m]) * (1.0f / (float)ADIV);
        const float sgn = (fq == 0) ? -1.f : 1.f;
#pragma unroll
        for (int ai = 0; ai < 2; ++ai) {
            if (ai) { asm volatile("s_waitcnt lgkmcnt(0)" ::: "memory"); __builtin_amdgcn_s_barrier(); }
            *(PG8_LAS f32x4*)(stg + (tid >> 2) * 20 + (tid & 3) * 4) = ai ? t1 : t0;
            asm volatile("s_waitcnt lgkmcnt(0)" ::: "memory"); __builtin_amdgcn_s_barrier(); asm volatile("" ::: "memory");
#pragma unroll
            for (int m = 0; m < 4; ++m) { const int row = row0 + ai * HALF + m * 16; bf16_t* rowp = O + (size_t)row * 1280 + col0;
                f32x4 c0 = (f32x4){1.f, 1.f, 1.f, 1.f}, c1 = c0, s0 = (f32x4){0.f, 0.f, 0.f, 0.f}, s1 = s0;
                if (ropew && fq < 2) { const PG8_LAS f32x4* cp = (const PG8_LAS f32x4*)(stg + (wr * 64 + m * 16 + fr) * 20); c0 = cp[0]; c1 = cp[1]; s0 = cp[2] * sgn; s1 = cp[3] * sgn; }
                const float rs = rsr[ai][m];
#pragma unroll
                for (int bj = 0; bj < 2; ++bj) { f32x4 v0 = acc[ai][bj][m][0] * rs + bv[bj][0], v1 = acc[ai][bj][m][1] * rs + bv[bj][1];
                    const int gc = colt + bj * HALF;
                    if (ropew && gc < 1152) { f32x4 p0, p1;
#pragma unroll
                        for (int j = 0; j < 4; ++j) { p0[j] = __shfl_xor(v0[j], 16); p1[j] = __shfl_xor(v1[j], 16); }
                        v0 = v0 * c0 + p0 * s0; v1 = v1 * c1 + p1 * s1; }
                    if (gc < 1024) { v0 = v0 * qscale; v1 = v1 * qscale; }
                    *(u32x4*)(rowp + bj * HALF) = pack8(v0, v1); }
                if (m & 1) asm volatile("" ::: "memory"); }
        }
        asm volatile("s_waitcnt lgkmcnt(0)" ::: "memory"); __builtin_amdgcn_s_barrier();
    }
};
typedef EpiQKVT<1> EpiQKV;
__device__ __forceinline__ void unpack8v(const u32x4 w, f32x4& a, f32x4& b) {
    a[0] = __uint_as_float(w.x << 16); a[1] = __uint_as_float(w.x & 0xffff0000u); a[2] = __uint_as_float(w.y << 16); a[3] = __uint_as_float(w.y & 0xffff0000u);
    b[0] = __uint_as_float(w.z << 16); b[1] = __uint_as_float(w.z & 0xffff0000u); b[2] = __uint_as_float(w.w << 16); b[3] = __uint_as_float(w.w & 0xffff0000u);
}
template <bool ONE_BATCH, int ADIV = 1, long H8OFF = 0> struct EpiResB {
    static constexpr bool PERM = true; static constexpr int NVM = 32;
    bf16_t* hb; const float* bias; float* ssp; PG8_LAS float* red; int norm;
    __device__ __forceinline__ void operator()(const f32x4 (&acc)[2][2][4][2], const Unit& u, int wr, int wc, int fr, int fq) const {
        constexpr float ascale = 1.0f / (float)ADIV;
        if constexpr (ADIV != 1) asm volatile("s_nop 15\n\ts_nop 7" ::: "memory");
        const int row0 = u.pm * BM + wr * 64 + fr, col0 = u.pn * BM + wc * 32 + 8 * fq;
        f32x4 bv[2][2];
#pragma unroll
        for (int bj = 0; bj < 2; ++bj)
#pragma unroll
            for (int n = 0; n < 2; ++n) bv[bj][n] = bias ? *(const f32x4*)(bias + col0 + bj * HALF + 4 * n) : (f32x4){0.f, 0.f, 0.f, 0.f};
        float sq[2][4];
        u32x4 b[2][4][2];
        if constexpr (ONE_BATCH) {
#pragma unroll
            for (int ai = 0; ai < 2; ++ai)
#pragma unroll
                for (int m = 0; m < 4; ++m)
#pragma unroll
                    for (int bj = 0; bj < 2; ++bj) b[ai][m][bj] = *(const u32x4*)(hb + (size_t)(row0 + ai * HALF + m * 16) * 1024 + col0 + bj * HALF);
            asm volatile("" ::: "memory");
        }
#pragma unroll
        for (int ai = 0; ai < 2; ++ai) {
            if constexpr (!ONE_BATCH) {
#pragma unroll
                for (int m = 0; m < 4; ++m)
#pragma unroll
                    for (int bj = 0; bj < 2; ++bj) b[ai][m][bj] = *(const u32x4*)(hb + (size_t)(row0 + ai * HALF + m * 16) * 1024 + col0 + bj * HALF);
                asm volatile("" ::: "memory");
            }
#pragma unroll
            for (int m = 0; m < 4; ++m) { float s = 0.f;
#pragma unroll
                for (int bj = 0; bj < 2; ++bj) { f32x4 h0, h1; unpack8v(b[ai][m][bj], h0, h1);
                    f32x4 v0, v1; if constexpr (ADIV != 1) { v0 = h0 + acc[ai][bj][m][0] * ascale + bv[bj][0]; v1 = h1 + acc[ai][bj][m][1] * ascale + bv[bj][1]; } else { v0 = h0 + acc[ai][bj][m][0] + bv[bj][0]; v1 = h1 + acc[ai][bj][m][1] + bv[bj][1]; }
                    s += ((v0[0] * v0[0] + v0[1] * v0[1]) + (v0[2] * v0[2] + v0[3] * v0[3])) + ((v1[0] * v1[0] + v1[1] * v1[1]) + (v1[2] * v1[2] + v1[3] * v1[3]));
                    *(u32x4*)(hb + (size_t)(row0 + ai * HALF + m * 16) * 1024 + col0 + bj * HALF) = pack8(v0, v1);
                    if constexpr (H8OFF != 0) { unsigned w0 = 0u, w1 = 0u;
#define PG8_C8(v) (v)
                        w0 = __builtin_amdgcn_cvt_pk_fp8_f32(PG8_C8(v0[0]), PG8_C8(v0[1]), w0, false); w0 = __builtin_amdgcn_cvt_pk_fp8_f32(PG8_C8(v0[2]), PG8_C8(v0[3]), w0, true);
                        w1 = __builtin_amdgcn_cvt_pk_fp8_f32(PG8_C8(v1[0]), PG8_C8(v1[1]), w1, false); w1 = __builtin_amdgcn_cvt_pk_fp8_f32(PG8_C8(v1[2]), PG8_C8(v1[3]), w1, true);
#undef PG8_C8
                        u32x2 w8; w8.x = w0; w8.y = w1; *(u32x2*)((unsigned char*)hb + H8OFF + (size_t)(row0 + ai * HALF + m * 16) * 1024 + col0 + bj * HALF) = w8; } }
                sq[ai][m] = s; }
            asm volatile("" ::: "memory");
        }
        if (norm) {
#pragma unroll
            for (int ai = 0; ai < 2; ++ai)
#pragma unroll
                for (int m = 0; m < 4; ++m) { float s = sq[ai][m]; s += __shfl_xor(s, 16); s += __shfl_xor(s, 32); if (fq == 0) red[(ai * HALF + wr * 64 + m * 16 + fr) * 4 + wc] = s; }
            asm volatile("s_waitcnt lgkmcnt(0)" ::: "memory"); __builtin_amdgcn_s_barrier(); asm volatile("" ::: "memory");
            const int tid = (wr * 4 + wc) * 64 + fq * 16 + fr;
            if (tid < 256) { const f32x4 r = *(const PG8_LAS f32x4*)(red + tid * 4); ssp[(size_t)(u.pm * BM + tid) * 4 + u.pn] = (r[0] + r[1]) + (r[2] + r[3]); }
        }
    }
};
struct EpiMoeDown {
    static constexpr bool PERM = true; static constexpr int NVM = 8;
    const PG8_LAS int* ltab; bf16_t* hb; float* ssp; PG8_LAS float* red; int norm; float gscale;
    __device__ __forceinline__ void operator()(const f32x4 (&acc)[2][2][4][2], const Unit& u, int wr, int wc, int fr, int fq) const {
        if (gscale != 1.0f) asm volatile("s_nop 15\n\ts_nop 7" ::: "memory");
        const int col0 = u.pn * BM + wc * 32 + 8 * fq;
        const int qa = (u.split - 1) >> 1, qb = (u.split - 1) & 1;
        float sq[2][4];
        int tok[2][4]; float gate[2][4]; u32x4 b[2][4][2];
#pragma unroll
        for (int ai = 0; ai < 2; ++ai)
#pragma unroll
            for (int m = 0; m < 4; ++m) { const int lrow = ai * HALF + wr * 64 + m * 16 + fr; tok[ai][m] = ltab[u.ui * 512 + lrow]; gate[ai][m] = __int_as_float(ltab[u.ui * 512 + 256 + lrow]) * gscale; sq[ai][m] = 0.f; }
#pragma unroll
        for (int ai = 0; ai < 2; ++ai) { if (u.split && ai != qa) continue;
#pragma unroll
            for (int m = 0; m < 4; ++m)
#pragma unroll
                for (int bj = 0; bj < 2; ++bj) b[ai][m][bj] = *(const u32x4*)(hb + (size_t)(tok[ai][m] < 0 ? 0 : tok[ai][m]) * 1024 + col0 + bj * HALF); }
        asm volatile("" ::: "memory");
#pragma unroll
        for (int ai = 0; ai < 2; ++ai) { if (u.split && ai != qa) continue;
#pragma unroll
            for (int m = 0; m < 4; ++m) { if (tok[ai][m] >= 0) {
#pragma unroll
                for (int bj = 0; bj < 2; ++bj) { if (u.split && bj != qb) continue;
                    f32x4 h0, h1; unpack8v(b[ai][m][bj], h0, h1);
                    const f32x4 v0 = h0 + acc[ai][bj][m][0] * gate[ai][m], v1 = h1 + acc[ai][bj][m][1] * gate[ai][m];
                    sq[ai][m] += ((v0[0] * v0[0] + v0[1] * v0[1]) + (v0[2] * v0[2] + v0[3] * v0[3])) + ((v1[0] * v1[0] + v1[1] * v1[1]) + (v1[2] * v1[2] + v1[3] * v1[3]));
                    *(u32x4*)(hb + (size_t)tok[ai][m] * 1024 + col0 + bj * HALF) = pack8(v0, v1); } } }
            asm volatile("" ::: "memory");
        }
        if (norm) {
#pragma unroll
            for (int ai = 0; ai < 2; ++ai)
#pragma unroll
                for (int m = 0; m < 4; ++m) { float s = sq[ai][m]; s += __shfl_xor(s, 16); s += __shfl_xor(s, 32); if (fq == 0) red[(ai * HALF + wr * 64 + m * 16 + fr) * 4 + wc] = s; }
            asm volatile("s_waitcnt lgkmcnt(0)" ::: "memory"); __builtin_amdgcn_s_barrier(); asm volatile("" ::: "memory");
            const int tid = (wr * 4 + wc) * 64 + fq * 16 + fr;
            if (tid < 256) { const int tk = ltab[u.ui * 512 + tid]; const f32x4 r = *(const PG8_LAS f32x4*)(red + tid * 4); if (tk >= 0) ssp[(size_t)tk * 4 + u.pn] = (r[0] + r[1]) + (r[2] + r[3]); }
        }
    }
};

template <class Epi, class Sched, bool ALIGN_EPI = false, bool SP2 = false>
__device__ __forceinline__ void gemm_phase(PG8_LAS unsigned char* lds, const Gemm g, const Sched& S, const Epi& E, int stag_ticks = 0) {
    if (stag_ticks > 0) {
        const unsigned long long t_end = __builtin_amdgcn_s_memrealtime() + (((unsigned long long)blockIdx.x * (unsigned)stag_ticks) >> 8);
        while (__builtin_amdgcn_s_memrealtime() < t_end) __builtin_amdgcn_s_sleep(4);
    }
    int tid_ = threadIdx.x; asm volatile("" : "+v"(tid_));
    const int tid = tid_, wid = __builtin_amdgcn_readfirstlane(tid >> 6), lane = tid & 63, wr = wid >> 2, wc = wid & 3, fr = lane & 15, fq = lane >> 4;
    const int K = g.K, nt = K / BK;
    constexpr int EPI_S = Epi::NVM < 48 ? Epi::NVM : 48;
    unsigned voffA[2], voffB[2];
#pragma unroll
    for (int i = 0; i < 2; ++i) { int R, C; stage_rc(tid * 16 + i * 8192, R, C); const int Rb = Epi::PERM ? ((R & ~31) + perm32(R & 31)) : R;
        voffA[i] = (unsigned)(R * K + C) * 2u; voffB[i] = (unsigned)(Rb * K + C) * 2u; }
    const size_t kstep = (size_t)(BK * 2);
    const size_t hstep = (size_t)HALF * K * 2;
    const size_t tstep = 2 * hstep;
    const unsigned ldsw = (unsigned)wid * 1024u;
    const int aoff = lds_byte(wr * 64 + fr, fq * 8), boff = lds_byte(wc * 32 + fr, fq * 8);
#define PG8_SA(b, h) (((b) * 2 + (h)) * HTB)
#define PG8_SB(b, h) ((4 + (b) * 2 + (h)) * HTB)
#define PG8_STAGE(bufoff, gbase, voff) do { _Pragma("unroll") for (int _i = 0; _i < 2; ++_i) \
        __builtin_amdgcn_global_load_lds((const unsigned*)((const char*)(gbase) + (voff)[_i]), (PG8_LAS unsigned*)(lds + (bufoff) + ldsw + _i * 8192), 16, 0, 0); } while (0)
#define PG8_LDA(dst, b, h) do { _Pragma("unroll") for (int m = 0; m < 4; ++m) _Pragma("unroll") for (int k = 0; k < 2; ++k) dst[m][k] = *(const PG8_LAS bf16x8*)(lds + PG8_SA(b, h) + aoff + m * 2048 + k * 1024); } while (0)
#define PG8_LDB(dst, b, h) do { _Pragma("unroll") for (int n = 0; n < 2; ++n) _Pragma("unroll") for (int k = 0; k < 2; ++k) dst[n][k] = *(const PG8_LAS bf16x8*)(lds + PG8_SB(b, h) + boff + n * 2048 + k * 1024); } while (0)
#define PG8_MMA(ai, bj, At, Bt) do { __builtin_amdgcn_s_setprio(1); _Pragma("unroll") for (int m = 0; m < 4; ++m) _Pragma("unroll") for (int n = 0; n < 2; ++n) _Pragma("unroll") for (int k = 0; k < 2; ++k) \
        acc[ai][bj][m][n] = __builtin_amdgcn_mfma_f32_16x16x32_bf16(Bt[n][k], At[m][k], acc[ai][bj][m][n], 0, 0, 0); __builtin_amdgcn_s_setprio(0); } while (0)
#define PG8_WAIT_V(n) asm volatile("s_waitcnt vmcnt(" #n ")" ::: "memory")
#define PG8_WAIT_V8R(rx) do { if (rx) asm volatile("s_waitcnt vmcnt(%0)" :: "n"(8 + EPI_S) : "memory"); else PG8_WAIT_V(8); } while (0)
#define PG8_WAIT_L(n) asm volatile("s_waitcnt lgkmcnt(" #n ")" ::: "memory")
#define PG8_BAR __builtin_amdgcn_s_barrier()
#define PG8_SCHED __builtin_amdgcn_sched_barrier(0)
    Unit cur, nxt; int ui = 0;
    if (!S.next(0, cur)) return;
    typename PreOf<Epi>::type pre = PreOf<Epi>::get(E, cur, wr, wc, fr, fq);
    f32x4 acc[2][2][4][2];
#pragma unroll
    for (int a = 0; a < 2; ++a)
#pragma unroll
        for (int b = 0; b < 2; ++b)
#pragma unroll
            for (int m = 0; m < 4; ++m)
#pragma unroll
                for (int n = 0; n < 2; ++n) acc[a][b][m][n] = (f32x4){0.f, 0.f, 0.f, 0.f};
    bf16x8 At[4][2], B0[2][2], B1[2][2];
    const char* cA = (const char*)g.A + (size_t)cur.pm * tstep; const char* cB = (const char*)g.Bt + (size_t)cur.e * g.estride + (size_t)cur.pn * tstep;
    if constexpr (SP2) {
        PG8_STAGE(PG8_SB(0, 0), cB, voffB); PG8_STAGE(PG8_SB(0, 1), cB + hstep, voffB); PG8_STAGE(PG8_SA(0, 0), cA, voffA); PG8_STAGE(PG8_SA(0, 1), cA + hstep, voffA);
        if (wr == 1) PG8_BAR;
        PG8_WAIT_V(2); PG8_BAR;
        PG8_STAGE(PG8_SB(1, 0), cB + kstep, voffB); PG8_STAGE(PG8_SA(1, 0), cA + kstep, voffA); PG8_STAGE(PG8_SB(1, 1), cB + hstep + kstep, voffB);
        PG8_WAIT_V(6); PG8_BAR;
    } else {
        PG8_STAGE(PG8_SB(0, 0), cB, voffB); PG8_STAGE(PG8_SA(0, 0), cA, voffA); PG8_STAGE(PG8_SB(0, 1), cB + hstep, voffB); PG8_STAGE(PG8_SA(0, 1), cA + hstep, voffA);
        if (wr == 1) PG8_BAR;
        PG8_WAIT_V(4); PG8_BAR;
        PG8_STAGE(PG8_SB(1, 0), cB + kstep, voffB); PG8_STAGE(PG8_SA(1, 0), cA + kstep, voffA); PG8_STAGE(PG8_SB(1, 1), cB + hstep + kstep, voffB);
        PG8_WAIT_V(6); PG8_BAR;
    }
    for (;;) {
        const bool has_next = S.next(ui + 1, nxt);
        const char* nA = has_next ? (const char*)g.A + (size_t)nxt.pm * tstep : cA; const char* nB = has_next ? (const char*)g.Bt + (size_t)nxt.e * g.estride + (size_t)nxt.pn * tstep : cB;
        for (int t = 0; t < nt; t += 2) {
            const bool last = (t == nt - 2);
            const char* a1 = cA + (size_t)(t + 1) * kstep;
            const char* a2 = last ? nA : cA + (size_t)(t + 2) * kstep; const char* b2 = last ? nB : cB + (size_t)(t + 2) * kstep;
            const char* a3 = a2 + kstep; const char* b3 = b2 + kstep;
            if constexpr (SP2) {
            PG8_LDB(B0, 0, 0); PG8_LDB(B1, 0, 1); PG8_SCHED; PG8_LDA(At, 0, 0); PG8_STAGE(PG8_SA(1, 1), a1 + hstep, voffA);
            PG8_WAIT_V(8); PG8_WAIT_L(0); PG8_BAR; PG8_MMA(0, 0, At, B0); PG8_MMA(0, 1, At, B1); PG8_BAR; PG8_SCHED;
            PG8_LDA(At, 0, 1); PG8_STAGE(PG8_SB(0, 0), b2, voffB); PG8_STAGE(PG8_SB(0, 1), b2 + hstep, voffB); PG8_STAGE(PG8_SA(0, 0), a2, voffA);
            PG8_WAIT_V(8); PG8_WAIT_L(0); PG8_BAR; PG8_MMA(1, 0, At, B0); PG8_MMA(1, 1, At, B1); PG8_BAR; PG8_SCHED;
            PG8_LDB(B0, 1, 0); PG8_LDB(B1, 1, 1); PG8_SCHED; PG8_LDA(At, 1, 0); PG8_STAGE(PG8_SA(0, 1), a2 + hstep, voffA);
            PG8_WAIT_V(8); PG8_WAIT_L(0); PG8_BAR; PG8_MMA(0, 0, At, B0); PG8_MMA(0, 1, At, B1); PG8_BAR; PG8_SCHED;
            PG8_LDA(At, 1, 1); PG8_STAGE(PG8_SB(1, 0), b3, voffB); PG8_STAGE(PG8_SB(1, 1), b3 + hstep, voffB); PG8_STAGE(PG8_SA(1, 0), a3, voffA);
            PG8_WAIT_V(8); PG8_WAIT_L(0); PG8_BAR; PG8_MMA(1, 0, At, B0); PG8_MMA(1, 1, At, B1); PG8_BAR; PG8_SCHED;
            } else {
            PG8_LDB(B0, 0, 0); PG8_SCHED; PG8_LDA(At, 0, 0); PG8_STAGE(PG8_SA(1, 1), a1 + hstep, voffA);
            PG8_WAIT_L(8); PG8_BAR; PG8_WAIT_L(0); PG8_MMA(0, 0, At, B0); PG8_BAR; PG8_SCHED;
            PG8_LDB(B1, 0, 1); PG8_STAGE(PG8_SB(0, 0), b2, voffB);
            PG8_BAR; PG8_WAIT_L(0); PG8_MMA(0, 1, At, B1); PG8_BAR;
            PG8_LDA(At, 0, 1); PG8_STAGE(PG8_SA(0, 0), a2, voffA);
            PG8_BAR; PG8_WAIT_L(0); PG8_MMA(1, 0, At, B0); PG8_BAR; PG8_SCHED;
            PG8_STAGE(PG8_SB(0, 1), b2 + hstep, voffB);
            PG8_WAIT_V(6); PG8_BAR; PG8_MMA(1, 1, At, B1); PG8_BAR;
            PG8_LDB(B0, 1, 0); PG8_SCHED; PG8_LDA(At, 1, 0); PG8_STAGE(PG8_SA(0, 1), a2 + hstep, voffA);
            PG8_WAIT_L(8); PG8_BAR; PG8_WAIT_L(0); PG8_MMA(0, 0, At, B0); PG8_BAR; PG8_SCHED;
            PG8_LDB(B1, 1, 1); PG8_STAGE(PG8_SB(1, 0), b3, voffB);
            PG8_BAR; PG8_WAIT_L(0); PG8_MMA(0, 1, At, B1); PG8_BAR;
            PG8_LDA(At, 1, 1); PG8_STAGE(PG8_SA(1, 0), a3, voffA);
            PG8_BAR; PG8_WAIT_L(0); PG8_MMA(1, 0, At, B0); PG8_BAR; PG8_SCHED;
            PG8_STAGE(PG8_SB(1, 1), b3 + hstep, voffB);
            PG8_WAIT_V(6); PG8_BAR; PG8_MMA(1, 1, At, B1); PG8_BAR;
            }
        }
        if constexpr (ALIGN_EPI) { if (wr == 0) PG8_BAR; }
        PreOf<Epi>::run(E, acc, cur, wr, wc, fr, fq, pre);
        asm volatile("" ::: "memory");
        if (!has_next) break;
        pre = PreOf<Epi>::get(E, nxt, wr, wc, fr, fq);
#pragma unroll
        for (int a = 0; a < 2; ++a)
#pragma unroll
            for (int b = 0; b < 2; ++b)
#pragma unroll
                for (int m = 0; m < 4; ++m)
#pragma unroll
                    for (int n = 0; n < 2; ++n) acc[a][b][m][n] = (f32x4){0.f, 0.f, 0.f, 0.f};
        cur = nxt; cA = nA; cB = nB; ++ui;
        if constexpr (ALIGN_EPI) { if (wr == 1) PG8_BAR; }
    }
    PG8_WAIT_V(0);
    if constexpr (!ALIGN_EPI) { if (wr == 0) PG8_BAR; }
    PG8_BAR;
#undef PG8_SA
#undef PG8_SB
#undef PG8_STAGE
#undef PG8_LDA
#undef PG8_LDB
#undef PG8_MMA
#undef PG8_WAIT_V
#undef PG8_WAIT_V8R
#undef PG8_WAIT_L
#undef PG8_BAR
#undef PG8_SCHED
}

template <class Epi, class Sched, bool GATHER, bool QUARTER = false, bool FP8 = false>
__device__ __forceinline__ void gemm_phase2(PG8_LAS unsigned char* lds, const Gemm g, const Sched& S, const Epi& E, const PG8_LAS unsigned short* tab, int stag_ticks = 0) {
    if (stag_ticks > 0) {
        const unsigned long long t_end = __builtin_amdgcn_s_memrealtime() + (((unsigned long long)blockIdx.x * (unsigned)stag_ticks) >> 8);
        while (__builtin_amdgcn_s_memrealtime() < t_end) __builtin_amdgcn_s_sleep(4);
    }
    int tid_ = threadIdx.x; asm volatile("" : "+v"(tid_));
    const int tid = tid_, wid = __builtin_amdgcn_readfirstlane(tid >> 6), lane = tid & 63, wr = wid >> 2, wc = wid & 3, fr = lane & 15, fq = lane >> 4;
    const int K = g.K;
    constexpr bool ZIL = std::is_same<Sched, TabOrder>::value;
    constexpr int EPI_S = Epi::NVM < 48 ? Epi::NVM : 48;
    unsigned cofA[2], voffB[2]; int R0 = 0;
#pragma unroll
    for (int i = 0; i < 2; ++i) { int R, C; stage_rc(tid * 16 + i * 8192, R, C); const int Rb = Epi::PERM ? ((R & ~31) + perm32(R & 31)) : R;
        cofA[i] = GATHER ? (unsigned)(C * 2) : (unsigned)(R * K + C) * 2u; voffB[i] = (unsigned)(Rb * K + C) * 2u; if (i == 0) R0 = R; }
    const unsigned pitchA = (unsigned)K * 2u;
    const size_t kstep = (size_t)(BK * 2), hstep = (size_t)HALF * K * 2, tstep = 2 * hstep, hstepA = GATHER ? 0 : hstep;
    const unsigned ldsw = (unsigned)wid * 1024u;
    const int aoff = lds_byte(wr * 64 + fr, fq * 8), boff = lds_byte(wc * 32 + fr, fq * 8);
#define PG8_SA(b, h) (((b) * 2 + (h)) * HTB)
#define PG8_SB(b, h) ((4 + (b) * 2 + (h)) * HTB)
#define PG8_STAGEB(bufoff, gbase) do { _Pragma("unroll") for (int _i = 0; _i < 2; ++_i) \
        __builtin_amdgcn_global_load_lds((const unsigned*)((const char*)(gbase) + voffB[_i]), (PG8_LAS unsigned*)(lds + (bufoff) + ldsw + _i * 8192), 16, 0, 0); } while (0)
#define PG8_STAGEA(bufoff, gbase, tkw) do { _Pragma("unroll") for (int _i = 0; _i < 2; ++_i) { const unsigned _vo = GATHER ? ((((tkw) >> (16 * _i)) & 0xffffu) * pitchA + cofA[_i]) : cofA[_i]; \
        __builtin_amdgcn_global_load_lds((const unsigned*)((const char*)(gbase) + _vo), (PG8_LAS unsigned*)(lds + (bufoff) + ldsw + _i * 8192), 16, 0, 0); } } while (0)
#define PG8_LOADTK(d0, d1, uidx) do { if constexpr (GATHER) { const PG8_LAS unsigned short* _tp = tab + (uidx) * 256 + R0; d0 = (unsigned)_tp[0] | ((unsigned)_tp[64] << 16); d1 = (unsigned)_tp[128] | ((unsigned)_tp[192] << 16); } } while (0)
#define PG8_LDA(dst, b, h) do { _Pragma("unroll") for (int m = 0; m < 4; ++m) { const PG8_LAS unsigned char* _p = lds + PG8_SA(b, h) + aoff + m * 2048; \
        if constexpr (FP8) dst##8[m] = __builtin_shufflevector(*(const PG8_LAS v4i_*)_p, *(const PG8_LAS v4i_*)(_p + 1024), 0, 1, 2, 3, 4, 5, 6, 7); \
        else { dst[m][0] = *(const PG8_LAS bf16x8*)_p; dst[m][1] = *(const PG8_LAS bf16x8*)(_p + 1024); } } } while (0)
#define PG8_LDB(dst, b, h) do { _Pragma("unroll") for (int n = 0; n < 2; ++n) { const PG8_LAS unsigned char* _p = lds + PG8_SB(b, h) + boff + n * 2048; \
        if constexpr (FP8) dst##8[n] = __builtin_shufflevector(*(const PG8_LAS v4i_*)_p, *(const PG8_LAS v4i_*)(_p + 1024), 0, 1, 2, 3, 4, 5, 6, 7); \
        else { dst[n][0] = *(const PG8_LAS bf16x8*)_p; dst[n][1] = *(const PG8_LAS bf16x8*)(_p + 1024); } } } while (0)
#define PG8_MMA(ai, bj, At, Bt) do { __builtin_amdgcn_s_setprio(1); _Pragma("unroll") for (int m = 0; m < 4; ++m) _Pragma("unroll") for (int n = 0; n < 2; ++n) { \
        if constexpr (FP8) asm volatile("v_mfma_f32_16x16x128_f8f6f4 %0, %1, %2, %0" : "+v"(acc[ai][bj][m][n]) : "v"(Bt##8[n]), "v"(At##8[m]));     \
        else { _Pragma("unroll") for (int k = 0; k < 2; ++k) acc[ai][bj][m][n] = __builtin_amdgcn_mfma_f32_16x16x32_bf16(Bt[n][k], At[m][k], acc[ai][bj][m][n], 0, 0, 0); } } \
        __builtin_amdgcn_s_setprio(0); } while (0)
#define PG8_ZERO(ai) do { _Pragma("unroll") for (int b_ = 0; b_ < 2; ++b_) _Pragma("unroll") for (int m_ = 0; m_ < 4; ++m_) _Pragma("unroll") for (int n_ = 0; n_ < 2; ++n_) acc[ai][b_][m_][n_] = (f32x4){0.f, 0.f, 0.f, 0.f}; } while (0)
#define PG8_WAIT_V(n) asm volatile("s_waitcnt vmcnt(" #n ")" ::: "memory")
#define PG8_WAIT_V8R(rx) do { if (rx) asm volatile("s_waitcnt vmcnt(%0)" :: "n"(8 + EPI_S) : "memory"); else PG8_WAIT_V(8); } while (0)
#define PG8_WAIT_L(n) asm volatile("s_waitcnt lgkmcnt(" #n ")" ::: "memory")
#define PG8_BAR __builtin_amdgcn_s_barrier()
#define PG8_SCHED __builtin_amdgcn_sched_barrier(0)
    Unit cur, nxt; int ui = 0;
    if (!S.next(0, cur)) return;
    typename PreOf<Epi>::type pre = PreOf<Epi>::get(E, cur, wr, wc, fr, fq);
    f32x4 acc[2][2][4][2];
#pragma unroll
    for (int a = 0; a < 2; ++a)
#pragma unroll
        for (int b = 0; b < 2; ++b)
#pragma unroll
            for (int m = 0; m < 4; ++m)
#pragma unroll
                for (int n = 0; n < 2; ++n) acc[a][b][m][n] = (f32x4){0.f, 0.f, 0.f, 0.f};
    typedef int v4i_ __attribute__((ext_vector_type(4))); typedef int v8i_ __attribute__((ext_vector_type(8)));
    bf16x8 At[4][2], B0[2][2], B1[2][2];
    v8i_ At8[4], B08[2], B18[2];
    unsigned tkc0 = 0u, tkc1 = 0u, tkn0 = 0u, tkn1 = 0u;
    PG8_LOADTK(tkc0, tkc1, 0);
    const char* cA = (const char*)g.A + (GATHER ? (size_t)0 : (size_t)cur.pm * tstep) + (size_t)cur.kt0 * kstep;
    const char* cB = (const char*)g.Bt + (size_t)cur.e * g.estride + (size_t)cur.pn * tstep + (size_t)cur.kt0 * kstep;
    PG8_STAGEB(PG8_SB(0, 0), cB); PG8_STAGEB(PG8_SB(0, 1), cB + hstep); PG8_STAGEA(PG8_SA(0, 0), cA, tkc0); PG8_STAGEA(PG8_SA(0, 1), cA + hstepA, tkc1);
    if (wr == 1) PG8_BAR;
    PG8_WAIT_V(2); PG8_BAR;
    PG8_STAGEB(PG8_SB(1, 0), cB + kstep); PG8_STAGEA(PG8_SA(1, 0), cA + kstep, tkc0); PG8_STAGEB(PG8_SB(1, 1), cB + hstep + kstep);
    PG8_WAIT_V(6); PG8_BAR;
    for (;;) {
        const bool has_next = S.next(ui + 1, nxt);
        const char* nA = has_next ? (const char*)g.A + (GATHER ? (size_t)0 : (size_t)nxt.pm * tstep) + (size_t)nxt.kt0 * kstep : cA;
        const char* nB = has_next ? (const char*)g.Bt + (size_t)nxt.e * g.estride + (size_t)nxt.pn * tstep + (size_t)nxt.kt0 * kstep : cB;
        tkn0 = tkc0; tkn1 = tkc1;
        if (has_next) PG8_LOADTK(tkn0, tkn1, ui + 1);
        const int nt = cur.nt;
        for (int t = 0; t < nt; t += 2) {
            const bool last = (t == nt - 2);
            int sp = 0; if constexpr (QUARTER) { sp = cur.split; asm volatile("" : "+s"(sp)); }
            const bool q00 = !QUARTER || (sp == 0) | (sp == 1), q01 = !QUARTER || (sp == 0) | (sp == 2), q10 = !QUARTER || (sp == 0) | (sp == 3), q11 = !QUARTER || (sp == 0) | (sp == 4);
            const char* a1 = cA + (size_t)(t + 1) * kstep;
            const char* a2 = last ? nA : cA + (size_t)(t + 2) * kstep; const char* b2 = last ? nB : cB + (size_t)(t + 2) * kstep;
            const char* a3 = a2 + kstep; const char* b3 = b2 + kstep;
            const unsigned t20 = last ? tkn0 : tkc0, t21 = last ? tkn1 : tkc1;
            PG8_LDB(B0, 0, 0); PG8_LDB(B1, 0, 1); PG8_SCHED; PG8_LDA(At, 0, 0); PG8_STAGEA(PG8_SA(1, 1), a1 + hstepA, tkc1);
            int tz = 1; if constexpr (ZIL) { tz = __builtin_amdgcn_readfirstlane(t | (ui > 0 ? 0 : 1)); asm volatile("" : "+s"(tz)); }
            if (tz == 0) { PG8_ZERO(0); PG8_SCHED; }
            PG8_WAIT_V(8); PG8_WAIT_L(0); PG8_BAR; if (q00) PG8_MMA(0, 0, At, B0); if (q01) PG8_MMA(0, 1, At, B1); PG8_BAR; PG8_SCHED;
            PG8_LDA(At, 0, 1); PG8_STAGEB(PG8_SB(0, 0), b2); PG8_STAGEB(PG8_SB(0, 1), b2 + hstep); PG8_STAGEA(PG8_SA(0, 0), a2, t20);
            if (tz == 0) { PG8_ZERO(1); PG8_SCHED; }
            PG8_WAIT_V(8); PG8_WAIT_L(0); PG8_BAR; if (q10) PG8_MMA(1, 0, At, B0); if (q11) PG8_MMA(1, 1, At, B1); PG8_BAR; PG8_SCHED;
            PG8_LDB(B0, 1, 0); PG8_LDB(B1, 1, 1); PG8_SCHED; PG8_LDA(At, 1, 0); PG8_STAGEA(PG8_SA(0, 1), a2 + hstepA, t21);
            PG8_WAIT_V(8); PG8_WAIT_L(0); PG8_BAR; if (q00) PG8_MMA(0, 0, At, B0); if (q01) PG8_MMA(0, 1, At, B1); PG8_BAR; PG8_SCHED;
            PG8_LDA(At, 1, 1); PG8_STAGEB(PG8_SB(1, 0), b3); PG8_STAGEB(PG8_SB(1, 1), b3 + hstep); PG8_STAGEA(PG8_SA(1, 0), a3, t20);
            PG8_WAIT_V(8); PG8_WAIT_L(0); PG8_BAR; if (q10) PG8_MMA(1, 0, At, B0); if (q11) PG8_MMA(1, 1, At, B1); PG8_BAR; PG8_SCHED;
        }
        if (wr == 0) PG8_BAR;
        PreOf<Epi>::run(E, acc, cur, wr, wc, fr, fq, pre);
        asm volatile("" ::: "memory");
        if (!has_next) break;
        pre = PreOf<Epi>::get(E, nxt, wr, wc, fr, fq);
        if constexpr (!ZIL) {
#pragma unroll
        for (int a = 0; a < 2; ++a)
#pragma unroll
            for (int b = 0; b < 2; ++b)
#pragma unroll
                for (int m = 0; m < 4; ++m)
#pragma unroll
                    for (int n = 0; n < 2; ++n) acc[a][b][m][n] = (f32x4){0.f, 0.f, 0.f, 0.f};
        }
        cur = nxt; cA = nA; cB = nB; tkc0 = tkn0; tkc1 = tkn1; ++ui;
        if (wr == 1) PG8_BAR;
    }
    PG8_WAIT_V(0);
    PG8_BAR;
#undef PG8_SA
#undef PG8_SB
#undef PG8_STAGEA
#undef PG8_STAGEB
#undef PG8_LOADTK
#undef PG8_LDA
#undef PG8_LDB
#undef PG8_MMA
#undef PG8_ZERO
#undef PG8_WAIT_V
#undef PG8_WAIT_V8R
#undef PG8_WAIT_L
#undef PG8_BAR
#undef PG8_SCHED
}
}

constexpr int NWAVES = 8;
constexpr int NTOK = 65536, DM = 1024, SEQ = 8192;
constexpr int MIXIN = 2560, FFN = 2816, QKVD = 1280, EXPD = 3584, NEXP = 8;
constexpr int SETROWS = NTOK + NEXP * 256;
constexpr float EPS = 1e-5f;
constexpr float LOG2E = 1.4426950408889634f;
constexpr float QSCALE = 0.125f * LOG2E;

constexpr size_t MiB = 1u << 20;
constexpr size_t WS_CTL = 0, CTL_ZERO_BYTES = 1 * MiB;
constexpr size_t WS_CS = 1 * MiB;
constexpr size_t WS_TOKINFO = 5 * MiB;
constexpr size_t WS_ROWTOK = 7 * MiB;
constexpr size_t WS_ROWGATE = 8 * MiB;
constexpr size_t WS_SSP = 12 * MiB;
constexpr size_t WS_AOOFF = 160 * MiB;
constexpr size_t WS_YOFF = 320 * MiB;
constexpr size_t WS_WSP = 9 * MiB;
constexpr size_t WS_WIN = 16 * MiB, WS_WOUT = 21 * MiB, WS_FGU = 23 * MiB, WS_FD = 34 * MiB;
constexpr size_t WS_WQKV = 40 * MiB, WS_WO = 43 * MiB, WS_MGU = 45 * MiB, WS_MD = 157 * MiB;
constexpr size_t WS_XN = 216 * MiB;
constexpr size_t WS_XG = 344 * MiB;
constexpr size_t WS_BIG = 476 * MiB;
constexpr size_t WS_END = WS_BIG + (size_t)SETROWS * EXPD * 2;
static_assert(WS_MD + (size_t)NEXP * DM * EXPD * 2 <= WS_XN && WS_XN + (size_t)NTOK * DM * 2 <= WS_XG && WS_XG + (size_t)SETROWS * DM * 2 <= WS_BIG, "d_ws map");
static_assert(WS_FD + (size_t)DM * FFN * 2 <= WS_WQKV && WS_MGU + (size_t)NEXP * 2 * EXPD * DM * 2 <= WS_MD, "d_ws map (weights)");
constexpr int CW_BAR = 4096;
constexpr int CW_CNT = 16384;

constexpr int RING_BYTES = 131072;
constexpr int TAB_OFF = RING_BYTES, TAB_ROUNDS = 29, TAB_BYTES = TAB_ROUNDS * 512;
constexpr int LDSCTL_OFF = TAB_OFF + TAB_BYTES, MISC_OFF = LDSCTL_OFF + 320;
constexpr int LDS_BYTES = 147456;
static_assert(MISC_OFF + 64 <= LDS_BYTES && 8 * 64 * 65 * 4 <= LDSCTL_OFF, "LDS map");

#define GAS __attribute__((address_space(1)))
#define LAS __attribute__((address_space(3)))
typedef unsigned short bf16;
typedef unsigned v4u __attribute__((ext_vector_type(4)));
typedef unsigned v2u __attribute__((ext_vector_type(2)));
typedef float f32x4 __attribute__((ext_vector_type(4)));
typedef GAS unsigned gu32;
#define RLX_AGENT __ATOMIC_RELAXED, __HIP_MEMORY_SCOPE_AGENT
#define LDS_WAIT() asm volatile("s_waitcnt lgkmcnt(0)" ::: "memory")
#define VM_WAIT() asm volatile("s_waitcnt vmcnt(0)" ::: "memory")
__device__ __forceinline__ unsigned pk2(float lo, float hi) { return pg8::cvt_pk_bf16(lo, hi); }
__device__ __forceinline__ float bflo(unsigned w) { return __uint_as_float(w << 16); }
__device__ __forceinline__ float bfhi(unsigned w) { return __uint_as_float(w & 0xffff0000u); }
__device__ __forceinline__ float bf1(bf16 h) { return __uint_as_float(((unsigned)h) << 16); }
__device__ __forceinline__ bf16 f2bf1(float f) { return (bf16)(pk2(f, 0.f) & 0xffffu); }
__device__ __forceinline__ void unpack8(const v4u w, float (&f)[8]) { f[0] = bflo(w.x); f[1] = bfhi(w.x); f[2] = bflo(w.y); f[3] = bfhi(w.y); f[4] = bflo(w.z); f[5] = bfhi(w.z); f[6] = bflo(w.w); f[7] = bfhi(w.w); }
__device__ __forceinline__ v4u pack8f(const float (&f)[8]) { v4u w; w.x = pk2(f[0], f[1]); w.y = pk2(f[2], f[3]); w.z = pk2(f[4], f[5]); w.w = pk2(f[6], f[7]); return w; }
__device__ __forceinline__ float gelu_erf(float v) { return 0.5f * v * (1.0f + erff(v * 0.70710678118654752f)); }

#define XB_TMO      128
#define XB_XCNT(j)  (256  + 64 * (j))
#define XB_XSUB(j)  (1280 + 64 * (j))
#define XB_XGEN(j)  (2304 + 64 * (j))
#define XB_TOP      3328
#define XB_TOPGEN   3392
#define XCD_BAR_WORDS 3456
#define XB_SPIN_CAP (1u << 18)

__device__ __forceinline__ unsigned xb_ld(unsigned* p)              { return __hip_atomic_load(p, __ATOMIC_RELAXED, __HIP_MEMORY_SCOPE_AGENT); }
__device__ __forceinline__ unsigned xb_add(unsigned* p, unsigned v) { return __hip_atomic_fetch_add(p, v, __ATOMIC_RELAXED, __HIP_MEMORY_SCOPE_AGENT); }
__device__ __forceinline__ unsigned xb_xcc_id() { return (unsigned)__builtin_amdgcn_s_getreg((3 << 11) | 20) & 0xFu; }
#define XB_SPIN(cond, bar) do { unsigned _sp = 0; while (cond) { __builtin_amdgcn_s_sleep(1); \
    if ((++_sp & 255u) == 0u) { if (xb_ld(&(bar)[XB_TMO])) break; if (_sp > XB_SPIN_CAP) { atomicAdd(&(bar)[XB_TMO], 1u); break; } } } } while (0)

struct XcdBarrier {
    unsigned* bar; unsigned x;
    volatile LAS unsigned* st;
};

__device__ __forceinline__ XcdBarrier xcd_barrier_post(unsigned* bar, volatile LAS unsigned* st) {
    XcdBarrier b; b.bar = bar; b.x = xb_xcc_id(); b.st = st;
    if (threadIdx.x == 0) (void)xb_add(&bar[XB_XCNT(b.x)], 1u);
    return b;
}
__device__ __forceinline__ void xcd_barrier_complete(unsigned* bar, unsigned x, unsigned& nloc, unsigned& nx) {
    const unsigned G = gridDim.x * gridDim.y * gridDim.z;
    unsigned sum, cnt, mine, sp = 0u;
    for (;;) {
        sum = 0u; cnt = 0u; mine = 0u;
#pragma unroll
        for (unsigned j = 0; j < 16; ++j) { const unsigned c = xb_ld(&bar[XB_XCNT(j)]); sum += c; cnt += (c > 0u) ? 1u : 0u; mine = (j == x) ? c : mine; }
        if (sum == G) break;
        __builtin_amdgcn_s_sleep(1);
        if ((++sp & 255u) == 0u) { if (xb_ld(&bar[XB_TMO])) break; if (sp > XB_SPIN_CAP) { atomicAdd(&bar[XB_TMO], 1u); break; } }
    }
    nloc = mine > 0u ? mine : 1u; nx = cnt > 0u ? cnt : 1u;
}

__device__ __forceinline__ void xcd_barrier(const XcdBarrier& b) {
    asm volatile("s_waitcnt vmcnt(0)" ::: "memory");
    __syncthreads();
    if (threadIdx.x == 0) {
        unsigned* bar = b.bar;
        __builtin_amdgcn_s_waitcnt(0);
        unsigned nloc = b.st[0], nx = b.st[1];
        if (nloc == 0u) { xcd_barrier_complete(bar, b.x, nloc, nx); b.st[0] = nloc; b.st[1] = nx; }
        const unsigned old = xb_add(&bar[XB_XSUB(b.x)], 1u);
        const unsigned gen = old / nloc;
        if (old + 1u == (gen + 1u) * nloc) {
            __builtin_amdgcn_fence(__ATOMIC_RELEASE, "agent");
            asm volatile("s_waitcnt vmcnt(0)" ::: "memory");
            const unsigned og = xb_add(&bar[XB_TOP], 1u);
            const unsigned tg = og / nx;
            if (og + 1u == (tg + 1u) * nx) xb_add(&bar[XB_TOPGEN], 1u);
            else XB_SPIN(xb_ld(&bar[XB_TOPGEN]) == tg, bar);
            __builtin_amdgcn_fence(__ATOMIC_ACQUIRE, "agent");
            xb_add(&bar[XB_XGEN(b.x)], 1u);
            asm volatile("s_waitcnt vmcnt(0)" ::: "memory");
        } else {
            XB_SPIN(xb_ld(&bar[XB_XGEN(b.x)]) == gen, bar);
            __builtin_amdgcn_fence(__ATOMIC_ACQUIRE, "agent");
            asm volatile("s_waitcnt vmcnt(0)" ::: "memory");
        }
    }
    __syncthreads();
}

struct Frame {
    LAS unsigned char* lds;
    int tid, lane, wave;
    int vcu, G;
};
__device__ __forceinline__ float wave_sum(float v) {
#pragma unroll
    for (int o = 1; o < 64; o <<= 1) v += __shfl_xor(v, o);
    return v;
}

constexpr int TR_SCR = 64 * 65 * 4;
struct TrItem { const float* W; int N, k0, n0; bf16* WT; int K, orow0; float scale; const float* gk; int f8; };
__device__ __forceinline__ void tr_load(const TrItem& t, float (&r)[64], int lane) {
#pragma unroll
    for (int i = 0; i < 64; ++i) r[i] = t.W[(size_t)(t.k0 + i) * t.N + t.n0 + lane];
}
__device__ __forceinline__ void tr_store(const TrItem& t, const float (&r)[64], LAS float* scr, int lane) {
#pragma unroll
    for (int i = 0; i < 64; ++i) scr[i * 65 + lane] = r[i] * (t.gk ? t.scale * t.gk[t.k0 + i] : t.scale);
    LDS_WAIT(); asm volatile("" ::: "memory");
    const int c = lane & 7;
#pragma unroll
    for (int j = 0; j < 8; ++j) { const int n = (lane >> 3) + 8 * j; const LAS float* s = scr + (8 * c) * 65 + n;
        v4u o; o.x = pk2(s[0 * 65], s[1 * 65]); o.y = pk2(s[2 * 65], s[3 * 65]); o.z = pk2(s[4 * 65], s[5 * 65]); o.w = pk2(s[6 * 65], s[7 * 65]);
        if (t.f8) { unsigned w0 = 0u, w1 = 0u;
            w0 = __builtin_amdgcn_cvt_pk_fp8_f32(s[0 * 65], s[1 * 65], w0, false); w0 = __builtin_amdgcn_cvt_pk_fp8_f32(s[2 * 65], s[3 * 65], w0, true);
            w1 = __builtin_amdgcn_cvt_pk_fp8_f32(s[4 * 65], s[5 * 65], w1, false); w1 = __builtin_amdgcn_cvt_pk_fp8_f32(s[6 * 65], s[7 * 65], w1, true);
            v2u o8; o8.x = w0; o8.y = w1; *(GAS v2u*)((unsigned char*)t.WT + (size_t)(t.orow0 + n) * t.K + t.k0 + 8 * c) = o8; continue; }
        *(GAS v4u*)(t.WT + (size_t)(t.orow0 + n) * t.K + t.k0 + 8 * c) = o; }
    LDS_WAIT(); asm volatile("" ::: "memory");
}
__device__ __forceinline__ TrItem tr_plain(const float* W, int K, int N, bf16* WT, int item, const float* gk = nullptr) {
    const int nblk = N / 64, kb = item / nblk, nb = item % nblk; return TrItem{W, N, 64 * kb, 64 * nb, WT, K, 64 * nb, 1.0f, gk, 0};
}
constexpr float F8_WSCALE = 64.0f;
__device__ __forceinline__ TrItem tr_gu(const float* W, int K, int N, bf16* WT, int up, int item, const float* gk = nullptr, int f8 = 0) {
    const int nblk = N / 64, kb = item / nblk, nb = item % nblk, n0 = 64 * nb; return TrItem{W, N, 64 * kb, n0, WT, K, 256 * (n0 / 128) + 128 * up + (n0 % 128), (up ? 0.6931471805599453f : 1.4426950408889634f) * (f8 ? F8_WSCALE : 1.0f), gk, f8};
}

__device__ __forceinline__ TrItem even_item(int r, const float* w_in, const float* w_out, const float* wg, const float* wu, const float* wd, const float* g1, const float* g2, unsigned char* ws, int f8) {
    constexpr int I_IN = (DM / 64) * (MIXIN / 64), I_OUT = (DM / 64) * (DM / 64), I_G = (DM / 64) * (FFN / 64);
    if (r < I_IN) { const int nblk = MIXIN / 64, kb = r / nblk, n0 = 64 * (r % nblk);
        const int j = (n0 - 512) & 511, orow = (n0 < 512 || n0 >= 1536) ? n0 : 512 + 256 * (j >> 7) + (n0 >= 1024 ? 128 : 0) + (j & 127);
        return TrItem{w_in, MIXIN, 64 * kb, n0, (bf16*)(ws + WS_WIN), DM, orow, 1.0f, g1, 0}; } r -= I_IN;
    if (r < I_OUT) return tr_plain(w_out, DM, DM, (bf16*)(ws + WS_WOUT), r); r -= I_OUT;
    if (r < I_G) return tr_gu(wg, DM, FFN, (bf16*)(ws + WS_FGU), 0, r, g2, f8); r -= I_G;
    if (r < I_G) return tr_gu(wu, DM, FFN, (bf16*)(ws + WS_FGU), 1, r, g2, f8); r -= I_G;
    { TrItem t = tr_plain(wd, FFN, DM, (bf16*)(ws + WS_FD), r); if (f8) { t.f8 = 1; t.scale = F8_WSCALE; } return t; }
}
__device__ __forceinline__ void conv_even_phase(const Frame& F, const float* w_in, const float* w_out, const float* wg, const float* wu, const float* wd, const float* sw, const float* g1, const float* g2, unsigned char* ws, int f8) {
    LAS float* scr = (LAS float*)(F.lds + F.wave * TR_SCR);
    const int gw = F.vcu * NWAVES + F.wave, NGW = F.G * NWAVES;
    constexpr int NITEMS = (DM / 64) * (MIXIN / 64) + (DM / 64) * (DM / 64) + 2 * (DM / 64) * (FFN / 64) + (FFN / 64) * (DM / 64);
    float r[64];
    if (gw < NITEMS) { const TrItem t = even_item(gw, w_in, w_out, wg, wu, wd, g1, g2, ws, f8); tr_load(t, r, F.lane); }
    for (int it = gw; it < NITEMS; it += NGW) {
        const TrItem t = even_item(it, w_in, w_out, wg, wu, wd, g1, g2, ws, f8);
        float cur[64];
#pragma unroll
        for (int i = 0; i < 64; ++i) cur[i] = r[i];
        if (it + NGW < NITEMS) { const TrItem tn = even_item(it + NGW, w_in, w_out, wg, wu, wd, g1, g2, ws, f8); tr_load(tn, r, F.lane); }
        tr_store(t, cur, scr, F.lane);
    }
    bf16* wsp = (bf16*)(ws + WS_WSP);
    for (int idx = (F.vcu * NWAVES * 64) + F.tid; idx < 4 * 128 * 128; idx += F.G * NWAVES * 64) { const int ii = (idx >> 7) & 127, jj = idx & 127; wsp[idx] = f2bf1((jj <= ii) ? sw[idx] : 0.f); }
}
__device__ __forceinline__ TrItem odd_item(int r, const float* wqkv, const float* wo, const float* ewg, const float* ewu, const float* ewd, const float* g1, unsigned char* ws, int f8) {
    constexpr int I_Q = (DM / 64) * (QKVD / 64), I_O = (DM / 64) * (DM / 64), I_G = (DM / 64) * (EXPD / 64), I_D = (EXPD / 64) * (DM / 64);
    if (r < I_Q) { TrItem t = tr_plain(wqkv, DM, QKVD, (bf16*)(ws + WS_WQKV), r, g1); if (f8 & 2) { t.f8 = 1; t.scale = F8_WSCALE; } return t; } r -= I_Q;
    if (r < I_O) { TrItem t = tr_plain(wo, DM, DM, (bf16*)(ws + WS_WO), r); if (f8 & 4) { t.f8 = 1; t.scale = F8_WSCALE; } return t; } r -= I_O;
    const int e = r / (2 * I_G + I_D); r -= e * (2 * I_G + I_D);
    const int f8e = f8 & 1;
    bf16* gu = (bf16*)(ws + WS_MGU + (size_t)e * 2 * EXPD * DM * (f8e ? 1 : 2)); bf16* dd = (bf16*)(ws + WS_MD) + (size_t)e * DM * EXPD;
    if (r < I_G) return tr_gu(ewg + (size_t)e * DM * EXPD, DM, EXPD, gu, 0, r, nullptr, f8e); r -= I_G;
    if (r < I_G) return tr_gu(ewu + (size_t)e * DM * EXPD, DM, EXPD, gu, 1, r, nullptr, f8e); r -= I_G;
    { TrItem t = tr_plain(ewd + (size_t)e * EXPD * DM, EXPD, DM, f8e ? (bf16*)(ws + WS_MD + (size_t)e * DM * EXPD) : dd, r); if (f8e) { t.f8 = 1; t.scale = F8_WSCALE; } return t; }
}
__device__ __forceinline__ void conv_odd_phase(const Frame& F, const float* wqkv, const float* wo, const float* ewg, const float* ewu, const float* ewd, const float* g1, unsigned char* ws, int f8) {
    LAS float* scr = (LAS float*)(F.lds + F.wave * TR_SCR);
    const int gw = F.vcu * NWAVES + F.wave, NGW = F.G * NWAVES;
    constexpr int NITEMS = (DM / 64) * (QKVD / 64) + (DM / 64) * (DM / 64) + NEXP * (2 * (DM / 64) * (EXPD / 64) + (EXPD / 64) * (DM / 64));
    float r[64];
    if (gw < NITEMS) { const TrItem t = odd_item(gw, wqkv, wo, ewg, ewu, ewd, g1, ws, f8); tr_load(t, r, F.lane); }
    for (int it = gw; it < NITEMS; it += NGW) {
        const TrItem t = odd_item(it, wqkv, wo, ewg, ewu, ewd, g1, ws, f8);
        float cur[64];
#pragma unroll
        for (int i = 0; i < 64; ++i) cur[i] = r[i];
        if (it + NGW < NITEMS) { const TrItem tn = odd_item(it + NGW, wqkv, wo, ewg, ewu, ewd, g1, ws, f8); tr_load(tn, r, F.lane); }
        tr_store(t, cur, scr, F.lane);
    }
}
__device__ __forceinline__ void rope_table_phase(const Frame& F, const int* pos, float* cs) {
    for (int idx = (F.vcu * NWAVES * 64) + F.tid; idx < NTOK * 8; idx += F.G * NWAVES * 64) {
        const int t = idx >> 3, i = idx & 7;
        const float inv = (float)exp(-log(500000.0) * (double)(2 * i) / 16.0);
        const float ang = (float)pos[t] * inv;
        cs[(size_t)t * 16 + i] = (float)cos((double)ang); cs[(size_t)t * 16 + 8 + i] = (float)sin((double)ang);
    }
}
__device__ __forceinline__ void rms_phase(const Frame& F, const float* hin, const float* g, bf16* XN) {
    const int gw = F.vcu * NWAVES + F.wave, NGW = F.G * NWAVES;
    f32x4 gv[4];
#pragma unroll
    for (int j = 0; j < 4; ++j) gv[j] = ((const f32x4*)g)[F.lane + 64 * j];
    for (int m = gw; m < NTOK; m += NGW) {
        const GAS f32x4* xr = (const GAS f32x4*)(hin + (size_t)m * DM) + F.lane;
        f32x4 v[4]; float s = 0.f;
#pragma unroll
        for (int j = 0; j < 4; ++j) { v[j] = xr[64 * j]; s += (v[j].x * v[j].x + v[j].y * v[j].y) + (v[j].z * v[j].z + v[j].w * v[j].w); }
        const float rstd = 1.0f / sqrtf(wave_sum(s) * (1.f / DM) + EPS);
        GAS v2u* o8 = (GAS v2u*)(XN + (size_t)m * DM) + F.lane;
#pragma unroll
        for (int j = 0; j < 4; ++j) { const f32x4 y = v[j] * rstd * gv[j]; v2u w; w.x = pk2(y.x, y.y); w.y = pk2(y.z, y.w); o8[64 * j] = w; }
    }
}
__device__ __forceinline__ void xcast_phase(const Frame& F, const float* x, bf16* XN, float* ssp) {
    const int gw = F.vcu * NWAVES + F.wave, NGW = F.G * NWAVES;
    f32x4 nx[4];
    if (gw < NTOK) { const GAS f32x4* xr = (const GAS f32x4*)(x + (size_t)gw * DM) + F.lane;
#pragma unroll
        for (int j = 0; j < 4; ++j) nx[j] = xr[64 * j]; }
    for (int m = gw; m < NTOK; m += NGW) {
        f32x4 v[4]; float s = 0.f;
#pragma unroll
        for (int j = 0; j < 4; ++j) { v[j] = nx[j]; s += (v[j].x * v[j].x + v[j].y * v[j].y) + (v[j].z * v[j].z + v[j].w * v[j].w); }
        if (m + NGW < NTOK) { const GAS f32x4* xr = (const GAS f32x4*)(x + (size_t)(m + NGW) * DM) + F.lane;
#pragma unroll
            for (int j = 0; j < 4; ++j) nx[j] = xr[64 * j]; }
        s = wave_sum(s);
        GAS v2u* o8 = (GAS v2u*)(XN + (size_t)m * DM) + F.lane;
#pragma unroll
        for (int j = 0; j < 4; ++j) { v2u w; w.x = pk2(v[j].x, v[j].y); w.y = pk2(v[j].z, v[j].w); o8[64 * j] = w; }
        if (F.lane == 0) *(GAS f32x4*)(ssp + (size_t)m * 4) = (f32x4){s, 0.f, 0.f, 0.f};
    }
}
__device__ __forceinline__ void rms_final_phase(const Frame& F, const bf16* hb, const float* g, float* out) {
    const int gw = F.vcu * NWAVES + F.wave, NGW = F.G * NWAVES;
    f32x4 gv[4];
#pragma unroll
    for (int j = 0; j < 2; ++j) { gv[2 * j] = *(const f32x4*)(g + 512 * j + 8 * F.lane); gv[2 * j + 1] = *(const f32x4*)(g + 512 * j + 8 * F.lane + 4); }
    v4u nx0 = {0u, 0u, 0u, 0u}, nx1 = nx0;
    if (gw < NTOK) { const bf16* hr = hb + (size_t)gw * DM + 8 * F.lane; nx0 = *(const GAS v4u*)hr; nx1 = *(const GAS v4u*)(hr + 512); }
    for (int m = gw; m < NTOK; m += NGW) {
        float v[16]; { float t[8]; unpack8(nx0, t);
#pragma unroll
            for (int j = 0; j < 8; ++j) v[j] = t[j];
            unpack8(nx1, t);
#pragma unroll
            for (int j = 0; j < 8; ++j) v[8 + j] = t[j]; }
        if (m + NGW < NTOK) { const bf16* hr = hb + (size_t)(m + NGW) * DM + 8 * F.lane; nx0 = *(const GAS v4u*)hr; nx1 = *(const GAS v4u*)(hr + 512); }
        float s = 0.f;
#pragma unroll
        for (int j = 0; j < 16; ++j) s += v[j] * v[j];
        const float rstd = 1.0f / sqrtf(wave_sum(s) * (1.f / DM) + EPS);
        float* orow = out + (size_t)m * DM + 8 * F.lane;
#pragma unroll
        for (int j = 0; j < 2; ++j) { *(GAS f32x4*)(orow + 512 * j) = (f32x4){v[8 * j], v[8 * j + 1], v[8 * j + 2], v[8 * j + 3]} * rstd * gv[2 * j]; *(GAS f32x4*)(orow + 512 * j + 4) = (f32x4){v[8 * j + 4], v[8 * j + 5], v[8 * j + 6], v[8 * j + 7]} * rstd * gv[2 * j + 1]; }
    }
}
__device__ __forceinline__ void rms_router_phase(const Frame& F, const bf16* hb, const float* g, const float* rw, bf16* XNR, unsigned* gcnt, unsigned* tokinfo, int* rowtok, int f8) {
    for (int idx = (F.vcu * NWAVES * 64) + F.tid; idx < 2 * SETROWS; idx += F.G * NWAVES * 64) rowtok[idx] = -1;
    LAS unsigned* lcnt = (LAS unsigned*)F.lds;
    LAS unsigned* lbase = lcnt + 16;
    LAS unsigned* rec = lcnt + 64;
    float gvf[16];
#pragma unroll
    for (int j = 0; j < 16; ++j) gvf[j] = g[512 * (j >> 3) + 8 * F.lane + (j & 7)];
    f32x4 rwv[16][2];
#pragma unroll
    for (int j = 0; j < 16; ++j) { const f32x4* p = (const f32x4*)(rw + (size_t)(512 * (j >> 3) + 8 * F.lane + (j & 7)) * 8); rwv[j][0] = p[0]; rwv[j][1] = p[1]; }
    for (int panel = F.vcu; panel < NTOK / 256; panel += F.G) {
        if (F.tid < 16) lcnt[F.tid] = 0u;
        __syncthreads();
        v4u nx[2][2];
#pragma unroll
        for (int h2 = 0; h2 < 2; ++h2) { const bf16* hr = hb + (size_t)(panel * 256 + F.wave * 32 + 16 * h2) * DM + 8 * F.lane; nx[h2][0] = *(const GAS v4u*)hr; nx[h2][1] = *(const GAS v4u*)(hr + 512); }
        for (int r = 0; r < 16; ++r) {
            float v[2][16], s[2];
#pragma unroll
            for (int h2 = 0; h2 < 2; ++h2) { float t[8]; unpack8(nx[h2][0], t);
#pragma unroll
                for (int j = 0; j < 8; ++j) v[h2][j] = t[j];
                unpack8(nx[h2][1], t);
#pragma unroll
                for (int j = 0; j < 8; ++j) v[h2][8 + j] = t[j];
                float ss = 0.f;
#pragma unroll
                for (int j = 0; j < 16; ++j) ss += v[h2][j] * v[h2][j];
                s[h2] = ss; }
            if (r + 1 < 16) {
#pragma unroll
                for (int h2 = 0; h2 < 2; ++h2) { const bf16* hr = hb + (size_t)(panel * 256 + F.wave * 32 + 16 * h2 + r + 1) * DM + 8 * F.lane; nx[h2][0] = *(const GAS v4u*)hr; nx[h2][1] = *(const GAS v4u*)(hr + 512); } }
#pragma unroll
            for (int o = 1; o < 64; o <<= 1) { s[0] += __shfl_xor(s[0], o); s[1] += __shfl_xor(s[1], o); }
            float lg[2][8];
#pragma unroll
            for (int h2 = 0; h2 < 2; ++h2) { const int m = panel * 256 + F.wave * 32 + 16 * h2 + r;
                const float rstd = 1.0f / sqrtf(s[h2] * (1.f / DM) + EPS);
                f32x4 l0 = (f32x4){0.f, 0.f, 0.f, 0.f}, l1 = l0; float y[16];
#pragma unroll
                for (int j = 0; j < 16; ++j) { y[j] = v[h2][j] * rstd * gvf[j]; l0 += rwv[j][0] * y[j]; l1 += rwv[j][1] * y[j]; }
                if (f8) { unsigned char* xr8 = (unsigned char*)XNR + (size_t)m * DM + 8 * F.lane;
#pragma unroll
                  for (int hh = 0; hh < 2; ++hh) { unsigned w0 = 0u, w1 = 0u;
                      w0 = __builtin_amdgcn_cvt_pk_fp8_f32(y[8 * hh + 0], y[8 * hh + 1], w0, false); w0 = __builtin_amdgcn_cvt_pk_fp8_f32(y[8 * hh + 2], y[8 * hh + 3], w0, true);
                      w1 = __builtin_amdgcn_cvt_pk_fp8_f32(y[8 * hh + 4], y[8 * hh + 5], w1, false); w1 = __builtin_amdgcn_cvt_pk_fp8_f32(y[8 * hh + 6], y[8 * hh + 7], w1, true);
                      v2u o8; o8.x = w0; o8.y = w1; *(GAS v2u*)(xr8 + 512 * hh) = o8; } }
                else { float t[8];
#pragma unroll
                  for (int j = 0; j < 8; ++j) t[j] = y[j];
                  *(GAS v4u*)(XNR + (size_t)m * DM + 8 * F.lane) = pack8f(t);
#pragma unroll
                  for (int j = 0; j < 8; ++j) t[j] = y[8 + j];
                  *(GAS v4u*)(XNR + (size_t)m * DM + 512 + 8 * F.lane) = pack8f(t); }
#pragma unroll
                for (int e = 0; e < 4; ++e) { lg[h2][e] = l0[e]; lg[h2][4 + e] = l1[e]; } }
#pragma unroll
            for (int o = 1; o < 64; o <<= 1) {
#pragma unroll
                for (int e = 0; e < 8; ++e) { lg[0][e] += __shfl_xor(lg[0][e], o); lg[1][e] += __shfl_xor(lg[1][e], o); } }
#pragma unroll
            for (int h2 = 0; h2 < 2; ++h2) { const int lrow = F.wave * 32 + 16 * h2 + r;
                int e1 = 0; float v1 = lg[h2][0];
#pragma unroll
                for (int e = 1; e < 8; ++e) if (lg[h2][e] > v1) { v1 = lg[h2][e]; e1 = e; }
                int e2 = -1; float v2 = -INFINITY;
#pragma unroll
                for (int e = 0; e < 8; ++e) if (e != e1 && (e2 < 0 || lg[h2][e] > v2)) { v2 = lg[h2][e]; e2 = e; }
                const float g2 = 1.0f / (1.0f + expf(v1 - v2)), g1 = 1.0f - g2;
                if (F.lane == 0) {
                    const unsigned p1 = __hip_atomic_fetch_add(lcnt + e1, 1u, __ATOMIC_RELAXED, __HIP_MEMORY_SCOPE_WORKGROUP), p2 = __hip_atomic_fetch_add(lcnt + 8 + e2, 1u, __ATOMIC_RELAXED, __HIP_MEMORY_SCOPE_WORKGROUP);
                    LAS unsigned* rr = rec + lrow * 8; rr[0] = (unsigned)e1; rr[1] = p1; rr[2] = __float_as_uint(g1); rr[3] = (unsigned)e2; rr[4] = p2; rr[5] = __float_as_uint(g2);
                } }
        }
        __syncthreads();
        if (F.tid < 16) lbase[F.tid] = __hip_atomic_fetch_add(gcnt + F.tid, lcnt[F.tid], RLX_AGENT);
        __syncthreads();
        if (F.tid < 256) { const LAS unsigned* rr = rec + F.tid * 8; v4u a, b; a.x = rr[0]; a.y = rr[1] + lbase[rr[0]]; a.z = rr[2]; a.w = rr[3]; b.x = rr[4] + lbase[8 + rr[3]]; b.y = rr[5]; b.z = 0u; b.w = 0u;
            GAS v4u* ti = (GAS v4u*)(tokinfo + (size_t)(panel * 256 + F.tid) * 8); ti[0] = a; ti[1] = b; }
        __syncthreads();
    }
}
__device__ __forceinline__ void moe_prefix(const unsigned* gcnt_set, int (&pend)[8]) {
    int acc = 0;
#pragma unroll
    for (int e = 0; e < 8; ++e) { const unsigned c = __hip_atomic_load(gcnt_set + e, RLX_AGENT); acc += (int)((c + 255u) >> 8); pend[e] = acc; }
}
__device__ __forceinline__ void slots_phase(const Frame& F, const unsigned* gcnt, const unsigned* tokinfo, int* rowtok, float* rowgate) {
    int pe0[8], pe1[8]; moe_prefix(gcnt, pe0); moe_prefix(gcnt + 8, pe1);
    for (int t = F.vcu * NWAVES * 64 + F.tid; t < NTOK; t += F.G * NWAVES * 64) {
        const v4u a = *(const GAS v4u*)(tokinfo + (size_t)t * 8), b = *(const GAS v4u*)(tokinfo + (size_t)t * 8 + 4);
        const int e1 = (int)a.x, e2 = (int)a.w; int s1 = 0, s2 = 0;
#pragma unroll
        for (int k = 0; k < 7; ++k) { s1 = (e1 == k + 1) ? pe0[k] : s1; s2 = (e2 == k + 1) ? pe1[k] : s2; }
        const size_t slot1 = (size_t)s1 * 256 + a.y, slot2 = (size_t)SETROWS + (size_t)s2 * 256 + b.x;
        rowtok[slot1] = t; rowgate[slot1] = __uint_as_float(a.z); rowtok[slot2] = t; rowgate[slot2] = __uint_as_float(b.y);
    }
}

typedef short bf16x8v __attribute__((ext_vector_type(8)));
typedef float f32x16 __attribute__((ext_vector_type(16)));
constexpr int AT_KP = 144, AT_VP = 528, AT_VOFF = 256 * AT_KP;
__device__ __forceinline__ void attn_mfma_phase(const Frame& F, const bf16* QKV, const float* sinks, bf16* AO, int ao8) {
    LAS unsigned char* Ks = F.lds; LAS unsigned char* Vt = F.lds + AT_VOFF;
    const int q = F.lane & 31, hi = F.lane >> 5;
    v4u kreg[4], vreg[4];
#define AT_FETCH(unit_) do { const int b_ = (unit_) >> 7, n_ = ((unit_) >> 1) & 63, hk_ = (unit_) & 1; _Pragma("unroll") for (int i = 0; i < 4; ++i) { const int p = F.tid + 512 * i, key = p >> 3, ch = p & 7; \
        const int kt = (n_ == 0 && key < 128) ? key : (n_ - 1) * 128 + key;        \
        const bf16* src = QKV + ((size_t)b_ * SEQ + kt) * QKVD + 1024 + hk_ * 64 + ch * 8; kreg[i] = *(const GAS v4u*)src; vreg[i] = *(const GAS v4u*)(src + 128); } } while (0)
    int unit = F.vcu;
    if (unit < 8 * 64 * 2) AT_FETCH(unit);
    for (; unit < 8 * 64 * 2; unit += F.G) {
        const int b = unit >> 7, n = (unit >> 1) & 63, hk = unit & 1;
        const size_t tb = (size_t)b * SEQ;
#pragma unroll
        for (int i = 0; i < 4; ++i) { const int p = F.tid + 512 * i, key = p >> 3, ch = p & 7;
            *(LAS v4u*)(Ks + key * AT_KP + ch * 16) = kreg[i];
            const v4u v = vreg[i];
            const int kg = key & 15, kpos = (key & ~15) + (kg & 3) + ((kg >> 3) & 1) * 4 + ((kg >> 2) & 1) * 8;
            LAS unsigned short* vp = (LAS unsigned short*)(Vt + (ch * 8) * AT_VP + kpos * 2);
            vp[0 * (AT_VP / 2)] = (unsigned short)(v.x & 0xffffu); vp[1 * (AT_VP / 2)] = (unsigned short)(v.x >> 16); vp[2 * (AT_VP / 2)] = (unsigned short)(v.y & 0xffffu); vp[3 * (AT_VP / 2)] = (unsigned short)(v.y >> 16);
            vp[4 * (AT_VP / 2)] = (unsigned short)(v.z & 0xffffu); vp[5 * (AT_VP / 2)] = (unsigned short)(v.z >> 16); vp[6 * (AT_VP / 2)] = (unsigned short)(v.w & 0xffffu); vp[7 * (AT_VP / 2)] = (unsigned short)(v.w >> 16); }
        const int head = hk * 8 + F.wave; const float sk = sinks[head] * LOG2E;
        bf16x8v qf[4][4];
#pragma unroll
        for (int qt = 0; qt < 4; ++qt)
#pragma unroll
            for (int d0 = 0; d0 < 4; ++d0) qf[qt][d0] = *(const GAS bf16x8v*)(QKV + (tb + (size_t)n * 128 + qt * 32 + q) * QKVD + head * 64 + 16 * d0 + 8 * hi);
        if (unit + F.G < 8 * 64 * 2) AT_FETCH(unit + F.G);
        __syncthreads();
#pragma unroll
        for (int qt = 0; qt < 4; ++qt) {
            const size_t qrow = tb + (size_t)n * 128 + qt * 32 + q;
            f32x16 p[5];
#pragma unroll
            for (int j = 0; j < 5; ++j) {
                const int kt = qt + j;
                if (n == 0 && kt < 4) {
#pragma unroll
                    for (int r = 0; r < 16; ++r) p[j][r] = -INFINITY;
                } else {
                    f32x16 a = {0.f, 0.f, 0.f, 0.f, 0.f, 0.f, 0.f, 0.f, 0.f, 0.f, 0.f, 0.f, 0.f, 0.f, 0.f, 0.f};
                    const LAS unsigned char* kp = Ks + (32 * kt + q) * AT_KP + 16 * hi;
#pragma unroll
                    for (int d0 = 0; d0 < 4; ++d0) a = __builtin_amdgcn_mfma_f32_32x32x16_bf16(*(const LAS bf16x8v*)(kp + 32 * d0), qf[qt][d0], a, 0, 0, 0);
                    p[j] = a;
                }
            }
#pragma unroll
            for (int r = 0; r < 16; ++r) { const int key = (r & 3) + 8 * (r >> 2) + 4 * hi; if (key <= q) p[0][r] = -INFINITY; if (key > q) p[4][r] = -INFINITY; }
            float mx = sk;
#pragma unroll
            for (int j = 0; j < 5; ++j)
#pragma unroll
                for (int r = 0; r < 16; ++r) mx = fmaxf(mx, p[j][r]);
            mx = fmaxf(mx, __shfl_xor(mx, 32));
            float ls = 0.f;
#pragma unroll
            for (int j = 0; j < 5; ++j)
#pragma unroll
                for (int r = 0; r < 16; ++r) { p[j][r] = __builtin_amdgcn_exp2f(p[j][r] - mx); ls += p[j][r]; }
            ls += __shfl_xor(ls, 32); ls += __builtin_amdgcn_exp2f(sk - mx);
            f32x16 o0 = {0.f, 0.f, 0.f, 0.f, 0.f, 0.f, 0.f, 0.f, 0.f, 0.f, 0.f, 0.f, 0.f, 0.f, 0.f, 0.f}, o1 = o0;
#pragma unroll
            for (int j = 0; j < 5; ++j) {
                const int kt = qt + j;
                if (!(n == 0 && kt < 4)) {
#pragma unroll
                    for (int ks = 0; ks < 2; ++ks) {
                        v4u pw; pw.x = pk2(p[j][8 * ks + 0], p[j][8 * ks + 1]); pw.y = pk2(p[j][8 * ks + 2], p[j][8 * ks + 3]); pw.z = pk2(p[j][8 * ks + 4], p[j][8 * ks + 5]); pw.w = pk2(p[j][8 * ks + 6], p[j][8 * ks + 7]);
                        const bf16x8v pf = __builtin_bit_cast(bf16x8v, pw);
                        const LAS unsigned char* vp = Vt + q * AT_VP + (32 * kt + 16 * ks + 8 * hi) * 2;
                        o0 = __builtin_amdgcn_mfma_f32_32x32x16_bf16(*(const LAS bf16x8v*)vp, pf, o0, 0, 0, 0);
                        o1 = __builtin_amdgcn_mfma_f32_32x32x16_bf16(*(const LAS bf16x8v*)(vp + 32 * AT_VP), pf, o1, 0, 0, 0);
                    }
                }
            }
            const float il = 1.0f / ls;
            if (ao8) { unsigned char* orow8 = (unsigned char*)AO + qrow * DM + head * 64 + 8 * hi; const float il8 = il * 8.0f;
#pragma unroll
                for (int jg = 0; jg < 4; jg += 2) { unsigned a0 = 0u, b0 = 0u, a1 = 0u, b1 = 0u;
                    a0 = __builtin_amdgcn_cvt_pk_fp8_f32(o0[4 * jg] * il8, o0[4 * jg + 1] * il8, a0, false); a0 = __builtin_amdgcn_cvt_pk_fp8_f32(o0[4 * jg + 2] * il8, o0[4 * jg + 3] * il8, a0, true);
                    b0 = __builtin_amdgcn_cvt_pk_fp8_f32(o0[4 * jg + 4] * il8, o0[4 * jg + 5] * il8, b0, false); b0 = __builtin_amdgcn_cvt_pk_fp8_f32(o0[4 * jg + 6] * il8, o0[4 * jg + 7] * il8, b0, true);
                    a1 = __builtin_amdgcn_cvt_pk_fp8_f32(o1[4 * jg] * il8, o1[4 * jg + 1] * il8, a1, false); a1 = __builtin_amdgcn_cvt_pk_fp8_f32(o1[4 * jg + 2] * il8, o1[4 * jg + 3] * il8, a1, true);
                    b1 = __builtin_amdgcn_cvt_pk_fp8_f32(o1[4 * jg + 4] * il8, o1[4 * jg + 5] * il8, b1, false); b1 = __builtin_amdgcn_cvt_pk_fp8_f32(o1[4 * jg + 6] * il8, o1[4 * jg + 7] * il8, b1, true);
                    { auto r = __builtin_amdgcn_permlane32_swap(a0, b0, false, false); a0 = r[0]; b0 = r[1]; }
                    { auto r = __builtin_amdgcn_permlane32_swap(a1, b1, false, false); a1 = r[0]; b1 = r[1]; }
                    *(GAS v2u*)(orow8 + 8 * jg) = (v2u){a0, b0}; *(GAS v2u*)(orow8 + 32 + 8 * jg) = (v2u){a1, b1}; }
                continue; }
            bf16* orow = AO + qrow * DM + head * 64 + 8 * hi;
#pragma unroll
            for (int jg = 0; jg < 4; jg += 2) { v2u a0, b0, a1, b1;
                a0.x = pk2(o0[4 * jg] * il, o0[4 * jg + 1] * il); a0.y = pk2(o0[4 * jg + 2] * il, o0[4 * jg + 3] * il);
                b0.x = pk2(o0[4 * jg + 4] * il, o0[4 * jg + 5] * il); b0.y = pk2(o0[4 * jg + 6] * il, o0[4 * jg + 7] * il);
                a1.x = pk2(o1[4 * jg] * il, o1[4 * jg + 1] * il); a1.y = pk2(o1[4 * jg + 2] * il, o1[4 * jg + 3] * il);
                b1.x = pk2(o1[4 * jg + 4] * il, o1[4 * jg + 5] * il); b1.y = pk2(o1[4 * jg + 6] * il, o1[4 * jg + 7] * il);
                { auto r = __builtin_amdgcn_permlane32_swap(a0.x, b0.x, false, false); a0.x = r[0]; b0.x = r[1]; }
                { auto r = __builtin_amdgcn_permlane32_swap(a0.y, b0.y, false, false); a0.y = r[0]; b0.y = r[1]; }
                { auto r = __builtin_amdgcn_permlane32_swap(a1.x, b1.x, false, false); a1.x = r[0]; b1.x = r[1]; }
                { auto r = __builtin_amdgcn_permlane32_swap(a1.y, b1.y, false, false); a1.y = r[0]; b1.y = r[1]; }
                *(GAS v4u*)(orow + 8 * jg) = (v4u){a0.x, a0.y, b0.x, b0.y}; *(GAS v4u*)(orow + 32 + 8 * jg) = (v4u){a1.x, a1.y, b1.x, b1.y}; }
        }
        __syncthreads();
    }
#undef AT_FETCH
}

typedef float f32x2 __attribute__((ext_vector_type(2)));
__device__ __forceinline__ f32x2 gelu_pk(f32x2 v) {
    const f32x2 av = __builtin_elementwise_abs(v), d = av * 0.2316418882f + 1.0f;
    f32x2 t; t.x = __builtin_amdgcn_rcpf(d.x); t.y = __builtin_amdgcn_rcpf(d.y);
    f32x2 q = t * 0.5307027145f + (-0.7265760135f); q = q * t + 0.7107068705f; q = q * t + (-0.142248368f); q = q * t + 0.127414796f; q = q * t;
    const f32x2 s = (v * v) * (-0.72134752044f);
    f32x2 e; e.x = __builtin_amdgcn_exp2f(s.x); e.y = __builtin_amdgcn_exp2f(s.y);
    const f32x2 m = v * (q * e), r = v - m;
    f32x2 o; o.x = v.x < 0.f ? m.x : r.x; o.y = v.y < 0.f ? m.y : r.y; return o;
}
constexpr int ZP = 2048;
__device__ __forceinline__ int mx_swz(int row) { return (row ^ (row >> 4)) & 15; }
__device__ __forceinline__ void mixer_fused_phase(const Frame& F, const bf16* Z, bf16* Y, const float* convw, const float* lng, const float* lnb, const bf16* Wb, const float* sb, int pmode = 0) {
    LAS unsigned char* vt = F.lds;
    const int c8 = 8 * F.lane, q = F.lane & 31, hi = F.lane >> 5;
    for (int unit = F.vcu; unit < NTOK / 128; unit += F.G) {
        const size_t t0 = (size_t)unit * 128;
        if (pmode != 2) {
            float cw0[8], cw1[8], cw2[8], lg[8], lb[8];
#pragma unroll
            for (int j = 0; j < 8; ++j) { cw0[j] = convw[(c8 + j) * 3 + 0]; cw1[j] = convw[(c8 + j) * 3 + 1]; cw2[j] = convw[(c8 + j) * 3 + 2]; lg[j] = lng[c8 + j]; lb[j] = lnb[c8 + j]; }
            const size_t tw = t0 + 16 * F.wave;
            float cx1[8], cx2[8];
            if ((tw % SEQ) != 0) {
                unpack8(*(const GAS v4u*)(Z + (tw - 1) * ZP + 512 + c8), cx1);
                unpack8(*(const GAS v4u*)(Z + (tw - 2) * ZP + 512 + c8), cx2);
            } else {
#pragma unroll
                for (int j = 0; j < 8; ++j) { cx1[j] = 0.f; cx2[j] = 0.f; }
            }
            constexpr int NTB = 2;
            v4u nab[NTB], ncx[NTB], nbv[NTB];
#pragma unroll
            for (int k = 0; k < NTB; ++k) { const bf16* zr = Z + (tw + k) * ZP; nab[k] = *(const GAS v4u*)(zr + c8); ncx[k] = *(const GAS v4u*)(zr + 512 + c8); nbv[k] = *(const GAS v4u*)(zr + 1536 + c8); }
#pragma unroll 1
            for (int r0 = 0; r0 < 16; r0 += NTB) {
                v4u wab[NTB], wcx[NTB], wbv[NTB];
#pragma unroll
                for (int k = 0; k < NTB; ++k) { wab[k] = nab[k]; wcx[k] = ncx[k]; wbv[k] = nbv[k]; }
                if (r0 + NTB < 16) {
#pragma unroll
                    for (int k = 0; k < NTB; ++k) { const bf16* zr = Z + (tw + r0 + NTB + k) * ZP; nab[k] = *(const GAS v4u*)(zr + c8); ncx[k] = *(const GAS v4u*)(zr + 512 + c8); nbv[k] = *(const GAS v4u*)(zr + 1536 + c8); } }
                float vv[NTB][8], s[NTB];
#pragma unroll
                for (int k = 0; k < NTB; ++k) {
                    float ab[8], cxv[8], bv[8], ya[8];
                    unpack8(wab[k], ab); unpack8(wcx[k], cxv); unpack8(wbv[k], bv);
#pragma unroll
                    for (int j = 0; j < 8; ++j) { const float cx0 = cxv[j]; ya[j] = ab[j] * (cw0[j] * cx2[j] + cw1[j] * cx1[j] + cw2[j] * cx0); cx2[j] = cx1[j]; cx1[j] = cx0; }
                    *(GAS v4u*)(Y + (tw + r0 + k) * DM + c8) = pack8f(ya);
                    float sk = 0.f;
#pragma unroll
                    for (int j = 0; j < 8; j += 2) { const f32x2 gv = gelu_pk((f32x2){bv[j], bv[j + 1]}); vv[k][j] = gv.x; vv[k][j + 1] = gv.y; sk += gv.x + gv.y; }
                    s[k] = sk;
                }
#pragma unroll
                for (int o = 1; o < 64; o <<= 1) {
#pragma unroll
                    for (int k = 0; k < NTB; ++k) s[k] += __shfl_xor(s[k], o); }
                float q[NTB];
#pragma unroll
                for (int k = 0; k < NTB; ++k) { const float mu = s[k] * (1.f / 512.f); float qq = 0.f;
#pragma unroll
                    for (int j = 0; j < 8; ++j) { vv[k][j] -= mu; qq += vv[k][j] * vv[k][j]; }
                    q[k] = qq; }
#pragma unroll
                for (int o = 1; o < 64; o <<= 1) {
#pragma unroll
                    for (int k = 0; k < NTB; ++k) q[k] += __shfl_xor(q[k], o); }
#pragma unroll
                for (int k = 0; k < NTB; ++k) { const float rstd = 1.0f / sqrtf(q[k] * (1.f / 512.f) + EPS); const int jl = 16 * F.wave + r0 + k;
#pragma unroll
                    for (int j = 0; j < 8; ++j) { const int row = c8 + j; const float y = vv[k][j] * rstd * lg[j] + lb[j];
                        *(LAS unsigned short*)(vt + row * 256 + (((jl >> 3) ^ mx_swz(row)) << 4) + (jl & 7) * 2) = f2bf1(y); } }
            }
        }
        __syncthreads();
        if (pmode != 1) {
            const int h = F.wave >> 1, dt0 = 2 * (F.wave & 1);
            v2u bwa[4][2][4];
#pragma unroll
            for (int it = 0; it < 4; ++it) {
#pragma unroll
                for (int dl = 0; dl < 2; ++dl)
#pragma unroll
                    for (int jg = 0; jg < 4; ++jg) bwa[it][dl][jg] = *(const GAS v2u*)(Z + (t0 + 32 * it + q) * ZP + 1024 + h * 128 + 32 * (dt0 + dl) + 4 * hi + 8 * jg);
            }
#pragma unroll
            for (int it = 0; it < 4; ++it) {
                const size_t tok = t0 + 32 * it + q; const float sbv = sb[h * 128 + 32 * it + q];
                bf16x8v wf[8];
                const bf16* wrow = Wb + (size_t)(h * 128 + 32 * it + q) * 128 + 8 * hi;
#pragma unroll
                for (int ks = 0; ks < 2 * (it + 1); ++ks) wf[ks] = *(const GAS bf16x8v*)(wrow + 16 * ks);
#pragma unroll
                for (int dl = 0; dl < 2; ++dl) {
                    const int dt = dt0 + dl, row = h * 128 + 32 * dt + q; const LAS unsigned char* ap = vt + row * 256; const int sw = mx_swz(row);
                    f32x16 acc = {0.f, 0.f, 0.f, 0.f, 0.f, 0.f, 0.f, 0.f, 0.f, 0.f, 0.f, 0.f, 0.f, 0.f, 0.f, 0.f};
#pragma unroll
                    for (int ks = 0; ks < 2 * (it + 1); ++ks) acc = __builtin_amdgcn_mfma_f32_32x32x16_bf16(*(const LAS bf16x8v*)(ap + (((2 * ks + hi) ^ sw) << 4)), wf[ks], acc, 0, 0, 0);
                    const int cb = h * 128 + 32 * dt + 8 * hi;
                    v2u wv[4];
#pragma unroll
                    for (int jg = 0; jg < 4; ++jg) { const v2u bw = bwa[it][dl][jg];
                        const f32x2 u0 = gelu_pk((f32x2){bflo(bw.x), bfhi(bw.x)}), u1 = gelu_pk((f32x2){bflo(bw.y), bfhi(bw.y)});
                        wv[jg].x = pk2(u0.x * (acc[4 * jg] + sbv), u0.y * (acc[4 * jg + 1] + sbv)); wv[jg].y = pk2(u1.x * (acc[4 * jg + 2] + sbv), u1.y * (acc[4 * jg + 3] + sbv)); }
#pragma unroll
                    for (int jg = 0; jg < 4; jg += 2) { v2u a = wv[jg], b = wv[jg + 1];
                        { auto r = __builtin_amdgcn_permlane32_swap(a.x, b.x, false, false); a.x = r[0]; b.x = r[1]; }
                        { auto r = __builtin_amdgcn_permlane32_swap(a.y, b.y, false, false); a.y = r[0]; b.y = r[1]; }
                        *(GAS v4u*)(Y + tok * DM + 512 + cb + 8 * jg) = (v4u){a.x, a.y, b.x, b.y}; }
                }
            }
        }
        __syncthreads();
    }
}

struct Args {
    const float* x; const int* pos; const float* fng;
    const float *e_n1, *e_win, *e_conv, *e_lng, *e_lnb, *e_sw, *e_sb, *e_wout, *e_n2, *e_wg, *e_wu, *e_wd;
    const float *o_n1, *o_wqkv, *o_bqkv, *o_sinks, *o_wo, *o_bo, *o_n2, *o_rw, *o_ewg, *o_ewu, *o_ewd;
    float* out; unsigned char* ws; int lo, hi, li, pad;
};
constexpr int PH_PER_PAIR = 16;
#ifndef F8_MOE_MASK
#define F8_MOE_MASK 3
#endif
#define F8M(i) (F8_MOE_MASK == 3 ? 1 : ((F8_MOE_MASK >> (i)) & 1))
#ifndef F8_FFN_MASK
#define F8_FFN_MASK 2
#endif
#define F8F(i) ((F8_FFN_MASK >> (i)) & 1)
#ifndef F8_QKV_MASK
#define F8_QKV_MASK 2
#endif
#define F8Q(i) (((F8_QKV_MASK & F8_FFN_MASK) >> (i)) & 1)
#ifndef F8_WO_MASK
#define F8_WO_MASK 2
#endif
#define F8O(i) ((F8_WO_MASK >> (i)) & 1)
#ifndef F8_H1SCALE
#define F8_H1SCALE 8.0f
#define F8_H1SCALE_I 8
constexpr size_t H1SET8 = (size_t)SETROWS * EXPD;
static_assert(WS_BIG + 2 * H1SET8 <= WS_END, "two e4m3 H1 buffers");
#endif
#ifndef WGM_MOEGU
#define WGM_MOEGU 4
#endif
#ifndef WGM_N1024
#define WGM_N1024 4
#endif
#ifndef WGM_E1
#define WGM_E1 4
#endif
#ifndef WGM_FFNGU
#define WGM_FFNGU 4
#endif
#ifndef WGM_QKV
#define WGM_QKV 4
#endif
#ifndef PROBE_MODE
#define PROBE_MODE 0
#endif
#ifndef PROBE_STAG
#define PROBE_STAG 0
#endif
#ifndef STAG_MOEGU
#define STAG_MOEGU 0
#endif
#ifndef STAG_FFNGU
#define STAG_FFNGU 0
#endif
constexpr int N_PHASES = 1 + 2 * PH_PER_PAIR + 1;

typedef const __attribute__((address_space(4))) Args* ArgsP;
#define PH_ARGS(ap) ArgsP ap = (ArgsP)__builtin_amdgcn_kernarg_segment_ptr(); asm volatile("" : "+s"(ap))
__device__ __forceinline__ Frame make_frame(LAS unsigned char* lds) {
    Frame F; int tid = threadIdx.x; asm volatile("" : "+v"(tid));
    F.lds = lds; F.tid = tid; F.lane = tid & 63; F.wave = __builtin_amdgcn_readfirstlane(tid >> 6);
    F.G = gridDim.x; { const int bx = blockIdx.x; F.vcu = (F.G % 8 == 0) ? (bx % 8) * (F.G / 8) + bx / 8 : bx; }
    return F;
}
__global__ void __launch_bounds__(NWAVES * 64, 2) fwd(Args A_unused) {
    extern __shared__ __attribute__((aligned(16))) unsigned char lds_raw[];
    LAS unsigned char* const lds = (LAS unsigned char*)lds_raw;
    asm volatile("s_setreg_imm32_b32 hwreg(HW_REG_MODE, 23, 1), 1");
    for (int u = threadIdx.x; u < (LDS_BYTES - LDSCTL_OFF) / 4; u += NWAVES * 64) ((LAS unsigned*)(lds + LDSCTL_OFF))[u] = 0u;
    __syncthreads();
    int lo, hi;
    { PH_ARGS(ap); lo = ap->lo; hi = ap->hi; }
#if MK_ONE_LAUNCH
    XcdBarrier bar;
    { PH_ARGS(ap); bar = xcd_barrier_post((unsigned*)(ap->ws + WS_CTL) + CW_BAR, (volatile LAS unsigned*)(lds + MISC_OFF) + 8); }
#define GRID_BAR() xcd_barrier(bar)
#else
#define GRID_BAR() do { } while (0)
#endif
#ifndef PHMASK
#define PHMASK 0xFFFFFFFFu
#endif
#define PHEN(k) (((PHMASK) >> (k)) & 1u)
#ifndef PROBE_DUP
#define PROBE_DUP 0u
#endif
#define DUP(k) (1 + (int)(((PROBE_DUP) >> (k)) & 1u))
#define IN(k) (lo <= (k) && (k) < hi)
#define SEAM(k) do { if (IN(k) && IN((k) + 1)) GRID_BAR(); } while (0)
#define PH_BEGIN() PH_ARGS(ap); const Frame F = make_frame(lds); unsigned char* const ws = ap->ws; const int G = F.G, cblk = (int)blockIdx.x; (void)G; (void)cblk

    if (IN(0) && PHEN(16)) { PH_BEGIN(); rope_table_phase(F, ap->pos, (float*)(ws + WS_CS)); }

#pragma unroll 1
    for (int i = 0; i < 2; ++i) {
        const int pb = 1 + i * PH_PER_PAIR;
        if (IN(pb + 0) && PHEN(0)) { PH_BEGIN(); for (int rep_ = 0; rep_ < DUP(0); ++rep_) { conv_even_phase(F, ap->e_win + (size_t)i * DM * MIXIN, ap->e_wout + (size_t)i * DM * DM, ap->e_wg + (size_t)i * DM * FFN, ap->e_wu + (size_t)i * DM * FFN, ap->e_wd + (size_t)i * FFN * DM, ap->e_sw + (size_t)i * 4 * 128 * 128, ap->e_n1 + i * DM, ap->e_n2 + i * DM, ws, F8F(i) ? 1 : 0);
                          if (i == 0) xcast_phase(F, ap->x, (bf16*)(ws + WS_XN), (float*)(ws + WS_SSP)); } } SEAM(pb + 0);
        if (IN(pb + 1) && PHEN(1)) { PH_BEGIN(); for (int rep_ = 0; rep_ < DUP(1); ++rep_) { pg8::Gemm g{(const bf16*)(ws + WS_XN), (const bf16*)(ws + WS_WIN), DM, 0}; pg8::StaticOrder S; S.init(NTOK, MIXIN, G, cblk, WGM_E1); if (rep_ + 1 < DUP(1)) {
#if PROBE_MODE >= 10
                              pg8::EpiMixIn E0{(bf16*)(ws + WS_BIG), PROBE_MODE == 10 ? (const float*)(ws + WS_SSP) : (const float*)nullptr}; pg8::gemm_phase<pg8::EpiMixIn, pg8::StaticOrder, true, true>(F.lds, g, S, E0);
#else
                              pg8::EpiProbe<PROBE_MODE> E0{(bf16*)(ws + WS_BIG), 2048}; pg8::gemm_phase<pg8::EpiProbe<PROBE_MODE>, pg8::StaticOrder, true, true>(F.lds, g, S, E0, PROBE_STAG);
#endif
                          }
                          else { pg8::EpiMixIn E{(bf16*)(ws + WS_BIG), (const float*)(ws + WS_SSP)};
                          pg8::gemm_phase<pg8::EpiMixIn, pg8::StaticOrder, true, true>(F.lds, g, S, E); } } } SEAM(pb + 1);
        if (IN(pb + 2) && PHEN(2)) { PH_BEGIN(); for (int rep_ = 0; rep_ < DUP(2); ++rep_) { mixer_fused_phase(F, (const bf16*)(ws + WS_BIG), (bf16*)(ws + WS_BIG + WS_YOFF), ap->e_conv + i * 512 * 3, ap->e_lng + i * 512, ap->e_lnb + i * 512, (const bf16*)(ws + WS_WSP), ap->e_sb + i * 4 * 128, (rep_ + 1 < DUP(2)) ? PROBE_MODE : 0); } } SEAM(pb + 2);
        if (IN(pb + 3) && PHEN(4)) { PH_BEGIN(); pg8::Gemm g{(const bf16*)(ws + WS_BIG + WS_YOFF), (const bf16*)(ws + WS_WOUT), DM, 0}; pg8::StaticOrder S; S.init(NTOK, DM, G, cblk, WGM_N1024);
                          if (F8F(i)) { typedef pg8::EpiResB<false, 1, (long)WS_XG - (long)WS_XN> EpiT; EpiT E{(bf16*)(ws + WS_XN), nullptr, (float*)(ws + WS_SSP), (LAS float*)(F.lds + TAB_OFF), 1};
                              pg8::gemm_phase<EpiT, pg8::StaticOrder, true, true>(F.lds, g, S, E); }
                          else { pg8::EpiResB<true> E{(bf16*)(ws + WS_XN), nullptr, (float*)(ws + WS_SSP), (LAS float*)(F.lds + TAB_OFF), 1};
                          pg8::gemm_phase<pg8::EpiResB<true>, pg8::StaticOrder, true, true>(F.lds, g, S, E); } } SEAM(pb + 3);
        if (IN(pb + 4) && PHEN(6)) { PH_BEGIN(); for (int rep_ = 0; rep_ < DUP(6); ++rep_) { if (F8F(i)) { pg8::Gemm g{(const bf16*)(ws + WS_XG), (const bf16*)(ws + WS_FGU), DM / 2, 0}; pg8::StaticOrder S; S.init(NTOK, 2 * FFN, G, cblk, WGM_FFNGU, DM / 128);
                              pg8::EpiSwiGLU E{(bf16*)(ws + WS_BIG), FFN, (const float*)(ws + WS_SSP), 1.0f / 64.0f, F8_H1SCALE}; pg8::gemm_phase2<pg8::EpiSwiGLU, pg8::StaticOrder, false, false, true>(F.lds, g, S, E, nullptr, STAG_FFNGU); }
                          else { pg8::Gemm g{(const bf16*)(ws + WS_XN), (const bf16*)(ws + WS_FGU), DM, 0}; pg8::StaticOrder S; S.init(NTOK, 2 * FFN, G, cblk, WGM_FFNGU);
                          pg8::EpiSwiGLU E{(bf16*)(ws + WS_BIG), FFN, (const float*)(ws + WS_SSP), 1.0f, 0.0f}; pg8::gemm_phase<pg8::EpiSwiGLU, pg8::StaticOrder, true, true>(F.lds, g, S, E, STAG_FFNGU); } } } SEAM(pb + 4);
        if (IN(pb + 5) && PHEN(7)) { PH_BEGIN();
                          if (F8F(i)) { pg8::Gemm g{(const bf16*)(ws + WS_BIG), (const bf16*)(ws + WS_FD), FFN / 2, 0}; pg8::StaticOrder S; S.init(NTOK, DM, G, cblk, WGM_N1024, FFN / 128);
                              if (F8Q(i)) { typedef pg8::EpiResB<false, 64 * F8_H1SCALE_I, (long)WS_XG - (long)WS_XN> EpiT; EpiT E{(bf16*)(ws + WS_XN), nullptr, (float*)(ws + WS_SSP), (LAS float*)(F.lds + TAB_OFF), 1};
                                  pg8::gemm_phase2<EpiT, pg8::StaticOrder, false, false, true>(F.lds, g, S, E, nullptr); }
                              else { typedef pg8::EpiResB<true, 64 * F8_H1SCALE_I> EpiT; EpiT E{(bf16*)(ws + WS_XN), nullptr, (float*)(ws + WS_SSP), (LAS float*)(F.lds + TAB_OFF), 1};
                              pg8::gemm_phase2<EpiT, pg8::StaticOrder, false, false, true>(F.lds, g, S, E, nullptr); } }
                          else { pg8::Gemm g{(const bf16*)(ws + WS_BIG), (const bf16*)(ws + WS_FD), FFN, 0}; pg8::StaticOrder S; S.init(NTOK, DM, G, cblk, WGM_N1024);
                          pg8::EpiResB<true> E{(bf16*)(ws + WS_XN), nullptr, (float*)(ws + WS_SSP), (LAS float*)(F.lds + TAB_OFF), 1};
                          pg8::gemm_phase<pg8::EpiResB<true>, pg8::StaticOrder, true, true>(F.lds, g, S, E); } }
        if (IN(pb + 6) && PHEN(8)) { PH_BEGIN(); for (int rep_ = 0; rep_ < DUP(8); ++rep_) { conv_odd_phase(F, ap->o_wqkv + (size_t)i * DM * QKVD, ap->o_wo + (size_t)i * DM * DM, ap->o_ewg + (size_t)i * NEXP * DM * EXPD, ap->o_ewu + (size_t)i * NEXP * DM * EXPD, ap->o_ewd + (size_t)i * NEXP * EXPD * DM, ap->o_n1 + i * DM, ws, (F8M(i) ? 1 : 0) | (F8Q(i) ? 2 : 0) | (F8O(i) ? 4 : 0)); } } SEAM(pb + 6);
        if (IN(pb + 7) && PHEN(9)) { PH_BEGIN(); for (int rep_ = 0; rep_ < DUP(9); ++rep_) { if (F8Q(i)) { pg8::Gemm g{(const bf16*)(ws + WS_XG), (const bf16*)(ws + WS_WQKV), DM / 2, 0}; pg8::StaticOrder S; S.init(NTOK, QKVD, G, cblk, WGM_QKV, DM / 128);
                              pg8::EpiQKVT<64> E{(bf16*)(ws + WS_BIG), ap->o_bqkv + i * QKVD, (const float*)(ws + WS_CS), QSCALE, (const float*)(ws + WS_SSP), (LAS float*)(F.lds + TAB_OFF)};
                              pg8::gemm_phase2<pg8::EpiQKVT<64>, pg8::StaticOrder, false, false, true>(F.lds, g, S, E, nullptr); }
                          else { pg8::Gemm g{(const bf16*)(ws + WS_XN), (const bf16*)(ws + WS_WQKV), DM, 0}; pg8::StaticOrder S; S.init(NTOK, QKVD, G, cblk, WGM_QKV); pg8::EpiQKV E{(bf16*)(ws + WS_BIG), ap->o_bqkv + i * QKVD, (const float*)(ws + WS_CS), QSCALE, (const float*)(ws + WS_SSP), (LAS float*)(F.lds + TAB_OFF)};
                          pg8::gemm_phase<pg8::EpiQKV, pg8::StaticOrder, true, true>(F.lds, g, S, E); } } } SEAM(pb + 7);
        if (IN(pb + 8) && PHEN(10)) { PH_BEGIN(); for (int rep_ = 0; rep_ < DUP(10); ++rep_) { attn_mfma_phase(F, (const bf16*)(ws + WS_BIG), ap->o_sinks + i * 16, (bf16*)(ws + WS_BIG + WS_AOOFF), F8O(i) ? 1 : 0); } } SEAM(pb + 8);
        if (IN(pb + 9) && PHEN(11)) { PH_BEGIN();
                           if (F8O(i)) { pg8::Gemm g{(const bf16*)(ws + WS_BIG + WS_AOOFF), (const bf16*)(ws + WS_WO), DM / 2, 0}; pg8::StaticOrder S; S.init(NTOK, DM, G, cblk, WGM_N1024, DM / 128);
                               typedef pg8::EpiResB<false, 64 * 8> EpiT; EpiT E{(bf16*)(ws + WS_XN), ap->o_bo + i * DM, nullptr, nullptr, 0};
                               pg8::gemm_phase2<EpiT, pg8::StaticOrder, false, false, true>(F.lds, g, S, E, nullptr); }
                           else { pg8::Gemm g{(const bf16*)(ws + WS_BIG + WS_AOOFF), (const bf16*)(ws + WS_WO), DM, 0}; pg8::StaticOrder S; S.init(NTOK, DM, G, cblk, WGM_N1024); pg8::EpiResB<false> E{(bf16*)(ws + WS_XN), ap->o_bo + i * DM, nullptr, nullptr, 0};
                           pg8::gemm_phase<pg8::EpiResB<false>, pg8::StaticOrder, true, true>(F.lds, g, S, E); } } SEAM(pb + 9);
        if (IN(pb + 10) && PHEN(12)) { PH_BEGIN(); rms_router_phase(F, (const bf16*)(ws + WS_XN), ap->o_n2 + i * DM, ap->o_rw + (size_t)i * DM * NEXP, (bf16*)(ws + WS_XG), (unsigned*)(ws + WS_CTL) + CW_CNT + 64 * i, (unsigned*)(ws + WS_TOKINFO), (int*)(ws + WS_ROWTOK), F8M(i) ? 1 : 0); } SEAM(pb + 10);
        if (IN(pb + 11) && PHEN(13)) { PH_BEGIN(); slots_phase(F, (const unsigned*)(ws + WS_CTL) + CW_CNT + 64 * i, (const unsigned*)(ws + WS_TOKINFO), (int*)(ws + WS_ROWTOK), (float*)(ws + WS_ROWGATE)); } SEAM(pb + 11);
#pragma unroll 1
        for (int s = 0; s < 2; ++s) {
            const int ps = pb + 12 + 2 * s;
            if (IN(ps + 0) && PHEN(14)) { PH_BEGIN(); for (int rep_ = 0; rep_ < DUP(14); ++rep_) {
                LAS unsigned short* tab = (LAS unsigned short*)(F.lds + TAB_OFF); LAS unsigned* ut = (LAS unsigned*)(F.lds + LDSCTL_OFF); int nun;
                { int pend[8]; moe_prefix((const unsigned*)(ws + WS_CTL) + CW_CNT + 64 * i + 8 * s, pend);
                  pg8::MoeOrder S; S.nM = pend[7]; S.nN = 2 * EXPD / 256; S.nwg = S.nM * S.nN; S.G = G; S.c = cblk; S.NT = F8M(i) ? DM / 128 : DM / 64; S.wgm = WGM_MOEGU; S.splitk = false; S.p0 = pend[0]; S.p1 = pend[1]; S.p2 = pend[2]; S.p3 = pend[3]; S.p4 = pend[4]; S.p5 = pend[5]; S.p6 = pend[6];
                  nun = 0; pg8::Unit u = {0, 0, 0, 0, 0, 0}; const int* rt = (const int*)(ws + WS_ROWTOK) + (size_t)s * SETROWS;
                  for (int r = 0; r < TAB_ROUNDS && S.next(r, u); ++r) { if (F.tid == 0) pg8::TabOrder::put(ut, r, u);
                      if (F.tid < 256) { const int tk = rt[(size_t)u.pm * 256 + F.tid]; tab[r * 256 + F.tid] = (unsigned short)(tk < 0 ? 0 : tk); } ++nun; } }
                __syncthreads();
                pg8::TabOrder T{ut, nun, 0};
                if (F8M(i)) {
                    pg8::Gemm g{(const bf16*)(ws + WS_XG), (const bf16*)(ws + WS_MGU), DM / 2, (size_t)2 * EXPD * DM}; pg8::EpiSwiGLU E{(bf16*)(ws + WS_BIG + (size_t)s * H1SET8), EXPD, nullptr, 1.0f / 64.0f, F8_H1SCALE};
                    pg8::gemm_phase2<pg8::EpiSwiGLU, pg8::TabOrder, true, false, true>(F.lds, g, T, E, tab, STAG_MOEGU); }
                else { pg8::Gemm g{(const bf16*)(ws + WS_XG), (const bf16*)(ws + WS_MGU), DM, (size_t)2 * EXPD * DM * 2}; pg8::EpiSwiGLU E{(bf16*)(ws + WS_BIG), EXPD, nullptr, 1.0f, 0.0f};
                    pg8::gemm_phase2<pg8::EpiSwiGLU, pg8::TabOrder, true>(F.lds, g, T, E, tab, STAG_MOEGU); }
                __syncthreads(); } } SEAM(ps + 0);
            if (IN(ps + 1) && PHEN(15)) { PH_BEGIN();
                LAS unsigned* ut = (LAS unsigned*)(F.lds + LDSCTL_OFF); int nun, nq;
                { int pend[8]; moe_prefix((const unsigned*)(ws + WS_CTL) + CW_CNT + 64 * i + 8 * s, pend);
                  pg8::MoeOrder S; S.nM = pend[7]; S.nN = DM / 256; S.nwg = S.nM * S.nN; S.G = G; S.c = cblk; S.NT = F8M(i) ? EXPD / 128 : EXPD / 64; S.wgm = WGM_N1024; S.splitk = !(s == 1 && i == 0);     S.p0 = pend[0]; S.p1 = pend[1]; S.p2 = pend[2]; S.p3 = pend[3]; S.p4 = pend[4]; S.p5 = pend[5]; S.p6 = pend[6];
                  nun = 0; nq = 0; pg8::Unit u = {0, 0, 0, 0, 0, 0}; for (int r = 0; r < 32 && S.next(r, u); ++r) { if (u.split) { if (F.tid == 0) pg8::TabOrder::put(ut + 64, nq, u); ++nq; } else { if (F.tid == 0) pg8::TabOrder::put(ut, nun, u); ++nun; } } }
                __syncthreads();
                const int normf = (s == 1 && i == 0) ? 1 : 0;
                LAS int* ltab = (LAS int*)(F.lds + TAB_OFF + (normf ? 4096 : 0));
                { const int* rt = (const int*)(ws + WS_ROWTOK) + (size_t)s * SETROWS; const int* rg = (const int*)(ws + WS_ROWGATE) + (size_t)s * SETROWS;
                  if (F.tid < 256) { for (int r = 0; r < nun + nq; ++r) { const int pm = (int)((r < nun ? ut[2 * r] : ut[64 + 2 * (r - nun)]) & 0xffffu);
                      ltab[r * 512 + F.tid] = rt[(size_t)pm * 256 + F.tid]; ltab[r * 512 + 256 + F.tid] = rg[(size_t)pm * 256 + F.tid]; } } }
                __syncthreads();
                pg8::TabOrder T{ut, nun, 0}, TQ{ut + 64, nq, nun};
                if (F8M(i)) {
                    pg8::Gemm g{(const bf16*)(ws + WS_BIG + (size_t)s * H1SET8), (const bf16*)(ws + WS_MD), EXPD / 2, (size_t)DM * EXPD};
                    pg8::EpiMoeDown E{ltab, (bf16*)(ws + WS_XN), (float*)(ws + WS_SSP), (LAS float*)(F.lds + TAB_OFF), normf, 1.0f / (64.0f * F8_H1SCALE)};
                    pg8::gemm_phase2<pg8::EpiMoeDown, pg8::TabOrder, false, false, true>(F.lds, g, T, E, nullptr); __syncthreads();
                    if (nq > 0) { pg8::gemm_phase2<pg8::EpiMoeDown, pg8::TabOrder, false, true, true>(F.lds, g, TQ, E, nullptr); __syncthreads(); } }
                else {
                pg8::Gemm g{(const bf16*)(ws + WS_BIG), (const bf16*)(ws + WS_MD), EXPD, (size_t)DM * EXPD * 2};
                pg8::EpiMoeDown E{ltab, (bf16*)(ws + WS_XN), (float*)(ws + WS_SSP), (LAS float*)(F.lds + TAB_OFF), normf, 1.0f};
                pg8::gemm_phase2<pg8::EpiMoeDown, pg8::TabOrder, false>(F.lds, g, T, E, nullptr); __syncthreads();
                if (nq > 0) { pg8::gemm_phase2<pg8::EpiMoeDown, pg8::TabOrder, false, true>(F.lds, g, TQ, E, nullptr); __syncthreads(); } } } if (!(s == 1 && i == 0) && !(s == 0 && F8M(i))) SEAM(ps + 1);
        }
    }
    if (IN(N_PHASES - 1) && PHEN(17)) { PH_BEGIN(); rms_final_phase(F, (const bf16*)(ws + WS_XN), ap->fng, ap->out); }
#undef IN
#undef SEAM
}

extern "C" void kernel_launch(void* const* d_in, const int* in_sizes, int n_in, void* d_out, int out_size, void* d_ws, size_t ws_size, hipStream_t stream) {
    static int grid = 0;
    if (grid == 0) {
        if (n_in != 26 || in_sizes[0] != NTOK * DM || out_size != NTOK * DM || ws_size < WS_END) { fprintf(stderr, "kernel_launch: unexpected shapes: n_in %d in0 %d out %d ws %zu (need %zu)\n", n_in, n_in > 0 ? in_sizes[0] : -1, out_size, ws_size, (size_t)WS_END); grid = -1; return; }
        int dev = 0, cus = 0, per_cu = 0;
        if (hipGetDevice(&dev) != hipSuccess || hipDeviceGetAttribute(&cus, hipDeviceAttributeMultiprocessorCount, dev) != hipSuccess) { grid = -1; return; }
        if (hipFuncSetAttribute((const void*)fwd, hipFuncAttributeMaxDynamicSharedMemorySize, LDS_BYTES) != hipSuccess) { fprintf(stderr, "kernel_launch: hipFuncSetAttribute failed\n"); grid = -1; return; }
        if (hipOccupancyMaxActiveBlocksPerMultiprocessor(&per_cu, (const void*)fwd, NWAVES * 64, LDS_BYTES) != hipSuccess || per_cu < 1) fprintf(stderr, "kernel_launch: occupancy query reports %d\n", per_cu);
        (void)hipGetLastError();
        grid = cus;
    }
    if (grid < 0) return;
    (void)hipMemsetAsync((char*)d_ws + WS_CTL, 0, CTL_ZERO_BYTES, stream);
    Args a{};
    a.x = (const float*)d_in[0]; a.pos = (const int*)d_in[1]; a.fng = (const float*)d_in[2];
    a.e_n1 = (const float*)d_in[3]; a.e_win = (const float*)d_in[4]; a.e_conv = (const float*)d_in[5]; a.e_lng = (const float*)d_in[6]; a.e_lnb = (const float*)d_in[7];
    a.e_sw = (const float*)d_in[8]; a.e_sb = (const float*)d_in[9]; a.e_wout = (const float*)d_in[10]; a.e_n2 = (const float*)d_in[11];
    a.e_wg = (const float*)d_in[12]; a.e_wu = (const float*)d_in[13]; a.e_wd = (const float*)d_in[14];
    a.o_n1 = (const float*)d_in[15]; a.o_wqkv = (const float*)d_in[16]; a.o_bqkv = (const float*)d_in[17]; a.o_sinks = (const float*)d_in[18]; a.o_wo = (const float*)d_in[19]; a.o_bo = (const float*)d_in[20];
    a.o_n2 = (const float*)d_in[21]; a.o_rw = (const float*)d_in[22]; a.o_ewg = (const float*)d_in[23]; a.o_ewu = (const float*)d_in[24]; a.o_ewd = (const float*)d_in[25];
    a.out = (float*)d_out; a.ws = (unsigned char*)d_ws;
#if MK_ONE_LAUNCH
    a.lo = 0; a.hi = N_PHASES; a.li = 0;
    hipLaunchKernelGGL(fwd, dim3(grid), dim3(NWAVES * 64), LDS_BYTES, stream, a);
#else
    for (int p = 0; p < N_PHASES; ++p) { a.lo = p; a.hi = p + 1; a.li = p; hipLaunchKernelGGL(fwd, dim3(grid), dim3(NWAVES * 64), LDS_BYTES, stream, a); }
#endif
}
```

```cpp
#include <type_traits>
#include <hip/hip_runtime.h>
#include <cstdio>
#include <cstdint>
#ifndef MK_ONE_LAUNCH
#define MK_ONE_LAUNCH 1
#endif
namespace pg8 {
#define PG8_LAS __attribute__((address_space(3)))
typedef unsigned short bf16_t;
typedef short bf16x8 __attribute__((ext_vector_type(8)));
typedef float f32x4 __attribute__((ext_vector_type(4)));
typedef unsigned u32x4 __attribute__((ext_vector_type(4)));
constexpr int BM = 256, BK = 64, HALF = 128, HTB = HALF * BK * 2  , STAGE_BYTES = 8 * HTB, NXCD = 8, WGM = 4;

__host__ __device__ __forceinline__ int lds_byte(int r, int c) { const int st = (r >> 4) * 2 + (c >> 5), rr = r & 15, cc = c & 31, ob = rr * 64 + cc * 2; return st * 1024 + (ob ^ (((ob >> 9) & 1) << 5)); }
__host__ __device__ __forceinline__ void stage_rc(int b, int& R, int& C) { const int st = b / 1024, sb = b % 1024, swz = sb ^ (((sb >> 9) & 1) << 5); R = (st >> 1) * 16 + swz / 64; C = (st & 1) * 32 + (swz % 64) / 2; }
__host__ __device__ __forceinline__ int perm32(int rho) { const int n = rho >> 4, i = rho & 15; return 8 * (i >> 2) + 4 * n + (i & 3); }

struct Unit { int pm, pn, e, kt0, nt, split, ui; };
struct Gemm { const bf16_t* A; const bf16_t* Bt; int K; size_t estride; };

struct StaticOrder {
    int nM, nN, nwg, G, c, wgm, NT;
    __host__ __device__ __forceinline__ void init(int M, int N, int G_, int c_, int wgm_ = WGM, int nt_ = 0) { nM = M / BM; nN = N / BM; nwg = nM * nN; G = G_; c = c_; wgm = wgm_; NT = nt_; }
    __host__ __device__ __forceinline__ bool next(int i, Unit& u) const {
        const long L = (long)i * G + c; if (L >= nwg) return false;
        int wgid = (int)L; { const int q = nwg / NXCD, r = nwg % NXCD, xcd = wgid % NXCD, off = wgid / NXCD; wgid = (xcd < r ? xcd * (q + 1) : r * (q + 1) + (xcd - r) * q) + off; }
        const int nig = wgm * nN, gid = wgid / nig, fm = gid * wgm, gsz = (nM - fm) < wgm ? (nM - fm) : wgm;
        u.pm = fm + ((wgid % nig) % gsz); u.pn = (wgid % nig) / gsz; u.e = 0; u.kt0 = 0; u.nt = NT; u.split = 0; u.ui = i; return true;
    }
};
struct MoeOrder {
    int nM, nN, nwg, G, c, NT, wgm; bool splitk; int p0, p1, p2, p3, p4, p5, p6;
    __device__ __forceinline__ bool next(int i, Unit& u) const {
        long L = (long)i * G + c; u.kt0 = 0; u.nt = NT; u.split = 0; u.ui = i;
        const int rfull = nwg / G, tail = nwg - rfull * G;
        if (splitk && tail > 0 && tail * 4 <= G) {
            if (i > rfull) return false;
            if (i == rfull) { if (c >= tail * 4) return false; L = (long)rfull * G + (c >> 2); u.split = 1 + (c & 3); }
        } else if (L >= nwg) return false;
        int wgid = (int)L; { const int q = nwg / NXCD, r = nwg % NXCD, xcd = wgid % NXCD, off = wgid / NXCD; wgid = (xcd < r ? xcd * (q + 1) : r * (q + 1) + (xcd - r) * q) + off; }
        const int nig = wgm * nN, gid = wgid / nig, fm = gid * wgm, gsz = (nM - fm) < wgm ? (nM - fm) : wgm;
        const unsigned inv = gsz == 1 ? 65536u : gsz == 2 ? 32768u : gsz == 3 ? 21846u : gsz == 4 ? 16384u : gsz == 5 ? 13108u : gsz == 6 ? 10923u : gsz == 7 ? 9363u : 8192u;
        const int x = wgid - gid * nig, xq = (int)(((unsigned)x * inv) >> 16);
        u.pm = fm + (x - xq * gsz); u.pn = xq;
        u.e = (u.pm >= p0) + (u.pm >= p1) + (u.pm >= p2) + (u.pm >= p3) + (u.pm >= p4) + (u.pm >= p5) + (u.pm >= p6); return true;
    }
};

struct TabOrder {
    const PG8_LAS unsigned* t; int n, base;
    __device__ __forceinline__ static void put(PG8_LAS unsigned* t, int i, const Unit& u) { t[2 * i] = (unsigned)u.pm | ((unsigned)u.pn << 16); t[2 * i + 1] = (unsigned)u.e | ((unsigned)u.kt0 << 8) | ((unsigned)u.nt << 16) | ((unsigned)u.split << 24); }
    __device__ __forceinline__ bool next(int i, Unit& u) const {
        if (i >= n) return false;
        const unsigned w0 = __builtin_amdgcn_readfirstlane(t[2 * i]), w1 = __builtin_amdgcn_readfirstlane(t[2 * i + 1]);
        u.pm = (int)(w0 & 0xffffu); u.pn = (int)(w0 >> 16); u.e = (int)(w1 & 0xffu); u.kt0 = (int)((w1 >> 8) & 0xffu); u.nt = (int)((w1 >> 16) & 0xffu); u.split = (int)(w1 >> 24); u.ui = i + base; return true;
    }
};

__device__ __forceinline__ unsigned cvt_pk_bf16(float lo, float hi) { unsigned r; asm volatile("v_cvt_pk_bf16_f32 %0, %1, %2" : "=v"(r) : "v"(lo), "v"(hi)); return r; }
__device__ __forceinline__ u32x4 pack8(const f32x4 v0, const f32x4 v1) { u32x4 w; w.x = cvt_pk_bf16(v0[0], v0[1]); w.y = cvt_pk_bf16(v0[2], v0[3]); w.z = cvt_pk_bf16(v1[0], v1[1]); w.w = cvt_pk_bf16(v1[2], v1[3]); return w; }

__device__ __forceinline__ float row_rstd(const float* ssp, int row) { const f32x4 q = *(const f32x4*)(ssp + (size_t)row * 4); return __builtin_amdgcn_rsqf(((q[0] + q[1]) + (q[2] + q[3])) * (1.0f / 1024.0f) + 1e-5f); }

struct RowPre { float q[2][4]; };
__device__ __forceinline__ RowPre row_prefetch(const float* ssp, int row0, int fq) { RowPre p;
#pragma unroll
    for (int ai = 0; ai < 2; ++ai)
#pragma unroll
        for (int m = 0; m < 4; ++m) p.q[ai][m] = ssp ? ssp[(size_t)(row0 + ai * HALF + m * 16) * 4 + fq] : 1024.0f;
    return p; }
__device__ __forceinline__ float pre_rstd(float q) { q += __shfl_xor(q, 16); q += __shfl_xor(q, 32); return __builtin_amdgcn_rsqf(q * (1.0f / 1024.0f) + 1e-5f); }
struct NoPre {};
template <class E, class = void> struct PreOf { typedef NoPre type;
    static __device__ __forceinline__ NoPre get(const E&, const Unit&, int, int, int, int) { return NoPre{}; }
    template <class A> static __device__ __forceinline__ void run(const E& e, const A& acc, const Unit& u, int wr, int wc, int fr, int fq, const NoPre&) { e(acc, u, wr, wc, fr, fq); } };
template <class E> struct PreOf<E, std::void_t<typename E::Pre>> { typedef typename E::Pre type;
    static __device__ __forceinline__ type get(const E& e, const Unit& u, int wr, int wc, int fr, int fq) { return e.prefetch(u, wr, wc, fr, fq); }
    template <class A> static __device__ __forceinline__ void run(const E& e, const A& acc, const Unit& u, int wr, int wc, int fr, int fq, const type& pre) { e(acc, u, wr, wc, fr, fq, pre); } };
struct EpiBf16Plain {
    static constexpr bool PERM = true; static constexpr int NVM = 16;
    bf16_t* O; int ldc; const float* ssp;
    __device__ __forceinline__ void operator()(const f32x4 (&acc)[2][2][4][2], const Unit& u, int wr, int wc, int fr, int fq) const {
        const int row0 = u.pm * BM + wr * 64 + fr, col0 = u.pn * BM + wc * 32 + 8 * fq;
        float rs[2][4];
#pragma unroll
        for (int ai = 0; ai < 2; ++ai)
#pragma unroll
            for (int m = 0; m < 4; ++m) rs[ai][m] = ssp ? row_rstd(ssp, row0 + ai * HALF + m * 16) : 1.0f;
#pragma unroll
        for (int ai = 0; ai < 2; ++ai)
#pragma unroll
            for (int m = 0; m < 4; ++m) { bf16_t* rowp = O + (size_t)(row0 + ai * HALF + m * 16) * ldc + col0;
#pragma unroll
                for (int bj = 0; bj < 2; ++bj) *(u32x4*)(rowp + bj * HALF) = pack8(acc[ai][bj][m][0] * rs[ai][m], acc[ai][bj][m][1] * rs[ai][m]); }
    }
};
template <int MODE> struct EpiProbe {
    static constexpr bool PERM = true; static constexpr int NVM = 0;
    bf16_t* O; int ldc;
    __device__ __forceinline__ void operator()(const f32x4 (&acc)[2][2][4][2], const Unit& u, int wr, int wc, int fr, int fq) const {
        const int row0 = u.pm * BM + wr * 64 + fr, col0 = (u.pn * BM) % ldc + wc * 32 + 8 * fq;
        if (MODE == 0) { f32x4 s = (f32x4){0.f, 0.f, 0.f, 0.f};
#pragma unroll
            for (int ai = 0; ai < 2; ++ai)
#pragma unroll
                for (int bj = 0; bj < 2; ++bj)
#pragma unroll
                    for (int m = 0; m < 4; ++m)
#pragma unroll
                        for (int n = 0; n < 2; ++n) s += acc[ai][bj][m][n];
            if (s[0] + s[1] + s[2] + s[3] == 12345.678f) O[row0] = 1; return; }
        unsigned chk = 0u;
#pragma unroll
        for (int ai = 0; ai < 2; ++ai)
#pragma unroll
            for (int m = 0; m < 4; ++m) { bf16_t* rowp = O + (size_t)(row0 + ai * HALF + m * 16) * ldc + col0;
#pragma unroll
                for (int bj = 0; bj < 2; ++bj) { const u32x4 w = pack8(acc[ai][bj][m][0], acc[ai][bj][m][1]);
                    if (MODE == 2 || MODE == 4 || (MODE == 5 && ai == 0)) *(u32x4*)(rowp + bj * HALF) = w; else if (MODE == 1 || MODE == 5) chk ^= (w.x + w.y) ^ (w.z + w.w);
                    if (MODE == 6) __builtin_nontemporal_store(w, (u32x4*)(rowp + bj * HALF));
                    if (MODE == 7 || MODE == 8) { const __amdgpu_buffer_rsrc_t rs = __builtin_amdgcn_make_buffer_rsrc((void*)O, 0, 0x7fffffff, 0x00020000);
                        __builtin_amdgcn_raw_buffer_store_b128(w, rs, (int)(((size_t)(row0 + ai * HALF + m * 16) * ldc + col0 + bj * HALF) * 2), 0, MODE == 7 ? 16 : 17); } } }
        if (MODE == 4) asm volatile("s_waitcnt vmcnt(0)" ::: "memory");
        if (MODE == 5 && chk == 0x9e3779b9u) O[row0] = 1;
        if (MODE == 1 && chk == 0x9e3779b9u) O[row0] = 1;
        if (MODE == 9) {
            const int lane = fq * 16 + fr, wid = wr * 4 + wc;
#pragma unroll
            for (int ai = 0; ai < 2; ++ai)
#pragma unroll
                for (int m = 0; m < 4; ++m)
#pragma unroll
                    for (int bj = 0; bj < 2; ++bj) { const u32x4 w = pack8(acc[ai][bj][m][0], acc[ai][bj][m][1]);
                        *(u32x4*)(O + (size_t)(u.pm * BM + wid * 32 + (ai * 8 + m * 2 + bj) * 2 + (lane >> 5)) * ldc + (u.pn * BM) % ldc + (lane & 31) * 8) = w; }
        }
        if (MODE == 3) {
            const int lane = fq * 16 + fr;
#pragma unroll
            for (int ai = 0; ai < 2; ++ai)
#pragma unroll
                for (int m = 0; m < 4; ++m)
#pragma unroll
                    for (int bj = 0; bj < 2; ++bj) { const u32x4 w = pack8(acc[ai][bj][m][0], acc[ai][bj][m][1]);
                        *(u32x4*)(O + (size_t)(u.pm * BM + ai * HALF + wr * 64 + m * 16 + 8 * bj + (lane >> 3)) * ldc + (u.pn * BM) % ldc + wc * 64 + (lane & 7) * 8) = w; }
        }
    }
};
struct EpiMixIn {
    static constexpr bool PERM = true; static constexpr int NVM = 16;
    bf16_t* O; const float* ssp;
    typedef RowPre Pre;
    __device__ __forceinline__ Pre prefetch(const Unit& u, int wr, int wc, int fr, int fq) const { return row_prefetch(ssp, u.pm * BM + wr * 64 + fr, fq); }
    __device__ __forceinline__ void operator()(const f32x4 (&acc)[2][2][4][2], const Unit& u, int wr, int wc, int fr, int fq, const Pre& pre) const {
        const int row0 = u.pm * BM + wr * 64 + fr;
        float rs[2][4];
#pragma unroll
        for (int ai = 0; ai < 2; ++ai)
#pragma unroll
            for (int m = 0; m < 4; ++m) rs[ai][m] = ssp ? pre_rstd(pre.q[ai][m]) : 1.0f;
        const bool paired = (u.pn >= 2) && (u.pn < 6);
        if (paired) {
            const int col0 = 512 + (u.pn - 2) * HALF + wc * 32 + 8 * fq;
#pragma unroll
            for (int ai = 0; ai < 2; ++ai)
#pragma unroll
                for (int m = 0; m < 4; ++m) { const float r2 = rs[ai][m] * rs[ai][m];
                    *(u32x4*)(O + (size_t)(row0 + ai * HALF + m * 16) * 2048 + col0) = pack8(acc[ai][0][m][0] * acc[ai][1][m][0] * r2, acc[ai][0][m][1] * acc[ai][1][m][1] * r2); }
        } else {
            const int col0 = (u.pn < 2 ? u.pn * BM : 1024 + (u.pn - 6) * BM) + wc * 32 + 8 * fq;
#pragma unroll
            for (int ai = 0; ai < 2; ++ai)
#pragma unroll
                for (int m = 0; m < 4; ++m) { bf16_t* rowp = O + (size_t)(row0 + ai * HALF + m * 16) * 2048 + col0;
#pragma unroll
                    for (int bj = 0; bj < 2; ++bj) *(u32x4*)(rowp + bj * HALF) = pack8(acc[ai][bj][m][0] * rs[ai][m], acc[ai][bj][m][1] * rs[ai][m]); }
        }
    }
};
typedef float f32x2 __attribute__((ext_vector_type(2)));
__device__ __forceinline__ f32x2 silu_mul2(f32x2 g, f32x2 u) {
    f32x2 e; e.x = __builtin_amdgcn_exp2f(-g.x); e.y = __builtin_amdgcn_exp2f(-g.y);
    const f32x2 d = e + 1.0f; f32x2 r; r.x = __builtin_amdgcn_rcpf(d.x); r.y = __builtin_amdgcn_rcpf(d.y);
    return (g * u) * r;
}
typedef unsigned u32x2 __attribute__((ext_vector_type(2)));
struct EpiSwiGLU {
    static constexpr bool PERM = true; static constexpr int NVM = 8;
    bf16_t* O; int ldc; const float* ssp; float escale; float o8scale;
    typedef RowPre Pre;
    __device__ __forceinline__ Pre prefetch(const Unit& u, int wr, int wc, int fr, int fq) const { return row_prefetch(ssp, u.pm * BM + wr * 64 + fr, fq); }
    __device__ __forceinline__ void operator()(const f32x4 (&acc)[2][2][4][2], const Unit& u, int wr, int wc, int fr, int fq, const Pre& pre) const {
        if (escale != 1.0f) asm volatile("s_nop 15\n\ts_nop 7" ::: "memory");
        const int row0 = u.pm * BM + wr * 64 + fr, col0 = u.pn * HALF + wc * 32 + 8 * fq;
        float rs[2][4];
#pragma unroll
        for (int ai = 0; ai < 2; ++ai)
#pragma unroll
            for (int m = 0; m < 4; ++m) { rs[ai][m] = escale;
                if (ssp) rs[ai][m] = escale * pre_rstd(pre.q[ai][m]); }
#pragma unroll
        for (int ai = 0; ai < 2; ++ai)
#pragma unroll
            for (int m = 0; m < 4; ++m) { bf16_t* rowp = O + (size_t)(row0 + ai * HALF + m * 16) * ldc + col0; const float r = rs[ai][m];
                const float ru = (o8scale != 0.0f) ? r * o8scale : r;
                const f32x4 g0 = acc[ai][0][m][0] * r, g1 = acc[ai][0][m][1] * r, u0 = acc[ai][1][m][0] * ru, u1 = acc[ai][1][m][1] * ru;
                const f32x2 a = silu_mul2((f32x2){g0[0], g0[1]}, (f32x2){u0[0], u0[1]}), b = silu_mul2((f32x2){g0[2], g0[3]}, (f32x2){u0[2], u0[3]});
                const f32x2 c = silu_mul2((f32x2){g1[0], g1[1]}, (f32x2){u1[0], u1[1]}), d = silu_mul2((f32x2){g1[2], g1[3]}, (f32x2){u1[2], u1[3]});
                if (o8scale != 0.0f) { unsigned w0 = 0u, w1 = 0u;
#define PG8_C8(v) (v)
                    w0 = __builtin_amdgcn_cvt_pk_fp8_f32(PG8_C8(a.x), PG8_C8(a.y), w0, false); w0 = __builtin_amdgcn_cvt_pk_fp8_f32(PG8_C8(b.x), PG8_C8(b.y), w0, true);
                    w1 = __builtin_amdgcn_cvt_pk_fp8_f32(PG8_C8(c.x), PG8_C8(c.y), w1, false); w1 = __builtin_amdgcn_cvt_pk_fp8_f32(PG8_C8(d.x), PG8_C8(d.y), w1, true);
#undef PG8_C8
                    u32x2 w8; w8.x = w0; w8.y = w1; *(u32x2*)((unsigned char*)O + (size_t)(row0 + ai * HALF + m * 16) * ldc + col0) = w8; continue; }
                u32x4 w; w.x = cvt_pk_bf16(a.x, a.y); w.y = cvt_pk_bf16(b.x, b.y); w.z = cvt_pk_bf16(c.x, c.y); w.w = cvt_pk_bf16(d.x, d.y);
                *(u32x4*)rowp = w; }
    }
};
struct EpiResF32 {
    static constexpr bool PERM = false; static constexpr int NVM = 64;
    const float* base; float* out; int ldc; const float* bias;
    __device__ __forceinline__ void operator()(const f32x4 (&acc)[2][2][4][2], const Unit& u, int wr, int wc, int fr, int fq) const {
        const int row0 = u.pm * BM + wr * 64 + fr, col0 = u.pn * BM + wc * 32 + 4 * fq;
        f32x4 bv[2][2];
#pragma unroll
        for (int bj = 0; bj < 2; ++bj)
#pragma unroll
            for (int n = 0; n < 2; ++n) bv[bj][n] = bias ? *(const f32x4*)(bias + col0 + bj * HALF + n * 16) : (f32x4){0.f, 0.f, 0.f, 0.f};
#pragma unroll
        for (int ai = 0; ai < 2; ++ai) {
            f32x4 b[4][2][2];
#pragma unroll
            for (int m = 0; m < 4; ++m) { const size_t off = (size_t)(row0 + ai * HALF + m * 16) * ldc + col0;
#pragma unroll
                for (int bj = 0; bj < 2; ++bj)
#pragma unroll
                    for (int n = 0; n < 2; ++n) b[m][bj][n] = *(const f32x4*)(base + off + bj * HALF + n * 16); }
            asm volatile("" ::: "memory");
#pragma unroll
            for (int m = 0; m < 4; ++m) { const size_t off = (size_t)(row0 + ai * HALF + m * 16) * ldc + col0;
#pragma unroll
                for (int bj = 0; bj < 2; ++bj)
#pragma unroll
                    for (int n = 0; n < 2; ++n) *(f32x4*)(out + off + bj * HALF + n * 16) = b[m][bj][n] + acc[ai][bj][m][n] + bv[bj][n]; }
            asm volatile("" ::: "memory");
        }
    }
};

struct EpiResNorm {
    static constexpr bool PERM = false; static constexpr int NVM = 96;
    const float* base; float* out; int ldc; const float* bias; bf16_t* xn; float* ssp; PG8_LAS float* red;
    __device__ __forceinline__ void operator()(const f32x4 (&acc)[2][2][4][2], const Unit& u, int wr, int wc, int fr, int fq) const {
        const int row0 = u.pm * BM + wr * 64 + fr, col0 = u.pn * BM + wc * 32 + 4 * fq;
        f32x4 bv[2][2];
#pragma unroll
        for (int bj = 0; bj < 2; ++bj)
#pragma unroll
            for (int n = 0; n < 2; ++n) bv[bj][n] = bias ? *(const f32x4*)(bias + col0 + bj * HALF + n * 16) : (f32x4){0.f, 0.f, 0.f, 0.f};
        float sq[2][4];
#pragma unroll
        for (int ai = 0; ai < 2; ++ai) {
            f32x4 b[4][2][2];
#pragma unroll
            for (int m = 0; m < 4; ++m) { const size_t off = (size_t)(row0 + ai * HALF + m * 16) * ldc + col0;
#pragma unroll
                for (int bj = 0; bj < 2; ++bj)
#pragma unroll
                    for (int n = 0; n < 2; ++n) b[m][bj][n] = *(const f32x4*)(base + off + bj * HALF + n * 16); }
            asm volatile("" ::: "memory");
#pragma unroll
            for (int m = 0; m < 4; ++m) { const size_t off = (size_t)(row0 + ai * HALF + m * 16) * ldc + col0; float s = 0.f;
#pragma unroll
                for (int bj = 0; bj < 2; ++bj)
#pragma unroll
                    for (int n = 0; n < 2; ++n) { const f32x4 v = b[m][bj][n] + acc[ai][bj][m][n] + bv[bj][n]; *(f32x4*)(out + off + bj * HALF + n * 16) = v;
                        s += (v[0] * v[0] + v[1] * v[1]) + (v[2] * v[2] + v[3] * v[3]);
                        u32x2 w; w.x = cvt_pk_bf16(v[0], v[1]); w.y = cvt_pk_bf16(v[2], v[3]); *(u32x2*)(xn + off + bj * HALF + n * 16) = w; }
                sq[ai][m] = s; }
            asm volatile("" ::: "memory");
        }
#pragma unroll
        for (int ai = 0; ai < 2; ++ai)
#pragma unroll
            for (int m = 0; m < 4; ++m) { float s = sq[ai][m]; s += __shfl_xor(s, 16); s += __shfl_xor(s, 32); if (fq == 0) red[(ai * HALF + wr * 64 + m * 16 + fr) * 4 + wc] = s; }
        asm volatile("s_waitcnt lgkmcnt(0)" ::: "memory"); __builtin_amdgcn_s_barrier(); asm volatile("" ::: "memory");
        const int tid = (wr * 4 + wc) * 64 + fq * 16 + fr;
        if (tid < 256) { const f32x4 r = *(const PG8_LAS f32x4*)(red + tid * 4); ssp[(size_t)(u.pm * BM + tid) * 4 + u.pn] = (r[0] + r[1]) + (r[2] + r[3]); }
    }
};
template <int ADIV = 1> struct EpiQKVT {
    static constexpr bool PERM = true; static constexpr int NVM = 26;
    bf16_t* O; const float* bias; const float* cs; float qscale; const float* ssp; PG8_LAS float* stg;
    typedef RowPre Pre;
    __device__ __forceinline__ Pre prefetch(const Unit& u, int wr, int wc, int fr, int fq) const { return row_prefetch(ssp, u.pm * BM + wr * 64 + fr, fq); }
    __device__ __forceinline__ void operator()(const f32x4 (&acc)[2][2][4][2], const Unit& u, int wr, int wc, int fr, int fq, const Pre& pre) const {
        if constexpr (ADIV != 1) asm volatile("s_nop 15\n\ts_nop 7" ::: "memory");
        const int row0 = u.pm * BM + wr * 64 + fr, colt = u.pn * BM, col0 = colt + wc * 32 + 8 * fq;
        const bool ropew = ((wc & 1) == 0);
        const int tid = (wr * 4 + wc) * 64 + fq * 16 + fr;
        const f32x4 t0 = *(const f32x4*)(cs + (size_t)(u.pm * BM + (tid >> 2)) * 16 + (tid & 3) * 4), t1 = *(const f32x4*)(cs + (size_t)(u.pm * BM + HALF + (tid >> 2)) * 16 + (tid & 3) * 4);
        f32x4 bv[2][2];
#pragma unroll
        for (int bj = 0; bj < 2; ++bj)
#pragma unroll
            for (int n = 0; n < 2; ++n) bv[bj][n] = *(const f32x4*)(bias + col0 + bj * HALF + 4 * n);
        float rsr[2][4];
#pragma unroll
        for (int ai = 0; ai < 2; ++ai)
#pragma unroll
            for (int m = 0; m < 4; ++m) rsr[ai][m] = pre_rstd(pre.q[ai][m]) * (1.0f / (float)ADIV);
        const float sgn = (fq == 0) ? -1.f : 1.f;
#pragma unroll
        for (int ai = 0; ai < 2; ++ai) {
            if (ai) { asm volatile("s_waitcnt lgkmcnt(0)" ::: "memory"); __builtin_amdgcn_s_barrier(); }
            *(PG8_LAS f32x4*)(stg + (tid >> 2) * 20 + (tid & 3) * 4) = ai ? t1 : t0;
            asm volatile("s_waitcnt lgkmcnt(0)" ::: "memory"); __builtin_amdgcn_s_barrier(); asm volatile("" ::: "memory");
#pragma unroll
            for (int m = 0; m < 4; ++m) { const int row = row0 + ai * HALF + m * 16; bf16_t* rowp = O + (size_t)row * 1280 + col0;
                f32x4 c0 = (f32x4){1.f, 1.f, 1.f, 1.f}, c1 = c0, s0 = (f32x4){0.f, 0.f, 0.f, 0.f}, s1 = s0;
                if (ropew && fq < 2) { const PG8_LAS f32x4* cp = (const PG8_LAS f32x4*)(stg + (wr * 64 + m * 16 + fr) * 20); c0 = cp[0]; c1 = cp[1]; s0 = cp[2] * sgn; s1 = cp[3] * sgn; }
                const float rs = rsr[ai][m];
#pragma unroll
                for (int bj = 0; bj < 2; ++bj) { f32x4 v0 = acc[ai][bj][m][0] * rs + bv[bj][0], v1 = acc[ai][bj][m][1] * rs + bv[bj][1];
                    const int gc = colt + bj * HALF;
                    if (ropew && gc < 1152) { f32x4 p0, p1;
#pragma unroll
                        for (int j = 0; j < 4; ++j) { p0[j] = __shfl_xor(v0[j], 16); p1[j] = __shfl_xor(v1[j], 16); }
                        v0 = v0 * c0 + p0 * s0; v1 = v1 * c1 + p1 * s1; }
                    if (gc < 1024) { v0 = v0 * qscale; v1 = v1 * qscale; }
                    *(u32x4*)(rowp + bj * HALF) = pack8(v0, v1); }
                if (ADIV != 1 || (m & 1)) asm volatile("" ::: "memory"); }
        }
        asm volatile("s_waitcnt lgkmcnt(0)" ::: "memory"); __builtin_amdgcn_s_barrier();
    }
};
typedef EpiQKVT<1> EpiQKV;
template <> struct PreOf<EpiQKVT<64>, void> { typedef NoPre type;
    static __device__ __forceinline__ NoPre get(const EpiQKVT<64>&, const Unit&, int, int, int, int) { return NoPre{}; }
    template <class A> static __device__ __forceinline__ void run(const EpiQKVT<64>& e, const A& acc, const Unit& u, int wr, int wc, int fr, int fq, const NoPre&) { e(acc, u, wr, wc, fr, fq, e.prefetch(u, wr, wc, fr, fq)); } };
__device__ __forceinline__ void unpack8v(const u32x4 w, f32x4& a, f32x4& b) {
    a[0] = __uint_as_float(w.x << 16); a[1] = __uint_as_float(w.x & 0xffff0000u); a[2] = __uint_as_float(w.y << 16); a[3] = __uint_as_float(w.y & 0xffff0000u);
    b[0] = __uint_as_float(w.z << 16); b[1] = __uint_as_float(w.z & 0xffff0000u); b[2] = __uint_as_float(w.w << 16); b[3] = __uint_as_float(w.w & 0xffff0000u);
}
template <bool ONE_BATCH, int ADIV = 1, long H8OFF = 0> struct EpiResB {
    static constexpr bool PERM = true; static constexpr int NVM = 32;
    bf16_t* hb; const float* bias; float* ssp; PG8_LAS float* red; int norm;
    __device__ __forceinline__ void operator()(const f32x4 (&acc)[2][2][4][2], const Unit& u, int wr, int wc, int fr, int fq) const {
        constexpr float ascale = 1.0f / (float)ADIV;
        if constexpr (ADIV != 1) asm volatile("s_nop 15\n\ts_nop 7" ::: "memory");
        const int row0 = u.pm * BM + wr * 64 + fr, col0 = u.pn * BM + wc * 32 + 8 * fq;
        f32x4 bv[2][2];
#pragma unroll
        for (int bj = 0; bj < 2; ++bj)
#pragma unroll
            for (int n = 0; n < 2; ++n) bv[bj][n] = bias ? *(const f32x4*)(bias + col0 + bj * HALF + 4 * n) : (f32x4){0.f, 0.f, 0.f, 0.f};
        float sq[2][4];
        u32x4 b[2][4][2];
        if constexpr (ONE_BATCH) {
#pragma unroll
            for (int ai = 0; ai < 2; ++ai)
#pragma unroll
                for (int m = 0; m < 4; ++m)
#pragma unroll
                    for (int bj = 0; bj < 2; ++bj) b[ai][m][bj] = *(const u32x4*)(hb + (size_t)(row0 + ai * HALF + m * 16) * 1024 + col0 + bj * HALF);
            asm volatile("" ::: "memory");
        }
#pragma unroll
        for (int ai = 0; ai < 2; ++ai) {
            if constexpr (!ONE_BATCH) {
#pragma unroll
                for (int m = 0; m < 4; ++m)
#pragma unroll
                    for (int bj = 0; bj < 2; ++bj) b[ai][m][bj] = *(const u32x4*)(hb + (size_t)(row0 + ai * HALF + m * 16) * 1024 + col0 + bj * HALF);
                asm volatile("" ::: "memory");
            }
#pragma unroll
            for (int m = 0; m < 4; ++m) { float s = 0.f;
#pragma unroll
                for (int bj = 0; bj < 2; ++bj) { f32x4 h0, h1; unpack8v(b[ai][m][bj], h0, h1);
                    f32x4 v0, v1; if constexpr (ADIV != 1) { v0 = h0 + acc[ai][bj][m][0] * ascale + bv[bj][0]; v1 = h1 + acc[ai][bj][m][1] * ascale + bv[bj][1]; } else { v0 = h0 + acc[ai][bj][m][0] + bv[bj][0]; v1 = h1 + acc[ai][bj][m][1] + bv[bj][1]; }
                    s += ((v0[0] * v0[0] + v0[1] * v0[1]) + (v0[2] * v0[2] + v0[3] * v0[3])) + ((v1[0] * v1[0] + v1[1] * v1[1]) + (v1[2] * v1[2] + v1[3] * v1[3]));
                    *(u32x4*)(hb + (size_t)(row0 + ai * HALF + m * 16) * 1024 + col0 + bj * HALF) = pack8(v0, v1);
                    if constexpr (H8OFF != 0) { unsigned w0 = 0u, w1 = 0u;
#define PG8_C8(v) (v)
                        w0 = __builtin_amdgcn_cvt_pk_fp8_f32(PG8_C8(v0[0]), PG8_C8(v0[1]), w0, false); w0 = __builtin_amdgcn_cvt_pk_fp8_f32(PG8_C8(v0[2]), PG8_C8(v0[3]), w0, true);
                        w1 = __builtin_amdgcn_cvt_pk_fp8_f32(PG8_C8(v1[0]), PG8_C8(v1[1]), w1, false); w1 = __builtin_amdgcn_cvt_pk_fp8_f32(PG8_C8(v1[2]), PG8_C8(v1[3]), w1, true);
#undef PG8_C8
                        u32x2 w8; w8.x = w0; w8.y = w1; *(u32x2*)((unsigned char*)hb + H8OFF + (size_t)(row0 + ai * HALF + m * 16) * 1024 + col0 + bj * HALF) = w8; } }
                sq[ai][m] = s; }
            asm volatile("" ::: "memory");
        }
        if (norm) {
#pragma unroll
            for (int ai = 0; ai < 2; ++ai)
#pragma unroll
                for (int m = 0; m < 4; ++m) { float s = sq[ai][m]; s += __shfl_xor(s, 16); s += __shfl_xor(s, 32); if (fq == 0) red[(ai * HALF + wr * 64 + m * 16 + fr) * 4 + wc] = s; }
            asm volatile("s_waitcnt lgkmcnt(0)" ::: "memory"); __builtin_amdgcn_s_barrier(); asm volatile("" ::: "memory");
            const int tid = (wr * 4 + wc) * 64 + fq * 16 + fr;
            if (tid < 256) { const f32x4 r = *(const PG8_LAS f32x4*)(red + tid * 4); ssp[(size_t)(u.pm * BM + tid) * 4 + u.pn] = (r[0] + r[1]) + (r[2] + r[3]); }
        }
    }
};
struct EpiMoeDown {
    static constexpr bool PERM = true; static constexpr int NVM = 8;
    const PG8_LAS int* ltab; bf16_t* hb; float* ssp; PG8_LAS float* red; int norm; float gscale;
    __device__ __forceinline__ void operator()(const f32x4 (&acc)[2][2][4][2], const Unit& u, int wr, int wc, int fr, int fq) const {
        if (gscale != 1.0f) asm volatile("s_nop 15\n\ts_nop 7" ::: "memory");
        const int col0 = u.pn * BM + wc * 32 + 8 * fq;
        const int qa = (u.split - 1) >> 1, qb = (u.split - 1) & 1;
        float sq[2][4];
        int tok[2][4]; float gate[2][4]; u32x4 b[2][4][2];
#pragma unroll
        for (int ai = 0; ai < 2; ++ai)
#pragma unroll
            for (int m = 0; m < 4; ++m) { const int lrow = ai * HALF + wr * 64 + m * 16 + fr; tok[ai][m] = ltab[u.ui * 512 + lrow]; gate[ai][m] = __int_as_float(ltab[u.ui * 512 + 256 + lrow]) * gscale; sq[ai][m] = 0.f; }
#pragma unroll
        for (int ai = 0; ai < 2; ++ai) { if (u.split && ai != qa) continue;
#pragma unroll
            for (int m = 0; m < 4; ++m)
#pragma unroll
                for (int bj = 0; bj < 2; ++bj) b[ai][m][bj] = *(const u32x4*)(hb + (size_t)(tok[ai][m] < 0 ? 0 : tok[ai][m]) * 1024 + col0 + bj * HALF); }
        asm volatile("" ::: "memory");
#pragma unroll
        for (int ai = 0; ai < 2; ++ai) { if (u.split && ai != qa) continue;
#pragma unroll
            for (int m = 0; m < 4; ++m) { if (tok[ai][m] >= 0) {
#pragma unroll
                for (int bj = 0; bj < 2; ++bj) { if (u.split && bj != qb) continue;
                    f32x4 h0, h1; unpack8v(b[ai][m][bj], h0, h1);
                    const f32x4 v0 = h0 + acc[ai][bj][m][0] * gate[ai][m], v1 = h1 + acc[ai][bj][m][1] * gate[ai][m];
                    sq[ai][m] += ((v0[0] * v0[0] + v0[1] * v0[1]) + (v0[2] * v0[2] + v0[3] * v0[3])) + ((v1[0] * v1[0] + v1[1] * v1[1]) + (v1[2] * v1[2] + v1[3] * v1[3]));
                    *(u32x4*)(hb + (size_t)tok[ai][m] * 1024 + col0 + bj * HALF) = pack8(v0, v1); } } }
            asm volatile("" ::: "memory");
        }
        if (norm) {
#pragma unroll
            for (int ai = 0; ai < 2; ++ai)
#pragma unroll
                for (int m = 0; m < 4; ++m) { float s = sq[ai][m]; s += __shfl_xor(s, 16); s += __shfl_xor(s, 32); if (fq == 0) red[(ai * HALF + wr * 64 + m * 16 + fr) * 4 + wc] = s; }
            asm volatile("s_waitcnt lgkmcnt(0)" ::: "memory"); __builtin_amdgcn_s_barrier(); asm volatile("" ::: "memory");
            const int tid = (wr * 4 + wc) * 64 + fq * 16 + fr;
            if (tid < 256) { const int tk = ltab[u.ui * 512 + tid]; const f32x4 r = *(const PG8_LAS f32x4*)(red + tid * 4); if (tk >= 0) ssp[(size_t)tk * 4 + u.pn] = (r[0] + r[1]) + (r[2] + r[3]); }
        }
    }
};

template <class Epi, class Sched, bool ALIGN_EPI = false, bool SP2 = false>
__device__ __forceinline__ void gemm_phase(PG8_LAS unsigned char* lds, const Gemm g, const Sched& S, const Epi& E, int stag_ticks = 0) {
    if (stag_ticks > 0) {
        const unsigned long long t_end = __builtin_amdgcn_s_memrealtime() + (((unsigned long long)blockIdx.x * (unsigned)stag_ticks) >> 8);
        while (__builtin_amdgcn_s_memrealtime() < t_end) __builtin_amdgcn_s_sleep(4);
    }
    int tid_ = threadIdx.x; asm volatile("" : "+v"(tid_));
    const int tid = tid_, wid = __builtin_amdgcn_readfirstlane(tid >> 6), lane = tid & 63, wr = wid >> 2, wc = wid & 3, fr = lane & 15, fq = lane >> 4;
    const int K = g.K, nt = K / BK;
    constexpr int EPI_S = Epi::NVM < 48 ? Epi::NVM : 48;
    unsigned voffA[2], voffB[2];
#pragma unroll
    for (int i = 0; i < 2; ++i) { int R, C; stage_rc(tid * 16 + i * 8192, R, C); const int Rb = Epi::PERM ? ((R & ~31) + perm32(R & 31)) : R;
        voffA[i] = (unsigned)(R * K + C) * 2u; voffB[i] = (unsigned)(Rb * K + C) * 2u; }
    const size_t kstep = (size_t)(BK * 2);
    const size_t hstep = (size_t)HALF * K * 2;
    const size_t tstep = 2 * hstep;
    const unsigned ldsw = (unsigned)wid * 1024u;
    const int aoff = lds_byte(wr * 64 + fr, fq * 8), boff = lds_byte(wc * 32 + fr, fq * 8);
#define PG8_SA(b, h) (((b) * 2 + (h)) * HTB)
#define PG8_SB(b, h) ((4 + (b) * 2 + (h)) * HTB)
#define PG8_STAGE(bufoff, gbase, voff) do { _Pragma("unroll") for (int _i = 0; _i < 2; ++_i) \
        __builtin_amdgcn_global_load_lds((const unsigned*)((const char*)(gbase) + (voff)[_i]), (PG8_LAS unsigned*)(lds + (bufoff) + ldsw + _i * 8192), 16, 0, 0); } while (0)
#define PG8_LDA(dst, b, h) do { _Pragma("unroll") for (int m = 0; m < 4; ++m) _Pragma("unroll") for (int k = 0; k < 2; ++k) dst[m][k] = *(const PG8_LAS bf16x8*)(lds + PG8_SA(b, h) + aoff + m * 2048 + k * 1024); } while (0)
#define PG8_LDB(dst, b, h) do { _Pragma("unroll") for (int n = 0; n < 2; ++n) _Pragma("unroll") for (int k = 0; k < 2; ++k) dst[n][k] = *(const PG8_LAS bf16x8*)(lds + PG8_SB(b, h) + boff + n * 2048 + k * 1024); } while (0)
#define PG8_MMA(ai, bj, At, Bt) do { __builtin_amdgcn_s_setprio(1); _Pragma("unroll") for (int m = 0; m < 4; ++m) _Pragma("unroll") for (int n = 0; n < 2; ++n) _Pragma("unroll") for (int k = 0; k < 2; ++k) \
        acc[ai][bj][m][n] = __builtin_amdgcn_mfma_f32_16x16x32_bf16(Bt[n][k], At[m][k], acc[ai][bj][m][n], 0, 0, 0); __builtin_amdgcn_s_setprio(0); } while (0)
#define PG8_WAIT_V(n) asm volatile("s_waitcnt vmcnt(" #n ")" ::: "memory")
#define PG8_WAIT_V8R(rx) do { if (rx) asm volatile("s_waitcnt vmcnt(%0)" :: "n"(8 + EPI_S) : "memory"); else PG8_WAIT_V(8); } while (0)
#define PG8_WAIT_L(n) asm volatile("s_waitcnt lgkmcnt(" #n ")" ::: "memory")
#define PG8_BAR __builtin_amdgcn_s_barrier()
#define PG8_SCHED __builtin_amdgcn_sched_barrier(0)
    Unit cur, nxt; int ui = 0;
    if (!S.next(0, cur)) return;
    typename PreOf<Epi>::type pre = PreOf<Epi>::get(E, cur, wr, wc, fr, fq);
    f32x4 acc[2][2][4][2];
#pragma unroll
    for (int a = 0; a < 2; ++a)
#pragma unroll
        for (int b = 0; b < 2; ++b)
#pragma unroll
            for (int m = 0; m < 4; ++m)
#pragma unroll
                for (int n = 0; n < 2; ++n) acc[a][b][m][n] = (f32x4){0.f, 0.f, 0.f, 0.f};
    bf16x8 At[4][2], B0[2][2], B1[2][2];
    const char* cA = (const char*)g.A + (size_t)cur.pm * tstep; const char* cB = (const char*)g.Bt + (size_t)cur.e * g.estride + (size_t)cur.pn * tstep;
    if constexpr (SP2) {
        PG8_STAGE(PG8_SB(0, 0), cB, voffB); PG8_STAGE(PG8_SB(0, 1), cB + hstep, voffB); PG8_STAGE(PG8_SA(0, 0), cA, voffA); PG8_STAGE(PG8_SA(0, 1), cA + hstep, voffA);
        if (wr == 1) PG8_BAR;
        PG8_WAIT_V(2); PG8_BAR;
        PG8_STAGE(PG8_SB(1, 0), cB + kstep, voffB); PG8_STAGE(PG8_SA(1, 0), cA + kstep, voffA); PG8_STAGE(PG8_SB(1, 1), cB + hstep + kstep, voffB);
        PG8_WAIT_V(6); PG8_BAR;
    } else {
        PG8_STAGE(PG8_SB(0, 0), cB, voffB); PG8_STAGE(PG8_SA(0, 0), cA, voffA); PG8_STAGE(PG8_SB(0, 1), cB + hstep, voffB); PG8_STAGE(PG8_SA(0, 1), cA + hstep, voffA);
        if (wr == 1) PG8_BAR;
        PG8_WAIT_V(4); PG8_BAR;
        PG8_STAGE(PG8_SB(1, 0), cB + kstep, voffB); PG8_STAGE(PG8_SA(1, 0), cA + kstep, voffA); PG8_STAGE(PG8_SB(1, 1), cB + hstep + kstep, voffB);
        PG8_WAIT_V(6); PG8_BAR;
    }
    for (;;) {
        const bool has_next = S.next(ui + 1, nxt);
        const char* nA = has_next ? (const char*)g.A + (size_t)nxt.pm * tstep : cA; const char* nB = has_next ? (const char*)g.Bt + (size_t)nxt.e * g.estride + (size_t)nxt.pn * tstep : cB;
        for (int t = 0; t < nt; t += 2) {
            const bool last = (t == nt - 2);
            const char* a1 = cA + (size_t)(t + 1) * kstep;
            const char* a2 = last ? nA : cA + (size_t)(t + 2) * kstep; const char* b2 = last ? nB : cB + (size_t)(t + 2) * kstep;
            const char* a3 = a2 + kstep; const char* b3 = b2 + kstep;
            if constexpr (SP2) {
            PG8_LDB(B0, 0, 0); PG8_LDB(B1, 0, 1); PG8_SCHED; PG8_LDA(At, 0, 0); PG8_STAGE(PG8_SA(1, 1), a1 + hstep, voffA);
            PG8_WAIT_V(8); PG8_WAIT_L(0); PG8_BAR; PG8_MMA(0, 0, At, B0); PG8_MMA(0, 1, At, B1); PG8_BAR; PG8_SCHED;
            PG8_LDA(At, 0, 1); PG8_STAGE(PG8_SB(0, 0), b2, voffB); PG8_STAGE(PG8_SB(0, 1), b2 + hstep, voffB); PG8_STAGE(PG8_SA(0, 0), a2, voffA);
            PG8_WAIT_V(8); PG8_WAIT_L(0); PG8_BAR; PG8_MMA(1, 0, At, B0); PG8_MMA(1, 1, At, B1); PG8_BAR; PG8_SCHED;
            PG8_LDB(B0, 1, 0); PG8_LDB(B1, 1, 1); PG8_SCHED; PG8_LDA(At, 1, 0); PG8_STAGE(PG8_SA(0, 1), a2 + hstep, voffA);
            PG8_WAIT_V(8); PG8_WAIT_L(0); PG8_BAR; PG8_MMA(0, 0, At, B0); PG8_MMA(0, 1, At, B1); PG8_BAR; PG8_SCHED;
            PG8_LDA(At, 1, 1); PG8_STAGE(PG8_SB(1, 0), b3, voffB); PG8_STAGE(PG8_SB(1, 1), b3 + hstep, voffB); PG8_STAGE(PG8_SA(1, 0), a3, voffA);
            PG8_WAIT_V(8); PG8_WAIT_L(0); PG8_BAR; PG8_MMA(1, 0, At, B0); PG8_MMA(1, 1, At, B1); PG8_BAR; PG8_SCHED;
            } else {
            PG8_LDB(B0, 0, 0); PG8_SCHED; PG8_LDA(At, 0, 0); PG8_STAGE(PG8_SA(1, 1), a1 + hstep, voffA);
            PG8_WAIT_L(8); PG8_BAR; PG8_WAIT_L(0); PG8_MMA(0, 0, At, B0); PG8_BAR; PG8_SCHED;
            PG8_LDB(B1, 0, 1); PG8_STAGE(PG8_SB(0, 0), b2, voffB);
            PG8_BAR; PG8_WAIT_L(0); PG8_MMA(0, 1, At, B1); PG8_BAR;
            PG8_LDA(At, 0, 1); PG8_STAGE(PG8_SA(0, 0), a2, voffA);
            PG8_BAR; PG8_WAIT_L(0); PG8_MMA(1, 0, At, B0); PG8_BAR; PG8_SCHED;
            PG8_STAGE(PG8_SB(0, 1), b2 + hstep, voffB);
            PG8_WAIT_V(6); PG8_BAR; PG8_MMA(1, 1, At, B1); PG8_BAR;
            PG8_LDB(B0, 1, 0); PG8_SCHED; PG8_LDA(At, 1, 0); PG8_STAGE(PG8_SA(0, 1), a2 + hstep, voffA);
            PG8_WAIT_L(8); PG8_BAR; PG8_WAIT_L(0); PG8_MMA(0, 0, At, B0); PG8_BAR; PG8_SCHED;
            PG8_LDB(B1, 1, 1); PG8_STAGE(PG8_SB(1, 0), b3, voffB);
            PG8_BAR; PG8_WAIT_L(0); PG8_MMA(0, 1, At, B1); PG8_BAR;
            PG8_LDA(At, 1, 1); PG8_STAGE(PG8_SA(1, 0), a3, voffA);
            PG8_BAR; PG8_WAIT_L(0); PG8_MMA(1, 0, At, B0); PG8_BAR; PG8_SCHED;
            PG8_STAGE(PG8_SB(1, 1), b3 + hstep, voffB);
            PG8_WAIT_V(6); PG8_BAR; PG8_MMA(1, 1, At, B1); PG8_BAR;
            }
        }
        if constexpr (ALIGN_EPI) { if (wr == 0) PG8_BAR; }
        PreOf<Epi>::run(E, acc, cur, wr, wc, fr, fq, pre);
        asm volatile("" ::: "memory");
        if (!has_next) break;
        pre = PreOf<Epi>::get(E, nxt, wr, wc, fr, fq);
#pragma unroll
        for (int a = 0; a < 2; ++a)
#pragma unroll
            for (int b = 0; b < 2; ++b)
#pragma unroll
                for (int m = 0; m < 4; ++m)
#pragma unroll
                    for (int n = 0; n < 2; ++n) acc[a][b][m][n] = (f32x4){0.f, 0.f, 0.f, 0.f};
        cur = nxt; cA = nA; cB = nB; ++ui;
        if constexpr (ALIGN_EPI) { if (wr == 1) PG8_BAR; }
    }
    PG8_WAIT_V(0);
    if constexpr (!ALIGN_EPI) { if (wr == 0) PG8_BAR; }
    PG8_BAR;
#undef PG8_SA
#undef PG8_SB
#undef PG8_STAGE
#undef PG8_LDA
#undef PG8_LDB
#undef PG8_MMA
#undef PG8_WAIT_V
#undef PG8_WAIT_V8R
#undef PG8_WAIT_L
#undef PG8_BAR
#undef PG8_SCHED
}

template <class Epi, class Sched, bool GATHER, bool QUARTER = false, bool FP8 = false>
__device__ __forceinline__ void gemm_phase2(PG8_LAS unsigned char* lds, const Gemm g, const Sched& S, const Epi& E, const PG8_LAS unsigned short* tab, int stag_ticks = 0) {
    if (stag_ticks > 0) {
        const unsigned long long t_end = __builtin_amdgcn_s_memrealtime() + (((unsigned long long)blockIdx.x * (unsigned)stag_ticks) >> 8);
        while (__builtin_amdgcn_s_memrealtime() < t_end) __builtin_amdgcn_s_sleep(4);
    }
    int tid_ = threadIdx.x; asm volatile("" : "+v"(tid_));
    const int tid = tid_, wid = __builtin_amdgcn_readfirstlane(tid >> 6), lane = tid & 63, wr = wid >> 2, wc = wid & 3, fr = lane & 15, fq = lane >> 4;
    const int K = g.K;
    constexpr bool ZIL = std::is_same<Sched, TabOrder>::value;
    constexpr int EPI_S = Epi::NVM < 48 ? Epi::NVM : 48;
    unsigned cofA[2], voffB[2]; int R0 = 0;
#pragma unroll
    for (int i = 0; i < 2; ++i) { int R, C; stage_rc(tid * 16 + i * 8192, R, C); const int Rb = Epi::PERM ? ((R & ~31) + perm32(R & 31)) : R;
        cofA[i] = GATHER ? (unsigned)(C * 2) : (unsigned)(R * K + C) * 2u; voffB[i] = (unsigned)(Rb * K + C) * 2u; if (i == 0) R0 = R; }
    const unsigned pitchA = (unsigned)K * 2u;
    const size_t kstep = (size_t)(BK * 2), hstep = (size_t)HALF * K * 2, tstep = 2 * hstep, hstepA = GATHER ? 0 : hstep;
    const unsigned ldsw = (unsigned)wid * 1024u;
    const int aoff = lds_byte(wr * 64 + fr, fq * 8), boff = lds_byte(wc * 32 + fr, fq * 8);
#define PG8_SA(b, h) (((b) * 2 + (h)) * HTB)
#define PG8_SB(b, h) ((4 + (b) * 2 + (h)) * HTB)
#define PG8_STAGEB(bufoff, gbase) do { _Pragma("unroll") for (int _i = 0; _i < 2; ++_i) \
        __builtin_amdgcn_global_load_lds((const unsigned*)((const char*)(gbase) + voffB[_i]), (PG8_LAS unsigned*)(lds + (bufoff) + ldsw + _i * 8192), 16, 0, 0); } while (0)
#define PG8_STAGEA(bufoff, gbase, tkw) do { _Pragma("unroll") for (int _i = 0; _i < 2; ++_i) { const unsigned _vo = GATHER ? ((((tkw) >> (16 * _i)) & 0xffffu) * pitchA + cofA[_i]) : cofA[_i]; \
        __builtin_amdgcn_global_load_lds((const unsigned*)((const char*)(gbase) + _vo), (PG8_LAS unsigned*)(lds + (bufoff) + ldsw + _i * 8192), 16, 0, 0); } } while (0)
#define PG8_LOADTK(d0, d1, uidx) do { if constexpr (GATHER) { const PG8_LAS unsigned short* _tp = tab + (uidx) * 256 + R0; d0 = (unsigned)_tp[0] | ((unsigned)_tp[64] << 16); d1 = (unsigned)_tp[128] | ((unsigned)_tp[192] << 16); } } while (0)
#define PG8_LDA(dst, b, h) do { _Pragma("unroll") for (int m = 0; m < 4; ++m) { const PG8_LAS unsigned char* _p = lds + PG8_SA(b, h) + aoff + m * 2048; \
        if constexpr (FP8) dst##8[m] = __builtin_shufflevector(*(const PG8_LAS v4i_*)_p, *(const PG8_LAS v4i_*)(_p + 1024), 0, 1, 2, 3, 4, 5, 6, 7); \
        else { dst[m][0] = *(const PG8_LAS bf16x8*)_p; dst[m][1] = *(const PG8_LAS bf16x8*)(_p + 1024); } } } while (0)
#define PG8_LDB(dst, b, h) do { _Pragma("unroll") for (int n = 0; n < 2; ++n) { const PG8_LAS unsigned char* _p = lds + PG8_SB(b, h) + boff + n * 2048; \
        if constexpr (FP8) dst##8[n] = __builtin_shufflevector(*(const PG8_LAS v4i_*)_p, *(const PG8_LAS v4i_*)(_p + 1024), 0, 1, 2, 3, 4, 5, 6, 7); \
        else { dst[n][0] = *(const PG8_LAS bf16x8*)_p; dst[n][1] = *(const PG8_LAS bf16x8*)(_p + 1024); } } } while (0)
#define PG8_MMA(ai, bj, At, Bt) do { __builtin_amdgcn_s_setprio(1); _Pragma("unroll") for (int m = 0; m < 4; ++m) _Pragma("unroll") for (int n = 0; n < 2; ++n) { \
        if constexpr (FP8) asm volatile("v_mfma_f32_16x16x128_f8f6f4 %0, %1, %2, %0" : "+v"(acc[ai][bj][m][n]) : "v"(Bt##8[n]), "v"(At##8[m]));     \
        else { _Pragma("unroll") for (int k = 0; k < 2; ++k) acc[ai][bj][m][n] = __builtin_amdgcn_mfma_f32_16x16x32_bf16(Bt[n][k], At[m][k], acc[ai][bj][m][n], 0, 0, 0); } } \
        __builtin_amdgcn_s_setprio(0); } while (0)
#define PG8_ZERO(ai) do { _Pragma("unroll") for (int b_ = 0; b_ < 2; ++b_) _Pragma("unroll") for (int m_ = 0; m_ < 4; ++m_) _Pragma("unroll") for (int n_ = 0; n_ < 2; ++n_) acc[ai][b_][m_][n_] = (f32x4){0.f, 0.f, 0.f, 0.f}; } while (0)
#define PG8_WAIT_V(n) asm volatile("s_waitcnt vmcnt(" #n ")" ::: "memory")
#define PG8_WAIT_V8R(rx) do { if (rx) asm volatile("s_waitcnt vmcnt(%0)" :: "n"(8 + EPI_S) : "memory"); else PG8_WAIT_V(8); } while (0)
#define PG8_WAIT_L(n) asm volatile("s_waitcnt lgkmcnt(" #n ")" ::: "memory")
#define PG8_BAR __builtin_amdgcn_s_barrier()
#define PG8_SCHED __builtin_amdgcn_sched_barrier(0)
    Unit cur, nxt; int ui = 0;
    if (!S.next(0, cur)) return;
    typename PreOf<Epi>::type pre = PreOf<Epi>::get(E, cur, wr, wc, fr, fq);
    f32x4 acc[2][2][4][2];
#pragma unroll
    for (int a = 0; a < 2; ++a)
#pragma unroll
        for (int b = 0; b < 2; ++b)
#pragma unroll
            for (int m = 0; m < 4; ++m)
#pragma unroll
                for (int n = 0; n < 2; ++n) acc[a][b][m][n] = (f32x4){0.f, 0.f, 0.f, 0.f};
    typedef int v4i_ __attribute__((ext_vector_type(4))); typedef int v8i_ __attribute__((ext_vector_type(8)));
    bf16x8 At[4][2], B0[2][2], B1[2][2];
    v8i_ At8[4], B08[2], B18[2];
    unsigned tkc0 = 0u, tkc1 = 0u, tkn0 = 0u, tkn1 = 0u;
    PG8_LOADTK(tkc0, tkc1, 0);
    const char* cA = (const char*)g.A + (GATHER ? (size_t)0 : (size_t)cur.pm * tstep) + (size_t)cur.kt0 * kstep;
    const char* cB = (const char*)g.Bt + (size_t)cur.e * g.estride + (size_t)cur.pn * tstep + (size_t)cur.kt0 * kstep;
    PG8_STAGEB(PG8_SB(0, 0), cB); PG8_STAGEB(PG8_SB(0, 1), cB + hstep); PG8_STAGEA(PG8_SA(0, 0), cA, tkc0); PG8_STAGEA(PG8_SA(0, 1), cA + hstepA, tkc1);
    if (wr == 1) PG8_BAR;
    PG8_WAIT_V(2); PG8_BAR;
    PG8_STAGEB(PG8_SB(1, 0), cB + kstep); PG8_STAGEA(PG8_SA(1, 0), cA + kstep, tkc0); PG8_STAGEB(PG8_SB(1, 1), cB + hstep + kstep);
    PG8_WAIT_V(6); PG8_BAR;
    for (;;) {
        const bool has_next = S.next(ui + 1, nxt);
        const char* nA = has_next ? (const char*)g.A + (GATHER ? (size_t)0 : (size_t)nxt.pm * tstep) + (size_t)nxt.kt0 * kstep : cA;
        const char* nB = has_next ? (const char*)g.Bt + (size_t)nxt.e * g.estride + (size_t)nxt.pn * tstep + (size_t)nxt.kt0 * kstep : cB;
        tkn0 = tkc0; tkn1 = tkc1;
        if (has_next) PG8_LOADTK(tkn0, tkn1, ui + 1);
        const int nt = cur.nt;
        for (int t = 0; t < nt; t += 2) {
            const bool last = (t == nt - 2);
            int sp = 0; if constexpr (QUARTER) { sp = cur.split; asm volatile("" : "+s"(sp)); }
            const bool q00 = !QUARTER || (sp == 0) | (sp == 1), q01 = !QUARTER || (sp == 0) | (sp == 2), q10 = !QUARTER || (sp == 0) | (sp == 3), q11 = !QUARTER || (sp == 0) | (sp == 4);
            const char* a1 = cA + (size_t)(t + 1) * kstep;
            const char* a2 = last ? nA : cA + (size_t)(t + 2) * kstep; const char* b2 = last ? nB : cB + (size_t)(t + 2) * kstep;
            const char* a3 = a2 + kstep; const char* b3 = b2 + kstep;
            const unsigned t20 = last ? tkn0 : tkc0, t21 = last ? tkn1 : tkc1;
            PG8_LDB(B0, 0, 0); PG8_LDB(B1, 0, 1); PG8_SCHED; PG8_LDA(At, 0, 0); PG8_STAGEA(PG8_SA(1, 1), a1 + hstepA, tkc1);
            int tz = 1; if constexpr (ZIL) { tz = __builtin_amdgcn_readfirstlane(t | (ui > 0 ? 0 : 1)); asm volatile("" : "+s"(tz)); }
            if (tz == 0) { PG8_ZERO(0); PG8_SCHED; }
            PG8_WAIT_V(8); PG8_WAIT_L(0); PG8_BAR; if (q00) PG8_MMA(0, 0, At, B0); if (q01) PG8_MMA(0, 1, At, B1); PG8_BAR; PG8_SCHED;
            PG8_LDA(At, 0, 1); PG8_STAGEB(PG8_SB(0, 0), b2); PG8_STAGEB(PG8_SB(0, 1), b2 + hstep); PG8_STAGEA(PG8_SA(0, 0), a2, t20);
            if (tz == 0) { PG8_ZERO(1); PG8_SCHED; }
            PG8_WAIT_V(8); PG8_WAIT_L(0); PG8_BAR; if (q10) PG8_MMA(1, 0, At, B0); if (q11) PG8_MMA(1, 1, At, B1); PG8_BAR; PG8_SCHED;
            PG8_LDB(B0, 1, 0); PG8_LDB(B1, 1, 1); PG8_SCHED; PG8_LDA(At, 1, 0); PG8_STAGEA(PG8_SA(0, 1), a2 + hstepA, t21);
            PG8_WAIT_V(8); PG8_WAIT_L(0); PG8_BAR; if (q00) PG8_MMA(0, 0, At, B0); if (q01) PG8_MMA(0, 1, At, B1); PG8_BAR; PG8_SCHED;
            PG8_LDA(At, 1, 1); PG8_STAGEB(PG8_SB(1, 0), b3); PG8_STAGEB(PG8_SB(1, 1), b3 + hstep); PG8_STAGEA(PG8_SA(1, 0), a3, t20);
            PG8_WAIT_V(8); PG8_WAIT_L(0); PG8_BAR; if (q10) PG8_MMA(1, 0, At, B0); if (q11) PG8_MMA(1, 1, At, B1); PG8_BAR; PG8_SCHED;
        }
        if (wr == 0) PG8_BAR;
        PreOf<Epi>::run(E, acc, cur, wr, wc, fr, fq, pre);
        asm volatile("" ::: "memory");
        if (!has_next) break;
        pre = PreOf<Epi>::get(E, nxt, wr, wc, fr, fq);
        if constexpr (!ZIL) {
#pragma unroll
        for (int a = 0; a < 2; ++a)
#pragma unroll
            for (int b = 0; b < 2; ++b)
#pragma unroll
                for (int m = 0; m < 4; ++m)
#pragma unroll
                    for (int n = 0; n < 2; ++n) acc[a][b][m][n] = (f32x4){0.f, 0.f, 0.f, 0.f};
        }
        cur = nxt; cA = nA; cB = nB; tkc0 = tkn0; tkc1 = tkn1; ++ui;
        if (wr == 1) PG8_BAR;
    }
    PG8_WAIT_V(0);
    PG8_BAR;
#undef PG8_SA
#undef PG8_SB
#undef PG8_STAGEA
#undef PG8_STAGEB
#undef PG8_LOADTK
#undef PG8_LDA
#undef PG8_LDB
#undef PG8_MMA
#undef PG8_ZERO
#undef PG8_WAIT_V
#undef PG8_WAIT_V8R
#undef PG8_WAIT_L
#undef PG8_BAR
#undef PG8_SCHED
}
}

constexpr int NWAVES = 8;
constexpr int NTOK = 65536, DM = 1024, SEQ = 8192;
constexpr int MIXIN = 2560, FFN = 2816, QKVD = 1280, EXPD = 3584, NEXP = 8;
constexpr int SETROWS = NTOK + NEXP * 256;
constexpr float EPS = 1e-5f;
constexpr float LOG2E = 1.4426950408889634f;
constexpr float QSCALE = 0.125f * LOG2E;

constexpr size_t MiB = 1u << 20;
constexpr size_t WS_CTL = 0, CTL_ZERO_BYTES = 1 * MiB;
constexpr size_t WS_CS = 1 * MiB;
constexpr size_t WS_TOKINFO = 5 * MiB;
constexpr size_t WS_ROWTOK = 7 * MiB;
constexpr size_t WS_ROWGATE = 8 * MiB;
constexpr size_t WS_SSP = 12 * MiB;
constexpr size_t WS_AOOFF = 160 * MiB;
constexpr size_t WS_YOFF = 320 * MiB;
constexpr size_t WS_WSP = 9 * MiB;
constexpr size_t WS_WIN = 16 * MiB, WS_WOUT = 21 * MiB, WS_FGU = 23 * MiB, WS_FD = 34 * MiB;
constexpr size_t WS_WQKV = 40 * MiB, WS_WO = 43 * MiB, WS_MGU = 45 * MiB, WS_MD = 157 * MiB;
constexpr size_t WS_XN = 216 * MiB;
constexpr size_t WS_XG = 344 * MiB;
constexpr size_t WS_BIG = 476 * MiB;
constexpr size_t WS_END = WS_BIG + (size_t)SETROWS * EXPD * 2;
static_assert(WS_MD + (size_t)NEXP * DM * EXPD * 2 <= WS_XN && WS_XN + (size_t)NTOK * DM * 2 <= WS_XG && WS_XG + (size_t)SETROWS * DM * 2 <= WS_BIG, "d_ws map");
static_assert(WS_FD + (size_t)DM * FFN * 2 <= WS_WQKV && WS_MGU + (size_t)NEXP * 2 * EXPD * DM * 2 <= WS_MD, "d_ws map (weights)");
constexpr int CW_BAR = 4096;
constexpr int CW_CNT = 16384;

constexpr int RING_BYTES = 131072;
constexpr int TAB_OFF = RING_BYTES, TAB_ROUNDS = 29, TAB_BYTES = TAB_ROUNDS * 512;
constexpr int LDSCTL_OFF = TAB_OFF + TAB_BYTES, MISC_OFF = LDSCTL_OFF + 320;
constexpr int LDS_BYTES = 147456;
static_assert(MISC_OFF + 64 <= LDS_BYTES && 8 * 64 * 65 * 4 <= LDSCTL_OFF, "LDS map");

#define GAS __attribute__((address_space(1)))
#define LAS __attribute__((address_space(3)))
typedef unsigned short bf16;
typedef unsigned v4u __attribute__((ext_vector_type(4)));
typedef unsigned v2u __attribute__((ext_vector_type(2)));
typedef float f32x4 __attribute__((ext_vector_type(4)));
typedef GAS unsigned gu32;
#define RLX_AGENT __ATOMIC_RELAXED, __HIP_MEMORY_SCOPE_AGENT
#define LDS_WAIT() asm volatile("s_waitcnt lgkmcnt(0)" ::: "memory")
#define VM_WAIT() asm volatile("s_waitcnt vmcnt(0)" ::: "memory")
__device__ __forceinline__ unsigned pk2(float lo, float hi) { return pg8::cvt_pk_bf16(lo, hi); }
__device__ __forceinline__ float bflo(unsigned w) { return __uint_as_float(w << 16); }
__device__ __forceinline__ float bfhi(unsigned w) { return __uint_as_float(w & 0xffff0000u); }
__device__ __forceinline__ float bf1(bf16 h) { return __uint_as_float(((unsigned)h) << 16); }
__device__ __forceinline__ bf16 f2bf1(float f) { return (bf16)(pk2(f, 0.f) & 0xffffu); }
__device__ __forceinline__ void unpack8(const v4u w, float (&f)[8]) { f[0] = bflo(w.x); f[1] = bfhi(w.x); f[2] = bflo(w.y); f[3] = bfhi(w.y); f[4] = bflo(w.z); f[5] = bfhi(w.z); f[6] = bflo(w.w); f[7] = bfhi(w.w); }
__device__ __forceinline__ v4u pack8f(const float (&f)[8]) { v4u w; w.x = pk2(f[0], f[1]); w.y = pk2(f[2], f[3]); w.z = pk2(f[4], f[5]); w.w = pk2(f[6], f[7]); return w; }
__device__ __forceinline__ float gelu_erf(float v) { return 0.5f * v * (1.0f + erff(v * 0.70710678118654752f)); }

#define XB_TMO      128
#define XB_XCNT(j)  (256  + 64 * (j))
#define XB_XSUB(j)  (1280 + 64 * (j))
#define XB_XGEN(j)  (2304 + 64 * (j))
#define XB_TOP      3328
#define XB_TOPGEN   3392
#define XCD_BAR_WORDS 3456
#define XB_SPIN_CAP (1u << 18)

__device__ __forceinline__ unsigned xb_ld(unsigned* p)              { return __hip_atomic_load(p, __ATOMIC_RELAXED, __HIP_MEMORY_SCOPE_AGENT); }
__device__ __forceinline__ unsigned xb_add(unsigned* p, unsigned v) { return __hip_atomic_fetch_add(p, v, __ATOMIC_RELAXED, __HIP_MEMORY_SCOPE_AGENT); }
__device__ __forceinline__ unsigned xb_xcc_id() { return (unsigned)__builtin_amdgcn_s_getreg((3 << 11) | 20) & 0xFu; }
#define XB_SPIN(cond, bar) do { unsigned _sp = 0; while (cond) { __builtin_amdgcn_s_sleep(1); \
    if ((++_sp & 255u) == 0u) { if (xb_ld(&(bar)[XB_TMO])) break; if (_sp > XB_SPIN_CAP) { atomicAdd(&(bar)[XB_TMO], 1u); break; } } } } while (0)

struct XcdBarrier {
    unsigned* bar; unsigned x;
    volatile LAS unsigned* st;
};

__device__ __forceinline__ XcdBarrier xcd_barrier_post(unsigned* bar, volatile LAS unsigned* st) {
    XcdBarrier b; b.bar = bar; b.x = xb_xcc_id(); b.st = st;
    if (threadIdx.x == 0) (void)xb_add(&bar[XB_XCNT(b.x)], 1u);
    return b;
}
__device__ __forceinline__ void xcd_barrier_complete(unsigned* bar, unsigned x, unsigned& nloc, unsigned& nx) {
    const unsigned G = gridDim.x * gridDim.y * gridDim.z;
    unsigned sum, cnt, mine, sp = 0u;
    for (;;) {
        sum = 0u; cnt = 0u; mine = 0u;
#pragma unroll
        for (unsigned j = 0; j < 16; ++j) { const unsigned c = xb_ld(&bar[XB_XCNT(j)]); sum += c; cnt += (c > 0u) ? 1u : 0u; mine = (j == x) ? c : mine; }
        if (sum == G) break;
        __builtin_amdgcn_s_sleep(1);
        if ((++sp & 255u) == 0u) { if (xb_ld(&bar[XB_TMO])) break; if (sp > XB_SPIN_CAP) { atomicAdd(&bar[XB_TMO], 1u); break; } }
    }
    nloc = mine > 0u ? mine : 1u; nx = cnt > 0u ? cnt : 1u;
}

__device__ __forceinline__ void xcd_barrier(const XcdBarrier& b) {
    asm volatile("s_waitcnt vmcnt(0)" ::: "memory");
    __syncthreads();
    if (threadIdx.x == 0) {
        unsigned* bar = b.bar;
        __builtin_amdgcn_s_waitcnt(0);
        unsigned nloc = b.st[0], nx = b.st[1];
        if (nloc == 0u) { xcd_barrier_complete(bar, b.x, nloc, nx); b.st[0] = nloc; b.st[1] = nx; }
        const unsigned old = xb_add(&bar[XB_XSUB(b.x)], 1u);
        const unsigned gen = old / nloc;
        if (old + 1u == (gen + 1u) * nloc) {
            __builtin_amdgcn_fence(__ATOMIC_RELEASE, "agent");
            asm volatile("s_waitcnt vmcnt(0)" ::: "memory");
            const unsigned og = xb_add(&bar[XB_TOP], 1u);
            const unsigned tg = og / nx;
            if (og + 1u == (tg + 1u) * nx) xb_add(&bar[XB_TOPGEN], 1u);
            else XB_SPIN(xb_ld(&bar[XB_TOPGEN]) == tg, bar);
            __builtin_amdgcn_fence(__ATOMIC_ACQUIRE, "agent");
            xb_add(&bar[XB_XGEN(b.x)], 1u);
            asm volatile("s_waitcnt vmcnt(0)" ::: "memory");
        } else {
            XB_SPIN(xb_ld(&bar[XB_XGEN(b.x)]) == gen, bar);
            __builtin_amdgcn_fence(__ATOMIC_ACQUIRE, "agent");
            asm volatile("s_waitcnt vmcnt(0)" ::: "memory");
        }
    }
    __syncthreads();
}

struct Frame {
    LAS unsigned char* lds;
    int tid, lane, wave;
    int vcu, G;
};
__device__ __forceinline__ float wave_sum(float v) {
#pragma unroll
    for (int o = 1; o < 64; o <<= 1) v += __shfl_xor(v, o);
    return v;
}

constexpr int TR_SCR = 64 * 65 * 4;
struct TrItem { const float* W; int N, k0, n0; bf16* WT; int K, orow0; float scale; const float* gk; int f8; };
__device__ __forceinline__ void tr_load(const TrItem& t, float (&r)[64], int lane) {
#pragma unroll
    for (int i = 0; i < 64; ++i) r[i] = t.W[(size_t)(t.k0 + i) * t.N + t.n0 + lane];
}
__device__ __forceinline__ void tr_store(const TrItem& t, const float (&r)[64], LAS float* scr, int lane) {
#pragma unroll
    for (int i = 0; i < 64; ++i) scr[i * 65 + lane] = r[i] * (t.gk ? t.scale * t.gk[t.k0 + i] : t.scale);
    LDS_WAIT(); asm volatile("" ::: "memory");
    const int c = lane & 7;
#pragma unroll
    for (int j = 0; j < 8; ++j) { const int n = (lane >> 3) + 8 * j; const LAS float* s = scr + (8 * c) * 65 + n;
        v4u o; o.x = pk2(s[0 * 65], s[1 * 65]); o.y = pk2(s[2 * 65], s[3 * 65]); o.z = pk2(s[4 * 65], s[5 * 65]); o.w = pk2(s[6 * 65], s[7 * 65]);
        if (t.f8) { unsigned w0 = 0u, w1 = 0u;
            w0 = __builtin_amdgcn_cvt_pk_fp8_f32(s[0 * 65], s[1 * 65], w0, false); w0 = __builtin_amdgcn_cvt_pk_fp8_f32(s[2 * 65], s[3 * 65], w0, true);
            w1 = __builtin_amdgcn_cvt_pk_fp8_f32(s[4 * 65], s[5 * 65], w1, false); w1 = __builtin_amdgcn_cvt_pk_fp8_f32(s[6 * 65], s[7 * 65], w1, true);
            v2u o8; o8.x = w0; o8.y = w1; *(GAS v2u*)((unsigned char*)t.WT + (size_t)(t.orow0 + n) * t.K + t.k0 + 8 * c) = o8; continue; }
        *(GAS v4u*)(t.WT + (size_t)(t.orow0 + n) * t.K + t.k0 + 8 * c) = o; }
    LDS_WAIT(); asm volatile("" ::: "memory");
}
__device__ __forceinline__ TrItem tr_plain(const float* W, int K, int N, bf16* WT, int item, const float* gk = nullptr) {
    const int nblk = N / 64, kb = item / nblk, nb = item % nblk; return TrItem{W, N, 64 * kb, 64 * nb, WT, K, 64 * nb, 1.0f, gk, 0};
}
constexpr float F8_WSCALE = 64.0f;
__device__ __forceinline__ TrItem tr_gu(const float* W, int K, int N, bf16* WT, int up, int item, const float* gk = nullptr, int f8 = 0) {
    const int nblk = N / 64, kb = item / nblk, nb = item % nblk, n0 = 64 * nb; return TrItem{W, N, 64 * kb, n0, WT, K, 256 * (n0 / 128) + 128 * up + (n0 % 128), (up ? 0.6931471805599453f : 1.4426950408889634f) * (f8 ? F8_WSCALE : 1.0f), gk, f8};
}

__device__ __forceinline__ TrItem even_item(int r, const float* w_in, const float* w_out, const float* wg, const float* wu, const float* wd, const float* g1, const float* g2, unsigned char* ws, int f8) {
    constexpr int I_IN = (DM / 64) * (MIXIN / 64), I_OUT = (DM / 64) * (DM / 64), I_G = (DM / 64) * (FFN / 64);
    if (r < I_IN) { const int nblk = MIXIN / 64, kb = r / nblk, n0 = 64 * (r % nblk);
        const int j = (n0 - 512) & 511, orow = (n0 < 512 || n0 >= 1536) ? n0 : 512 + 256 * (j >> 7) + (n0 >= 1024 ? 128 : 0) + (j & 127);
        return TrItem{w_in, MIXIN, 64 * kb, n0, (bf16*)(ws + WS_WIN), DM, orow, 1.0f, g1, 0}; } r -= I_IN;
    if (r < I_OUT) return tr_plain(w_out, DM, DM, (bf16*)(ws + WS_WOUT), r); r -= I_OUT;
    if (r < I_G) return tr_gu(wg, DM, FFN, (bf16*)(ws + WS_FGU), 0, r, g2, f8); r -= I_G;
    if (r < I_G) return tr_gu(wu, DM, FFN, (bf16*)(ws + WS_FGU), 1, r, g2, f8); r -= I_G;
    { TrItem t = tr_plain(wd, FFN, DM, (bf16*)(ws + WS_FD), r); if (f8) { t.f8 = 1; t.scale = F8_WSCALE; } return t; }
}
__device__ __forceinline__ void conv_even_phase(const Frame& F, const float* w_in, const float* w_out, const float* wg, const float* wu, const float* wd, const float* sw, const float* g1, const float* g2, unsigned char* ws, int f8) {
    LAS float* scr = (LAS float*)(F.lds + F.wave * TR_SCR);
    const int gw = F.vcu * NWAVES + F.wave, NGW = F.G * NWAVES;
    constexpr int NITEMS = (DM / 64) * (MIXIN / 64) + (DM / 64) * (DM / 64) + 2 * (DM / 64) * (FFN / 64) + (FFN / 64) * (DM / 64);
    float r[64];
    if (gw < NITEMS) { const TrItem t = even_item(gw, w_in, w_out, wg, wu, wd, g1, g2, ws, f8); tr_load(t, r, F.lane); }
    for (int it = gw; it < NITEMS; it += NGW) {
        const TrItem t = even_item(it, w_in, w_out, wg, wu, wd, g1, g2, ws, f8);
        float cur[64];
#pragma unroll
        for (int i = 0; i < 64; ++i) cur[i] = r[i];
        if (it + NGW < NITEMS) { const TrItem tn = even_item(it + NGW, w_in, w_out, wg, wu, wd, g1, g2, ws, f8); tr_load(tn, r, F.lane); }
        tr_store(t, cur, scr, F.lane);
    }
    bf16* wsp = (bf16*)(ws + WS_WSP);
    for (int idx = (F.vcu * NWAVES * 64) + F.tid; idx < 4 * 128 * 128; idx += F.G * NWAVES * 64) { const int ii = (idx >> 7) & 127, jj = idx & 127; wsp[idx] = f2bf1((jj <= ii) ? sw[idx] : 0.f); }
}
__device__ __forceinline__ TrItem odd_item(int r, const float* wqkv, const float* wo, const float* ewg, const float* ewu, const float* ewd, const float* g1, unsigned char* ws, int f8) {
    constexpr int I_Q = (DM / 64) * (QKVD / 64), I_O = (DM / 64) * (DM / 64), I_G = (DM / 64) * (EXPD / 64), I_D = (EXPD / 64) * (DM / 64);
    if (r < I_Q) { TrItem t = tr_plain(wqkv, DM, QKVD, (bf16*)(ws + WS_WQKV), r, g1); if (f8 & 2) { t.f8 = 1; t.scale = F8_WSCALE; } return t; } r -= I_Q;
    if (r < I_O) { TrItem t = tr_plain(wo, DM, DM, (bf16*)(ws + WS_WO), r); if (f8 & 4) { t.f8 = 1; t.scale = F8_WSCALE; } return t; } r -= I_O;
    const int e = r / (2 * I_G + I_D); r -= e * (2 * I_G + I_D);
    const int f8e = f8 & 1;
    bf16* gu = (bf16*)(ws + WS_MGU + (size_t)e * 2 * EXPD * DM * (f8e ? 1 : 2)); bf16* dd = (bf16*)(ws + WS_MD) + (size_t)e * DM * EXPD;
    if (r < I_G) return tr_gu(ewg + (size_t)e * DM * EXPD, DM, EXPD, gu, 0, r, nullptr, f8e); r -= I_G;
    if (r < I_G) return tr_gu(ewu + (size_t)e * DM * EXPD, DM, EXPD, gu, 1, r, nullptr, f8e); r -= I_G;
    { TrItem t = tr_plain(ewd + (size_t)e * EXPD * DM, EXPD, DM, f8e ? (bf16*)(ws + WS_MD + (size_t)e * DM * EXPD) : dd, r); if (f8e) { t.f8 = 1; t.scale = F8_WSCALE; } return t; }
}
__device__ __forceinline__ void conv_odd_phase(const Frame& F, const float* wqkv, const float* wo, const float* ewg, const float* ewu, const float* ewd, const float* g1, unsigned char* ws, int f8) {
    LAS float* scr = (LAS float*)(F.lds + F.wave * TR_SCR);
    const int gw = F.vcu * NWAVES + F.wave, NGW = F.G * NWAVES;
    constexpr int NITEMS = (DM / 64) * (QKVD / 64) + (DM / 64) * (DM / 64) + NEXP * (2 * (DM / 64) * (EXPD / 64) + (EXPD / 64) * (DM / 64));
    float r[64];
    if (gw < NITEMS) { const TrItem t = odd_item(gw, wqkv, wo, ewg, ewu, ewd, g1, ws, f8); tr_load(t, r, F.lane); }
    for (int it = gw; it < NITEMS; it += NGW) {
        const TrItem t = odd_item(it, wqkv, wo, ewg, ewu, ewd, g1, ws, f8);
        float cur[64];
#pragma unroll
        for (int i = 0; i < 64; ++i) cur[i] = r[i];
        if (it + NGW < NITEMS) { const TrItem tn = odd_item(it + NGW, wqkv, wo, ewg, ewu, ewd, g1, ws, f8); tr_load(tn, r, F.lane); }
        tr_store(t, cur, scr, F.lane);
    }
}
__device__ __forceinline__ void rope_table_phase(const Frame& F, const int* pos, float* cs) {
    for (int idx = (F.vcu * NWAVES * 64) + F.tid; idx < NTOK * 8; idx += F.G * NWAVES * 64) {
        const int t = idx >> 3, i = idx & 7;
        const float inv = (float)exp(-log(500000.0) * (double)(2 * i) / 16.0);
        const float ang = (float)pos[t] * inv;
        cs[(size_t)t * 16 + i] = (float)cos((double)ang); cs[(size_t)t * 16 + 8 + i] = (float)sin((double)ang);
    }
}
__device__ __forceinline__ void rms_phase(const Frame& F, const float* hin, const float* g, bf16* XN) {
    const int gw = F.vcu * NWAVES + F.wave, NGW = F.G * NWAVES;
    f32x4 gv[4];
#pragma unroll
    for (int j = 0; j < 4; ++j) gv[j] = ((const f32x4*)g)[F.lane + 64 * j];
    for (int m = gw; m < NTOK; m += NGW) {
        const GAS f32x4* xr = (const GAS f32x4*)(hin + (size_t)m * DM) + F.lane;
        f32x4 v[4]; float s = 0.f;
#pragma unroll
        for (int j = 0; j < 4; ++j) { v[j] = xr[64 * j]; s += (v[j].x * v[j].x + v[j].y * v[j].y) + (v[j].z * v[j].z + v[j].w * v[j].w); }
        const float rstd = 1.0f / sqrtf(wave_sum(s) * (1.f / DM) + EPS);
        GAS v2u* o8 = (GAS v2u*)(XN + (size_t)m * DM) + F.lane;
#pragma unroll
        for (int j = 0; j < 4; ++j) { const f32x4 y = v[j] * rstd * gv[j]; v2u w; w.x = pk2(y.x, y.y); w.y = pk2(y.z, y.w); o8[64 * j] = w; }
    }
}
__device__ __forceinline__ void xcast_phase(const Frame& F, const float* x, bf16* XN, float* ssp) {
    const int gw = F.vcu * NWAVES + F.wave, NGW = F.G * NWAVES;
    f32x4 nx[4];
    if (gw < NTOK) { const GAS f32x4* xr = (const GAS f32x4*)(x + (size_t)gw * DM) + F.lane;
#pragma unroll
        for (int j = 0; j < 4; ++j) nx[j] = xr[64 * j]; }
    for (int m = gw; m < NTOK; m += NGW) {
        f32x4 v[4]; float s = 0.f;
#pragma unroll
        for (int j = 0; j < 4; ++j) { v[j] = nx[j]; s += (v[j].x * v[j].x + v[j].y * v[j].y) + (v[j].z * v[j].z + v[j].w * v[j].w); }
        if (m + NGW < NTOK) { const GAS f32x4* xr = (const GAS f32x4*)(x + (size_t)(m + NGW) * DM) + F.lane;
#pragma unroll
            for (int j = 0; j < 4; ++j) nx[j] = xr[64 * j]; }
        s = wave_sum(s);
        GAS v2u* o8 = (GAS v2u*)(XN + (size_t)m * DM) + F.lane;
#pragma unroll
        for (int j = 0; j < 4; ++j) { v2u w; w.x = pk2(v[j].x, v[j].y); w.y = pk2(v[j].z, v[j].w); o8[64 * j] = w; }
        if (F.lane == 0) *(GAS f32x4*)(ssp + (size_t)m * 4) = (f32x4){s, 0.f, 0.f, 0.f};
    }
}
__device__ __forceinline__ void rms_final_phase(const Frame& F, const bf16* hb, const float* g, float* out) {
    const int gw = F.vcu * NWAVES + F.wave, NGW = F.G * NWAVES;
    f32x4 gv[4];
#pragma unroll
    for (int j = 0; j < 2; ++j) { gv[2 * j] = *(const f32x4*)(g + 512 * j + 8 * F.lane); gv[2 * j + 1] = *(const f32x4*)(g + 512 * j + 8 * F.lane + 4); }
    v4u nx0 = {0u, 0u, 0u, 0u}, nx1 = nx0;
    if (gw < NTOK) { const bf16* hr = hb + (size_t)gw * DM + 8 * F.lane; nx0 = *(const GAS v4u*)hr; nx1 = *(const GAS v4u*)(hr + 512); }
    for (int m = gw; m < NTOK; m += NGW) {
        float v[16]; { float t[8]; unpack8(nx0, t);
#pragma unroll
            for (int j = 0; j < 8; ++j) v[j] = t[j];
            unpack8(nx1, t);
#pragma unroll
            for (int j = 0; j < 8; ++j) v[8 + j] = t[j]; }
        if (m + NGW < NTOK) { const bf16* hr = hb + (size_t)(m + NGW) * DM + 8 * F.lane; nx0 = *(const GAS v4u*)hr; nx1 = *(const GAS v4u*)(hr + 512); }
        float s = 0.f;
#pragma unroll
        for (int j = 0; j < 16; ++j) s += v[j] * v[j];
        const float rstd = 1.0f / sqrtf(wave_sum(s) * (1.f / DM) + EPS);
        float* orow = out + (size_t)m * DM + 8 * F.lane;
#pragma unroll
        for (int j = 0; j < 2; ++j) { *(GAS f32x4*)(orow + 512 * j) = (f32x4){v[8 * j], v[8 * j + 1], v[8 * j + 2], v[8 * j + 3]} * rstd * gv[2 * j]; *(GAS f32x4*)(orow + 512 * j + 4) = (f32x4){v[8 * j + 4], v[8 * j + 5], v[8 * j + 6], v[8 * j + 7]} * rstd * gv[2 * j + 1]; }
    }
}
__device__ __forceinline__ void rms_router_phase(const Frame& F, const bf16* hb, const float* g, const float* rw, bf16* XNR, unsigned* gcnt, unsigned* tokinfo, int* rowtok, int f8) {
    for (int idx = (F.vcu * NWAVES * 64) + F.tid; idx < 2 * SETROWS; idx += F.G * NWAVES * 64) rowtok[idx] = -1;
    LAS unsigned* lcnt = (LAS unsigned*)F.lds;
    LAS unsigned* lbase = lcnt + 16;
    LAS unsigned* rec = lcnt + 64;
    float gvf[16];
#pragma unroll
    for (int j = 0; j < 16; ++j) gvf[j] = g[512 * (j >> 3) + 8 * F.lane + (j & 7)];
    f32x4 rwv[16][2];
#pragma unroll
    for (int j = 0; j < 16; ++j) { const f32x4* p = (const f32x4*)(rw + (size_t)(512 * (j >> 3) + 8 * F.lane + (j & 7)) * 8); rwv[j][0] = p[0]; rwv[j][1] = p[1]; }
    for (int panel = F.vcu; panel < NTOK / 256; panel += F.G) {
        if (F.tid < 16) lcnt[F.tid] = 0u;
        __syncthreads();
        v4u nx[2][2];
#pragma unroll
        for (int h2 = 0; h2 < 2; ++h2) { const bf16* hr = hb + (size_t)(panel * 256 + F.wave * 32 + 16 * h2) * DM + 8 * F.lane; nx[h2][0] = *(const GAS v4u*)hr; nx[h2][1] = *(const GAS v4u*)(hr + 512); }
        for (int r = 0; r < 16; ++r) {
            float v[2][16], s[2];
#pragma unroll
            for (int h2 = 0; h2 < 2; ++h2) { float t[8]; unpack8(nx[h2][0], t);
#pragma unroll
                for (int j = 0; j < 8; ++j) v[h2][j] = t[j];
                unpack8(nx[h2][1], t);
#pragma unroll
                for (int j = 0; j < 8; ++j) v[h2][8 + j] = t[j];
                float ss = 0.f;
#pragma unroll
                for (int j = 0; j < 16; ++j) ss += v[h2][j] * v[h2][j];
                s[h2] = ss; }
            if (r + 1 < 16) {
#pragma unroll
                for (int h2 = 0; h2 < 2; ++h2) { const bf16* hr = hb + (size_t)(panel * 256 + F.wave * 32 + 16 * h2 + r + 1) * DM + 8 * F.lane; nx[h2][0] = *(const GAS v4u*)hr; nx[h2][1] = *(const GAS v4u*)(hr + 512); } }
#pragma unroll
            for (int o = 1; o < 64; o <<= 1) { s[0] += __shfl_xor(s[0], o); s[1] += __shfl_xor(s[1], o); }
            float lg[2][8];
#pragma unroll
            for (int h2 = 0; h2 < 2; ++h2) { const int m = panel * 256 + F.wave * 32 + 16 * h2 + r;
                const float rstd = 1.0f / sqrtf(s[h2] * (1.f / DM) + EPS);
                f32x4 l0 = (f32x4){0.f, 0.f, 0.f, 0.f}, l1 = l0; float y[16];
#pragma unroll
                for (int j = 0; j < 16; ++j) { y[j] = v[h2][j] * rstd * gvf[j]; l0 += rwv[j][0] * y[j]; l1 += rwv[j][1] * y[j]; }
                if (f8) { unsigned char* xr8 = (unsigned char*)XNR + (size_t)m * DM + 8 * F.lane;
#pragma unroll
                  for (int hh = 0; hh < 2; ++hh) { unsigned w0 = 0u, w1 = 0u;
                      w0 = __builtin_amdgcn_cvt_pk_fp8_f32(y[8 * hh + 0], y[8 * hh + 1], w0, false); w0 = __builtin_amdgcn_cvt_pk_fp8_f32(y[8 * hh + 2], y[8 * hh + 3], w0, true);
                      w1 = __builtin_amdgcn_cvt_pk_fp8_f32(y[8 * hh + 4], y[8 * hh + 5], w1, false); w1 = __builtin_amdgcn_cvt_pk_fp8_f32(y[8 * hh + 6], y[8 * hh + 7], w1, true);
                      v2u o8; o8.x = w0; o8.y = w1; *(GAS v2u*)(xr8 + 512 * hh) = o8; } }
                else { float t[8];
#pragma unroll
                  for (int j = 0; j < 8; ++j) t[j] = y[j];
                  *(GAS v4u*)(XNR + (size_t)m * DM + 8 * F.lane) = pack8f(t);
#pragma unroll
                  for (int j = 0; j < 8; ++j) t[j] = y[8 + j];
                  *(GAS v4u*)(XNR + (size_t)m * DM + 512 + 8 * F.lane) = pack8f(t); }
#pragma unroll
                for (int e = 0; e < 4; ++e) { lg[h2][e] = l0[e]; lg[h2][4 + e] = l1[e]; } }
#pragma unroll
            for (int o = 1; o < 64; o <<= 1) {
#pragma unroll
                for (int e = 0; e < 8; ++e) { lg[0][e] += __shfl_xor(lg[0][e], o); lg[1][e] += __shfl_xor(lg[1][e], o); } }
#pragma unroll
            for (int h2 = 0; h2 < 2; ++h2) { const int lrow = F.wave * 32 + 16 * h2 + r;
                int e1 = 0; float v1 = lg[h2][0];
#pragma unroll
                for (int e = 1; e < 8; ++e) if (lg[h2][e] > v1) { v1 = lg[h2][e]; e1 = e; }
                int e2 = -1; float v2 = -INFINITY;
#pragma unroll
                for (int e = 0; e < 8; ++e) if (e != e1 && (e2 < 0 || lg[h2][e] > v2)) { v2 = lg[h2][e]; e2 = e; }
                const float g2 = 1.0f / (1.0f + expf(v1 - v2)), g1 = 1.0f - g2;
                if (F.lane == 0) {
                    const unsigned p1 = __hip_atomic_fetch_add(lcnt + e1, 1u, __ATOMIC_RELAXED, __HIP_MEMORY_SCOPE_WORKGROUP), p2 = __hip_atomic_fetch_add(lcnt + 8 + e2, 1u, __ATOMIC_RELAXED, __HIP_MEMORY_SCOPE_WORKGROUP);
                    LAS unsigned* rr = rec + lrow * 8; rr[0] = (unsigned)e1; rr[1] = p1; rr[2] = __float_as_uint(g1); rr[3] = (unsigned)e2; rr[4] = p2; rr[5] = __float_as_uint(g2);
                } }
        }
        __syncthreads();
        if (F.tid < 16) lbase[F.tid] = __hip_atomic_fetch_add(gcnt + F.tid, lcnt[F.tid], RLX_AGENT);
        __syncthreads();
        if (F.tid < 256) { const LAS unsigned* rr = rec + F.tid * 8; v4u a, b; a.x = rr[0]; a.y = rr[1] + lbase[rr[0]]; a.z = rr[2]; a.w = rr[3]; b.x = rr[4] + lbase[8 + rr[3]]; b.y = rr[5]; b.z = 0u; b.w = 0u;
            GAS v4u* ti = (GAS v4u*)(tokinfo + (size_t)(panel * 256 + F.tid) * 8); ti[0] = a; ti[1] = b; }
        __syncthreads();
    }
}
__device__ __forceinline__ void moe_prefix(const unsigned* gcnt_set, int (&pend)[8]) {
    int acc = 0;
#pragma unroll
    for (int e = 0; e < 8; ++e) { const unsigned c = __hip_atomic_load(gcnt_set + e, RLX_AGENT); acc += (int)((c + 255u) >> 8); pend[e] = acc; }
}
__device__ __forceinline__ void slots_phase(const Frame& F, const unsigned* gcnt, const unsigned* tokinfo, int* rowtok, float* rowgate) {
    int pe0[8], pe1[8]; moe_prefix(gcnt, pe0); moe_prefix(gcnt + 8, pe1);
    for (int t = F.vcu * NWAVES * 64 + F.tid; t < NTOK; t += F.G * NWAVES * 64) {
        const v4u a = *(const GAS v4u*)(tokinfo + (size_t)t * 8), b = *(const GAS v4u*)(tokinfo + (size_t)t * 8 + 4);
        const int e1 = (int)a.x, e2 = (int)a.w; int s1 = 0, s2 = 0;
#pragma unroll
        for (int k = 0; k < 7; ++k) { s1 = (e1 == k + 1) ? pe0[k] : s1; s2 = (e2 == k + 1) ? pe1[k] : s2; }
        const size_t slot1 = (size_t)s1 * 256 + a.y, slot2 = (size_t)SETROWS + (size_t)s2 * 256 + b.x;
        rowtok[slot1] = t; rowgate[slot1] = __uint_as_float(a.z); rowtok[slot2] = t; rowgate[slot2] = __uint_as_float(b.y);
    }
}

typedef short bf16x8v __attribute__((ext_vector_type(8)));
typedef float f32x16 __attribute__((ext_vector_type(16)));
constexpr int AT_KP = 144, AT_VP = 528, AT_VOFF = 256 * AT_KP;
__device__ __forceinline__ void attn_mfma_phase(const Frame& F, const bf16* QKV, const float* sinks, bf16* AO, int ao8) {
    LAS unsigned char* Ks = F.lds; LAS unsigned char* Vt = F.lds + AT_VOFF;
    const int q = F.lane & 31, hi = F.lane >> 5;
    v4u kreg[4], vreg[4];
#define AT_FETCH(unit_) do { const int b_ = (unit_) >> 7, n_ = ((unit_) >> 1) & 63, hk_ = (unit_) & 1; _Pragma("unroll") for (int i = 0; i < 4; ++i) { const int p = F.tid + 512 * i, key = p >> 3, ch = p & 7; \
        const int kt = (n_ == 0 && key < 128) ? key : (n_ - 1) * 128 + key;        \
        const bf16* src = QKV + ((size_t)b_ * SEQ + kt) * QKVD + 1024 + hk_ * 64 + ch * 8; kreg[i] = *(const GAS v4u*)src; vreg[i] = *(const GAS v4u*)(src + 128); } } while (0)
    int unit = F.vcu;
    if (unit < 8 * 64 * 2) AT_FETCH(unit);
    for (; unit < 8 * 64 * 2; unit += F.G) {
        const int b = unit >> 7, n = (unit >> 1) & 63, hk = unit & 1;
        const size_t tb = (size_t)b * SEQ;
#pragma unroll
        for (int i = 0; i < 4; ++i) { const int p = F.tid + 512 * i, key = p >> 3, ch = p & 7;
            *(LAS v4u*)(Ks + key * AT_KP + ch * 16) = kreg[i];
            const v4u v = vreg[i];
            const int kg = key & 15, kpos = (key & ~15) + (kg & 3) + ((kg >> 3) & 1) * 4 + ((kg >> 2) & 1) * 8;
            LAS unsigned short* vp = (LAS unsigned short*)(Vt + (ch * 8) * AT_VP + kpos * 2);
            vp[0 * (AT_VP / 2)] = (unsigned short)(v.x & 0xffffu); vp[1 * (AT_VP / 2)] = (unsigned short)(v.x >> 16); vp[2 * (AT_VP / 2)] = (unsigned short)(v.y & 0xffffu); vp[3 * (AT_VP / 2)] = (unsigned short)(v.y >> 16);
            vp[4 * (AT_VP / 2)] = (unsigned short)(v.z & 0xffffu); vp[5 * (AT_VP / 2)] = (unsigned short)(v.z >> 16); vp[6 * (AT_VP / 2)] = (unsigned short)(v.w & 0xffffu); vp[7 * (AT_VP / 2)] = (unsigned short)(v.w >> 16); }
        const int head = hk * 8 + F.wave; const float sk = sinks[head] * LOG2E;
        bf16x8v qf[4][4];
#pragma unroll
        for (int qt = 0; qt < 4; ++qt)
#pragma unroll
            for (int d0 = 0; d0 < 4; ++d0) qf[qt][d0] = *(const GAS bf16x8v*)(QKV + (tb + (size_t)n * 128 + qt * 32 + q) * QKVD + head * 64 + 16 * d0 + 8 * hi);
        if (unit + F.G < 8 * 64 * 2) AT_FETCH(unit + F.G);
        __syncthreads();
#pragma unroll
        for (int qt = 0; qt < 4; ++qt) {
            const size_t qrow = tb + (size_t)n * 128 + qt * 32 + q;
            f32x16 p[5];
#pragma unroll
            for (int j = 0; j < 5; ++j) {
                const int kt = qt + j;
                if (n == 0 && kt < 4) {
#pragma unroll
                    for (int r = 0; r < 16; ++r) p[j][r] = -INFINITY;
                } else {
                    f32x16 a = {0.f, 0.f, 0.f, 0.f, 0.f, 0.f, 0.f, 0.f, 0.f, 0.f, 0.f, 0.f, 0.f, 0.f, 0.f, 0.f};
                    const LAS unsigned char* kp = Ks + (32 * kt + q) * AT_KP + 16 * hi;
#pragma unroll
                    for (int d0 = 0; d0 < 4; ++d0) a = __builtin_amdgcn_mfma_f32_32x32x16_bf16(*(const LAS bf16x8v*)(kp + 32 * d0), qf[qt][d0], a, 0, 0, 0);
                    p[j] = a;
                }
            }
#pragma unroll
            for (int r = 0; r < 16; ++r) { const int key = (r & 3) + 8 * (r >> 2) + 4 * hi; if (key <= q) p[0][r] = -INFINITY; if (key > q) p[4][r] = -INFINITY; }
            float mx = sk;
#pragma unroll
            for (int j = 0; j < 5; ++j)
#pragma unroll
                for (int r = 0; r < 16; ++r) mx = fmaxf(mx, p[j][r]);
            mx = fmaxf(mx, __shfl_xor(mx, 32));
            float ls = 0.f;
#pragma unroll
            for (int j = 0; j < 5; ++j)
#pragma unroll
                for (int r = 0; r < 16; ++r) { p[j][r] = __builtin_amdgcn_exp2f(p[j][r] - mx); ls += p[j][r]; }
            ls += __shfl_xor(ls, 32); ls += __builtin_amdgcn_exp2f(sk - mx);
            f32x16 o0 = {0.f, 0.f, 0.f, 0.f, 0.f, 0.f, 0.f, 0.f, 0.f, 0.f, 0.f, 0.f, 0.f, 0.f, 0.f, 0.f}, o1 = o0;
#pragma unroll
            for (int j = 0; j < 5; ++j) {
                const int kt = qt + j;
                if (!(n == 0 && kt < 4)) {
#pragma unroll
                    for (int ks = 0; ks < 2; ++ks) {
                        v4u pw; pw.x = pk2(p[j][8 * ks + 0], p[j][8 * ks + 1]); pw.y = pk2(p[j][8 * ks + 2], p[j][8 * ks + 3]); pw.z = pk2(p[j][8 * ks + 4], p[j][8 * ks + 5]); pw.w = pk2(p[j][8 * ks + 6], p[j][8 * ks + 7]);
                        const bf16x8v pf = __builtin_bit_cast(bf16x8v, pw);
                        const LAS unsigned char* vp = Vt + q * AT_VP + (32 * kt + 16 * ks + 8 * hi) * 2;
                        o0 = __builtin_amdgcn_mfma_f32_32x32x16_bf16(*(const LAS bf16x8v*)vp, pf, o0, 0, 0, 0);
                        o1 = __builtin_amdgcn_mfma_f32_32x32x16_bf16(*(const LAS bf16x8v*)(vp + 32 * AT_VP), pf, o1, 0, 0, 0);
                    }
                }
            }
            const float il = 1.0f / ls;
            if (ao8) { unsigned char* orow8 = (unsigned char*)AO + qrow * DM + head * 64 + 8 * hi; const float il8 = il * 8.0f;
#pragma unroll
                for (int jg = 0; jg < 4; jg += 2) { unsigned a0 = 0u, b0 = 0u, a1 = 0u, b1 = 0u;
                    a0 = __builtin_amdgcn_cvt_pk_fp8_f32(o0[4 * jg] * il8, o0[4 * jg + 1] * il8, a0, false); a0 = __builtin_amdgcn_cvt_pk_fp8_f32(o0[4 * jg + 2] * il8, o0[4 * jg + 3] * il8, a0, true);
                    b0 = __builtin_amdgcn_cvt_pk_fp8_f32(o0[4 * jg + 4] * il8, o0[4 * jg + 5] * il8, b0, false); b0 = __builtin_amdgcn_cvt_pk_fp8_f32(o0[4 * jg + 6] * il8, o0[4 * jg + 7] * il8, b0, true);
                    a1 = __builtin_amdgcn_cvt_pk_fp8_f32(o1[4 * jg] * il8, o1[4 * jg + 1] * il8, a1, false); a1 = __builtin_amdgcn_cvt_pk_fp8_f32(o1[4 * jg + 2] * il8, o1[4 * jg + 3] * il8, a1, true);
                    b1 = __builtin_amdgcn_cvt_pk_fp8_f32(o1[4 * jg + 4] * il8, o1[4 * jg + 5] * il8, b1, false); b1 = __builtin_amdgcn_cvt_pk_fp8_f32(o1[4 * jg + 6] * il8, o1[4 * jg + 7] * il8, b1, true);
                    { auto r = __builtin_amdgcn_permlane32_swap(a0, b0, false, false); a0 = r[0]; b0 = r[1]; }
                    { auto r = __builtin_amdgcn_permlane32_swap(a1, b1, false, false); a1 = r[0]; b1 = r[1]; }
                    *(GAS v2u*)(orow8 + 8 * jg) = (v2u){a0, b0}; *(GAS v2u*)(orow8 + 32 + 8 * jg) = (v2u){a1, b1}; }
                continue; }
            bf16* orow = AO + qrow * DM + head * 64 + 8 * hi;
#pragma unroll
            for (int jg = 0; jg < 4; jg += 2) { v2u a0, b0, a1, b1;
                a0.x = pk2(o0[4 * jg] * il, o0[4 * jg + 1] * il); a0.y = pk2(o0[4 * jg + 2] * il, o0[4 * jg + 3] * il);
                b0.x = pk2(o0[4 * jg + 4] * il, o0[4 * jg + 5] * il); b0.y = pk2(o0[4 * jg + 6] * il, o0[4 * jg + 7] * il);
                a1.x = pk2(o1[4 * jg] * il, o1[4 * jg + 1] * il); a1.y = pk2(o1[4 * jg + 2] * il, o1[4 * jg + 3] * il);
                b1.x = pk2(o1[4 * jg + 4] * il, o1[4 * jg + 5] * il); b1.y = pk2(o1[4 * jg + 6] * il, o1[4 * jg + 7] * il);
                { auto r = __builtin_amdgcn_permlane32_swap(a0.x, b0.x, false, false); a0.x = r[0]; b0.x = r[1]; }
                { auto r = __builtin_amdgcn_permlane32_swap(a0.y, b0.y, false, false); a0.y = r[0]; b0.y = r[1]; }
                { auto r = __builtin_amdgcn_permlane32_swap(a1.x, b1.x, false, false); a1.x = r[0]; b1.x = r[1]; }
                { auto r = __builtin_amdgcn_permlane32_swap(a1.y, b1.y, false, false); a1.y = r[0]; b1.y = r[1]; }
                *(GAS v4u*)(orow + 8 * jg) = (v4u){a0.x, a0.y, b0.x, b0.y}; *(GAS v4u*)(orow + 32 + 8 * jg) = (v4u){a1.x, a1.y, b1.x, b1.y}; }
        }
        __syncthreads();
    }
#undef AT_FETCH
}

typedef float f32x2 __attribute__((ext_vector_type(2)));
__device__ __forceinline__ f32x2 gelu_pk(f32x2 v) {
    const f32x2 av = __builtin_elementwise_abs(v), d = av * 0.2316418882f + 1.0f;
    f32x2 t; t.x = __builtin_amdgcn_rcpf(d.x); t.y = __builtin_amdgcn_rcpf(d.y);
    f32x2 q = t * 0.5307027145f + (-0.7265760135f); q = q * t + 0.7107068705f; q = q * t + (-0.142248368f); q = q * t + 0.127414796f; q = q * t;
    const f32x2 s = (v * v) * (-0.72134752044f);
    f32x2 e; e.x = __builtin_amdgcn_exp2f(s.x); e.y = __builtin_amdgcn_exp2f(s.y);
    const f32x2 m = v * (q * e), r = v - m;
    f32x2 o; o.x = v.x < 0.f ? m.x : r.x; o.y = v.y < 0.f ? m.y : r.y; return o;
}
constexpr int ZP = 2048;
__device__ __forceinline__ int mx_swz(int row) { return (row ^ (row >> 4)) & 15; }
__device__ __forceinline__ void mixer_fused_phase(const Frame& F, const bf16* Z, bf16* Y, const float* convw, const float* lng, const float* lnb, const bf16* Wb, const float* sb, int pmode = 0) {
    LAS unsigned char* vt = F.lds;
    const int c8 = 8 * F.lane, q = F.lane & 31, hi = F.lane >> 5;
    for (int unit = F.vcu; unit < NTOK / 128; unit += F.G) {
        const size_t t0 = (size_t)unit * 128;
        if (pmode != 2) {
            float cw0[8], cw1[8], cw2[8], lg[8], lb[8];
#pragma unroll
            for (int j = 0; j < 8; ++j) { cw0[j] = convw[(c8 + j) * 3 + 0]; cw1[j] = convw[(c8 + j) * 3 + 1]; cw2[j] = convw[(c8 + j) * 3 + 2]; lg[j] = lng[c8 + j]; lb[j] = lnb[c8 + j]; }
            const size_t tw = t0 + 16 * F.wave;
            float cx1[8], cx2[8];
            if ((tw % SEQ) != 0) {
                unpack8(*(const GAS v4u*)(Z + (tw - 1) * ZP + 512 + c8), cx1);
                unpack8(*(const GAS v4u*)(Z + (tw - 2) * ZP + 512 + c8), cx2);
            } else {
#pragma unroll
                for (int j = 0; j < 8; ++j) { cx1[j] = 0.f; cx2[j] = 0.f; }
            }
            constexpr int NTB = 2;
            v4u nab[NTB], ncx[NTB], nbv[NTB];
#pragma unroll
            for (int k = 0; k < NTB; ++k) { const bf16* zr = Z + (tw + k) * ZP; nab[k] = *(const GAS v4u*)(zr + c8); ncx[k] = *(const GAS v4u*)(zr + 512 + c8); nbv[k] = *(const GAS v4u*)(zr + 1536 + c8); }
#pragma unroll 1
            for (int r0 = 0; r0 < 16; r0 += NTB) {
                v4u wab[NTB], wcx[NTB], wbv[NTB];
#pragma unroll
                for (int k = 0; k < NTB; ++k) { wab[k] = nab[k]; wcx[k] = ncx[k]; wbv[k] = nbv[k]; }
                if (r0 + NTB < 16) {
#pragma unroll
                    for (int k = 0; k < NTB; ++k) { const bf16* zr = Z + (tw + r0 + NTB + k) * ZP; nab[k] = *(const GAS v4u*)(zr + c8); ncx[k] = *(const GAS v4u*)(zr + 512 + c8); nbv[k] = *(const GAS v4u*)(zr + 1536 + c8); } }
                float vv[NTB][8], s[NTB];
#pragma unroll
                for (int k = 0; k < NTB; ++k) {
                    float ab[8], cxv[8], bv[8], ya[8];
                    unpack8(wab[k], ab); unpack8(wcx[k], cxv); unpack8(wbv[k], bv);
#pragma unroll
                    for (int j = 0; j < 8; ++j) { const float cx0 = cxv[j]; ya[j] = ab[j] * (cw0[j] * cx2[j] + cw1[j] * cx1[j] + cw2[j] * cx0); cx2[j] = cx1[j]; cx1[j] = cx0; }
                    *(GAS v4u*)(Y + (tw + r0 + k) * DM + c8) = pack8f(ya);
                    float sk = 0.f;
#pragma unroll
                    for (int j = 0; j < 8; j += 2) { const f32x2 gv = gelu_pk((f32x2){bv[j], bv[j + 1]}); vv[k][j] = gv.x; vv[k][j + 1] = gv.y; sk += gv.x + gv.y; }
                    s[k] = sk;
                }
#pragma unroll
                for (int o = 1; o < 64; o <<= 1) {
#pragma unroll
                    for (int k = 0; k < NTB; ++k) s[k] += __shfl_xor(s[k], o); }
                float q[NTB];
#pragma unroll
                for (int k = 0; k < NTB; ++k) { const float mu = s[k] * (1.f / 512.f); float qq = 0.f;
#pragma unroll
                    for (int j = 0; j < 8; ++j) { vv[k][j] -= mu; qq += vv[k][j] * vv[k][j]; }
                    q[k] = qq; }
#pragma unroll
                for (int o = 1; o < 64; o <<= 1) {
#pragma unroll
                    for (int k = 0; k < NTB; ++k) q[k] += __shfl_xor(q[k], o); }
#pragma unroll
                for (int k = 0; k < NTB; ++k) { const float rstd = 1.0f / sqrtf(q[k] * (1.f / 512.f) + EPS); const int jl = 16 * F.wave + r0 + k;
#pragma unroll
                    for (int j = 0; j < 8; ++j) { const int row = c8 + j; const float y = vv[k][j] * rstd * lg[j] + lb[j];
                        *(LAS unsigned short*)(vt + row * 256 + (((jl >> 3) ^ mx_swz(row)) << 4) + (jl & 7) * 2) = f2bf1(y); } }
            }
        }
        __syncthreads();
        if (pmode != 1) {
            const int h = F.wave >> 1, dt0 = 2 * (F.wave & 1);
            v2u bwa[4][2][4];
#pragma unroll
            for (int it = 0; it < 4; ++it) {
#pragma unroll
                for (int dl = 0; dl < 2; ++dl)
#pragma unroll
                    for (int jg = 0; jg < 4; ++jg) bwa[it][dl][jg] = *(const GAS v2u*)(Z + (t0 + 32 * it + q) * ZP + 1024 + h * 128 + 32 * (dt0 + dl) + 4 * hi + 8 * jg);
            }
#pragma unroll
            for (int it = 0; it < 4; ++it) {
                const size_t tok = t0 + 32 * it + q; const float sbv = sb[h * 128 + 32 * it + q];
                bf16x8v wf[8];
                const bf16* wrow = Wb + (size_t)(h * 128 + 32 * it + q) * 128 + 8 * hi;
#pragma unroll
                for (int ks = 0; ks < 2 * (it + 1); ++ks) wf[ks] = *(const GAS bf16x8v*)(wrow + 16 * ks);
#pragma unroll
                for (int dl = 0; dl < 2; ++dl) {
                    const int dt = dt0 + dl, row = h * 128 + 32 * dt + q; const LAS unsigned char* ap = vt + row * 256; const int sw = mx_swz(row);
                    f32x16 acc = {0.f, 0.f, 0.f, 0.f, 0.f, 0.f, 0.f, 0.f, 0.f, 0.f, 0.f, 0.f, 0.f, 0.f, 0.f, 0.f};
#pragma unroll
                    for (int ks = 0; ks < 2 * (it + 1); ++ks) acc = __builtin_amdgcn_mfma_f32_32x32x16_bf16(*(const LAS bf16x8v*)(ap + (((2 * ks + hi) ^ sw) << 4)), wf[ks], acc, 0, 0, 0);
                    const int cb = h * 128 + 32 * dt + 8 * hi;
                    v2u wv[4];
#pragma unroll
                    for (int jg = 0; jg < 4; ++jg) { const v2u bw = bwa[it][dl][jg];
                        const f32x2 u0 = gelu_pk((f32x2){bflo(bw.x), bfhi(bw.x)}), u1 = gelu_pk((f32x2){bflo(bw.y), bfhi(bw.y)});
                        wv[jg].x = pk2(u0.x * (acc[4 * jg] + sbv), u0.y * (acc[4 * jg + 1] + sbv)); wv[jg].y = pk2(u1.x * (acc[4 * jg + 2] + sbv), u1.y * (acc[4 * jg + 3] + sbv)); }
#pragma unroll
                    for (int jg = 0; jg < 4; jg += 2) { v2u a = wv[jg], b = wv[jg + 1];
                        { auto r = __builtin_amdgcn_permlane32_swap(a.x, b.x, false, false); a.x = r[0]; b.x = r[1]; }
                        { auto r = __builtin_amdgcn_permlane32_swap(a.y, b.y, false, false); a.y = r[0]; b.y = r[1]; }
                        *(GAS v4u*)(Y + tok * DM + 512 + cb + 8 * jg) = (v4u){a.x, a.y, b.x, b.y}; }
                }
            }
        }
        __syncthreads();
    }
}

struct Args {
    const float* x; const int* pos; const float* fng;
    const float *e_n1, *e_win, *e_conv, *e_lng, *e_lnb, *e_sw, *e_sb, *e_wout, *e_n2, *e_wg, *e_wu, *e_wd;
    const float *o_n1, *o_wqkv, *o_bqkv, *o_sinks, *o_wo, *o_bo, *o_n2, *o_rw, *o_ewg, *o_ewu, *o_ewd;
    float* out; unsigned char* ws; int lo, hi, li, pad;
};
constexpr int PH_PER_PAIR = 16;
#ifndef F8_MOE_MASK
#define F8_MOE_MASK 3
#endif
#define F8M(i) (F8_MOE_MASK == 3 ? 1 : ((F8_MOE_MASK >> (i)) & 1))
#ifndef F8_FFN_MASK
#define F8_FFN_MASK 2
#endif
#define F8F(i) ((F8_FFN_MASK >> (i)) & 1)
#ifndef F8_QKV_MASK
#define F8_QKV_MASK 3
#endif
#define F8Q(i) (F8_QKV_MASK == 3 ? 1 : ((F8_QKV_MASK >> (i)) & 1))
#ifndef F8_WO_MASK
#define F8_WO_MASK 3
#endif
#define F8O(i) (F8_WO_MASK == 3 ? 1 : ((F8_WO_MASK >> (i)) & 1))
#ifndef F8_H1SCALE
#define F8_H1SCALE 8.0f
#define F8_H1SCALE_I 8
constexpr size_t H1SET8 = (size_t)SETROWS * EXPD;
static_assert(WS_BIG + 2 * H1SET8 <= WS_END, "two e4m3 H1 buffers");
#endif
#ifndef WGM_MOEGU
#define WGM_MOEGU 4
#endif
#ifndef WGM_N1024
#define WGM_N1024 4
#endif
#ifndef WGM_E1
#define WGM_E1 4
#endif
#ifndef WGM_FFNGU
#define WGM_FFNGU 4
#endif
#ifndef WGM_QKV
#define WGM_QKV 4
#endif
#ifndef PROBE_MODE
#define PROBE_MODE 0
#endif
#ifndef PROBE_STAG
#define PROBE_STAG 0
#endif
#ifndef STAG_MOEGU
#define STAG_MOEGU 0
#endif
#ifndef STAG_FFNGU
#define STAG_FFNGU 0
#endif
constexpr int N_PHASES = 1 + 2 * PH_PER_PAIR + 1;

typedef const __attribute__((address_space(4))) Args* ArgsP;
#define PH_ARGS(ap) ArgsP ap = (ArgsP)__builtin_amdgcn_kernarg_segment_ptr(); asm volatile("" : "+s"(ap))
__device__ __forceinline__ Frame make_frame(LAS unsigned char* lds) {
    Frame F; int tid = threadIdx.x; asm volatile("" : "+v"(tid));
    F.lds = lds; F.tid = tid; F.lane = tid & 63; F.wave = __builtin_amdgcn_readfirstlane(tid >> 6);
    F.G = gridDim.x; { const int bx = blockIdx.x; F.vcu = (F.G % 8 == 0) ? (bx % 8) * (F.G / 8) + bx / 8 : bx; }
    return F;
}
__global__ void __launch_bounds__(NWAVES * 64, 2) fwd(Args A_unused) {
    extern __shared__ __attribute__((aligned(16))) unsigned char lds_raw[];
    LAS unsigned char* const lds = (LAS unsigned char*)lds_raw;
    asm volatile("s_setreg_imm32_b32 hwreg(HW_REG_MODE, 23, 1), 1");
    for (int u = threadIdx.x; u < (LDS_BYTES - LDSCTL_OFF) / 4; u += NWAVES * 64) ((LAS unsigned*)(lds + LDSCTL_OFF))[u] = 0u;
    __syncthreads();
    int lo, hi;
    { PH_ARGS(ap); lo = ap->lo; hi = ap->hi; }
#if MK_ONE_LAUNCH
    XcdBarrier bar;
    { PH_ARGS(ap); bar = xcd_barrier_post((unsigned*)(ap->ws + WS_CTL) + CW_BAR, (volatile LAS unsigned*)(lds + MISC_OFF) + 8); }
#define GRID_BAR() xcd_barrier(bar)
#else
#define GRID_BAR() do { } while (0)
#endif
#ifndef PHMASK
#define PHMASK 0xFFFFFFFFu
#endif
#define PHEN(k) (((PHMASK) >> (k)) & 1u)
#ifndef PROBE_DUP
#define PROBE_DUP 0u
#endif
#define DUP(k) (1 + (int)(((PROBE_DUP) >> (k)) & 1u))
#define IN(k) (lo <= (k) && (k) < hi)
#define SEAM(k) do { if (IN(k) && IN((k) + 1)) GRID_BAR(); } while (0)
#define PH_BEGIN() PH_ARGS(ap); const Frame F = make_frame(lds); unsigned char* const ws = ap->ws; const int G = F.G, cblk = (int)blockIdx.x; (void)G; (void)cblk

    if (IN(0) && PHEN(16)) { PH_BEGIN(); rope_table_phase(F, ap->pos, (float*)(ws + WS_CS)); }

#pragma unroll 1
    for (int i = 0; i < 2; ++i) {
        const int pb = 1 + i * PH_PER_PAIR;
        if (IN(pb + 0) && PHEN(0)) { PH_BEGIN(); for (int rep_ = 0; rep_ < DUP(0); ++rep_) { conv_even_phase(F, ap->e_win + (size_t)i * DM * MIXIN, ap->e_wout + (size_t)i * DM * DM, ap->e_wg + (size_t)i * DM * FFN, ap->e_wu + (size_t)i * DM * FFN, ap->e_wd + (size_t)i * FFN * DM, ap->e_sw + (size_t)i * 4 * 128 * 128, ap->e_n1 + i * DM, ap->e_n2 + i * DM, ws, F8F(i) ? 1 : 0);
                          if (i == 0) xcast_phase(F, ap->x, (bf16*)(ws + WS_XN), (float*)(ws + WS_SSP)); } } SEAM(pb + 0);
        if (IN(pb + 1) && PHEN(1)) { PH_BEGIN(); for (int rep_ = 0; rep_ < DUP(1); ++rep_) { pg8::Gemm g{(const bf16*)(ws + WS_XN), (const bf16*)(ws + WS_WIN), DM, 0}; pg8::StaticOrder S; S.init(NTOK, MIXIN, G, cblk, WGM_E1); if (rep_ + 1 < DUP(1)) {
#if PROBE_MODE >= 10
                              pg8::EpiMixIn E0{(bf16*)(ws + WS_BIG), PROBE_MODE == 10 ? (const float*)(ws + WS_SSP) : (const float*)nullptr}; pg8::gemm_phase<pg8::EpiMixIn, pg8::StaticOrder, true, true>(F.lds, g, S, E0);
#else
                              pg8::EpiProbe<PROBE_MODE> E0{(bf16*)(ws + WS_BIG), 2048}; pg8::gemm_phase<pg8::EpiProbe<PROBE_MODE>, pg8::StaticOrder, true, true>(F.lds, g, S, E0, PROBE_STAG);
#endif
                          }
                          else { pg8::EpiMixIn E{(bf16*)(ws + WS_BIG), (const float*)(ws + WS_SSP)};
                          pg8::gemm_phase<pg8::EpiMixIn, pg8::StaticOrder, true, true>(F.lds, g, S, E); } } } SEAM(pb + 1);
        if (IN(pb + 2) && PHEN(2)) { PH_BEGIN(); for (int rep_ = 0; rep_ < DUP(2); ++rep_) { mixer_fused_phase(F, (const bf16*)(ws + WS_BIG), (bf16*)(ws + WS_BIG + WS_YOFF), ap->e_conv + i * 512 * 3, ap->e_lng + i * 512, ap->e_lnb + i * 512, (const bf16*)(ws + WS_WSP), ap->e_sb + i * 4 * 128, (rep_ + 1 < DUP(2)) ? PROBE_MODE : 0); } } SEAM(pb + 2);
        if (IN(pb + 3) && PHEN(4)) { PH_BEGIN(); pg8::Gemm g{(const bf16*)(ws + WS_BIG + WS_YOFF), (const bf16*)(ws + WS_WOUT), DM, 0}; pg8::StaticOrder S; S.init(NTOK, DM, G, cblk, WGM_N1024);
                          if (F8F(i)) { typedef pg8::EpiResB<false, 1, (long)WS_XG - (long)WS_XN> EpiT; EpiT E{(bf16*)(ws + WS_XN), nullptr, (float*)(ws + WS_SSP), (LAS float*)(F.lds + TAB_OFF), 1};
                              pg8::gemm_phase<EpiT, pg8::StaticOrder, true, true>(F.lds, g, S, E); }
                          else { pg8::EpiResB<true> E{(bf16*)(ws + WS_XN), nullptr, (float*)(ws + WS_SSP), (LAS float*)(F.lds + TAB_OFF), 1};
                          pg8::gemm_phase<pg8::EpiResB<true>, pg8::StaticOrder, true, true>(F.lds, g, S, E); } } SEAM(pb + 3);
        if (IN(pb + 4) && PHEN(6)) { PH_BEGIN(); for (int rep_ = 0; rep_ < DUP(6); ++rep_) { if (F8F(i)) { pg8::Gemm g{(const bf16*)(ws + WS_XG), (const bf16*)(ws + WS_FGU), DM / 2, 0}; pg8::StaticOrder S; S.init(NTOK, 2 * FFN, G, cblk, WGM_FFNGU, DM / 128);
                              pg8::EpiSwiGLU E{(bf16*)(ws + WS_BIG), FFN, (const float*)(ws + WS_SSP), 1.0f / 64.0f, F8_H1SCALE}; pg8::gemm_phase2<pg8::EpiSwiGLU, pg8::StaticOrder, false, false, true>(F.lds, g, S, E, nullptr, STAG_FFNGU); }
                          else { pg8::Gemm g{(const bf16*)(ws + WS_XN), (const bf16*)(ws + WS_FGU), DM, 0}; pg8::StaticOrder S; S.init(NTOK, 2 * FFN, G, cblk, WGM_FFNGU);
                          pg8::EpiSwiGLU E{(bf16*)(ws + WS_BIG), FFN, (const float*)(ws + WS_SSP), 1.0f, 0.0f}; pg8::gemm_phase<pg8::EpiSwiGLU, pg8::StaticOrder, true, true>(F.lds, g, S, E, STAG_FFNGU); } } } SEAM(pb + 4);
        if (IN(pb + 5) && PHEN(7)) { PH_BEGIN();
                          if (F8F(i)) { pg8::Gemm g{(const bf16*)(ws + WS_BIG), (const bf16*)(ws + WS_FD), FFN / 2, 0}; pg8::StaticOrder S; S.init(NTOK, DM, G, cblk, WGM_N1024, FFN / 128);
                              if (F8Q(i)) { typedef pg8::EpiResB<false, 64 * F8_H1SCALE_I, (long)WS_XG - (long)WS_XN> EpiT; EpiT E{(bf16*)(ws + WS_XN), nullptr, (float*)(ws + WS_SSP), (LAS float*)(F.lds + TAB_OFF), 1};
                                  pg8::gemm_phase2<EpiT, pg8::StaticOrder, false, false, true>(F.lds, g, S, E, nullptr); }
                              else { typedef pg8::EpiResB<true, 64 * F8_H1SCALE_I> EpiT; EpiT E{(bf16*)(ws + WS_XN), nullptr, (float*)(ws + WS_SSP), (LAS float*)(F.lds + TAB_OFF), 1};
                              pg8::gemm_phase2<EpiT, pg8::StaticOrder, false, false, true>(F.lds, g, S, E, nullptr); } }
                          else { pg8::Gemm g{(const bf16*)(ws + WS_BIG), (const bf16*)(ws + WS_FD), FFN, 0}; pg8::StaticOrder S; S.init(NTOK, DM, G, cblk, WGM_N1024);
                          if (F8Q(i)) { typedef pg8::EpiResB<false, 1, (long)WS_XG - (long)WS_XN> EpiT; EpiT E{(bf16*)(ws + WS_XN), nullptr, (float*)(ws + WS_SSP), (LAS float*)(F.lds + TAB_OFF), 1};
                              pg8::gemm_phase<EpiT, pg8::StaticOrder, true, true>(F.lds, g, S, E); }
                          else { pg8::EpiResB<true> E{(bf16*)(ws + WS_XN), nullptr, (float*)(ws + WS_SSP), (LAS float*)(F.lds + TAB_OFF), 1};
                          pg8::gemm_phase<pg8::EpiResB<true>, pg8::StaticOrder, true, true>(F.lds, g, S, E); } } }
        if (IN(pb + 6) && PHEN(8)) { PH_BEGIN(); for (int rep_ = 0; rep_ < DUP(8); ++rep_) { conv_odd_phase(F, ap->o_wqkv + (size_t)i * DM * QKVD, ap->o_wo + (size_t)i * DM * DM, ap->o_ewg + (size_t)i * NEXP * DM * EXPD, ap->o_ewu + (size_t)i * NEXP * DM * EXPD, ap->o_ewd + (size_t)i * NEXP * EXPD * DM, ap->o_n1 + i * DM, ws, (F8M(i) ? 1 : 0) | (F8Q(i) ? 2 : 0) | (F8O(i) ? 4 : 0)); } } SEAM(pb + 6);
        if (IN(pb + 7) && PHEN(9)) { PH_BEGIN(); for (int rep_ = 0; rep_ < DUP(9); ++rep_) { if (F8Q(i)) { pg8::Gemm g{(const bf16*)(ws + WS_XG), (const bf16*)(ws + WS_WQKV), DM / 2, 0}; pg8::StaticOrder S; S.init(NTOK, QKVD, G, cblk, WGM_QKV, DM / 128);
                              pg8::EpiQKVT<64> E{(bf16*)(ws + WS_BIG), ap->o_bqkv + i * QKVD, (const float*)(ws + WS_CS), QSCALE, (const float*)(ws + WS_SSP), (LAS float*)(F.lds + TAB_OFF)};
                              pg8::gemm_phase2<pg8::EpiQKVT<64>, pg8::StaticOrder, false, false, true>(F.lds, g, S, E, nullptr); }
                          else { pg8::Gemm g{(const bf16*)(ws + WS_XN), (const bf16*)(ws + WS_WQKV), DM, 0}; pg8::StaticOrder S; S.init(NTOK, QKVD, G, cblk, WGM_QKV); pg8::EpiQKV E{(bf16*)(ws + WS_BIG), ap->o_bqkv + i * QKVD, (const float*)(ws + WS_CS), QSCALE, (const float*)(ws + WS_SSP), (LAS float*)(F.lds + TAB_OFF)};
                          pg8::gemm_phase<pg8::EpiQKV, pg8::StaticOrder, true, true>(F.lds, g, S, E); } } } SEAM(pb + 7);
        if (IN(pb + 8) && PHEN(10)) { PH_BEGIN(); for (int rep_ = 0; rep_ < DUP(10); ++rep_) { attn_mfma_phase(F, (const bf16*)(ws + WS_BIG), ap->o_sinks + i * 16, (bf16*)(ws + WS_BIG + WS_AOOFF), F8O(i) ? 1 : 0); } } SEAM(pb + 8);
        if (IN(pb + 9) && PHEN(11)) { PH_BEGIN();
                           if (F8O(i)) { pg8::Gemm g{(const bf16*)(ws + WS_BIG + WS_AOOFF), (const bf16*)(ws + WS_WO), DM / 2, 0}; pg8::StaticOrder S; S.init(NTOK, DM, G, cblk, WGM_N1024, DM / 128);
                               typedef pg8::EpiResB<false, 64 * 8> EpiT; EpiT E{(bf16*)(ws + WS_XN), ap->o_bo + i * DM, nullptr, nullptr, 0};
                               pg8::gemm_phase2<EpiT, pg8::StaticOrder, false, false, true>(F.lds, g, S, E, nullptr); }
                           else { pg8::Gemm g{(const bf16*)(ws + WS_BIG + WS_AOOFF), (const bf16*)(ws + WS_WO), DM, 0}; pg8::StaticOrder S; S.init(NTOK, DM, G, cblk, WGM_N1024); pg8::EpiResB<false> E{(bf16*)(ws + WS_XN), ap->o_bo + i * DM, nullptr, nullptr, 0};
                           pg8::gemm_phase<pg8::EpiResB<false>, pg8::StaticOrder, true, true>(F.lds, g, S, E); } } SEAM(pb + 9);
        if (IN(pb + 10) && PHEN(12)) { PH_BEGIN(); rms_router_phase(F, (const bf16*)(ws + WS_XN), ap->o_n2 + i * DM, ap->o_rw + (size_t)i * DM * NEXP, (bf16*)(ws + WS_XG), (unsigned*)(ws + WS_CTL) + CW_CNT + 64 * i, (unsigned*)(ws + WS_TOKINFO), (int*)(ws + WS_ROWTOK), F8M(i) ? 1 : 0); } SEAM(pb + 10);
        if (IN(pb + 11) && PHEN(13)) { PH_BEGIN(); slots_phase(F, (const unsigned*)(ws + WS_CTL) + CW_CNT + 64 * i, (const unsigned*)(ws + WS_TOKINFO), (int*)(ws + WS_ROWTOK), (float*)(ws + WS_ROWGATE)); } SEAM(pb + 11);
#pragma unroll 1
        for (int s = 0; s < 2; ++s) {
            const int ps = pb + 12 + 2 * s;
            if (IN(ps + 0) && PHEN(14)) { PH_BEGIN(); for (int rep_ = 0; rep_ < DUP(14); ++rep_) {
                LAS unsigned short* tab = (LAS unsigned short*)(F.lds + TAB_OFF); LAS unsigned* ut = (LAS unsigned*)(F.lds + LDSCTL_OFF); int nun;
                { int pend[8]; moe_prefix((const unsigned*)(ws + WS_CTL) + CW_CNT + 64 * i + 8 * s, pend);
                  pg8::MoeOrder S; S.nM = pend[7]; S.nN = 2 * EXPD / 256; S.nwg = S.nM * S.nN; S.G = G; S.c = cblk; S.NT = F8M(i) ? DM / 128 : DM / 64; S.wgm = WGM_MOEGU; S.splitk = false; S.p0 = pend[0]; S.p1 = pend[1]; S.p2 = pend[2]; S.p3 = pend[3]; S.p4 = pend[4]; S.p5 = pend[5]; S.p6 = pend[6];
                  nun = 0; pg8::Unit u = {0, 0, 0, 0, 0, 0}; const int* rt = (const int*)(ws + WS_ROWTOK) + (size_t)s * SETROWS;
                  for (int r = 0; r < TAB_ROUNDS && S.next(r, u); ++r) { if (F.tid == 0) pg8::TabOrder::put(ut, r, u);
                      if (F.tid < 256) { const int tk = rt[(size_t)u.pm * 256 + F.tid]; tab[r * 256 + F.tid] = (unsigned short)(tk < 0 ? 0 : tk); } ++nun; } }
                __syncthreads();
                pg8::TabOrder T{ut, nun, 0};
                if (F8M(i)) {
                    pg8::Gemm g{(const bf16*)(ws + WS_XG), (const bf16*)(ws + WS_MGU), DM / 2, (size_t)2 * EXPD * DM}; pg8::EpiSwiGLU E{(bf16*)(ws + WS_BIG + (size_t)s * H1SET8), EXPD, nullptr, 1.0f / 64.0f, F8_H1SCALE};
                    pg8::gemm_phase2<pg8::EpiSwiGLU, pg8::TabOrder, true, false, true>(F.lds, g, T, E, tab, STAG_MOEGU); }
                else { pg8::Gemm g{(const bf16*)(ws + WS_XG), (const bf16*)(ws + WS_MGU), DM, (size_t)2 * EXPD * DM * 2}; pg8::EpiSwiGLU E{(bf16*)(ws + WS_BIG), EXPD, nullptr, 1.0f, 0.0f};
                    pg8::gemm_phase2<pg8::EpiSwiGLU, pg8::TabOrder, true>(F.lds, g, T, E, tab, STAG_MOEGU); }
                __syncthreads(); } } SEAM(ps + 0);
            if (IN(ps + 1) && PHEN(15)) { PH_BEGIN();
                LAS unsigned* ut = (LAS unsigned*)(F.lds + LDSCTL_OFF); int nun, nq;
                { int pend[8]; moe_prefix((const unsigned*)(ws + WS_CTL) + CW_CNT + 64 * i + 8 * s, pend);
                  pg8::MoeOrder S; S.nM = pend[7]; S.nN = DM / 256; S.nwg = S.nM * S.nN; S.G = G; S.c = cblk; S.NT = F8M(i) ? EXPD / 128 : EXPD / 64; S.wgm = WGM_N1024; S.splitk = !(s == 1 && i == 0);     S.p0 = pend[0]; S.p1 = pend[1]; S.p2 = pend[2]; S.p3 = pend[3]; S.p4 = pend[4]; S.p5 = pend[5]; S.p6 = pend[6];
                  nun = 0; nq = 0; pg8::Unit u = {0, 0, 0, 0, 0, 0}; for (int r = 0; r < 32 && S.next(r, u); ++r) { if (u.split) { if (F.tid == 0) pg8::TabOrder::put(ut + 64, nq, u); ++nq; } else { if (F.tid == 0) pg8::TabOrder::put(ut, nun, u); ++nun; } } }
                __syncthreads();
                const int normf = (s == 1 && i == 0) ? 1 : 0;
                LAS int* ltab = (LAS int*)(F.lds + TAB_OFF + (normf ? 4096 : 0));
                { const int* rt = (const int*)(ws + WS_ROWTOK) + (size_t)s * SETROWS; const int* rg = (const int*)(ws + WS_ROWGATE) + (size_t)s * SETROWS;
                  if (F.tid < 256) { for (int r = 0; r < nun + nq; ++r) { const int pm = (int)((r < nun ? ut[2 * r] : ut[64 + 2 * (r - nun)]) & 0xffffu);
                      ltab[r * 512 + F.tid] = rt[(size_t)pm * 256 + F.tid]; ltab[r * 512 + 256 + F.tid] = rg[(size_t)pm * 256 + F.tid]; } } }
                __syncthreads();
                pg8::TabOrder T{ut, nun, 0}, TQ{ut + 64, nq, nun};
                if (F8M(i)) {
                    pg8::Gemm g{(const bf16*)(ws + WS_BIG + (size_t)s * H1SET8), (const bf16*)(ws + WS_MD), EXPD / 2, (size_t)DM * EXPD};
                    pg8::EpiMoeDown E{ltab, (bf16*)(ws + WS_XN), (float*)(ws + WS_SSP), (LAS float*)(F.lds + TAB_OFF), normf, 1.0f / (64.0f * F8_H1SCALE)};
                    pg8::gemm_phase2<pg8::EpiMoeDown, pg8::TabOrder, false, false, true>(F.lds, g, T, E, nullptr); __syncthreads();
                    if (nq > 0) { pg8::gemm_phase2<pg8::EpiMoeDown, pg8::TabOrder, false, true, true>(F.lds, g, TQ, E, nullptr); __syncthreads(); } }
                else {
                pg8::Gemm g{(const bf16*)(ws + WS_BIG), (const bf16*)(ws + WS_MD), EXPD, (size_t)DM * EXPD * 2};
                pg8::EpiMoeDown E{ltab, (bf16*)(ws + WS_XN), (float*)(ws + WS_SSP), (LAS float*)(F.lds + TAB_OFF), normf, 1.0f};
                pg8::gemm_phase2<pg8::EpiMoeDown, pg8::TabOrder, false>(F.lds, g, T, E, nullptr); __syncthreads();
                if (nq > 0) { pg8::gemm_phase2<pg8::EpiMoeDown, pg8::TabOrder, false, true>(F.lds, g, TQ, E, nullptr); __syncthreads(); } } } if (!(s == 1 && i == 0) && !(s == 0 && F8M(i))) SEAM(ps + 1);
        }
    }
    if (IN(N_PHASES - 1) && PHEN(17)) { PH_BEGIN(); rms_final_phase(F, (const bf16*)(ws + WS_XN), ap->fng, ap->out); }
#undef IN
#undef SEAM
}

extern "C" void kernel_launch(void* const* d_in, const int* in_sizes, int n_in, void* d_out, int out_size, void* d_ws, size_t ws_size, hipStream_t stream) {
    static int grid = 0;
    if (grid == 0) {
        if (n_in != 26 || in_sizes[0] != NTOK * DM || out_size != NTOK * DM || ws_size < WS_END) { fprintf(stderr, "kernel_launch: unexpected shapes: n_in %d in0 %d out %d ws %zu (need %zu)\n", n_in, n_in > 0 ? in_sizes[0] : -1, out_size, ws_size, (size_t)WS_END); grid = -1; return; }
        int dev = 0, cus = 0, per_cu = 0;
        if (hipGetDevice(&dev) != hipSuccess || hipDeviceGetAttribute(&cus, hipDeviceAttributeMultiprocessorCount, dev) != hipSuccess) { grid = -1; return; }
        if (hipFuncSetAttribute((const void*)fwd, hipFuncAttributeMaxDynamicSharedMemorySize, LDS_BYTES) != hipSuccess) { fprintf(stderr, "kernel_launch: hipFuncSetAttribute failed\n"); grid = -1; return; }
        if (hipOccupancyMaxActiveBlocksPerMultiprocessor(&per_cu, (const void*)fwd, NWAVES * 64, LDS_BYTES) != hipSuccess || per_cu < 1) fprintf(stderr, "kernel_launch: occupancy query reports %d\n", per_cu);
        (void)hipGetLastError();
        grid = cus;
    }
    if (grid < 0) return;
    (void)hipMemsetAsync((char*)d_ws + WS_CTL, 0, CTL_ZERO_BYTES, stream);
    Args a{};
    a.x = (const float*)d_in[0]; a.pos = (const int*)d_in[1]; a.fng = (const float*)d_in[2];
    a.e_n1 = (const float*)d_in[3]; a.e_win = (const float*)d_in[4]; a.e_conv = (const float*)d_in[5]; a.e_lng = (const float*)d_in[6]; a.e_lnb = (const float*)d_in[7];
    a.e_sw = (const float*)d_in[8]; a.e_sb = (const float*)d_in[9]; a.e_wout = (const float*)d_in[10]; a.e_n2 = (const float*)d_in[11];
    a.e_wg = (const float*)d_in[12]; a.e_wu = (const float*)d_in[13]; a.e_wd = (const float*)d_in[14];
    a.o_n1 = (const float*)d_in[15]; a.o_wqkv = (const float*)d_in[16]; a.o_bqkv = (const float*)d_in[17]; a.o_sinks = (const float*)d_in[18]; a.o_wo = (const float*)d_in[19]; a.o_bo = (const float*)d_in[20];
    a.o_n2 = (const float*)d_in[21]; a.o_rw = (const float*)d_in[22]; a.o_ewg = (const float*)d_in[23]; a.o_ewu = (const float*)d_in[24]; a.o_ewd = (const float*)d_in[25];
    a.out = (float*)d_out; a.ws = (unsigned char*)d_ws;
#if MK_ONE_LAUNCH
    a.lo = 0; a.hi = N_PHASES; a.li = 0;
    hipLaunchKernelGGL(fwd, dim3(grid), dim3(NWAVES * 64), LDS_BYTES, stream, a);
#else
    for (int p = 0; p < N_PHASES; ++p) { a.lo = p; a.hi = p + 1; a.li = p; hipLaunchKernelGGL(fwd, dim3(grid), dim3(NWAVES * 64), LDS_BYTES, stream, a); }
#endif
}
```
